# Optimizing an MI355X kernel written in HIP

```python
import math
import jax
import jax.numpy as jnp
from jax import lax
import numpy as np

D_MODEL = 1024
BATCH = 2
SEQ = 16384
DEPTH = 2

GRID_W = 64
CTX_LEN = 256
EPS = 1e-6
NEG_INF = -1e30

RW_HEADS = 6
RW_HD = 64
RW_W = RW_HEADS * RW_HD
RW_LORA = 32
RW_DECAY_SCALE = math.exp(-0.5)
RW_GN_EPS = 64e-5

S5_GROUP = 16
S5_GROUPS = 16
S5_W = S5_GROUP * S5_GROUPS
S5_STATE = 64

ML_HEADS = 4
ML_HD = 96
ML_W = ML_HEADS * ML_HD
ML_CONV = 3
ML_QKV_BLOCK = 4
ML_CHUNK = 64

MIX_W = RW_W + S5_W + ML_W
RW_SHIFT_W = 3 * RW_W + 4 * RW_LORA
RW_IN = RW_SHIFT_W + RW_W
S5_OFF = RW_IN
ML_OFF = S5_OFF + 2 * S5_W
IN_W = ML_OFF + 2 * ML_W

kernel_name = 'hybrid_rwkv7_s5_mlstm_prefix_dit'


def rms_norm(x, g):
    xf = x.astype(jnp.float32)
    return xf * lax.rsqrt(jnp.mean(xf * xf, axis=-1, keepdims=True) + EPS) * g.astype(jnp.float32)


def head_norm(y, eps):
    mu = jnp.mean(y, axis=-1, keepdims=True)
    var = jnp.mean(jnp.square(y - mu), axis=-1, keepdims=True)
    return (y - mu) * lax.rsqrt(var + eps)


def bidir(x):
    return jnp.stack([x, jnp.flip(x, 1)], 0)


def flip_dir1(x):
    return jnp.stack([x[0], jnp.flip(x[1], 1)], 0)


def merge_dirs(y):
    return y[0] + jnp.flip(y[1], 1)


def qshift_grid(p):
    B, T, C = p.shape
    rows = T // GRID_W
    g = p.reshape(B, rows, GRID_W, C // 4, 4)
    left = jnp.pad(g[:, :, :-1, :, 0], ((0, 0), (0, 0), (1, 0), (0, 0)))
    right = jnp.pad(g[:, :, 1:, :, 1], ((0, 0), (0, 0), (0, 1), (0, 0)))
    up = jnp.pad(g[:, :-1, :, :, 2], ((0, 0), (1, 0), (0, 0), (0, 0)))
    down = jnp.pad(g[:, 1:, :, :, 3], ((0, 0), (0, 1), (0, 0), (0, 0)))
    return jnp.stack([left, right, up, down], axis=-1).reshape(B, T, C)


def bishift_seq(p):
    B, T, C = p.shape
    g = p.reshape(B, T, C // 2, 2)
    prev = jnp.pad(g[:, :-1, :, 0], ((0, 0), (1, 0), (0, 0)))
    nxt = jnp.pad(g[:, 1:, :, 1], ((0, 0), (0, 1), (0, 0)))
    return jnp.stack([prev, nxt], axis=-1).reshape(B, T, C)


def centred_dwconv(x, w, b):
    K, C = w.shape
    y = lax.conv_general_dilated(x, w.astype(x.dtype)[:, None, :], window_strides=(1,),
                                 padding=[(K // 2, K // 2)], dimension_numbers=('NWC', 'WIO', 'NWC'),
                                 feature_group_count=C)
    return y + b


def rwkv7_step(S, inp):
    r, w, k, v, kk, b = inp
    sa = jnp.einsum('zbhvk,zbhk->zbhv', S, kk)
    S = S * w[..., None, :] - sa[..., :, None] * b[..., None, :] + v[..., :, None] * k[..., None, :]
    return S, jnp.einsum('zbhvk,zbhk->zbhv', S, r)


def rwkv7_branch(p, shift_fn, S0, want_out, mu, w0, w_up, a0, a_up, k_k, k_a, r_k, ln_g, ln_b):
    B, T, _ = p.shape
    s = p[..., :RW_SHIFT_W].astype(jnp.float32)
    s = s + (shift_fn(s) - s) * mu
    r = s[..., 0:RW_W]
    k = s[..., RW_W:2 * RW_W]
    v = s[..., 2 * RW_W:3 * RW_W]
    wd = s[..., 3 * RW_W:3 * RW_W + 2 * RW_LORA].reshape(B, T, 2, RW_LORA)
    ad = s[..., 3 * RW_W + 2 * RW_LORA:RW_SHIFT_W].reshape(B, T, 2, RW_LORA)
    w_pre = w0[:, None, None, :] + jnp.einsum('btzr,zrc->zbtc', jnp.tanh(wd), w_up)
    log_w = -RW_DECAY_SCALE * jax.nn.sigmoid(w_pre)
    a = jax.nn.sigmoid(a0[:, None, None, :] + jnp.einsum('btzr,zrc->zbtc', ad, a_up))

    def heads(t):
        return t.reshape(t.shape[:-1] + (RW_HEADS, RW_HD))

    kk = heads(k * k_k)
    kk = kk * lax.rsqrt(jnp.sum(kk * kk, axis=-1, keepdims=True) + EPS)
    k_dir = heads(k[None] * (1.0 + (a - 1.0) * k_a))
    r_h = heads(r)
    v_h = heads(v)
    kk_d = bidir(kk)
    seq = (bidir(r_h), flip_dir1(jnp.exp(heads(log_w))), flip_dir1(k_dir), bidir(v_h),
           kk_d, flip_dir1(heads(a)) * kk_d)
    seq = tuple(jnp.moveaxis(t, 2, 0) for t in seq)
    S_fin, y = lax.scan(rwkv7_step, S0, seq)
    if not want_out:
        return None, S_fin
    y = merge_dirs(jnp.moveaxis(y, 0, 2))
    y = head_norm(y, RW_GN_EPS).reshape(B, T, RW_W) * ln_g + ln_b
    bonus = jnp.sum(r_h * (k_dir[0] + k_dir[1]) * r_k, axis=-1, keepdims=True) * v_h
    y = y + bonus.reshape(B, T, RW_W)
    gate = p[..., RW_SHIFT_W:RW_IN]
    return y * jax.nn.silu(gate), S_fin


def complex_affine_combine(e1, e2):
    a1r, a1i, b1r, b1i = e1
    a2r, a2i, b2r, b2i = e2
    ar = a2r * a1r - a2i * a1i
    ai = a2r * a1i + a2i * a1r
    br = a2r * b1r - a2i * b1i + b2r
    bi = a2r * b1i + a2i * b1r + b2i
    return ar, ai, br, bi


def s5_branch(p, h0, want_out, a_re, a_im, log_dt, b_re, b_im, c_re, c_im, d_skip, glu_w, glu_b):
    f32 = jnp.float32
    B, T, _ = p.shape
    a_re, a_im, log_dt = a_re.astype(f32), a_im.astype(f32), log_dt.astype(f32)
    b_re, b_im, c_re, c_im = b_re.astype(f32), b_im.astype(f32), c_re.astype(f32), c_im.astype(f32)
    u = p[..., S5_OFF:S5_OFF + S5_W].astype(f32)
    dt = jnp.exp(log_dt)
    mag = jnp.exp(a_re * dt)
    abar_re = mag * jnp.cos(a_im * dt)
    abar_im = mag * jnp.sin(a_im * dt)
    den = a_re * a_re + a_im * a_im
    q_re = ((abar_re - 1.0) * a_re + abar_im * a_im) / den
    q_im = (abar_im * a_re - (abar_re - 1.0) * a_im) / den
    bb_re = q_re[..., None] * b_re - q_im[..., None] * b_im
    bb_im = q_re[..., None] * b_im + q_im[..., None] * b_re
    u_dir = bidir(u.reshape(B, T, S5_GROUPS, S5_GROUP))
    bu_re = jnp.einsum('zgnp,zbtgp->zbtgn', bb_re, u_dir)
    bu_im = jnp.einsum('zgnp,zbtgp->zbtgn', bb_im, u_dir)
    el_ar = jnp.broadcast_to(abar_re[:, None, None], bu_re.shape)
    el_ai = jnp.broadcast_to(abar_im[:, None, None], bu_re.shape)
    acr, aci, h_re, h_im = lax.associative_scan(complex_affine_combine, (el_ar, el_ai, bu_re, bu_im), axis=2)
    if h0 is not None:
        h0_re, h0_im = h0[0][:, :, None], h0[1][:, :, None]
        h_re = h_re + acr * h0_re - aci * h0_im
        h_im = h_im + acr * h0_im + aci * h0_re
    h_fin = (h_re[:, :, -1], h_im[:, :, -1])
    if not want_out:
        return None, h_fin
    y = jnp.einsum('zgpn,zbtgn->zbtgp', c_re, h_re) - jnp.einsum('zgpn,zbtgn->zbtgp', c_im, h_im)
    y = merge_dirs(y).reshape(B, T, S5_W) + d_skip * u
    y = jax.nn.gelu(y)
    y = y * jax.nn.sigmoid(y @ glu_w + glu_b)
    gate = p[..., S5_OFF + S5_W:ML_OFF]
    return y * jax.nn.silu(gate), h_fin


def mlstm_chunkwise(q, k, v, logi, logf, state0):
    Z, B, T, H, d = q.shape
    nc = T // ML_CHUNK

    def chunks(t):
        t = t.reshape((Z, B, nc, ML_CHUNK) + t.shape[3:])
        return jnp.moveaxis(t, 2, 0)

    order_mask = jnp.tril(jnp.ones((ML_CHUNK, ML_CHUNK), dtype=bool))

    def step(carry, inp):
        C, n, m = carry
        qc, kc, vc, li, lf = inp
        bcum = jnp.cumsum(lf, axis=2)
        dmat = bcum[:, :, :, None, :] - bcum[:, :, None, :, :] + li[:, :, None, :, :]
        dmat = jnp.where(order_mask[:, :, None], dmat, NEG_INF)
        inter = bcum + m[:, :, None, :]
        m_t = jnp.maximum(inter, jnp.max(dmat, axis=3))
        wts = jnp.exp(dmat - m_t[:, :, :, None, :]) * jnp.einsum('zbthd,zbshd->zbtsh', qc, kc)
        cw_t = jnp.exp(inter - m_t)
        num = jnp.einsum('zbtsh,zbshd->zbthd', wts, vc) + cw_t[..., None] * jnp.einsum('zbhvk,zbthk->zbthv', C, qc)
        den = jnp.sum(wts, axis=3) + cw_t * jnp.einsum('zbhk,zbthk->zbth', n, qc)
        h = num / jnp.maximum(jnp.abs(den), jnp.exp(-m_t))[..., None]
        b_end = bcum[:, :, -1, :]
        dec = b_end[:, :, None, :] - bcum + li
        m_new = jnp.maximum(b_end + m, jnp.max(dec, axis=2))
        ws = jnp.exp(dec - m_new[:, :, None, :])
        cw = jnp.exp(b_end + m - m_new)
        C_new = cw[..., None, None] * C + jnp.einsum('zbsh,zbshv,zbshk->zbhvk', ws, vc, kc)
        n_new = cw[..., None] * n + jnp.einsum('zbsh,zbshk->zbhk', ws, kc)
        return (C_new, n_new, m_new), h

    state, h = lax.scan(step, state0, (chunks(q), chunks(k), chunks(v), chunks(logi), chunks(logf)))
    h = jnp.moveaxis(h, 0, 2).reshape(Z, B, T, H, d)
    return state, h


def mlstm_branch(p, state0, want_out, conv_w, conv_b, wq, wk, wv, wi, bi, wf, bf, norm_g, skip):
    B, T, _ = p.shape
    xm = p[..., ML_OFF:ML_OFF + ML_W].astype(jnp.float32)
    xc = jax.nn.silu(centred_dwconv(xm, conv_w, conv_b))

    def blockdiag(t, w):
        t = t.reshape(B, T, ML_W // ML_QKV_BLOCK, ML_QKV_BLOCK)
        return jnp.einsum('btnj,nji->btni', t, w).reshape(B, T, ML_W)

    q = blockdiag(xc, wq)
    k = blockdiag(xc, wk)
    v = blockdiag(xm, wv)
    gin = jnp.concatenate([q, k, v], axis=-1)
    logi = jnp.einsum('btc,zch->zbth', gin, wi) + bi[:, None, None, :]
    logf = jax.nn.log_sigmoid(jnp.einsum('btc,zch->zbth', gin, wf) + bf[:, None, None, :])

    def heads(t):
        return t.reshape(B, T, ML_HEADS, ML_HD)

    state, h = mlstm_chunkwise(bidir(heads(q)), bidir(heads(k) * (ML_HD ** -0.5)), bidir(heads(v)),
                               flip_dir1(logi), flip_dir1(logf), state0)
    if not want_out:
        return None, state
    h = head_norm(merge_dirs(h), EPS).reshape(B, T, ML_W) * norm_g
    h = h + skip * xc
    z = p[..., ML_OFF + ML_W:IN_W]
    return h * jax.nn.silu(z), state


def setup_inputs(seed: int = 0) -> dict:
    key = jax.random.key(seed)
    ks = iter(jax.random.split(key, 48))
    f32 = jnp.float32
    L, D = DEPTH, D_MODEL
    G, N, P = S5_GROUPS, S5_STATE, S5_GROUP

    def nrm(shape, scale):
        return jax.random.normal(next(ks), shape, f32) * scale

    def uni(shape, lo, hi):
        return jax.random.uniform(next(ks), shape, f32, lo, hi)

    return {
        'x': nrm((BATCH, SEQ, D), 1.0),
        'c': nrm((BATCH, D), 1.0),
        'ctx': nrm((BATCH, CTX_LEN, D), 1.0),
        'c_ctx': nrm((D,), 1.0),
        'ada_w': nrm((L, D, 3 * D), 0.5 * D ** -0.5),
        'ada_b': nrm((L, 3 * D), 0.02),
        'norm_g': 1.0 + nrm((L, D), 0.02),
        'w_in': nrm((L, D, IN_W), D ** -0.5),
        'w_out': nrm((L, MIX_W, D), MIX_W ** -0.5),
        'rw_mu': uni((L, RW_SHIFT_W), 0.0, 1.0),
        'rw_w0': uni((L, 2, RW_W), -4.0, 0.0),
        'rw_w_up': nrm((L, 2, RW_LORA, RW_W), 0.1 * RW_LORA ** -0.5),
        'rw_a0': nrm((L, 2, RW_W), 0.1),
        'rw_a_up': nrm((L, 2, RW_LORA, RW_W), 0.1 * RW_LORA ** -0.5),
        'rw_k_k': 0.85 + nrm((L, RW_W), 0.05),
        'rw_k_a': 1.0 + nrm((L, RW_W), 0.05),
        'rw_r_k': nrm((L, RW_HEADS, RW_HD), 0.1),
        'rw_ln_g': 1.0 + nrm((L, RW_W), 0.02),
        'rw_ln_b': nrm((L, RW_W), 0.02),
        's5_a_re': -0.5 + nrm((L, 2, G, N), 0.01),
        's5_a_im': jnp.pi * jnp.arange(N, dtype=f32) + nrm((L, 2, G, N), 0.01),
        's5_log_dt': uni((L, 2, G, N), math.log(1e-3), math.log(1e-1)),
        's5_b_re': nrm((L, 2, G, N, P), (2 * P) ** -0.5),
        's5_b_im': nrm((L, 2, G, N, P), (2 * P) ** -0.5),
        's5_c_re': nrm((L, 2, G, P, N), 2.0 ** -0.5),
        's5_c_im': nrm((L, 2, G, P, N), 2.0 ** -0.5),
        's5_d': nrm((L, S5_W), 1.0),
        's5_glu_w': nrm((L, S5_W, S5_W), S5_W ** -0.5),
        's5_glu_b': nrm((L, S5_W), 0.02),
        'ml_conv_w': nrm((L, ML_CONV, ML_W), ML_CONV ** -0.5),
        'ml_conv_b': nrm((L, ML_W), 0.02),
        'ml_wq': nrm((L, ML_W // ML_QKV_BLOCK, ML_QKV_BLOCK, ML_QKV_BLOCK), ML_QKV_BLOCK ** -0.5),
        'ml_wk': nrm((L, ML_W // ML_QKV_BLOCK, ML_QKV_BLOCK, ML_QKV_BLOCK), ML_QKV_BLOCK ** -0.5),
        'ml_wv': nrm((L, ML_W // ML_QKV_BLOCK, ML_QKV_BLOCK, ML_QKV_BLOCK), ML_QKV_BLOCK ** -0.5),
        'ml_wi': nrm((L, 2, 3 * ML_W, ML_HEADS), 0.1 * (3 * ML_W) ** -0.5),
        'ml_bi': nrm((L, 2, ML_HEADS), 0.1),
        'ml_wf': nrm((L, 2, 3 * ML_W, ML_HEADS), 0.1 * (3 * ML_W) ** -0.5),
        'ml_bf': jnp.linspace(3.0, 6.0, ML_HEADS, dtype=f32) + nrm((L, 2, ML_HEADS), 0.1),
        'ml_norm_g': 1.0 + nrm((L, ML_W), 0.02),
        'ml_skip': 1.0 + nrm((L, ML_W), 0.02),
        'final_g': 1.0 + nrm((D,), 0.02),
    }


def reference(x, c, ctx, c_ctx, ada_w, ada_b, norm_g, w_in, w_out,
              rw_mu, rw_w0, rw_w_up, rw_a0, rw_a_up, rw_k_k, rw_k_a, rw_r_k, rw_ln_g, rw_ln_b,
              s5_a_re, s5_a_im, s5_log_dt, s5_b_re, s5_b_im, s5_c_re, s5_c_im, s5_d, s5_glu_w, s5_glu_b,
              ml_conv_w, ml_conv_b, ml_wq, ml_wk, ml_wv, ml_wi, ml_bi, ml_wf, ml_bf, ml_norm_g, ml_skip,
              final_g):
    f32 = jnp.float32
    B = x.shape[0]
    for l in range(DEPTH):
        last = l == DEPTH - 1
        mod_x = jax.nn.silu(c.astype(f32)) @ ada_w[l] + ada_b[l]
        mod_c = jax.nn.silu(c_ctx.astype(f32)) @ ada_w[l] + ada_b[l]
        shx, scx, gx = jnp.split(mod_x, 3, axis=-1)
        shc, scc, gc = jnp.split(mod_c, 3, axis=-1)
        hx = rms_norm(x, norm_g[l]) * (1.0 + scx[:, None]) + shx[:, None]
        hc = rms_norm(ctx, norm_g[l]) * (1.0 + scc) + shc
        px = hx @ w_in[l]
        pc = hc @ w_in[l]

        rw_p = (rw_mu[l], rw_w0[l], rw_w_up[l], rw_a0[l], rw_a_up[l], rw_k_k[l], rw_k_a[l], rw_r_k[l],
                rw_ln_g[l], rw_ln_b[l])
        s5_p = (s5_a_re[l], s5_a_im[l], s5_log_dt[l], s5_b_re[l], s5_b_im[l], s5_c_re[l], s5_c_im[l],
                s5_d[l], s5_glu_w[l], s5_glu_b[l])
        ml_p = (ml_conv_w[l], ml_conv_b[l], ml_wq[l], ml_wk[l], ml_wv[l], ml_wi[l], ml_bi[l], ml_wf[l],
                ml_bf[l], ml_norm_g[l], ml_skip[l])

        rw_S0 = jnp.zeros((2, B, RW_HEADS, RW_HD, RW_HD), f32)
        ml_S0 = (jnp.zeros((2, B, ML_HEADS, ML_HD, ML_HD), f32), jnp.zeros((2, B, ML_HEADS, ML_HD), f32),
                 jnp.zeros((2, B, ML_HEADS), f32))
        rw_c, rw_S = rwkv7_branch(pc, bishift_seq, rw_S0, not last, *rw_p)
        s5_c, s5_h = s5_branch(pc, None, not last, *s5_p)
        ml_c, ml_S = mlstm_branch(pc, ml_S0, not last, *ml_p)

        rw_x, _ = rwkv7_branch(px, qshift_grid, rw_S, True, *rw_p)
        s5_x, _ = s5_branch(px, s5_h, True, *s5_p)
        ml_x, _ = mlstm_branch(px, ml_S, True, *ml_p)

        out_x = jnp.concatenate([rw_x, s5_x, ml_x], axis=-1) @ w_out[l]
        x = (x + gx[:, None] * out_x).astype(x.dtype)
        if not last:
            out_c = jnp.concatenate([rw_c, s5_c, ml_c], axis=-1) @ w_out[l]
            ctx = (ctx + gc * out_c).astype(ctx.dtype)
    return rms_norm(x, final_g).astype(x.dtype)
```

```cpp
#ifndef CPU_EMU
#include <hip/hip_runtime.h>
#endif
#include <cstdint>
#include <cmath>
#include <cstdio>

#ifndef SEQ
#define SEQ 16384
#endif
#ifndef CTX
#define CTX 256
#endif

typedef _Float16 f16;

constexpr int D = 1024, NB = 2, INW = 2944;
constexpr int NCTX = NB * CTX, NLAT = NB * SEQ, NROWS = NCTX + NLAT;
constexpr int TSCAN = CTX + SEQ, NCHUNK = TSCAN / 64;
constexpr int NT = 256;

#ifdef CPU_EMU
#define DEV static inline
#define PAR(tid) for (int tid = 0; tid < NT; ++tid)
#define SYNC()
#define PRIV(type, name, n) static type name##_all[NT][n]
#define PRIV_USE(type, name) type* name = name##_all[tid]
#else
#define DEV __device__ __forceinline__
#define PAR(tid) for (int tid = threadIdx.x, once_ = 1; once_; once_ = 0)
#define SYNC() __syncthreads()
#define PRIV(type, name, n) type name[n]
#define PRIV_USE(type, name)
#endif

struct Params {
    const float *x, *c, *ctx, *c_ctx, *ada_w, *ada_b, *norm_g, *w_in, *w_out;
    const float *rw_mu, *rw_w0, *rw_w_up, *rw_a0, *rw_a_up, *rw_k_k, *rw_k_a, *rw_r_k, *rw_ln_g, *rw_ln_b;
    const float *s5_a_re, *s5_a_im, *s5_log_dt, *s5_b_re, *s5_b_im, *s5_c_re, *s5_c_im, *s5_d, *s5_glu_w, *s5_glu_b;
    const float *ml_conv_w, *ml_conv_b, *ml_wq, *ml_wk, *ml_wv, *ml_wi, *ml_bi, *ml_wf, *ml_bf, *ml_norm_g, *ml_skip;
    const float* final_g;
    float* out;
    float* mods;
    float* rstd;
    f16* p;
    float* Y;
    float* qkv;
    float* gates;
    float* bon;
    float* ys5;
    float* ctx1;
};

DEV float sigmoidf_(float x) { return 1.f / (1.f + expf(-x)); }
DEV float siluf_(float x) { return x / (1.f + expf(-x)); }

DEV int scan_row(int z, int b, int s) {
    if (s < CTX) { int t = z ? CTX - 1 - s : s; return b * CTX + t; }
    int u = s - CTX; int t = z ? SEQ - 1 - u : u; return NCTX + b * SEQ + t;
}
DEV int row_mod(int R) { return R < NCTX ? 2 : (R - NCTX) / SEQ; }
DEV const float* xrow(const Params& P, int l, int R) {
    const float* xl = l == 0 ? P.x : P.out; const float* xc = l == 0 ? P.ctx : P.ctx1;
    return R < NCTX ? xc + (size_t)R * D : xl + (size_t)(R - NCTX) * D;
}
DEV int nbr_row(int R, int c) {
    if (R < NCTX) { int t = R % CTX; if ((c & 1) == 0) return t > 0 ? R - 1 : -1; return t < CTX - 1 ? R + 1 : -1; }
    int t = (R - NCTX) % SEQ; int m = c & 3, col = t & 63;
    if (m == 0) return col > 0 ? R - 1 : -1;
    if (m == 1) return col < 63 ? R + 1 : -1;
    if (m == 2) return t >= 64 ? R - 64 : -1;
    return t < SEQ - 64 ? R + 64 : -1;
}
DEV float shl(const Params& P, int l, int R, int c) {
    float pv = (float)P.p[(size_t)R * INW + c];
    int nb = nbr_row(R, c);
    float nv = nb >= 0 ? (float)P.p[(size_t)nb * INW + c] : 0.f;
    return pv + (nv - pv) * P.rw_mu[l * 1280 + c];
}

DEV void ph_mods(const Params& P, int bid, int nblk) {
    PAR(tid) {
        for (int idx = bid * NT + tid; idx < 2 * 3 * 3072; idx += nblk * NT) {
            int l = idx / 9216, rem = idx % 9216, j = rem / 3072, col = rem % 3072;
            const float* cin = j < 2 ? P.c + j * D : P.c_ctx;
            float acc = P.ada_b[l * 3072 + col];
            for (int k = 0; k < D; ++k) acc += siluf_(cin[k]) * P.ada_w[((size_t)l * D + k) * 3072 + col];
            P.mods[idx] = acc;
        }
    }
}
DEV void ph_rstd(const Params& P, int l, int bid, int nblk) {
    PAR(tid) {
        for (int R = bid * NT + tid; R < NROWS; R += nblk * NT) {
            const float* xr = xrow(P, l, R); float ss = 0.f;
            for (int k = 0; k < D; ++k) ss += xr[k] * xr[k];
            P.rstd[R] = 1.f / sqrtf(ss * (1.f / D) + 1e-6f);
        }
    }
}
DEV float gemm1_a(const Params& P, int l, int R, int k) {
    int j = row_mod(R); const float* m = P.mods + (l * 3 + j) * 3072;
    return xrow(P, l, R)[k] * P.rstd[R] * P.norm_g[l * D + k] * (1.f + m[D + k]) + m[k];
}
DEV int a2col(int k) { return k < 384 ? 1280 + k : (k < 640 ? 1920 + (k - 384) : 2560 + (k - 640)); }
DEV float gemm2_a(const Params& P, int R, int k) { return (float)P.p[(size_t)R * INW + a2col(k)]; }
DEV void gemm1_epi(const Params& P, int R, int n, float acc) { P.p[(size_t)R * INW + n] = (f16)acc; }
DEV void gemm2_epi(const Params& P, int l, int R, int n, float acc) {
    int j = row_mod(R); float g = P.mods[(l * 3 + j) * 3072 + 2 * D + n];
    float xo = xrow(P, l, R)[n];
    float* dst = R < NCTX ? P.ctx1 + (size_t)R * D + n : P.out + (size_t)(R - NCTX) * D + n;
    *dst = xo + g * acc;
}
template <int MODE>
DEV void ph_gemm(const Params& P, int l, int bid, int nblk, float* sm) {
    constexpr int N = MODE == 1 ? INW : D, K = D;
    const float* Bm = MODE == 1 ? P.w_in + (size_t)l * D * INW : P.w_out + (size_t)l * D * D;
    const int tm0 = (MODE == 2 && l == 1) ? NCTX / 128 : 0;
    const int ntm = NROWS / 128 - tm0, ntn = N / 128;
#ifdef CPU_EMU
    for (int t = bid; t < ntm * ntn; t += nblk) {
        int tm = tm0 + t / ntn, tn = t % ntn;
        static float arow[K];
        for (int r = 0; r < 128; ++r) {
            int R = tm * 128 + r;
            for (int k = 0; k < K; ++k) arow[k] = MODE == 1 ? gemm1_a(P, l, R, k) : gemm2_a(P, R, k);
            float acc[128];
            for (int n = 0; n < 128; ++n) acc[n] = 0.f;
            for (int k = 0; k < K; ++k) { float a = arow[k]; const float* br = Bm + (size_t)k * N + tn * 128; for (int n = 0; n < 128; ++n) acc[n] += a * br[n]; }
            for (int n = 0; n < 128; ++n) { if (MODE == 1) gemm1_epi(P, R, tn * 128 + n, acc[n]); else gemm2_epi(P, l, R, tn * 128 + n, acc[n]); }
        }
    }
#else
    float* As = sm;
    float* Bs = sm + 16 * 132;
    const int tid = threadIdx.x, ty = tid >> 4, tx = tid & 15;
    for (int t = bid; t < ntm * ntn; t += nblk) {
        const int tm = tm0 + t / ntn, tn = t % ntn;
        float acc[8][8];
#pragma unroll
        for (int i = 0; i < 8; ++i)
#pragma unroll
            for (int j = 0; j < 8; ++j) acc[i][j] = 0.f;
        const int ar = tid >> 1, ak = (tid & 1) * 8;
        const int bk = tid >> 4, bn = (tid & 15) * 8;
        for (int k0 = 0; k0 < K; k0 += 16) {
            float av[8], bv[8];
#pragma unroll
            for (int i = 0; i < 8; ++i) av[i] = MODE == 1 ? gemm1_a(P, l, tm * 128 + ar, k0 + ak + i) : gemm2_a(P, tm * 128 + ar, k0 + ak + i);
#pragma unroll
            for (int i = 0; i < 8; ++i) bv[i] = Bm[(size_t)(k0 + bk) * N + tn * 128 + bn + i];
            __syncthreads();
#pragma unroll
            for (int i = 0; i < 8; ++i) As[(ak + i) * 132 + ar] = av[i];
#pragma unroll
            for (int i = 0; i < 8; ++i) Bs[bk * 128 + bn + i] = bv[i];
            __syncthreads();
#pragma unroll
            for (int kk = 0; kk < 16; ++kk) {
                float a[8], b[8];
#pragma unroll
                for (int i = 0; i < 8; ++i) a[i] = As[kk * 132 + ty * 8 + i];
#pragma unroll
                for (int j = 0; j < 8; ++j) b[j] = Bs[kk * 128 + tx * 8 + j];
#pragma unroll
                for (int i = 0; i < 8; ++i)
#pragma unroll
                    for (int j = 0; j < 8; ++j) acc[i][j] += a[i] * b[j];
            }
        }
#pragma unroll
        for (int i = 0; i < 8; ++i)
#pragma unroll
            for (int j = 0; j < 8; ++j) {
                int R = tm * 128 + ty * 8 + i, n = tn * 128 + tx * 8 + j;
                if (MODE == 1) gemm1_epi(P, R, n, acc[i][j]); else gemm2_epi(P, l, R, n, acc[i][j]);
            }
    }
#endif
}

constexpr int RW_LDS = 8 * 4096 + 64;
DEV void ph_rwkv_scan(const Params& P, int l, int bid, int nblk, float* sm) {
    float *sw = sm, *sk = sw + 4096, *sb = sk + 4096, *skk = sb + 4096, *sr = skk + 4096, *sv = sr + 4096, *lora = sv + 4096, *sy = lora + 4096, *sinv = sy + 4096;
    PRIV(float, S, 64);
    for (int chain = bid; chain < 24; chain += nblk) {
        const int z = chain / 12, b = (chain / 6) % 2, h = chain % 6;
        PAR(tid) { PRIV_USE(float, S);
#pragma unroll
            for (int j = 0; j < 64; ++j) S[j] = 0.f; }
        for (int ck = 0; ck < NCHUNK; ++ck) {
            const int s0 = ck * 64;
            PAR(tid) {
                for (int idx = tid; idx < 4096; idx += NT) {
                    int t = idx >> 6, q = idx & 63; int R = scan_row(z, b, s0 + t);
                    int ch = q < 32 ? 1152 + z * 32 + q : 1216 + z * 32 + (q - 32);
                    float v = shl(P, l, R, ch);
                    lora[idx] = q < 32 ? tanhf(v) : v;
                }
            }
            SYNC();
            PAR(tid) {
                for (int idx = tid; idx < 4096; idx += NT) {
                    int t = idx >> 6, j = idx & 63, c = h * 64 + j; int R = scan_row(z, b, s0 + t);
                    float r_ = shl(P, l, R, c), k_ = shl(P, l, R, 384 + c), v_ = shl(P, l, R, 768 + c);
                    float wp = P.rw_w0[(l * 2 + z) * 384 + c], ap = P.rw_a0[(l * 2 + z) * 384 + c];
                    for (int rr = 0; rr < 32; ++rr) {
                        wp += lora[t * 64 + rr] * P.rw_w_up[((l * 2 + z) * 32 + rr) * 384 + c];
                        ap += lora[t * 64 + 32 + rr] * P.rw_a_up[((l * 2 + z) * 32 + rr) * 384 + c];
                    }
                    float w = expf(-0.6065306597126334f * sigmoidf_(wp)), a = sigmoidf_(ap);
                    sw[idx] = w; sk[idx] = k_ * (1.f + (a - 1.f) * P.rw_k_a[l * 384 + c]); sb[idx] = a;
                    skk[idx] = k_ * P.rw_k_k[l * 384 + c]; sr[idx] = r_; sv[idx] = v_;
                }
            }
            SYNC();
            PAR(tid) {
                if (tid < 64) {
                    int t = tid; float ss = 0.f, bn = 0.f;
                    for (int j = 0; j < 64; ++j) { float q = skk[t * 64 + j]; ss += q * q; bn += sr[t * 64 + j] * sk[t * 64 + j] * P.rw_r_k[l * 384 + h * 64 + j]; }
                    sinv[t] = 1.f / sqrtf(ss + 1e-6f);
                    int R = scan_row(z, b, s0 + t);
                    P.bon[((size_t)z * NROWS + R) * 6 + h] = bn;
                }
            }
            SYNC();
            PAR(tid) {
                for (int idx = tid; idx < 4096; idx += NT) { int t = idx >> 6; float kn = skk[idx] * sinv[t]; skk[idx] = kn; sb[idx] = sb[idx] * kn; }
            }
            SYNC();
            PAR(tid) { PRIV_USE(float, S);
                if (tid < 64) {
                    for (int t = 0; t < 64; ++t) {
                        float sa = 0.f;
#pragma unroll
                        for (int j = 0; j < 64; ++j) sa += S[j] * skk[t * 64 + j];
                        float vv = sv[t * 64 + tid], y = 0.f;
#pragma unroll
                        for (int j = 0; j < 64; ++j) { S[j] = S[j] * sw[t * 64 + j] - sa * sb[t * 64 + j] + vv * sk[t * 64 + j]; y += S[j] * sr[t * 64 + j]; }
                        sy[t * 64 + tid] = y;
                    }
                }
            }
            SYNC();
            PAR(tid) {
                for (int idx = tid; idx < 4096; idx += NT) { int t = idx >> 6, j = idx & 63; int R = scan_row(z, b, s0 + t); P.Y[((size_t)z * NROWS + R) * 384 + h * 64 + j] = sy[idx]; }
            }
            SYNC();
        }
    }
}
DEV void ph_rwkv_fin(const Params& P, int l, int bid, int nblk) {
    PAR(tid) {
        for (int idx = bid * NT + tid; idx < NROWS * 6; idx += nblk * NT) {
            int R = idx / 6, h = idx % 6;
            const float* y0 = P.Y + (size_t)R * 384 + h * 64; const float* y1 = P.Y + ((size_t)NROWS + R) * 384 + h * 64;
            float mu = 0.f;
            for (int j = 0; j < 64; ++j) mu += y0[j] + y1[j];
            mu *= (1.f / 64.f);
            float var = 0.f;
            for (int j = 0; j < 64; ++j) { float d = y0[j] + y1[j] - mu; var += d * d; }
            float rs = 1.f / sqrtf(var * (1.f / 64.f) + 64e-5f);
            float bonus = P.bon[(size_t)R * 6 + h] + P.bon[((size_t)NROWS + R) * 6 + h];
            for (int j = 0; j < 64; ++j) {
                int c = h * 64 + j;
                float y = (y0[j] + y1[j] - mu) * rs * P.rw_ln_g[l * 384 + c] + P.rw_ln_b[l * 384 + c];
                y += bonus * shl(P, l, R, 768 + c);
                float g = (float)P.p[(size_t)R * INW + 1280 + c];
                P.p[(size_t)R * INW + 1280 + c] = (f16)(y * siluf_(g));
            }
        }
    }
}

constexpr int S5_LDS = 1024 + 8192 + 1024 + 1024;
DEV void ph_s5_scan(const Params& P, int l, int bid, int nblk, float* sm) {
    float *su = sm, *shb = su + 1024, *scre = shb + 8192, *scim = scre + 1024;
    PRIV(float, st, 36);
    for (int item = bid; item < 32; item += nblk) {
        const int b = item / 16, g = item % 16;
        for (int z = 0; z < 2; ++z) {
            PAR(tid) { PRIV_USE(float, st);
                if (tid < 64) {
                    int n = tid; int pi = ((l * 2 + z) * 16 + g) * 64 + n;
                    float are_ = P.s5_a_re[pi], aim_ = P.s5_a_im[pi], dt = expf(P.s5_log_dt[pi]);
                    float mag = expf(are_ * dt), abr = mag * cosf(aim_ * dt), abi = mag * sinf(aim_ * dt);
                    float den = are_ * are_ + aim_ * aim_;
                    float qre = ((abr - 1.f) * are_ + abi * aim_) / den, qim = (abi * are_ - (abr - 1.f) * aim_) / den;
                    st[0] = abr; st[1] = abi;
#pragma unroll
                    for (int pp = 0; pp < 16; ++pp) {
                        float br = P.s5_b_re[(size_t)pi * 16 + pp], bi = P.s5_b_im[(size_t)pi * 16 + pp];
                        st[2 + pp] = qre * br - qim * bi; st[18 + pp] = qre * bi + qim * br;
                    }
                    st[34] = 0.f; st[35] = 0.f;
                }
                for (int idx = tid; idx < 1024; idx += NT) {
                    scre[idx] = P.s5_c_re[(size_t)((l * 2 + z) * 16 + g) * 1024 + idx];
                    scim[idx] = P.s5_c_im[(size_t)((l * 2 + z) * 16 + g) * 1024 + idx];
                }
            }
            SYNC();
            for (int ck = 0; ck < NCHUNK; ++ck) {
                const int s0 = ck * 64;
                PAR(tid) {
                    for (int idx = tid; idx < 1024; idx += NT) { int t = idx >> 4, pp = idx & 15; int R = scan_row(z, b, s0 + t); su[idx] = (float)P.p[(size_t)R * INW + 1664 + g * 16 + pp]; }
                }
                SYNC();
                PAR(tid) { PRIV_USE(float, st);
                    if (tid < 64) {
                        float hre = st[34], him = st[35];
                        for (int t = 0; t < 64; ++t) {
                            float bur = 0.f, bui = 0.f;
#pragma unroll
                            for (int pp = 0; pp < 16; ++pp) { float u = su[t * 16 + pp]; bur += st[2 + pp] * u; bui += st[18 + pp] * u; }
                            float nr = st[0] * hre - st[1] * him + bur, ni = st[0] * him + st[1] * hre + bui;
                            hre = nr; him = ni;
                            shb[t * 128 + tid] = hre; shb[t * 128 + 64 + tid] = him;
                        }
                        st[34] = hre; st[35] = him;
                    }
                }
                SYNC();
                PAR(tid) {
                    for (int idx = tid; idx < 1024; idx += NT) {
                        int t = idx >> 4, pp = idx & 15; float y = 0.f;
                        for (int n = 0; n < 64; ++n) y += scre[pp * 64 + n] * shb[t * 128 + n] - scim[pp * 64 + n] * shb[t * 128 + 64 + n];
                        int R = scan_row(z, b, s0 + t); float* dst = P.ys5 + (size_t)R * 256 + g * 16 + pp;
                        if (z == 0) *dst = y; else *dst += y;
                    }
                }
                SYNC();
            }
        }
    }
}
DEV void ph_s5_gelu(const Params& P, int l, int bid, int nblk) {
    PAR(tid) {
        for (size_t idx = (size_t)bid * NT + tid; idx < (size_t)NROWS * 256; idx += (size_t)nblk * NT) {
            int R = (int)(idx >> 8), j = (int)(idx & 255);
            float u = (float)P.p[(size_t)R * INW + 1664 + j];
            float y = P.ys5[idx] + P.s5_d[l * 256 + j] * u;
            P.ys5[idx] = 0.5f * y * (1.f + tanhf(0.7978845608028654f * (y + 0.044715f * y * y * y)));
        }
    }
}
DEV void ph_s5_glu(const Params& P, int l, int bid, int nblk) {
    PAR(tid) {
        for (size_t idx = (size_t)bid * NT + tid; idx < (size_t)NROWS * 256; idx += (size_t)nblk * NT) {
            int R = (int)(idx >> 8), j = (int)(idx & 255);
            const float* yr = P.ys5 + (size_t)R * 256;
            float acc = P.s5_glu_b[l * 256 + j];
            for (int i = 0; i < 256; ++i) acc += yr[i] * P.s5_glu_w[((size_t)l * 256 + i) * 256 + j];
            float g = (float)P.p[(size_t)R * INW + 1920 + j];
            P.p[(size_t)R * INW + 1920 + j] = (f16)(yr[j] * sigmoidf_(acc) * siluf_(g));
        }
    }
}

DEV float ml_xm(const Params& P, int R, int c) { return (float)P.p[(size_t)R * INW + 2176 + c]; }
DEV float ml_xc(const Params& P, int l, int R, int c) {
    int t, len; if (R < NCTX) { t = R % CTX; len = CTX; } else { t = (R - NCTX) % SEQ; len = SEQ; }
    float a = P.ml_conv_b[l * 384 + c] + P.ml_conv_w[(l * 3 + 1) * 384 + c] * ml_xm(P, R, c);
    if (t > 0) a += P.ml_conv_w[(l * 3 + 0) * 384 + c] * ml_xm(P, R - 1, c);
    if (t < len - 1) a += P.ml_conv_w[(l * 3 + 2) * 384 + c] * ml_xm(P, R + 1, c);
    return siluf_(a);
}
DEV void ph_ml_qkv(const Params& P, int l, int bid, int nblk) {
    PAR(tid) {
        for (int idx = bid * NT + tid; idx < NROWS * 96; idx += nblk * NT) {
            int R = idx / 96, n = idx % 96;
            float xc[4], xm[4];
            for (int j = 0; j < 4; ++j) { xc[j] = ml_xc(P, l, R, 4 * n + j); xm[j] = ml_xm(P, R, 4 * n + j); }
            for (int i = 0; i < 4; ++i) {
                float q = 0.f, k = 0.f, v = 0.f;
                for (int j = 0; j < 4; ++j) {
                    int wi = ((l * 96 + n) * 4 + j) * 4 + i;
                    q += xc[j] * P.ml_wq[wi]; k += xc[j] * P.ml_wk[wi]; v += xm[j] * P.ml_wv[wi];
                }
                float* o = P.qkv + (size_t)R * 1152 + 4 * n + i; o[0] = q; o[384] = k; o[768] = v;
            }
        }
    }
}
DEV void ph_ml_gates(const Params& P, int l, int bid, int nblk) {
    PAR(tid) {
        for (int idx = bid * NT + tid; idx < NROWS * 16; idx += nblk * NT) {
            int R = idx >> 4, o = idx & 15, z = o >> 3, hh = (o >> 1) & 3, which = o & 1;
            const float* W = (which ? P.ml_wf : P.ml_wi) + (size_t)(l * 2 + z) * 1152 * 4;
            float acc = (which ? P.ml_bf : P.ml_bi)[(l * 2 + z) * 4 + hh];
            const float* g = P.qkv + (size_t)R * 1152;
            for (int c = 0; c < 1152; ++c) acc += g[c] * W[c * 4 + hh];
            P.gates[idx] = which ? sigmoidf_(acc) : expf(acc);
        }
    }
}
constexpr int ML_LDS = 3 * 6144 + 64 * 97 + 128;
DEV void ph_ml_scan(const Params& P, int l, int bid, int nblk, float* sm) {
    float *sq = sm, *sk = sq + 6144, *sv = sk + 6144, *snum = sv + 6144, *sf = snum + 64 * 97, *si = sf + 64;
    PRIV(float, C, 96);
    for (int chain = bid; chain < 16; chain += nblk) {
        const int z = chain / 8, b = (chain / 4) % 2, hh = chain % 4;
        PAR(tid) { PRIV_USE(float, C);
#pragma unroll
            for (int j = 0; j < 96; ++j) C[j] = 0.f; }
        for (int ck = 0; ck < NCHUNK; ++ck) {
            const int s0 = ck * 64;
            PAR(tid) {
                for (int idx = tid; idx < 6144; idx += NT) {
                    int t = idx / 96, j = idx % 96; int R = scan_row(z, b, s0 + t);
                    const float* g = P.qkv + (size_t)R * 1152 + hh * 96 + j;
                    sq[idx] = g[0]; sk[idx] = g[384] * 0.10206207261596577f; sv[idx] = g[768];
                }
                if (tid < 64) { int R = scan_row(z, b, s0 + tid); sf[tid] = P.gates[R * 16 + z * 8 + hh * 2 + 1]; si[tid] = P.gates[R * 16 + z * 8 + hh * 2]; }
            }
            SYNC();
            PAR(tid) { PRIV_USE(float, C);
                if (tid < 97) {
                    for (int t = 0; t < 64; ++t) {
                        float f = sf[t], iv = si[t] * (tid < 96 ? sv[t * 96 + (tid < 96 ? tid : 0)] : 1.f), num = 0.f;
#pragma unroll
                        for (int j = 0; j < 96; ++j) { C[j] = C[j] * f + iv * sk[t * 96 + j]; num += C[j] * sq[t * 96 + j]; }
                        snum[t * 97 + tid] = num;
                    }
                }
            }
            SYNC();
            PAR(tid) {
                for (int idx = tid; idx < 6144; idx += NT) {
                    int t = idx / 96, j = idx % 96; int R = scan_row(z, b, s0 + t);
                    float den = snum[t * 97 + 96];
                    P.Y[((size_t)z * NROWS + R) * 384 + hh * 96 + j] = snum[t * 97 + j] / fmaxf(fabsf(den), 1.f);
                }
            }
            SYNC();
        }
    }
}
DEV void ph_ml_fin(const Params& P, int l, int bid, int nblk) {
    PAR(tid) {
        for (int idx = bid * NT + tid; idx < NROWS * 4; idx += nblk * NT) {
            int R = idx >> 2, hh = idx & 3;
            const float* y0 = P.Y + (size_t)R * 384 + hh * 96; const float* y1 = P.Y + ((size_t)NROWS + R) * 384 + hh * 96;
            float mu = 0.f;
            for (int j = 0; j < 96; ++j) mu += y0[j] + y1[j];
            mu *= (1.f / 96.f);
            float var = 0.f;
            for (int j = 0; j < 96; ++j) { float d = y0[j] + y1[j] - mu; var += d * d; }
            float rs = 1.f / sqrtf(var * (1.f / 96.f) + 1e-6f);
            for (int j = 0; j < 96; ++j) {
                int c = hh * 96 + j;
                float hv = (y0[j] + y1[j] - mu) * rs * P.ml_norm_g[l * 384 + c] + P.ml_skip[l * 384 + c] * ml_xc(P, l, R, c);
                float zg = (float)P.p[(size_t)R * INW + 2560 + c];
                P.p[(size_t)R * INW + 2560 + c] = (f16)(hv * siluf_(zg));
            }
        }
    }
}
DEV void ph_final(const Params& P, int bid, int nblk) {
    PAR(tid) {
        for (int r = bid * NT + tid; r < NLAT; r += nblk * NT) {
            float* xr = P.out + (size_t)r * D; float ss = 0.f;
            for (int k = 0; k < D; ++k) ss += xr[k] * xr[k];
            float rs = 1.f / sqrtf(ss * (1.f / D) + 1e-6f);
            for (int k = 0; k < D; ++k) xr[k] = xr[k] * rs * P.final_g[k];
        }
    }
}

constexpr size_t al256(size_t x) { return (x + 255) & ~(size_t)255; }
constexpr size_t WS_MODS = 0;
constexpr size_t WS_RSTD = al256(WS_MODS + 2 * 3 * 3072 * 4);
constexpr size_t WS_P = al256(WS_RSTD + (size_t)NROWS * 4);
constexpr size_t WS_Y = al256(WS_P + (size_t)NROWS * INW * 2);
constexpr size_t WS_QKV = al256(WS_Y + (size_t)2 * NROWS * 384 * 4);
constexpr size_t WS_GATES = al256(WS_QKV + (size_t)NROWS * 1152 * 4);
constexpr size_t WS_BON = al256(WS_GATES + (size_t)NROWS * 16 * 4);
constexpr size_t WS_YS5 = al256(WS_BON + (size_t)2 * NROWS * 6 * 4);
constexpr size_t WS_CTX1 = al256(WS_YS5 + (size_t)NROWS * 256 * 4);
constexpr size_t WS_END = al256(WS_CTX1 + (size_t)NCTX * D * 4);

static void fill_params(Params& P, void* const* d_in, void* d_out, void* d_ws) {
    const float** pp = (const float**)&P;
    for (int i = 0; i < 41; ++i) pp[i] = (const float*)d_in[i];
    unsigned char* ws = (unsigned char*)d_ws;
    P.out = (float*)d_out;
    P.mods = (float*)(ws + WS_MODS); P.rstd = (float*)(ws + WS_RSTD); P.p = (f16*)(ws + WS_P); P.Y = (float*)(ws + WS_Y);
    P.qkv = (float*)(ws + WS_QKV); P.gates = (float*)(ws + WS_GATES); P.bon = (float*)(ws + WS_BON); P.ys5 = (float*)(ws + WS_YS5);
    P.ctx1 = (float*)(ws + WS_CTX1);
}

enum { PH_MODS, PH_RSTD, PH_GEMM1, PH_RW_SCAN, PH_RW_FIN, PH_S5_SCAN, PH_S5_GELU, PH_S5_GLU, PH_ML_QKV, PH_ML_GATES, PH_ML_SCAN, PH_ML_FIN, PH_GEMM2, PH_FINAL };
constexpr int lds_floats(int ph) { return ph == PH_GEMM1 || ph == PH_GEMM2 ? 16 * 132 + 16 * 128 : ph == PH_RW_SCAN ? RW_LDS : ph == PH_S5_SCAN ? S5_LDS : ph == PH_ML_SCAN ? ML_LDS : 4; }

template <int PH>
DEV void run_phase(const Params& P, int l, int bid, int nblk, float* sm) {
    if (PH == PH_MODS) ph_mods(P, bid, nblk);
    else if (PH == PH_RSTD) ph_rstd(P, l, bid, nblk);
    else if (PH == PH_GEMM1) ph_gemm<1>(P, l, bid, nblk, sm);
    else if (PH == PH_RW_SCAN) ph_rwkv_scan(P, l, bid, nblk, sm);
    else if (PH == PH_RW_FIN) ph_rwkv_fin(P, l, bid, nblk);
    else if (PH == PH_S5_SCAN) ph_s5_scan(P, l, bid, nblk, sm);
    else if (PH == PH_S5_GELU) ph_s5_gelu(P, l, bid, nblk);
    else if (PH == PH_S5_GLU) ph_s5_glu(P, l, bid, nblk);
    else if (PH == PH_ML_QKV) ph_ml_qkv(P, l, bid, nblk);
    else if (PH == PH_ML_GATES) ph_ml_gates(P, l, bid, nblk);
    else if (PH == PH_ML_SCAN) ph_ml_scan(P, l, bid, nblk, sm);
    else if (PH == PH_ML_FIN) ph_ml_fin(P, l, bid, nblk);
    else if (PH == PH_GEMM2) ph_gemm<2>(P, l, bid, nblk, sm);
    else if (PH == PH_FINAL) ph_final(P, bid, nblk);
}

#ifndef CPU_EMU
template <int PH>
__global__ void __launch_bounds__(NT) k_phase(Params P, int l) {
    __shared__ float sm[lds_floats(PH)];
    run_phase<PH>(P, l, blockIdx.x, gridDim.x, sm);
}
template <int PH>
static void launch(const Params& P, int l, int grid, hipStream_t s) { hipLaunchKernelGGL(k_phase<PH>, dim3(grid), dim3(NT), 0, s, P, l); }

extern "C" void kernel_launch(void* const* d_in, const int* in_sizes, int n_in, void* d_out, int out_size, void* d_ws, size_t ws_size, hipStream_t stream) {
    if (ws_size < WS_END) { fprintf(stderr, "workspace too small: %zu < %zu\n", ws_size, (size_t)WS_END); return; }
    Params P{};
    fill_params(P, d_in, d_out, d_ws);
    launch<PH_MODS>(P, 0, 72, stream);
    for (int l = 0; l < 2; ++l) {
        launch<PH_RSTD>(P, l, (NROWS + NT - 1) / NT, stream);
        launch<PH_GEMM1>(P, l, 2048, stream);
        launch<PH_RW_SCAN>(P, l, 24, stream);
        launch<PH_RW_FIN>(P, l, 780, stream);
        launch<PH_S5_SCAN>(P, l, 32, stream);
        launch<PH_S5_GELU>(P, l, 2048, stream);
        launch<PH_S5_GLU>(P, l, 2048, stream);
        launch<PH_ML_QKV>(P, l, 2048, stream);
        launch<PH_ML_GATES>(P, l, 2048, stream);
        launch<PH_ML_SCAN>(P, l, 16, stream);
        launch<PH_ML_FIN>(P, l, 520, stream);
        launch<PH_GEMM2>(P, l, 2048, stream);
    }
    launch<PH_FINAL>(P, 0, NLAT / NT, stream);
}
#endif
```

```cpp
#ifndef CPU_EMU
#include <hip/hip_runtime.h>
#include <hip/hip_cooperative_groups.h>
namespace cg = cooperative_groups;
#endif
#include <cstdint>
#include <cmath>
#include <cstdio>

#ifndef SEQ
#define SEQ 16384
#endif
#ifndef CTX
#define CTX 256
#endif

typedef _Float16 f16;

constexpr int D = 1024, NB = 2, INW = 2944;
constexpr int NCTX = NB * CTX, NLAT = NB * SEQ, NROWS = NCTX + NLAT;
constexpr int TSCAN = CTX + SEQ, NCHUNK = TSCAN / 64;
constexpr int NT = 256;

#ifdef CPU_EMU
#define DEV static inline
#define PAR(tid) for (int tid = 0; tid < NT; ++tid)
#define SYNC()
#define PRIV(type, name, n) static type name##_all[NT][n]
#define PRIV_USE(type, name) type* name = name##_all[tid]
#else
#define DEV __device__ __forceinline__
#define PAR(tid) for (int tid = threadIdx.x, once_ = 1; once_; once_ = 0)
#define SYNC() __syncthreads()
#define PRIV(type, name, n) type name[n]
#define PRIV_USE(type, name)
#endif

struct Params {
    const float *x, *c, *ctx, *c_ctx, *ada_w, *ada_b, *norm_g, *w_in, *w_out;
    const float *rw_mu, *rw_w0, *rw_w_up, *rw_a0, *rw_a_up, *rw_k_k, *rw_k_a, *rw_r_k, *rw_ln_g, *rw_ln_b;
    const float *s5_a_re, *s5_a_im, *s5_log_dt, *s5_b_re, *s5_b_im, *s5_c_re, *s5_c_im, *s5_d, *s5_glu_w, *s5_glu_b;
    const float *ml_conv_w, *ml_conv_b, *ml_wq, *ml_wk, *ml_wv, *ml_wi, *ml_bi, *ml_wf, *ml_bf, *ml_norm_g, *ml_skip;
    const float* final_g;
    float* out;
    float* mods;
    float* rstd;
    f16* p;
    float* Y;
    float* qkv;
    float* gates;
    float* bon;
    float* ys5;
    float* ctx1;
};

DEV float sigmoidf_(float x) { return 1.f / (1.f + expf(-x)); }
DEV float siluf_(float x) { return x / (1.f + expf(-x)); }

DEV int scan_row(int z, int b, int s) {
    if (s < CTX) { int t = z ? CTX - 1 - s : s; return b * CTX + t; }
    int u = s - CTX; int t = z ? SEQ - 1 - u : u; return NCTX + b * SEQ + t;
}
DEV int row_mod(int R) { return R < NCTX ? 2 : (R - NCTX) / SEQ; }
DEV const float* xrow(const Params& P, int l, int R) {
    const float* xl = l == 0 ? P.x : P.out; const float* xc = l == 0 ? P.ctx : P.ctx1;
    return R < NCTX ? xc + (size_t)R * D : xl + (size_t)(R - NCTX) * D;
}
DEV int nbr_row(int R, int c) {
    if (R < NCTX) { int t = R % CTX; if ((c & 1) == 0) return t > 0 ? R - 1 : -1; return t < CTX - 1 ? R + 1 : -1; }
    int t = (R - NCTX) % SEQ; int m = c & 3, col = t & 63;
    if (m == 0) return col > 0 ? R - 1 : -1;
    if (m == 1) return col < 63 ? R + 1 : -1;
    if (m == 2) return t >= 64 ? R - 64 : -1;
    return t < SEQ - 64 ? R + 64 : -1;
}
DEV float shl(const Params& P, int l, int R, int c) {
    float pv = (float)P.p[(size_t)R * INW + c];
    int nb = nbr_row(R, c);
    float nv = nb >= 0 ? (float)P.p[(size_t)nb * INW + c] : 0.f;
    return pv + (nv - pv) * P.rw_mu[l * 1280 + c];
}

DEV void ph_mods(const Params& P, int bid, int nblk) {
    PAR(tid) {
        for (int idx = bid * NT + tid; idx < 2 * 3 * 3072; idx += nblk * NT) {
            int l = idx / 9216, rem = idx % 9216, j = rem / 3072, col = rem % 3072;
            const float* cin = j < 2 ? P.c + j * D : P.c_ctx;
            float acc = P.ada_b[l * 3072 + col];
            for (int k = 0; k < D; ++k) acc += siluf_(cin[k]) * P.ada_w[((size_t)l * D + k) * 3072 + col];
            P.mods[idx] = acc;
        }
    }
}
DEV void ph_rstd(const Params& P, int l, int bid, int nblk) {
    PAR(tid) {
        for (int R = bid * NT + tid; R < NROWS; R += nblk * NT) {
            const float* xr = xrow(P, l, R); float ss = 0.f;
            for (int k = 0; k < D; ++k) ss += xr[k] * xr[k];
            P.rstd[R] = 1.f / sqrtf(ss * (1.f / D) + 1e-6f);
        }
    }
}
DEV float gemm1_a(const Params& P, int l, int R, int k) {
    int j = row_mod(R); const float* m = P.mods + (l * 3 + j) * 3072;
    return xrow(P, l, R)[k] * P.rstd[R] * P.norm_g[l * D + k] * (1.f + m[D + k]) + m[k];
}
DEV int a2col(int k) { return k < 384 ? 1280 + k : (k < 640 ? 1920 + (k - 384) : 2560 + (k - 640)); }
DEV float gemm2_a(const Params& P, int R, int k) { return (float)P.p[(size_t)R * INW + a2col(k)]; }
DEV void gemm1_epi(const Params& P, int R, int n, float acc) { P.p[(size_t)R * INW + n] = (f16)acc; }
DEV void gemm2_epi(const Params& P, int l, int R, int n, float acc) {
    int j = row_mod(R); float g = P.mods[(l * 3 + j) * 3072 + 2 * D + n];
    float xo = xrow(P, l, R)[n];
    float* dst = R < NCTX ? P.ctx1 + (size_t)R * D + n : P.out + (size_t)(R - NCTX) * D + n;
    *dst = xo + g * acc;
}
template <int MODE>
DEV void ph_gemm(const Params& P, int l, int bid, int nblk, float* sm) {
    constexpr int N = MODE == 1 ? INW : D, K = D;
    const float* Bm = MODE == 1 ? P.w_in + (size_t)l * D * INW : P.w_out + (size_t)l * D * D;
    const int tm0 = (MODE == 2 && l == 1) ? NCTX / 128 : 0;
    const int ntm = NROWS / 128 - tm0, ntn = N / 128;
#ifdef CPU_EMU
    for (int t = bid; t < ntm * ntn; t += nblk) {
        int tm = tm0 + t / ntn, tn = t % ntn;
        static float arow[K];
        for (int r = 0; r < 128; ++r) {
            int R = tm * 128 + r;
            for (int k = 0; k < K; ++k) arow[k] = MODE == 1 ? gemm1_a(P, l, R, k) : gemm2_a(P, R, k);
            float acc[128];
            for (int n = 0; n < 128; ++n) acc[n] = 0.f;
            for (int k = 0; k < K; ++k) { float a = arow[k]; const float* br = Bm + (size_t)k * N + tn * 128; for (int n = 0; n < 128; ++n) acc[n] += a * br[n]; }
            for (int n = 0; n < 128; ++n) { if (MODE == 1) gemm1_epi(P, R, tn * 128 + n, acc[n]); else gemm2_epi(P, l, R, tn * 128 + n, acc[n]); }
        }
    }
#else
    float* As = sm;
    float* Bs = sm + 16 * 132;
    const int tid = threadIdx.x, ty = tid >> 4, tx = tid & 15;
    for (int t = bid; t < ntm * ntn; t += nblk) {
        const int tm = tm0 + t / ntn, tn = t % ntn;
        float acc[8][8];
#pragma unroll
        for (int i = 0; i < 8; ++i)
#pragma unroll
            for (int j = 0; j < 8; ++j) acc[i][j] = 0.f;
        const int ar = tid >> 1, ak = (tid & 1) * 8;
        const int bk = tid >> 4, bn = (tid & 15) * 8;
        for (int k0 = 0; k0 < K; k0 += 16) {
            float av[8], bv[8];
#pragma unroll
            for (int i = 0; i < 8; ++i) av[i] = MODE == 1 ? gemm1_a(P, l, tm * 128 + ar, k0 + ak + i) : gemm2_a(P, tm * 128 + ar, k0 + ak + i);
#pragma unroll
            for (int i = 0; i < 8; ++i) bv[i] = Bm[(size_t)(k0 + bk) * N + tn * 128 + bn + i];
            __syncthreads();
#pragma unroll
            for (int i = 0; i < 8; ++i) As[(ak + i) * 132 + ar] = av[i];
#pragma unroll
            for (int i = 0; i < 8; ++i) Bs[bk * 128 + bn + i] = bv[i];
            __syncthreads();
#pragma unroll
            for (int kk = 0; kk < 16; ++kk) {
                float a[8], b[8];
#pragma unroll
                for (int i = 0; i < 8; ++i) a[i] = As[kk * 132 + ty * 8 + i];
#pragma unroll
                for (int j = 0; j < 8; ++j) b[j] = Bs[kk * 128 + tx * 8 + j];
#pragma unroll
                for (int i = 0; i < 8; ++i)
#pragma unroll
                    for (int j = 0; j < 8; ++j) acc[i][j] += a[i] * b[j];
            }
        }
#pragma unroll
        for (int i = 0; i < 8; ++i)
#pragma unroll
            for (int j = 0; j < 8; ++j) {
                int R = tm * 128 + ty * 8 + i, n = tn * 128 + tx * 8 + j;
                if (MODE == 1) gemm1_epi(P, R, n, acc[i][j]); else gemm2_epi(P, l, R, n, acc[i][j]);
            }
    }
#endif
}

constexpr int RW_LDS = 8 * 4096 + 64;
DEV void ph_rwkv_scan(const Params& P, int l, int bid, int nblk, float* sm) {
    float *sw = sm, *sk = sw + 4096, *sb = sk + 4096, *skk = sb + 4096, *sr = skk + 4096, *sv = sr + 4096, *lora = sv + 4096, *sy = lora + 4096, *sinv = sy + 4096;
    PRIV(float, S, 64);
    for (int chain = bid; chain < 24; chain += nblk) {
        const int z = chain / 12, b = (chain / 6) % 2, h = chain % 6;
        PAR(tid) { PRIV_USE(float, S);
#pragma unroll
            for (int j = 0; j < 64; ++j) S[j] = 0.f; }
        for (int ck = 0; ck < NCHUNK; ++ck) {
            const int s0 = ck * 64;
            PAR(tid) {
                for (int idx = tid; idx < 4096; idx += NT) {
                    int t = idx >> 6, q = idx & 63; int R = scan_row(z, b, s0 + t);
                    int ch = q < 32 ? 1152 + z * 32 + q : 1216 + z * 32 + (q - 32);
                    float v = shl(P, l, R, ch);
                    lora[idx] = q < 32 ? tanhf(v) : v;
                }
            }
            SYNC();
            PAR(tid) {
                for (int idx = tid; idx < 4096; idx += NT) {
                    int t = idx >> 6, j = idx & 63, c = h * 64 + j; int R = scan_row(z, b, s0 + t);
                    float r_ = shl(P, l, R, c), k_ = shl(P, l, R, 384 + c), v_ = shl(P, l, R, 768 + c);
                    float wp = P.rw_w0[(l * 2 + z) * 384 + c], ap = P.rw_a0[(l * 2 + z) * 384 + c];
                    for (int rr = 0; rr < 32; ++rr) {
                        wp += lora[t * 64 + rr] * P.rw_w_up[((l * 2 + z) * 32 + rr) * 384 + c];
                        ap += lora[t * 64 + 32 + rr] * P.rw_a_up[((l * 2 + z) * 32 + rr) * 384 + c];
                    }
                    float w = expf(-0.6065306597126334f * sigmoidf_(wp)), a = sigmoidf_(ap);
                    sw[idx] = w; sk[idx] = k_ * (1.f + (a - 1.f) * P.rw_k_a[l * 384 + c]); sb[idx] = a;
                    skk[idx] = k_ * P.rw_k_k[l * 384 + c]; sr[idx] = r_; sv[idx] = v_;
                }
            }
            SYNC();
            PAR(tid) {
                if (tid < 64) {
                    int t = tid; float ss = 0.f, bn = 0.f;
                    for (int j = 0; j < 64; ++j) { float q = skk[t * 64 + j]; ss += q * q; bn += sr[t * 64 + j] * sk[t * 64 + j] * P.rw_r_k[l * 384 + h * 64 + j]; }
                    sinv[t] = 1.f / sqrtf(ss + 1e-6f);
                    int R = scan_row(z, b, s0 + t);
                    P.bon[((size_t)z * NROWS + R) * 6 + h] = bn;
                }
            }
            SYNC();
            PAR(tid) {
                for (int idx = tid; idx < 4096; idx += NT) { int t = idx >> 6; float kn = skk[idx] * sinv[t]; skk[idx] = kn; sb[idx] = sb[idx] * kn; }
            }
            SYNC();
            PAR(tid) { PRIV_USE(float, S);
                if (tid < 64) {
                    for (int t = 0; t < 64; ++t) {
                        float sa = 0.f;
#pragma unroll
                        for (int j = 0; j < 64; ++j) sa += S[j] * skk[t * 64 + j];
                        float vv = sv[t * 64 + tid], y = 0.f;
#pragma unroll
                        for (int j = 0; j < 64; ++j) { S[j] = S[j] * sw[t * 64 + j] - sa * sb[t * 64 + j] + vv * sk[t * 64 + j]; y += S[j] * sr[t * 64 + j]; }
                        sy[t * 64 + tid] = y;
                    }
                }
            }
            SYNC();
            PAR(tid) {
                for (int idx = tid; idx < 4096; idx += NT) { int t = idx >> 6, j = idx & 63; int R = scan_row(z, b, s0 + t); P.Y[((size_t)z * NROWS + R) * 384 + h * 64 + j] = sy[idx]; }
            }
            SYNC();
        }
    }
}
DEV void ph_rwkv_fin(const Params& P, int l, int bid, int nblk) {
    PAR(tid) {
        for (int idx = bid * NT + tid; idx < NROWS * 6; idx += nblk * NT) {
            int R = idx / 6, h = idx % 6;
            const float* y0 = P.Y + (size_t)R * 384 + h * 64; const float* y1 = P.Y + ((size_t)NROWS + R) * 384 + h * 64;
            float mu = 0.f;
            for (int j = 0; j < 64; ++j) mu += y0[j] + y1[j];
            mu *= (1.f / 64.f);
            float var = 0.f;
            for (int j = 0; j < 64; ++j) { float d = y0[j] + y1[j] - mu; var += d * d; }
            float rs = 1.f / sqrtf(var * (1.f / 64.f) + 64e-5f);
            float bonus = P.bon[(size_t)R * 6 + h] + P.bon[((size_t)NROWS + R) * 6 + h];
            for (int j = 0; j < 64; ++j) {
                int c = h * 64 + j;
                float y = (y0[j] + y1[j] - mu) * rs * P.rw_ln_g[l * 384 + c] + P.rw_ln_b[l * 384 + c];
                y += bonus * shl(P, l, R, 768 + c);
                float g = (float)P.p[(size_t)R * INW + 1280 + c];
                P.p[(size_t)R * INW + 1280 + c] = (f16)(y * siluf_(g));
            }
        }
    }
}

constexpr int S5_LDS = 1024 + 8192 + 1024 + 1024;
DEV void ph_s5_scan(const Params& P, int l, int bid, int nblk, float* sm) {
    float *su = sm, *shb = su + 1024, *scre = shb + 8192, *scim = scre + 1024;
    PRIV(float, st, 36);
    for (int item = bid; item < 32; item += nblk) {
        const int b = item / 16, g = item % 16;
        for (int z = 0; z < 2; ++z) {
            PAR(tid) { PRIV_USE(float, st);
                if (tid < 64) {
                    int n = tid; int pi = ((l * 2 + z) * 16 + g) * 64 + n;
                    float are_ = P.s5_a_re[pi], aim_ = P.s5_a_im[pi], dt = expf(P.s5_log_dt[pi]);
                    float mag = expf(are_ * dt), abr = mag * cosf(aim_ * dt), abi = mag * sinf(aim_ * dt);
                    float den = are_ * are_ + aim_ * aim_;
                    float qre = ((abr - 1.f) * are_ + abi * aim_) / den, qim = (abi * are_ - (abr - 1.f) * aim_) / den;
                    st[0] = abr; st[1] = abi;
#pragma unroll
                    for (int pp = 0; pp < 16; ++pp) {
                        float br = P.s5_b_re[(size_t)pi * 16 + pp], bi = P.s5_b_im[(size_t)pi * 16 + pp];
                        st[2 + pp] = qre * br - qim * bi; st[18 + pp] = qre * bi + qim * br;
                    }
                    st[34] = 0.f; st[35] = 0.f;
                }
                for (int idx = tid; idx < 1024; idx += NT) {
                    scre[idx] = P.s5_c_re[(size_t)((l * 2 + z) * 16 + g) * 1024 + idx];
                    scim[idx] = P.s5_c_im[(size_t)((l * 2 + z) * 16 + g) * 1024 + idx];
                }
            }
            SYNC();
            for (int ck = 0; ck < NCHUNK; ++ck) {
                const int s0 = ck * 64;
                PAR(tid) {
                    for (int idx = tid; idx < 1024; idx += NT) { int t = idx >> 4, pp = idx & 15; int R = scan_row(z, b, s0 + t); su[idx] = (float)P.p[(size_t)R * INW + 1664 + g * 16 + pp]; }
                }
                SYNC();
                PAR(tid) { PRIV_USE(float, st);
                    if (tid < 64) {
                        float hre = st[34], him = st[35];
                        for (int t = 0; t < 64; ++t) {
                            float bur = 0.f, bui = 0.f;
#pragma unroll
                            for (int pp = 0; pp < 16; ++pp) { float u = su[t * 16 + pp]; bur += st[2 + pp] * u; bui += st[18 + pp] * u; }
                            float nr = st[0] * hre - st[1] * him + bur, ni = st[0] * him + st[1] * hre + bui;
                            hre = nr; him = ni;
                            shb[t * 128 + tid] = hre; shb[t * 128 + 64 + tid] = him;
                        }
                        st[34] = hre; st[35] = him;
                    }
                }
                SYNC();
                PAR(tid) {
                    for (int idx = tid; idx < 1024; idx += NT) {
                        int t = idx >> 4, pp = idx & 15; float y = 0.f;
                        for (int n = 0; n < 64; ++n) y += scre[pp * 64 + n] * shb[t * 128 + n] - scim[pp * 64 + n] * shb[t * 128 + 64 + n];
                        int R = scan_row(z, b, s0 + t); float* dst = P.ys5 + (size_t)R * 256 + g * 16 + pp;
                        if (z == 0) *dst = y; else *dst += y;
                    }
                }
                SYNC();
            }
        }
    }
}
DEV void ph_s5_gelu(const Params& P, int l, int bid, int nblk) {
    PAR(tid) {
        for (size_t idx = (size_t)bid * NT + tid; idx < (size_t)NROWS * 256; idx += (size_t)nblk * NT) {
            int R = (int)(idx >> 8), j = (int)(idx & 255);
            float u = (float)P.p[(size_t)R * INW + 1664 + j];
            float y = P.ys5[idx] + P.s5_d[l * 256 + j] * u;
            P.ys5[idx] = 0.5f * y * (1.f + tanhf(0.7978845608028654f * (y + 0.044715f * y * y * y)));
        }
    }
}
DEV void ph_s5_glu(const Params& P, int l, int bid, int nblk) {
    PAR(tid) {
        for (size_t idx = (size_t)bid * NT + tid; idx < (size_t)NROWS * 256; idx += (size_t)nblk * NT) {
            int R = (int)(idx >> 8), j = (int)(idx & 255);
            const float* yr = P.ys5 + (size_t)R * 256;
            float acc = P.s5_glu_b[l * 256 + j];
            for (int i = 0; i < 256; ++i) acc += yr[i] * P.s5_glu_w[((size_t)l * 256 + i) * 256 + j];
            float g = (float)P.p[(size_t)R * INW + 1920 + j];
            P.p[(size_t)R * INW + 1920 + j] = (f16)(yr[j] * sigmoidf_(acc) * siluf_(g));
        }
    }
}

DEV float ml_xm(const Params& P, int R, int c) { return (float)P.p[(size_t)R * INW + 2176 + c]; }
DEV float ml_xc(const Params& P, int l, int R, int c) {
    int t, len; if (R < NCTX) { t = R % CTX; len = CTX; } else { t = (R - NCTX) % SEQ; len = SEQ; }
    float a = P.ml_conv_b[l * 384 + c] + P.ml_conv_w[(l * 3 + 1) * 384 + c] * ml_xm(P, R, c);
    if (t > 0) a += P.ml_conv_w[(l * 3 + 0) * 384 + c] * ml_xm(P, R - 1, c);
    if (t < len - 1) a += P.ml_conv_w[(l * 3 + 2) * 384 + c] * ml_xm(P, R + 1, c);
    return siluf_(a);
}
DEV void ph_ml_qkv(const Params& P, int l, int bid, int nblk) {
    PAR(tid) {
        for (int idx = bid * NT + tid; idx < NROWS * 96; idx += nblk * NT) {
            int R = idx / 96, n = idx % 96;
            float xc[4], xm[4];
            for (int j = 0; j < 4; ++j) { xc[j] = ml_xc(P, l, R, 4 * n + j); xm[j] = ml_xm(P, R, 4 * n + j); }
            for (int i = 0; i < 4; ++i) {
                float q = 0.f, k = 0.f, v = 0.f;
                for (int j = 0; j < 4; ++j) {
                    int wi = ((l * 96 + n) * 4 + j) * 4 + i;
                    q += xc[j] * P.ml_wq[wi]; k += xc[j] * P.ml_wk[wi]; v += xm[j] * P.ml_wv[wi];
                }
                float* o = P.qkv + (size_t)R * 1152 + 4 * n + i; o[0] = q; o[384] = k; o[768] = v;
            }
        }
    }
}
DEV void ph_ml_gates(const Params& P, int l, int bid, int nblk) {
    PAR(tid) {
        for (int idx = bid * NT + tid; idx < NROWS * 16; idx += nblk * NT) {
            int R = idx >> 4, o = idx & 15, z = o >> 3, hh = (o >> 1) & 3, which = o & 1;
            const float* W = (which ? P.ml_wf : P.ml_wi) + (size_t)(l * 2 + z) * 1152 * 4;
            float acc = (which ? P.ml_bf : P.ml_bi)[(l * 2 + z) * 4 + hh];
            const float* g = P.qkv + (size_t)R * 1152;
            for (int c = 0; c < 1152; ++c) acc += g[c] * W[c * 4 + hh];
            P.gates[idx] = which ? sigmoidf_(acc) : expf(acc);
        }
    }
}
constexpr int ML_LDS = 3 * 6144 + 64 * 97 + 128;
DEV void ph_ml_scan(const Params& P, int l, int bid, int nblk, float* sm) {
    float *sq = sm, *sk = sq + 6144, *sv = sk + 6144, *snum = sv + 6144, *sf = snum + 64 * 97, *si = sf + 64;
    PRIV(float, C, 96);
    for (int chain = bid; chain < 16; chain += nblk) {
        const int z = chain / 8, b = (chain / 4) % 2, hh = chain % 4;
        PAR(tid) { PRIV_USE(float, C);
#pragma unroll
            for (int j = 0; j < 96; ++j) C[j] = 0.f; }
        for (int ck = 0; ck < NCHUNK; ++ck) {
            const int s0 = ck * 64;
            PAR(tid) {
                for (int idx = tid; idx < 6144; idx += NT) {
                    int t = idx / 96, j = idx % 96; int R = scan_row(z, b, s0 + t);
                    const float* g = P.qkv + (size_t)R * 1152 + hh * 96 + j;
                    sq[idx] = g[0]; sk[idx] = g[384] * 0.10206207261596577f; sv[idx] = g[768];
                }
                if (tid < 64) { int R = scan_row(z, b, s0 + tid); sf[tid] = P.gates[R * 16 + z * 8 + hh * 2 + 1]; si[tid] = P.gates[R * 16 + z * 8 + hh * 2]; }
            }
            SYNC();
            PAR(tid) { PRIV_USE(float, C);
                if (tid < 97) {
                    for (int t = 0; t < 64; ++t) {
                        float f = sf[t], iv = si[t] * (tid < 96 ? sv[t * 96 + (tid < 96 ? tid : 0)] : 1.f), num = 0.f;
#pragma unroll
                        for (int j = 0; j < 96; ++j) { C[j] = C[j] * f + iv * sk[t * 96 + j]; num += C[j] * sq[t * 96 + j]; }
                        snum[t * 97 + tid] = num;
                    }
                }
            }
            SYNC();
            PAR(tid) {
                for (int idx = tid; idx < 6144; idx += NT) {
                    int t = idx / 96, j = idx % 96; int R = scan_row(z, b, s0 + t);
                    float den = snum[t * 97 + 96];
                    P.Y[((size_t)z * NROWS + R) * 384 + hh * 96 + j] = snum[t * 97 + j] / fmaxf(fabsf(den), 1.f);
                }
            }
            SYNC();
        }
    }
}
DEV void ph_ml_fin(const Params& P, int l, int bid, int nblk) {
    PAR(tid) {
        for (int idx = bid * NT + tid; idx < NROWS * 4; idx += nblk * NT) {
            int R = idx >> 2, hh = idx & 3;
            const float* y0 = P.Y + (size_t)R * 384 + hh * 96; const float* y1 = P.Y + ((size_t)NROWS + R) * 384 + hh * 96;
            float mu = 0.f;
            for (int j = 0; j < 96; ++j) mu += y0[j] + y1[j];
            mu *= (1.f / 96.f);
            float var = 0.f;
            for (int j = 0; j < 96; ++j) { float d = y0[j] + y1[j] - mu; var += d * d; }
            float rs = 1.f / sqrtf(var * (1.f / 96.f) + 1e-6f);
            for (int j = 0; j < 96; ++j) {
                int c = hh * 96 + j;
                float hv = (y0[j] + y1[j] - mu) * rs * P.ml_norm_g[l * 384 + c] + P.ml_skip[l * 384 + c] * ml_xc(P, l, R, c);
                float zg = (float)P.p[(size_t)R * INW + 2560 + c];
                P.p[(size_t)R * INW + 2560 + c] = (f16)(hv * siluf_(zg));
            }
        }
    }
}
DEV void ph_final(const Params& P, int bid, int nblk) {
    PAR(tid) {
        for (int r = bid * NT + tid; r < NLAT; r += nblk * NT) {
            float* xr = P.out + (size_t)r * D; float ss = 0.f;
            for (int k = 0; k < D; ++k) ss += xr[k] * xr[k];
            float rs = 1.f / sqrtf(ss * (1.f / D) + 1e-6f);
            for (int k = 0; k < D; ++k) xr[k] = xr[k] * rs * P.final_g[k];
        }
    }
}

constexpr size_t al256(size_t x) { return (x + 255) & ~(size_t)255; }
constexpr size_t WS_MODS = 0;
constexpr size_t WS_RSTD = al256(WS_MODS + 2 * 3 * 3072 * 4);
constexpr size_t WS_P = al256(WS_RSTD + (size_t)NROWS * 4);
constexpr size_t WS_Y = al256(WS_P + (size_t)NROWS * INW * 2);
constexpr size_t WS_QKV = al256(WS_Y + (size_t)2 * NROWS * 384 * 4);
constexpr size_t WS_GATES = al256(WS_QKV + (size_t)NROWS * 1152 * 4);
constexpr size_t WS_BON = al256(WS_GATES + (size_t)NROWS * 16 * 4);
constexpr size_t WS_YS5 = al256(WS_BON + (size_t)2 * NROWS * 6 * 4);
constexpr size_t WS_CTX1 = al256(WS_YS5 + (size_t)NROWS * 256 * 4);
constexpr size_t WS_END = al256(WS_CTX1 + (size_t)NCTX * D * 4);

static void fill_params(Params& P, void* const* d_in, void* d_out, void* d_ws) {
    const float** pp = (const float**)&P;
    for (int i = 0; i < 41; ++i) pp[i] = (const float*)d_in[i];
    unsigned char* ws = (unsigned char*)d_ws;
    P.out = (float*)d_out;
    P.mods = (float*)(ws + WS_MODS); P.rstd = (float*)(ws + WS_RSTD); P.p = (f16*)(ws + WS_P); P.Y = (float*)(ws + WS_Y);
    P.qkv = (float*)(ws + WS_QKV); P.gates = (float*)(ws + WS_GATES); P.bon = (float*)(ws + WS_BON); P.ys5 = (float*)(ws + WS_YS5);
    P.ctx1 = (float*)(ws + WS_CTX1);
}

enum { PH_MODS, PH_RSTD, PH_GEMM1, PH_RW_SCAN, PH_RW_FIN, PH_S5_SCAN, PH_S5_GELU, PH_S5_GLU, PH_ML_QKV, PH_ML_GATES, PH_ML_SCAN, PH_ML_FIN, PH_GEMM2, PH_FINAL };
constexpr int lds_floats(int ph) { return ph == PH_GEMM1 || ph == PH_GEMM2 ? 16 * 132 + 16 * 128 : ph == PH_RW_SCAN ? RW_LDS : ph == PH_S5_SCAN ? S5_LDS : ph == PH_ML_SCAN ? ML_LDS : 4; }

template <int PH>
DEV void run_phase(const Params& P, int l, int bid, int nblk, float* sm) {
    if (PH == PH_MODS) ph_mods(P, bid, nblk);
    else if (PH == PH_RSTD) ph_rstd(P, l, bid, nblk);
    else if (PH == PH_GEMM1) ph_gemm<1>(P, l, bid, nblk, sm);
    else if (PH == PH_RW_SCAN) ph_rwkv_scan(P, l, bid, nblk, sm);
    else if (PH == PH_RW_FIN) ph_rwkv_fin(P, l, bid, nblk);
    else if (PH == PH_S5_SCAN) ph_s5_scan(P, l, bid, nblk, sm);
    else if (PH == PH_S5_GELU) ph_s5_gelu(P, l, bid, nblk);
    else if (PH == PH_S5_GLU) ph_s5_glu(P, l, bid, nblk);
    else if (PH == PH_ML_QKV) ph_ml_qkv(P, l, bid, nblk);
    else if (PH == PH_ML_GATES) ph_ml_gates(P, l, bid, nblk);
    else if (PH == PH_ML_SCAN) ph_ml_scan(P, l, bid, nblk, sm);
    else if (PH == PH_ML_FIN) ph_ml_fin(P, l, bid, nblk);
    else if (PH == PH_GEMM2) ph_gemm<2>(P, l, bid, nblk, sm);
    else if (PH == PH_FINAL) ph_final(P, bid, nblk);
}

#ifndef CPU_EMU
constexpr int MEGA_LDS = RW_LDS;
__global__ void __launch_bounds__(NT) mega_fwd(Params P) {
    __shared__ float sm[MEGA_LDS];
    cg::grid_group grid = cg::this_grid();
    const int bid = blockIdx.x, nblk = gridDim.x;
    run_phase<PH_MODS>(P, 0, bid, nblk, sm);
    grid.sync();
    for (int l = 0; l < 2; ++l) {
        run_phase<PH_RSTD>(P, l, bid, nblk, sm); grid.sync();
        run_phase<PH_GEMM1>(P, l, bid, nblk, sm); grid.sync();
        run_phase<PH_RW_SCAN>(P, l, bid, nblk, sm); grid.sync();
        run_phase<PH_RW_FIN>(P, l, bid, nblk, sm); grid.sync();
        run_phase<PH_S5_SCAN>(P, l, bid, nblk, sm); grid.sync();
        run_phase<PH_S5_GELU>(P, l, bid, nblk, sm); grid.sync();
        run_phase<PH_S5_GLU>(P, l, bid, nblk, sm);
        run_phase<PH_ML_QKV>(P, l, bid, nblk, sm); grid.sync();
        run_phase<PH_ML_GATES>(P, l, bid, nblk, sm); grid.sync();
        run_phase<PH_ML_SCAN>(P, l, bid, nblk, sm); grid.sync();
        run_phase<PH_ML_FIN>(P, l, bid, nblk, sm); grid.sync();
        run_phase<PH_GEMM2>(P, l, bid, nblk, sm); grid.sync();
    }
    run_phase<PH_FINAL>(P, 0, bid, nblk, sm);
}

extern "C" void kernel_launch(void* const* d_in, const int* in_sizes, int n_in, void* d_out, int out_size, void* d_ws, size_t ws_size, hipStream_t stream) {
    if (ws_size < WS_END) { fprintf(stderr, "workspace too small: %zu < %zu\n", ws_size, (size_t)WS_END); return; }
    static int grid_blocks = 0;
    if (!grid_blocks) {
        int dev = 0, cus = 0, per_cu = 0;
        hipGetDevice(&dev);
        hipDeviceGetAttribute(&cus, hipDeviceAttributeMultiprocessorCount, dev);
        hipOccupancyMaxActiveBlocksPerMultiprocessor(&per_cu, mega_fwd, NT, 0);
        if (per_cu < 1) per_cu = 1;
        grid_blocks = cus * per_cu;
        fprintf(stderr, "mega_fwd: %d CUs x %d blocks/CU\n", cus, per_cu);
    }
    Params P{};
    fill_params(P, d_in, d_out, d_ws);
    void* args[] = {&P};
    hipError_t e = hipLaunchCooperativeKernel((void*)mega_fwd, dim3(grid_blocks), dim3(NT), args, 0, stream);
    if (e != hipSuccess) fprintf(stderr, "cooperative launch failed: %s (grid %d)\n", hipGetErrorString(e), grid_blocks);
}
#endif
```

```cpp
#ifndef CPU_EMU
#include <hip/hip_runtime.h>
#include <hip/hip_cooperative_groups.h>
namespace cg = cooperative_groups;
#endif
#include <cstdint>
#include <cmath>
#include <cstdio>

#ifndef SEQ
#define SEQ 16384
#endif
#ifndef CTX
#define CTX 256
#endif

typedef _Float16 f16;

constexpr int D = 1024, NB = 2, INW = 2944;
constexpr int NCTX = NB * CTX, NLAT = NB * SEQ, NROWS = NCTX + NLAT;
constexpr int TSCAN = CTX + SEQ, NCHUNK = TSCAN / 64;
constexpr int NT = 256;

#ifdef CPU_EMU
#define DEV static inline
#define PAR(tid) for (int tid = 0; tid < NT; ++tid)
#define SYNC()
#define PRIV(type, name, n) static type name##_all[NT][n]
#define PRIV_USE(type, name) type* name = name##_all[tid]
#else
#define DEV __device__ __forceinline__
#define PAR(tid) for (int tid = threadIdx.x, once_ = 1; once_; once_ = 0)
#define SYNC() __syncthreads()
#define PRIV(type, name, n) type name[n]
#define PRIV_USE(type, name)
#endif

struct Params {
    const float *x, *c, *ctx, *c_ctx, *ada_w, *ada_b, *norm_g, *w_in, *w_out;
    const float *rw_mu, *rw_w0, *rw_w_up, *rw_a0, *rw_a_up, *rw_k_k, *rw_k_a, *rw_r_k, *rw_ln_g, *rw_ln_b;
    const float *s5_a_re, *s5_a_im, *s5_log_dt, *s5_b_re, *s5_b_im, *s5_c_re, *s5_c_im, *s5_d, *s5_glu_w, *s5_glu_b;
    const float *ml_conv_w, *ml_conv_b, *ml_wq, *ml_wk, *ml_wv, *ml_wi, *ml_bi, *ml_wf, *ml_bf, *ml_norm_g, *ml_skip;
    const float* final_g;
    float* out;
    float* mods;
    float* rstd;
    f16* p;
    float* Y;
    float* qkv;
    float* gates;
    float* bon;
    float* ys5;
    float* ctx1;
    f16* hx;
    f16* wt_in;
    f16* wt_out;
    Params* gp;
};

DEV float sigmoidf_(float x) { return 1.f / (1.f + expf(-x)); }
DEV float siluf_(float x) { return x / (1.f + expf(-x)); }

DEV int scan_row(int z, int b, int s) {
    if (s < CTX) { int t = z ? CTX - 1 - s : s; return b * CTX + t; }
    int u = s - CTX; int t = z ? SEQ - 1 - u : u; return NCTX + b * SEQ + t;
}
DEV int row_mod(int R) { return R < NCTX ? 2 : (R - NCTX) / SEQ; }
DEV const float* xrow(const Params& P, int l, int R) {
    const float* xl = l == 0 ? P.x : P.out; const float* xc = l == 0 ? P.ctx : P.ctx1;
    return R < NCTX ? xc + (size_t)R * D : xl + (size_t)(R - NCTX) * D;
}
DEV int nbr_row(int R, int c) {
    if (R < NCTX) { int t = R % CTX; if ((c & 1) == 0) return t > 0 ? R - 1 : -1; return t < CTX - 1 ? R + 1 : -1; }
    int t = (R - NCTX) % SEQ; int m = c & 3, col = t & 63;
    if (m == 0) return col > 0 ? R - 1 : -1;
    if (m == 1) return col < 63 ? R + 1 : -1;
    if (m == 2) return t >= 64 ? R - 64 : -1;
    return t < SEQ - 64 ? R + 64 : -1;
}
DEV float shl(const Params& P, int l, int R, int c) {
    float pv = (float)P.p[(size_t)R * INW + c];
    int nb = nbr_row(R, c);
    float nv = nb >= 0 ? (float)P.p[(size_t)nb * INW + c] : 0.f;
    return pv + (nv - pv) * P.rw_mu[l * 1280 + c];
}

DEV void ph_mods(const Params& P, int bid, int nblk) {
    PAR(tid) {
        for (int idx = bid * NT + tid; idx < 2 * 3 * 3072; idx += nblk * NT) {
            int l = idx / 9216, rem = idx % 9216, j = rem / 3072, col = rem % 3072;
            const float* cin = j < 2 ? P.c + j * D : P.c_ctx;
            float acc = P.ada_b[l * 3072 + col];
            for (int k = 0; k < D; ++k) acc += siluf_(cin[k]) * P.ada_w[((size_t)l * D + k) * 3072 + col];
            P.mods[idx] = acc;
        }
    }
}
DEV void ph_rstd(const Params& P, int l, int bid, int nblk) {
    PAR(tid) {
        for (int R = bid * NT + tid; R < NROWS; R += nblk * NT) {
            const float* xr = xrow(P, l, R); float ss = 0.f;
            for (int k = 0; k < D; ++k) ss += xr[k] * xr[k];
            P.rstd[R] = 1.f / sqrtf(ss * (1.f / D) + 1e-6f);
        }
    }
}
DEV float gemm1_a(const Params& P, int l, int R, int k) {
    int j = row_mod(R); const float* m = P.mods + (l * 3 + j) * 3072;
    return xrow(P, l, R)[k] * P.rstd[R] * P.norm_g[l * D + k] * (1.f + m[D + k]) + m[k];
}
DEV int a2col(int k) { return k < 384 ? 1280 + k : (k < 640 ? 1920 + (k - 384) : 2560 + (k - 640)); }
DEV float gemm2_a(const Params& P, int R, int k) { return (float)P.p[(size_t)R * INW + a2col(k)]; }
DEV void gemm1_epi(const Params& P, int R, int n, float acc) { P.p[(size_t)R * INW + n] = (f16)acc; }
DEV void gemm2_epi(const Params& P, int l, int R, int n, float acc) {
    int j = row_mod(R); float g = P.mods[(l * 3 + j) * 3072 + 2 * D + n];
    float xo = xrow(P, l, R)[n];
    float* dst = R < NCTX ? P.ctx1 + (size_t)R * D + n : P.out + (size_t)(R - NCTX) * D + n;
    *dst = xo + g * acc;
}
template <int MODE>
DEV void ph_gemm(const Params& P, int l, int bid, int nblk, float* sm) {
    constexpr int N = MODE == 1 ? INW : D, K = D;
    const float* Bm = MODE == 1 ? P.w_in + (size_t)l * D * INW : P.w_out + (size_t)l * D * D;
    const int tm0 = (MODE == 2 && l == 1) ? NCTX / 128 : 0;
    const int ntm = NROWS / 128 - tm0, ntn = N / 128;
#ifdef CPU_EMU
    for (int t = bid; t < ntm * ntn; t += nblk) {
        int tm = tm0 + t / ntn, tn = t % ntn;
        static float arow[K];
        for (int r = 0; r < 128; ++r) {
            int R = tm * 128 + r;
            for (int k = 0; k < K; ++k) arow[k] = MODE == 1 ? gemm1_a(P, l, R, k) : gemm2_a(P, R, k);
            float acc[128];
            for (int n = 0; n < 128; ++n) acc[n] = 0.f;
            for (int k = 0; k < K; ++k) { float a = arow[k]; const float* br = Bm + (size_t)k * N + tn * 128; for (int n = 0; n < 128; ++n) acc[n] += a * br[n]; }
            for (int n = 0; n < 128; ++n) { if (MODE == 1) gemm1_epi(P, R, tn * 128 + n, acc[n]); else gemm2_epi(P, l, R, tn * 128 + n, acc[n]); }
        }
    }
#else
    float* As = sm;
    float* Bs = sm + 16 * 132;
    const int tid = threadIdx.x, ty = tid >> 4, tx = tid & 15;
    for (int t = bid; t < ntm * ntn; t += nblk) {
        const int tm = tm0 + t / ntn, tn = t % ntn;
        float acc[8][8];
#pragma unroll
        for (int i = 0; i < 8; ++i)
#pragma unroll
            for (int j = 0; j < 8; ++j) acc[i][j] = 0.f;
        const int ar = tid >> 1, ak = (tid & 1) * 8;
        const int bk = tid >> 4, bn = (tid & 15) * 8;
        for (int k0 = 0; k0 < K; k0 += 16) {
            float av[8], bv[8];
#pragma unroll
            for (int i = 0; i < 8; ++i) av[i] = MODE == 1 ? gemm1_a(P, l, tm * 128 + ar, k0 + ak + i) : gemm2_a(P, tm * 128 + ar, k0 + ak + i);
#pragma unroll
            for (int i = 0; i < 8; ++i) bv[i] = Bm[(size_t)(k0 + bk) * N + tn * 128 + bn + i];
            __syncthreads();
#pragma unroll
            for (int i = 0; i < 8; ++i) As[(ak + i) * 132 + ar] = av[i];
#pragma unroll
            for (int i = 0; i < 8; ++i) Bs[bk * 128 + bn + i] = bv[i];
            __syncthreads();
#pragma unroll
            for (int kk = 0; kk < 16; ++kk) {
                float a[8], b[8];
#pragma unroll
                for (int i = 0; i < 8; ++i) a[i] = As[kk * 132 + ty * 8 + i];
#pragma unroll
                for (int j = 0; j < 8; ++j) b[j] = Bs[kk * 128 + tx * 8 + j];
#pragma unroll
                for (int i = 0; i < 8; ++i)
#pragma unroll
                    for (int j = 0; j < 8; ++j) acc[i][j] += a[i] * b[j];
            }
        }
#pragma unroll
        for (int i = 0; i < 8; ++i)
#pragma unroll
            for (int j = 0; j < 8; ++j) {
                int R = tm * 128 + ty * 8 + i, n = tn * 128 + tx * 8 + j;
                if (MODE == 1) gemm1_epi(P, R, n, acc[i][j]); else gemm2_epi(P, l, R, n, acc[i][j]);
            }
    }
#endif
}

constexpr int RW_LDS = 8 * 4096 + 64;
DEV void ph_rwkv_scan(const Params& P, int l, int bid, int nblk, float* sm) {
    float *sw = sm, *sk = sw + 4096, *sb = sk + 4096, *skk = sb + 4096, *sr = skk + 4096, *sv = sr + 4096, *lora = sv + 4096, *sy = lora + 4096, *sinv = sy + 4096;
    PRIV(float, S, 64);
    for (int chain = bid; chain < 24; chain += nblk) {
        const int z = chain / 12, b = (chain / 6) % 2, h = chain % 6;
        PAR(tid) { PRIV_USE(float, S);
#pragma unroll
            for (int j = 0; j < 64; ++j) S[j] = 0.f; }
        for (int ck = 0; ck < NCHUNK; ++ck) {
            const int s0 = ck * 64;
            PAR(tid) {
                for (int idx = tid; idx < 4096; idx += NT) {
                    int t = idx >> 6, q = idx & 63; int R = scan_row(z, b, s0 + t);
                    int ch = q < 32 ? 1152 + z * 32 + q : 1216 + z * 32 + (q - 32);
                    float v = shl(P, l, R, ch);
                    lora[idx] = q < 32 ? tanhf(v) : v;
                }
            }
            SYNC();
            PAR(tid) {
                for (int idx = tid; idx < 4096; idx += NT) {
                    int t = idx >> 6, j = idx & 63, c = h * 64 + j; int R = scan_row(z, b, s0 + t);
                    float r_ = shl(P, l, R, c), k_ = shl(P, l, R, 384 + c), v_ = shl(P, l, R, 768 + c);
                    float wp = P.rw_w0[(l * 2 + z) * 384 + c], ap = P.rw_a0[(l * 2 + z) * 384 + c];
                    for (int rr = 0; rr < 32; ++rr) {
                        wp += lora[t * 64 + rr] * P.rw_w_up[((l * 2 + z) * 32 + rr) * 384 + c];
                        ap += lora[t * 64 + 32 + rr] * P.rw_a_up[((l * 2 + z) * 32 + rr) * 384 + c];
                    }
                    float w = expf(-0.6065306597126334f * sigmoidf_(wp)), a = sigmoidf_(ap);
                    sw[idx] = w; sk[idx] = k_ * (1.f + (a - 1.f) * P.rw_k_a[l * 384 + c]); sb[idx] = a;
                    skk[idx] = k_ * P.rw_k_k[l * 384 + c]; sr[idx] = r_; sv[idx] = v_;
                }
            }
            SYNC();
            PAR(tid) {
                if (tid < 64) {
                    int t = tid; float ss = 0.f, bn = 0.f;
                    for (int j = 0; j < 64; ++j) { float q = skk[t * 64 + j]; ss += q * q; bn += sr[t * 64 + j] * sk[t * 64 + j] * P.rw_r_k[l * 384 + h * 64 + j]; }
                    sinv[t] = 1.f / sqrtf(ss + 1e-6f);
                    int R = scan_row(z, b, s0 + t);
                    P.bon[((size_t)z * NROWS + R) * 6 + h] = bn;
                }
            }
            SYNC();
            PAR(tid) {
                for (int idx = tid; idx < 4096; idx += NT) { int t = idx >> 6; float kn = skk[idx] * sinv[t]; skk[idx] = kn; sb[idx] = sb[idx] * kn; }
            }
            SYNC();
            PAR(tid) { PRIV_USE(float, S);
                if (tid < 64) {
                    for (int t = 0; t < 64; ++t) {
                        float sa = 0.f;
#pragma unroll
                        for (int j = 0; j < 64; ++j) sa += S[j] * skk[t * 64 + j];
                        float vv = sv[t * 64 + tid], y = 0.f;
#pragma unroll
                        for (int j = 0; j < 64; ++j) { S[j] = S[j] * sw[t * 64 + j] - sa * sb[t * 64 + j] + vv * sk[t * 64 + j]; y += S[j] * sr[t * 64 + j]; }
                        sy[t * 64 + tid] = y;
                    }
                }
            }
            SYNC();
            PAR(tid) {
                for (int idx = tid; idx < 4096; idx += NT) { int t = idx >> 6, j = idx & 63; int R = scan_row(z, b, s0 + t); P.Y[((size_t)z * NROWS + R) * 384 + h * 64 + j] = sy[idx]; }
            }
            SYNC();
        }
    }
}
DEV void ph_rwkv_fin(const Params& P, int l, int bid, int nblk) {
    PAR(tid) {
        for (int idx = bid * NT + tid; idx < NROWS * 6; idx += nblk * NT) {
            int R = idx / 6, h = idx % 6;
            const float* y0 = P.Y + (size_t)R * 384 + h * 64; const float* y1 = P.Y + ((size_t)NROWS + R) * 384 + h * 64;
            float mu = 0.f;
            for (int j = 0; j < 64; ++j) mu += y0[j] + y1[j];
            mu *= (1.f / 64.f);
            float var = 0.f;
            for (int j = 0; j < 64; ++j) { float d = y0[j] + y1[j] - mu; var += d * d; }
            float rs = 1.f / sqrtf(var * (1.f / 64.f) + 64e-5f);
            float bonus = P.bon[(size_t)R * 6 + h] + P.bon[((size_t)NROWS + R) * 6 + h];
            for (int j = 0; j < 64; ++j) {
                int c = h * 64 + j;
                float y = (y0[j] + y1[j] - mu) * rs * P.rw_ln_g[l * 384 + c] + P.rw_ln_b[l * 384 + c];
                y += bonus * shl(P, l, R, 768 + c);
                float g = (float)P.p[(size_t)R * INW + 1280 + c];
                P.p[(size_t)R * INW + 1280 + c] = (f16)(y * siluf_(g));
            }
        }
    }
}

constexpr int S5_LDS = 1024 + 8192 + 1024 + 1024;
DEV void ph_s5_scan(const Params& P, int l, int bid, int nblk, float* sm) {
    float *su = sm, *shb = su + 1024, *scre = shb + 8192, *scim = scre + 1024;
    PRIV(float, st, 36);
    for (int item = bid; item < 32; item += nblk) {
        const int b = item / 16, g = item % 16;
        for (int z = 0; z < 2; ++z) {
            PAR(tid) { PRIV_USE(float, st);
                if (tid < 64) {
                    int n = tid; int pi = ((l * 2 + z) * 16 + g) * 64 + n;
                    float are_ = P.s5_a_re[pi], aim_ = P.s5_a_im[pi], dt = expf(P.s5_log_dt[pi]);
                    float mag = expf(are_ * dt), abr = mag * cosf(aim_ * dt), abi = mag * sinf(aim_ * dt);
                    float den = are_ * are_ + aim_ * aim_;
                    float qre = ((abr - 1.f) * are_ + abi * aim_) / den, qim = (abi * are_ - (abr - 1.f) * aim_) / den;
                    st[0] = abr; st[1] = abi;
#pragma unroll
                    for (int pp = 0; pp < 16; ++pp) {
                        float br = P.s5_b_re[(size_t)pi * 16 + pp], bi = P.s5_b_im[(size_t)pi * 16 + pp];
                        st[2 + pp] = qre * br - qim * bi; st[18 + pp] = qre * bi + qim * br;
                    }
                    st[34] = 0.f; st[35] = 0.f;
                }
                for (int idx = tid; idx < 1024; idx += NT) {
                    scre[idx] = P.s5_c_re[(size_t)((l * 2 + z) * 16 + g) * 1024 + idx];
                    scim[idx] = P.s5_c_im[(size_t)((l * 2 + z) * 16 + g) * 1024 + idx];
                }
            }
            SYNC();
            for (int ck = 0; ck < NCHUNK; ++ck) {
                const int s0 = ck * 64;
                PAR(tid) {
                    for (int idx = tid; idx < 1024; idx += NT) { int t = idx >> 4, pp = idx & 15; int R = scan_row(z, b, s0 + t); su[idx] = (float)P.p[(size_t)R * INW + 1664 + g * 16 + pp]; }
                }
                SYNC();
                PAR(tid) { PRIV_USE(float, st);
                    if (tid < 64) {
                        float hre = st[34], him = st[35];
                        for (int t = 0; t < 64; ++t) {
                            float bur = 0.f, bui = 0.f;
#pragma unroll
                            for (int pp = 0; pp < 16; ++pp) { float u = su[t * 16 + pp]; bur += st[2 + pp] * u; bui += st[18 + pp] * u; }
                            float nr = st[0] * hre - st[1] * him + bur, ni = st[0] * him + st[1] * hre + bui;
                            hre = nr; him = ni;
                            shb[t * 128 + tid] = hre; shb[t * 128 + 64 + tid] = him;
                        }
                        st[34] = hre; st[35] = him;
                    }
                }
                SYNC();
                PAR(tid) {
                    for (int idx = tid; idx < 1024; idx += NT) {
                        int t = idx >> 4, pp = idx & 15; float y = 0.f;
                        for (int n = 0; n < 64; ++n) y += scre[pp * 64 + n] * shb[t * 128 + n] - scim[pp * 64 + n] * shb[t * 128 + 64 + n];
                        int R = scan_row(z, b, s0 + t); float* dst = P.ys5 + (size_t)R * 256 + g * 16 + pp;
                        if (z == 0) *dst = y; else *dst += y;
                    }
                }
                SYNC();
            }
        }
    }
}
DEV void ph_s5_gelu(const Params& P, int l, int bid, int nblk) {
    PAR(tid) {
        for (size_t idx = (size_t)bid * NT + tid; idx < (size_t)NROWS * 256; idx += (size_t)nblk * NT) {
            int R = (int)(idx >> 8), j = (int)(idx & 255);
            float u = (float)P.p[(size_t)R * INW + 1664 + j];
            float y = P.ys5[idx] + P.s5_d[l * 256 + j] * u;
            P.ys5[idx] = 0.5f * y * (1.f + tanhf(0.7978845608028654f * (y + 0.044715f * y * y * y)));
        }
    }
}
DEV void ph_s5_glu(const Params& P, int l, int bid, int nblk) {
    PAR(tid) {
        for (size_t idx = (size_t)bid * NT + tid; idx < (size_t)NROWS * 256; idx += (size_t)nblk * NT) {
            int R = (int)(idx >> 8), j = (int)(idx & 255);
            const float* yr = P.ys5 + (size_t)R * 256;
            float acc = P.s5_glu_b[l * 256 + j];
            for (int i = 0; i < 256; ++i) acc += yr[i] * P.s5_glu_w[((size_t)l * 256 + i) * 256 + j];
            float g = (float)P.p[(size_t)R * INW + 1920 + j];
            P.p[(size_t)R * INW + 1920 + j] = (f16)(yr[j] * sigmoidf_(acc) * siluf_(g));
        }
    }
}

DEV float ml_xm(const Params& P, int R, int c) { return (float)P.p[(size_t)R * INW + 2176 + c]; }
DEV float ml_xc(const Params& P, int l, int R, int c) {
    int t, len; if (R < NCTX) { t = R % CTX; len = CTX; } else { t = (R - NCTX) % SEQ; len = SEQ; }
    float a = P.ml_conv_b[l * 384 + c] + P.ml_conv_w[(l * 3 + 1) * 384 + c] * ml_xm(P, R, c);
    if (t > 0) a += P.ml_conv_w[(l * 3 + 0) * 384 + c] * ml_xm(P, R - 1, c);
    if (t < len - 1) a += P.ml_conv_w[(l * 3 + 2) * 384 + c] * ml_xm(P, R + 1, c);
    return siluf_(a);
}
DEV void ph_ml_qkv(const Params& P, int l, int bid, int nblk) {
    PAR(tid) {
        for (int idx = bid * NT + tid; idx < NROWS * 96; idx += nblk * NT) {
            int R = idx / 96, n = idx % 96;
            float xc[4], xm[4];
            for (int j = 0; j < 4; ++j) { xc[j] = ml_xc(P, l, R, 4 * n + j); xm[j] = ml_xm(P, R, 4 * n + j); }
            for (int i = 0; i < 4; ++i) {
                float q = 0.f, k = 0.f, v = 0.f;
                for (int j = 0; j < 4; ++j) {
                    int wi = ((l * 96 + n) * 4 + j) * 4 + i;
                    q += xc[j] * P.ml_wq[wi]; k += xc[j] * P.ml_wk[wi]; v += xm[j] * P.ml_wv[wi];
                }
                float* o = P.qkv + (size_t)R * 1152 + 4 * n + i; o[0] = q; o[384] = k; o[768] = v;
            }
        }
    }
}
DEV void ph_ml_gates(const Params& P, int l, int bid, int nblk) {
    PAR(tid) {
        for (int idx = bid * NT + tid; idx < NROWS * 16; idx += nblk * NT) {
            int R = idx >> 4, o = idx & 15, z = o >> 3, hh = (o >> 1) & 3, which = o & 1;
            const float* W = (which ? P.ml_wf : P.ml_wi) + (size_t)(l * 2 + z) * 1152 * 4;
            float acc = (which ? P.ml_bf : P.ml_bi)[(l * 2 + z) * 4 + hh];
            const float* g = P.qkv + (size_t)R * 1152;
            for (int c = 0; c < 1152; ++c) acc += g[c] * W[c * 4 + hh];
            P.gates[idx] = which ? sigmoidf_(acc) : expf(acc);
        }
    }
}
constexpr int ML_LDS = 3 * 6144 + 64 * 97 + 128;
DEV void ph_ml_scan(const Params& P, int l, int bid, int nblk, float* sm) {
    float *sq = sm, *sk = sq + 6144, *sv = sk + 6144, *snum = sv + 6144, *sf = snum + 64 * 97, *si = sf + 64;
    PRIV(float, C, 96);
    for (int chain = bid; chain < 16; chain += nblk) {
        const int z = chain / 8, b = (chain / 4) % 2, hh = chain % 4;
        PAR(tid) { PRIV_USE(float, C);
#pragma unroll
            for (int j = 0; j < 96; ++j) C[j] = 0.f; }
        for (int ck = 0; ck < NCHUNK; ++ck) {
            const int s0 = ck * 64;
            PAR(tid) {
                for (int idx = tid; idx < 6144; idx += NT) {
                    int t = idx / 96, j = idx % 96; int R = scan_row(z, b, s0 + t);
                    const float* g = P.qkv + (size_t)R * 1152 + hh * 96 + j;
                    sq[idx] = g[0]; sk[idx] = g[384] * 0.10206207261596577f; sv[idx] = g[768];
                }
                if (tid < 64) { int R = scan_row(z, b, s0 + tid); sf[tid] = P.gates[R * 16 + z * 8 + hh * 2 + 1]; si[tid] = P.gates[R * 16 + z * 8 + hh * 2]; }
            }
            SYNC();
            PAR(tid) { PRIV_USE(float, C);
                if (tid < 97) {
                    for (int t = 0; t < 64; ++t) {
                        float f = sf[t], iv = si[t] * (tid < 96 ? sv[t * 96 + (tid < 96 ? tid : 0)] : 1.f), num = 0.f;
#pragma unroll
                        for (int j = 0; j < 96; ++j) { C[j] = C[j] * f + iv * sk[t * 96 + j]; num += C[j] * sq[t * 96 + j]; }
                        snum[t * 97 + tid] = num;
                    }
                }
            }
            SYNC();
            PAR(tid) {
                for (int idx = tid; idx < 6144; idx += NT) {
                    int t = idx / 96, j = idx % 96; int R = scan_row(z, b, s0 + t);
                    float den = snum[t * 97 + 96];
                    P.Y[((size_t)z * NROWS + R) * 384 + hh * 96 + j] = snum[t * 97 + j] / fmaxf(fabsf(den), 1.f);
                }
            }
            SYNC();
        }
    }
}
DEV void ph_ml_fin(const Params& P, int l, int bid, int nblk) {
    PAR(tid) {
        for (int idx = bid * NT + tid; idx < NROWS * 4; idx += nblk * NT) {
            int R = idx >> 2, hh = idx & 3;
            const float* y0 = P.Y + (size_t)R * 384 + hh * 96; const float* y1 = P.Y + ((size_t)NROWS + R) * 384 + hh * 96;
            float mu = 0.f;
            for (int j = 0; j < 96; ++j) mu += y0[j] + y1[j];
            mu *= (1.f / 96.f);
            float var = 0.f;
            for (int j = 0; j < 96; ++j) { float d = y0[j] + y1[j] - mu; var += d * d; }
            float rs = 1.f / sqrtf(var * (1.f / 96.f) + 1e-6f);
            for (int j = 0; j < 96; ++j) {
                int c = hh * 96 + j;
                float hv = (y0[j] + y1[j] - mu) * rs * P.ml_norm_g[l * 384 + c] + P.ml_skip[l * 384 + c] * ml_xc(P, l, R, c);
                float zg = (float)P.p[(size_t)R * INW + 2560 + c];
                P.p[(size_t)R * INW + 2560 + c] = (f16)(hv * siluf_(zg));
            }
        }
    }
}
DEV void ph_final(const Params& P, int bid, int nblk) {
    PAR(tid) {
        for (int r = bid * NT + tid; r < NLAT; r += nblk * NT) {
            float* xr = P.out + (size_t)r * D; float ss = 0.f;
            for (int k = 0; k < D; ++k) ss += xr[k] * xr[k];
            float rs = 1.f / sqrtf(ss * (1.f / D) + 1e-6f);
            for (int k = 0; k < D; ++k) xr[k] = xr[k] * rs * P.final_g[k];
        }
    }
}


#ifndef CPU_EMU
typedef _Float16 half8 __attribute__((ext_vector_type(8)));
typedef _Float16 half4 __attribute__((ext_vector_type(4)));
typedef float floatx16 __attribute__((ext_vector_type(16)));
typedef float floatx4 __attribute__((ext_vector_type(4)));
typedef unsigned uintx4 __attribute__((ext_vector_type(4)));

__device__ __forceinline__ float wave_sum(float v) {
#pragma unroll
    for (int o = 1; o < 64; o <<= 1) v += __shfl_xor(v, o);
    return v;
}
__device__ __forceinline__ void ph_mods2(const Params& P, int bid, int nblk, float* sm) {
    const int tid = threadIdx.x, cl = tid & 15, kq = tid >> 4;
    for (int g = bid; g < 2 * 3 * 3072 / 16; g += nblk) {
        const int idx = g * 16 + cl; const int l = idx / 9216, rem = idx % 9216, j = rem / 3072, col = rem % 3072;
        const float* cin = j < 2 ? P.c + j * D : P.c_ctx;
        float acc = 0.f;
        for (int k = kq * 64; k < kq * 64 + 64; ++k) acc += siluf_(cin[k]) * P.ada_w[((size_t)l * D + k) * 3072 + col];
        sm[kq * 16 + cl] = acc;
        __syncthreads();
        if (tid < 16) { float s = P.ada_b[l * 3072 + col]; for (int q = 0; q < 16; ++q) s += sm[q * 16 + tid]; P.mods[idx] = s; }
        __syncthreads();
    }
}
__device__ __forceinline__ void ph_wprep(const Params& P, int bid, int nblk, float* sm) {
    const int tid = threadIdx.x;
    constexpr int T_IN = 16 * 46, T_OUT = 16 * 16;
    for (int t = bid; t < 2 * (T_IN + T_OUT); t += nblk) {
        int l = t / (T_IN + T_OUT), r = t % (T_IN + T_OUT);
        const float* W; f16* Wt; int N, tk, tn;
        if (r < T_IN) { W = P.w_in + (size_t)l * D * INW; Wt = P.wt_in + (size_t)l * INW * D; N = INW; tk = r / 46; tn = r % 46; }
        else { r -= T_IN; W = P.w_out + (size_t)l * D * D; Wt = P.wt_out + (size_t)l * D * D; N = D; tk = r / 16; tn = r % 16; }
#pragma unroll
        for (int i = 0; i < 4; ++i) {
            int k = (tid >> 4) + 16 * i, n4 = (tid & 15) * 4;
            floatx4 v = *(const floatx4*)(W + (size_t)(tk * 64 + k) * N + tn * 64 + n4);
            sm[k * 65 + n4] = v[0]; sm[k * 65 + n4 + 1] = v[1]; sm[k * 65 + n4 + 2] = v[2]; sm[k * 65 + n4 + 3] = v[3];
        }
        __syncthreads();
#pragma unroll
        for (int i = 0; i < 2; ++i) {
            int n = (tid >> 3) + 32 * i, k8 = (tid & 7) * 8;
            half8 h;
#pragma unroll
            for (int j = 0; j < 8; ++j) h[j] = (f16)sm[(k8 + j) * 65 + n];
            *(half8*)(Wt + (size_t)(tn * 64 + n) * D + tk * 64 + k8) = h;
        }
        __syncthreads();
    }
}
__device__ __forceinline__ void ph_hx(const Params& P, int l, int bid, int nblk) {
    const int lane = threadIdx.x & 63, wv = threadIdx.x >> 6;
    for (int R = bid * 4 + wv; R < NROWS; R += nblk * 4) {
        const float* xr = xrow(P, l, R);
        floatx4 v[4]; float ss = 0.f;
#pragma unroll
        for (int i = 0; i < 4; ++i) { v[i] = *(const floatx4*)(xr + i * 256 + lane * 4); ss += v[i][0] * v[i][0] + v[i][1] * v[i][1] + v[i][2] * v[i][2] + v[i][3] * v[i][3]; }
        ss = wave_sum(ss);
        const float rs = 1.f / sqrtf(ss * (1.f / D) + 1e-6f);
        const float* m = P.mods + (l * 3 + row_mod(R)) * 3072; const float* g = P.norm_g + l * D;
#pragma unroll
        for (int i = 0; i < 4; ++i) {
            int k = i * 256 + lane * 4; half4 h;
#pragma unroll
            for (int j = 0; j < 4; ++j) h[j] = (f16)(v[i][j] * rs * g[k + j] * (1.f + m[D + k + j]) + m[k + j]);
            *(half4*)(P.hx + (size_t)R * D + k) = h;
        }
    }
}
template <int MODE>
__device__ __forceinline__ void gemm_epi_tile(const Params& P, int l, const floatx16 acc, int R0, int n0, int lane) {
#pragma unroll
    for (int r = 0; r < 16; ++r) {
        const int R = R0 + (r & 3) + 8 * (r >> 2) + 4 * (lane >> 5), n = n0 + (lane & 31);
        if (MODE == 1) gemm1_epi(P, R, n, acc[r]); else gemm2_epi(P, l, R, n, acc[r]);
    }
}
constexpr int G_LDA = 72;
constexpr int GEMM_LDS_BYTES = 2 * 2 * 128 * G_LDA * 2;
template <int MODE>
__device__ __forceinline__ void ph_gemm_mfma(const Params& P, int l, int bid, int nblk, unsigned char* smraw) {
    constexpr int N = MODE == 1 ? INW : D, K = D;
    const f16* Bt = MODE == 1 ? P.wt_in + (size_t)l * INW * D : P.wt_out + (size_t)l * D * D;
    const int tm0 = (MODE == 2 && l == 1) ? NCTX / 128 : 0;
    const int ntm = NROWS / 128 - tm0, ntn = N / 128;
    const int tid = threadIdx.x, lane = tid & 63, wv = tid >> 6, wm = wv & 1, wn = wv >> 1;
    f16* sbase = (f16*)smraw;
    const int ldrow = tid >> 3, ldch = tid & 7;
    constexpr int GM = 16;
    for (int t = bid; t < ntm * ntn; t += nblk) {
        int sg = t / (GM * ntn), rem = t % (GM * ntn);
        int gsz = ntm - sg * GM < GM ? ntm - sg * GM : GM;
        const int tm = tm0 + sg * GM + rem % gsz, tn = rem / gsz;
        floatx16 acc00, acc01, acc10, acc11;
#pragma unroll
        for (int r = 0; r < 16; ++r) { acc00[r] = 0.f; acc01[r] = 0.f; acc10[r] = 0.f; acc11[r] = 0.f; }
        uintx4 ra0, ra1, ra2, ra3, rb0, rb1, rb2, rb3;
        const f16* arow = MODE == 1 ? P.hx + (size_t)(tm * 128 + ldrow) * D + ldch * 8 : P.p + (size_t)(tm * 128 + ldrow) * INW + ldch * 8;
        const size_t astr = (size_t)32 * (MODE == 1 ? D : INW);
        const f16* brow = Bt + (size_t)(tn * 128 + ldrow) * K + ldch * 8;
#define GLOAD(kt_) { const int ka = MODE == 1 ? (kt_) * 64 : a2col((kt_) * 64); const int kb = (kt_) * 64; \
            ra0 = *(const uintx4*)(arow + ka); ra1 = *(const uintx4*)(arow + astr + ka); ra2 = *(const uintx4*)(arow + 2 * astr + ka); ra3 = *(const uintx4*)(arow + 3 * astr + ka); \
            rb0 = *(const uintx4*)(brow + kb); rb1 = *(const uintx4*)(brow + (size_t)32 * K + kb); rb2 = *(const uintx4*)(brow + (size_t)64 * K + kb); rb3 = *(const uintx4*)(brow + (size_t)96 * K + kb); }
#define SWRITE(st_) { f16* sA_ = sbase + (st_) * (2 * 128 * G_LDA) + ldrow * G_LDA + ldch * 8; f16* sB_ = sA_ + 128 * G_LDA; \
            *(uintx4*)(sA_) = ra0; *(uintx4*)(sA_ + 32 * G_LDA) = ra1; *(uintx4*)(sA_ + 64 * G_LDA) = ra2; *(uintx4*)(sA_ + 96 * G_LDA) = ra3; \
            *(uintx4*)(sB_) = rb0; *(uintx4*)(sB_ + 32 * G_LDA) = rb1; *(uintx4*)(sB_ + 64 * G_LDA) = rb2; *(uintx4*)(sB_ + 96 * G_LDA) = rb3; }
        __syncthreads();
        GLOAD(0); SWRITE(0);
        __syncthreads();
        for (int kt = 0; kt < K / 64; ++kt) {
            if (kt + 1 < K / 64) GLOAD(kt + 1);
            const f16* sA = sbase + (kt & 1) * (2 * 128 * G_LDA); const f16* sB = sA + 128 * G_LDA;
#pragma unroll
            for (int ks = 0; ks < 4; ++ks) {
                const int kof = ks * 16 + (lane >> 5) * 8;
                const half8 af0 = *(const half8*)(sA + (wm * 64 + (lane & 31)) * G_LDA + kof);
                const half8 af1 = *(const half8*)(sA + (wm * 64 + 32 + (lane & 31)) * G_LDA + kof);
                const half8 bf0 = *(const half8*)(sB + (wn * 64 + (lane & 31)) * G_LDA + kof);
                const half8 bf1 = *(const half8*)(sB + (wn * 64 + 32 + (lane & 31)) * G_LDA + kof);
                acc00 = __builtin_amdgcn_mfma_f32_32x32x16_f16(af0, bf0, acc00, 0, 0, 0);
                acc01 = __builtin_amdgcn_mfma_f32_32x32x16_f16(af0, bf1, acc01, 0, 0, 0);
                acc10 = __builtin_amdgcn_mfma_f32_32x32x16_f16(af1, bf0, acc10, 0, 0, 0);
                acc11 = __builtin_amdgcn_mfma_f32_32x32x16_f16(af1, bf1, acc11, 0, 0, 0);
            }
            if (kt + 1 < K / 64) SWRITE((kt + 1) & 1);
            __syncthreads();
        }
#undef GLOAD
#undef SWRITE
        gemm_epi_tile<MODE>(P, l, acc00, tm * 128 + wm * 64, tn * 128 + wn * 64, lane);
        gemm_epi_tile<MODE>(P, l, acc01, tm * 128 + wm * 64, tn * 128 + wn * 64 + 32, lane);
        gemm_epi_tile<MODE>(P, l, acc10, tm * 128 + wm * 64 + 32, tn * 128 + wn * 64, lane);
        gemm_epi_tile<MODE>(P, l, acc11, tm * 128 + wm * 64 + 32, tn * 128 + wn * 64 + 32, lane);
    }
}
#endif


#ifndef CPU_EMU
typedef __bf16 bf16;
typedef __bf16 bf16x8 __attribute__((ext_vector_type(8)));
typedef __bf16 bf16x4 __attribute__((ext_vector_type(4)));
constexpr int RLD = 72;
constexpr int RSLOT = 64 * RLD;
constexpr int RWP1_LDS_BYTES = 11 * RSLOT * 2 + 2 * 64 * 65 * 4 + 768 * 4 + 64 * 4;

__device__ __forceinline__ bf16x8 ldfrag(const bf16* M, int rowbase, int lane, int ks) {
    return *(const bf16x8*)(M + (rowbase + (lane & 31)) * RLD + ks * 16 + (lane >> 5) * 8);
}
__device__ __forceinline__ floatx16 mm64(const bf16* A, const bf16* Bt, int wm, int wn, int lane) {
    floatx16 acc;
#pragma unroll
    for (int r = 0; r < 16; ++r) acc[r] = 0.f;
#pragma unroll
    for (int ks = 0; ks < 4; ++ks) acc = __builtin_amdgcn_mfma_f32_32x32x16_bf16(ldfrag(A, wm * 32, lane, ks), ldfrag(Bt, wn * 32, lane, ks), acc, 0, 0, 0);
    return acc;
}
__device__ __forceinline__ void storeT(bf16* dst, const floatx16 c, int wm, int wn, int lane) {
    const int n = wn * 32 + (lane & 31);
#pragma unroll
    for (int g = 0; g < 4; ++g) {
        const int m0 = wm * 32 + 8 * g + 4 * (lane >> 5);
        bf16x4 v; v[0] = (bf16)c[4 * g]; v[1] = (bf16)c[4 * g + 1]; v[2] = (bf16)c[4 * g + 2]; v[3] = (bf16)c[4 * g + 3];
        *(bf16x4*)(dst + n * RLD + m0) = v;
    }
}

__device__ __forceinline__ void ph_rw_p1(const Params& P, int l, int bid, int nblk, unsigned char* smraw) {
    bf16* sl = (bf16*)smraw;
    bf16 *Am = sl, *AmT = sl + RSLOT, *Bp = sl + 2 * RSLOT, *Kp = sl + 3 * RSLOT, *Rt = sl + 4 * RSLOT, *VT = sl + 5 * RSLOT,
         *BendT = sl + 6 * RSLOT, *KendT = sl + 7 * RSLOT, *Nak = sl + 8 * RSLOT, *Mrb = sl + 9 * RSLOT, *Mrk = sl + 10 * RSLOT;
    bf16 *Tb = Am, *UtT = AmT, *WmT = Bp, *NVT = Kp;
    float* Nf = (float*)(smraw + 11 * RSLOT * 2); float* Tf = Nf + 64 * 65; float* Wb = Tf + 64 * 65; float* gl = Wb + 768;
    float* lora = Nf; float* lwb = Tf;
    const int tid = threadIdx.x, lane = tid & 63, wv = tid >> 6, wm = wv & 1, wn = wv >> 1;
    f16* PTg = (f16*)P.qkv; f16* RPg = PTg + (size_t)24 * NCHUNK * 4096; f16* Qg = RPg + (size_t)24 * NCHUNK * 4096;
    for (int item = bid; item < 24 * NCHUNK; item += nblk) {
        const int chain = item / NCHUNK, ck = item % NCHUNK;
        const int z = chain / 12, b = (chain / 6) % 2, h = chain % 6, s0 = ck * 64;
        const int j = lane, tq = wv, c = h * 64 + j;
        {
            const int ch = lane < 32 ? 1152 + z * 32 + lane : 1216 + z * 32 + (lane - 32);
#pragma unroll 4
            for (int tt = 0; tt < 16; ++tt) {
                const int t = tq * 16 + tt; const int R = scan_row(z, b, s0 + t);
                const float v = shl(P, l, R, ch);
                lora[t * 64 + lane] = lane < 32 ? tanhf(v) : v;
            }
        }
        __syncthreads();
        {
            float wup[32];
#pragma unroll
            for (int r = 0; r < 32; ++r) wup[r] = P.rw_w_up[((l * 2 + z) * 32 + r) * 384 + c];
            const float w0 = P.rw_w0[(l * 2 + z) * 384 + c];
#pragma unroll 4
            for (int tt = 0; tt < 16; ++tt) {
                const int t = tq * 16 + tt; float wp = w0;
#pragma unroll
                for (int r = 0; r < 32; ++r) wp += lora[t * 64 + r] * wup[r];
                lwb[t * 64 + j] = -0.6065306597126334f * sigmoidf_(wp);
            }
        }
        __syncthreads();
        {
            float aup[32];
#pragma unroll
            for (int r = 0; r < 32; ++r) aup[r] = P.rw_a_up[((l * 2 + z) * 32 + r) * 384 + c];
            const float a0 = P.rw_a0[(l * 2 + z) * 384 + c], kkc = P.rw_k_k[l * 384 + c], kac = P.rw_k_a[l * 384 + c], rkc = P.rw_r_k[l * 384 + c];
            float gpre = 0.f, gtot = 0.f;
            for (int t2 = 0; t2 < 64; ++t2) { const float x = lwb[t2 * 64 + j]; gtot += x; if (t2 < tq * 16) gpre += x; }
            if (tq == 0) gl[j] = expf(gtot);
            float g = gpre;
#pragma unroll 2
            for (int tt = 0; tt < 16; ++tt) {
                const int t = tq * 16 + tt; const int R = scan_row(z, b, s0 + t);
                const float r_ = shl(P, l, R, c), k_ = shl(P, l, R, 384 + c), v_ = shl(P, l, R, 768 + c);
                float ap = a0;
#pragma unroll
                for (int r = 0; r < 32; ++r) ap += lora[t * 64 + 32 + r] * aup[r];
                const float a = sigmoidf_(ap);
                const float kku = k_ * kkc;
                const float ss = wave_sum(kku * kku);
                const float kkn = kku * (1.f / sqrtf(ss + 1e-6f));
                const float kd = k_ * (1.f + (a - 1.f) * kac), bb = a * kkn;
                const float bn = wave_sum(r_ * kd * rkc);
                if (lane == 0) P.bon[((size_t)z * NROWS + R) * 6 + h] = bn;
                const float lw = lwb[t * 64 + j];
                const float gm1 = g; g += lw;
                const float e_m = expf(gm1), e_p = expf(-g), e_t = expf(g), e_e = expf(gtot - g);
                const bf16 am = (bf16)(kkn * e_m);
                Am[t * RLD + j] = am; Bp[t * RLD + j] = (bf16)(bb * e_p); Kp[t * RLD + j] = (bf16)(kd * e_p); Rt[t * RLD + j] = (bf16)(r_ * e_t);
                AmT[j * RLD + t] = am; VT[j * RLD + t] = (bf16)v_; BendT[j * RLD + t] = (bf16)(bb * e_e); KendT[j * RLD + t] = (bf16)(kd * e_e);
            }
        }
        __syncthreads();
        {
            floatx16 cab, cak, crb, crk;
#pragma unroll
            for (int r = 0; r < 16; ++r) { cab[r] = 0.f; cak[r] = 0.f; crb[r] = 0.f; crk[r] = 0.f; }
            if (!(wm == 0 && wn == 1)) {
#pragma unroll
                for (int ks = 0; ks < 4; ++ks) {
                    const bf16x8 a1 = ldfrag(Am, wm * 32, lane, ks), a2 = ldfrag(Rt, wm * 32, lane, ks), b1 = ldfrag(Bp, wn * 32, lane, ks), b2 = ldfrag(Kp, wn * 32, lane, ks);
                    cab = __builtin_amdgcn_mfma_f32_32x32x16_bf16(a1, b1, cab, 0, 0, 0);
                    cak = __builtin_amdgcn_mfma_f32_32x32x16_bf16(a1, b2, cak, 0, 0, 0);
                    crb = __builtin_amdgcn_mfma_f32_32x32x16_bf16(a2, b1, crb, 0, 0, 0);
                    crk = __builtin_amdgcn_mfma_f32_32x32x16_bf16(a2, b2, crk, 0, 0, 0);
                }
            }
#pragma unroll
            for (int r = 0; r < 16; ++r) {
                const int m = wm * 32 + (r & 3) + 8 * (r >> 2) + 4 * (lane >> 5), n = wn * 32 + (lane & 31);
                Nf[m * 65 + n] = n < m ? cab[r] : 0.f;
                Nak[m * RLD + n] = (bf16)(n < m ? cak[r] : 0.f);
                Mrb[m * RLD + n] = (bf16)(n <= m ? crb[r] : 0.f);
                Mrk[m * RLD + n] = (bf16)(n <= m ? crk[r] : 0.f);
            }
        }
        __syncthreads();
        if (tid < 64) {
            const int i = tid >> 4, jc = tid & 15; float x[16];
#pragma unroll
            for (int row = 0; row < 16; ++row) {
                float s = row == jc ? 1.f : 0.f;
#pragma unroll
                for (int m = 0; m < row; ++m) s -= Nf[(16 * i + row) * 65 + 16 * i + m] * x[m];
                x[row] = s;
            }
#pragma unroll
            for (int row = 0; row < 16; ++row) Tf[(16 * i + row) * 65 + 16 * i + jc] = x[row];
        }
        __syncthreads();
        {
            const int a = tid >> 4, cc = tid & 15;
#pragma unroll
            for (int i = 1; i < 4; ++i) {
#pragma unroll
                for (int jb = 0; jb < i; ++jb) {
                    float s = 0.f;
#pragma unroll
                    for (int mb = jb; mb < i; ++mb)
#pragma unroll
                        for (int m = 0; m < 16; ++m) s += Nf[(16 * i + a) * 65 + 16 * mb + m] * Tf[(16 * mb + m) * 65 + 16 * jb + cc];
                    Wb[jb * 256 + a * 16 + cc] = s;
                }
                __syncthreads();
#pragma unroll
                for (int jb = 0; jb < i; ++jb) {
                    float s = 0.f;
#pragma unroll
                    for (int m = 0; m < 16; ++m) s += Tf[(16 * i + a) * 65 + 16 * i + m] * Wb[jb * 256 + m * 16 + cc];
                    Tf[(16 * i + a) * 65 + 16 * jb + cc] = -s;
                }
                __syncthreads();
            }
        }
        for (int idx = tid; idx < 4096; idx += NT) { const int t = idx >> 6, s = idx & 63; Tb[t * RLD + s] = (bf16)(((s >> 4) <= (t >> 4)) ? Tf[t * 65 + s] : 0.f); }
        __syncthreads();
        { const floatx16 c1 = mm64(Tb, AmT, wm, wn, lane); const floatx16 c2 = mm64(Nak, VT, wm, wn, lane); storeT(WmT, c1, wm, wn, lane); storeT(NVT, c2, wm, wn, lane); }
        __syncthreads();
        { const floatx16 c1 = mm64(Tb, NVT, wm, wn, lane); storeT(UtT, c1, wm, wn, lane); }
        __syncthreads();
        {
            const size_t gb = (size_t)item * 4096;
            {
                const floatx16 c1 = mm64(Mrb, WmT, wm, wn, lane);
#pragma unroll
                for (int r = 0; r < 16; ++r) {
                    const int m = wm * 32 + (r & 3) + 8 * (r >> 2) + 4 * (lane >> 5), n = wn * 32 + (lane & 31);
                    RPg[gb + m * 64 + n] = (f16)((float)Rt[m * RLD + n] - c1[r]);
                }
            }
            {
                const floatx16 c2 = mm64(Mrk, VT, wm, wn, lane); const floatx16 c3 = mm64(Mrb, UtT, wm, wn, lane);
#pragma unroll
                for (int r = 0; r < 16; ++r) {
                    const int m = wm * 32 + (r & 3) + 8 * (r >> 2) + 4 * (lane >> 5), n = wn * 32 + (lane & 31);
                    const int R = scan_row(z, b, s0 + m);
                    P.Y[((size_t)z * NROWS + R) * 384 + h * 64 + n] = c2[r] - c3[r];
                }
            }
            {
                const floatx16 c4 = mm64(BendT, WmT, wm, wn, lane);
#pragma unroll
                for (int r = 0; r < 16; ++r) {
                    const int m = wm * 32 + (r & 3) + 8 * (r >> 2) + 4 * (lane >> 5), n = wn * 32 + (lane & 31);
                    PTg[gb + m * 64 + n] = (f16)((m == n ? gl[m] : 0.f) - c4[r]);
                }
            }
            {
                const floatx16 c5 = mm64(KendT, VT, wm, wn, lane); const floatx16 c6 = mm64(BendT, UtT, wm, wn, lane);
                const int n = wn * 32 + (lane & 31);
#pragma unroll
                for (int g = 0; g < 4; ++g) {
                    const int m0 = wm * 32 + 8 * g + 4 * (lane >> 5);
                    half4 v; v[0] = (f16)(c5[4 * g] - c6[4 * g]); v[1] = (f16)(c5[4 * g + 1] - c6[4 * g + 1]); v[2] = (f16)(c5[4 * g + 2] - c6[4 * g + 2]); v[3] = (f16)(c5[4 * g + 3] - c6[4 * g + 3]);
                    *(half4*)(Qg + gb + n * 64 + m0) = v;
                }
            }
        }
        __syncthreads();
    }
}

#define BAR_LDS() asm volatile("s_waitcnt lgkmcnt(0)\n\ts_barrier" ::: "memory")
__device__ __forceinline__ void ph_rw_stream(const Params& P, int l, int bid, int nblk, unsigned char* smraw) {
    f16* S16 = (f16*)smraw;
    const int tid = threadIdx.x, lane = tid & 63, wv = tid >> 6;
    const f16* PTg = (const f16*)P.qkv; const f16* RPg = PTg + (size_t)24 * NCHUNK * 4096; const f16* Qg = RPg + (size_t)24 * NCHUNK * 4096;
    for (int item = bid; item < 96; item += nblk) {
        const int chain = item >> 2, vs = item & 3;
        const int z = chain / 12, b = (chain / 6) % 2, h = chain % 6;
        __syncthreads();
        for (int idx = tid; idx < 16 * 72; idx += NT) S16[idx] = (f16)0.f;
        __syncthreads();
        const size_t cb = (size_t)chain * NCHUNK * 4096;
        const int rowA = 16 * wv + (lane & 15), kof = 8 * (lane >> 4);
        const int qoff = (vs * 16 + (lane & 15)) * 64 + 16 * wv + (lane >> 4) * 4;
        float* ycol = P.Y + (size_t)z * NROWS * 384 + h * 64 + vs * 16 + (lane & 15);
        const int trow = 16 * wv + (lane >> 4) * 4;
        half8 ap0[4], ap1[4], ar0[4], ar1[4]; half4 qv[4]; float yv[4][4];
#define RW_LOAD(slot_, ck_) { const size_t gb_ = cb + (size_t)(ck_) * 4096; \
            ap0[slot_] = *(const half8*)(PTg + gb_ + rowA * 64 + kof); ap1[slot_] = *(const half8*)(PTg + gb_ + rowA * 64 + 32 + kof); \
            ar0[slot_] = *(const half8*)(RPg + gb_ + rowA * 64 + kof); ar1[slot_] = *(const half8*)(RPg + gb_ + rowA * 64 + 32 + kof); \
            qv[slot_] = *(const half4*)(Qg + gb_ + qoff); \
            _Pragma("unroll") for (int r_ = 0; r_ < 4; ++r_) yv[slot_][r_] = ycol[(size_t)scan_row(z, b, (ck_) * 64 + trow + r_) * 384]; }
#define RW_STEP(slot_, ck_) { \
            const half8 b0_ = *(const half8*)(S16 + (lane & 15) * 72 + kof); const half8 b1_ = *(const half8*)(S16 + (lane & 15) * 72 + 32 + kof); \
            floatx4 accY_ = {0.f, 0.f, 0.f, 0.f}; \
            accY_ = __builtin_amdgcn_mfma_f32_16x16x32_f16(ar0[slot_], b0_, accY_, 0, 0, 0); accY_ = __builtin_amdgcn_mfma_f32_16x16x32_f16(ar1[slot_], b1_, accY_, 0, 0, 0); \
            floatx4 accS_; accS_[0] = (float)qv[slot_][0]; accS_[1] = (float)qv[slot_][1]; accS_[2] = (float)qv[slot_][2]; accS_[3] = (float)qv[slot_][3]; \
            accS_ = __builtin_amdgcn_mfma_f32_16x16x32_f16(ap0[slot_], b0_, accS_, 0, 0, 0); accS_ = __builtin_amdgcn_mfma_f32_16x16x32_f16(ap1[slot_], b1_, accS_, 0, 0, 0); \
            _Pragma("unroll") for (int r_ = 0; r_ < 4; ++r_) ycol[(size_t)scan_row(z, b, (ck_) * 64 + trow + r_) * 384] = yv[slot_][r_] + accY_[r_]; \
            BAR_LDS(); \
            half4 sn_; sn_[0] = (f16)accS_[0]; sn_[1] = (f16)accS_[1]; sn_[2] = (f16)accS_[2]; sn_[3] = (f16)accS_[3]; \
            *(half4*)(S16 + (lane & 15) * 72 + trow) = sn_; \
            BAR_LDS(); }
        RW_LOAD(0, 0); RW_LOAD(1, 1); RW_LOAD(2, 2);
        for (int ck = 0; ck < NCHUNK; ck += 4) {
            if (ck + 3 < NCHUNK) RW_LOAD(3, ck + 3);
            RW_STEP(0, ck);
            if (ck + 4 < NCHUNK) RW_LOAD(0, ck + 4);
            RW_STEP(1, ck + 1);
            if (ck + 5 < NCHUNK) RW_LOAD(1, ck + 5);
            RW_STEP(2, ck + 2);
            if (ck + 6 < NCHUNK) RW_LOAD(2, ck + 6);
            RW_STEP(3, ck + 3);
        }
#undef RW_LOAD
#undef RW_STEP
    }
}
#endif

constexpr size_t al256(size_t x) { return (x + 255) & ~(size_t)255; }
constexpr size_t WS_MODS = 0;
constexpr size_t WS_RSTD = al256(WS_MODS + 2 * 3 * 3072 * 4);
constexpr size_t WS_P = al256(WS_RSTD + (size_t)NROWS * 4);
constexpr size_t WS_Y = al256(WS_P + (size_t)NROWS * INW * 2);
constexpr size_t WS_QKV = al256(WS_Y + (size_t)2 * NROWS * 384 * 4);
constexpr size_t WS_GATES = al256(WS_QKV + (size_t)NROWS * 1152 * 4);
constexpr size_t WS_BON = al256(WS_GATES + (size_t)NROWS * 16 * 4);
constexpr size_t WS_YS5 = al256(WS_BON + (size_t)2 * NROWS * 6 * 4);
constexpr size_t WS_CTX1 = al256(WS_YS5 + (size_t)NROWS * 256 * 4);
constexpr size_t WS_WTIN = al256(WS_CTX1 + (size_t)NCTX * D * 4);
constexpr size_t WS_WTOUT = al256(WS_WTIN + (size_t)2 * INW * D * 2);
constexpr size_t WS_GP = al256(WS_WTOUT + (size_t)2 * D * D * 2);
constexpr size_t WS_END = al256(WS_GP + 1024);

static void fill_params(Params& P, void* const* d_in, void* d_out, void* d_ws) {
    const float** pp = (const float**)&P;
    for (int i = 0; i < 41; ++i) pp[i] = (const float*)d_in[i];
    unsigned char* ws = (unsigned char*)d_ws;
    P.out = (float*)d_out;
    P.mods = (float*)(ws + WS_MODS); P.rstd = (float*)(ws + WS_RSTD); P.p = (f16*)(ws + WS_P); P.Y = (float*)(ws + WS_Y);
    P.qkv = (float*)(ws + WS_QKV); P.gates = (float*)(ws + WS_GATES); P.bon = (float*)(ws + WS_BON); P.ys5 = (float*)(ws + WS_YS5);
    P.ctx1 = (float*)(ws + WS_CTX1);
    P.hx = (f16*)(ws + WS_QKV); P.wt_in = (f16*)(ws + WS_WTIN); P.wt_out = (f16*)(ws + WS_WTOUT);
    P.gp = (Params*)(ws + WS_GP);
}

enum { PH_MODS, PH_RSTD, PH_GEMM1, PH_RW_SCAN, PH_RW_FIN, PH_S5_SCAN, PH_S5_GELU, PH_S5_GLU, PH_ML_QKV, PH_ML_GATES, PH_ML_SCAN, PH_ML_FIN, PH_GEMM2, PH_FINAL };
constexpr int lds_floats(int ph) { return ph == PH_GEMM1 || ph == PH_GEMM2 ? 16 * 132 + 16 * 128 : ph == PH_RW_SCAN ? RW_LDS : ph == PH_S5_SCAN ? S5_LDS : ph == PH_ML_SCAN ? ML_LDS : 4; }

template <int PH>
DEV void run_phase(const Params& P, int l, int bid, int nblk, float* sm) {
    if (PH == PH_MODS) ph_mods(P, bid, nblk);
    else if (PH == PH_RSTD) ph_rstd(P, l, bid, nblk);
    else if (PH == PH_GEMM1) ph_gemm<1>(P, l, bid, nblk, sm);
    else if (PH == PH_RW_SCAN) ph_rwkv_scan(P, l, bid, nblk, sm);
    else if (PH == PH_RW_FIN) ph_rwkv_fin(P, l, bid, nblk);
    else if (PH == PH_S5_SCAN) ph_s5_scan(P, l, bid, nblk, sm);
    else if (PH == PH_S5_GELU) ph_s5_gelu(P, l, bid, nblk);
    else if (PH == PH_S5_GLU) ph_s5_glu(P, l, bid, nblk);
    else if (PH == PH_ML_QKV) ph_ml_qkv(P, l, bid, nblk);
    else if (PH == PH_ML_GATES) ph_ml_gates(P, l, bid, nblk);
    else if (PH == PH_ML_SCAN) ph_ml_scan(P, l, bid, nblk, sm);
    else if (PH == PH_ML_FIN) ph_ml_fin(P, l, bid, nblk);
    else if (PH == PH_GEMM2) ph_gemm<2>(P, l, bid, nblk, sm);
    else if (PH == PH_FINAL) ph_final(P, bid, nblk);
}

#ifndef CPU_EMU
constexpr int MEGA_LDS = RWP1_LDS_BYTES / 4 + 16;
__global__ void __launch_bounds__(NT) mega_fwd(Params Pk) {
    __shared__ __attribute__((aligned(16))) float sm[MEGA_LDS];
    cg::grid_group grid = cg::this_grid();
    const int bid = blockIdx.x, nblk = gridDim.x;
    if (threadIdx.x == 0) *Pk.gp = Pk;
    ph_mods2(Pk, bid, nblk, sm);
    ph_wprep(Pk, bid, nblk, sm);
    grid.sync();
    const Params* pg = Pk.gp;
    asm volatile("" : "+s"(pg) :: "memory");
    const Params& P = *pg;
    for (int l = 0; l < 2; ++l) {
        ph_hx(P, l, bid, nblk); grid.sync();
        ph_gemm_mfma<1>(P, l, bid, nblk, (unsigned char*)sm); grid.sync();
        ph_rw_p1(P, l, bid, nblk, (unsigned char*)sm); grid.sync();
        ph_rw_stream(P, l, bid, nblk, (unsigned char*)sm); grid.sync();
        run_phase<PH_RW_FIN>(P, l, bid, nblk, sm); grid.sync();
        run_phase<PH_S5_SCAN>(P, l, bid, nblk, sm); grid.sync();
        run_phase<PH_S5_GELU>(P, l, bid, nblk, sm); grid.sync();
        run_phase<PH_S5_GLU>(P, l, bid, nblk, sm);
        run_phase<PH_ML_QKV>(P, l, bid, nblk, sm); grid.sync();
        run_phase<PH_ML_GATES>(P, l, bid, nblk, sm); grid.sync();
        run_phase<PH_ML_SCAN>(P, l, bid, nblk, sm); grid.sync();
        run_phase<PH_ML_FIN>(P, l, bid, nblk, sm); grid.sync();
        ph_gemm_mfma<2>(P, l, bid, nblk, (unsigned char*)sm); grid.sync();
    }
    run_phase<PH_FINAL>(P, 0, bid, nblk, sm);
}

extern "C" void kernel_launch(void* const* d_in, const int* in_sizes, int n_in, void* d_out, int out_size, void* d_ws, size_t ws_size, hipStream_t stream) {
    if (ws_size < WS_END) { fprintf(stderr, "workspace too small: %zu < %zu\n", ws_size, (size_t)WS_END); return; }
    static int grid_blocks = 0;
    if (!grid_blocks) {
        int dev = 0, cus = 0, per_cu = 0;
        hipGetDevice(&dev);
        hipDeviceGetAttribute(&cus, hipDeviceAttributeMultiprocessorCount, dev);
        hipOccupancyMaxActiveBlocksPerMultiprocessor(&per_cu, mega_fwd, NT, 0);
        if (per_cu < 1) per_cu = 1;
        grid_blocks = cus * per_cu;
        fprintf(stderr, "mega_fwd: %d CUs x %d blocks/CU\n", cus, per_cu);
    }
    Params P{};
    fill_params(P, d_in, d_out, d_ws);
    void* args[] = {&P};
    hipError_t e = hipLaunchCooperativeKernel((void*)mega_fwd, dim3(grid_blocks), dim3(NT), args, 0, stream);
    if (e != hipSuccess) fprintf(stderr, "cooperative launch failed: %s (grid %d)\n", hipGetErrorString(e), grid_blocks);
}
#endif
```

```cpp
#ifndef CPU_EMU
#include <hip/hip_runtime.h>
#include <hip/hip_cooperative_groups.h>
namespace cg = cooperative_groups;
#endif
#include <cstdint>
#include <cmath>
#include <cstdio>

#ifndef SEQ
#define SEQ 16384
#endif
#ifndef CTX
#define CTX 256
#endif

typedef _Float16 f16;

constexpr int D = 1024, NB = 2, INW = 2944;
constexpr int NCTX = NB * CTX, NLAT = NB * SEQ, NROWS = NCTX + NLAT;
constexpr int TSCAN = CTX + SEQ, NCHUNK = TSCAN / 64;
constexpr int NT = 256;

#ifdef CPU_EMU
#define DEV static inline
#define PAR(tid) for (int tid = 0; tid < NT; ++tid)
#define SYNC()
#define PRIV(type, name, n) static type name##_all[NT][n]
#define PRIV_USE(type, name) type* name = name##_all[tid]
#else
#define DEV __device__ __forceinline__
#define PAR(tid) for (int tid = ltid(), once_ = 1; once_; once_ = 0)
#define SYNC() __syncthreads()
#define PRIV(type, name, n) type name[n]
#define PRIV_USE(type, name)
#endif


#ifndef CPU_EMU
__device__ __forceinline__ int ltid() { int t = threadIdx.x; asm volatile("" : "+v"(t)); return t; }
__device__ __forceinline__ int lsgpr(int x) { asm volatile("" : "+s"(x)); return x; }
#endif

struct Params {
    const float *x, *c, *ctx, *c_ctx, *ada_w, *ada_b, *norm_g, *w_in, *w_out;
    const float *rw_mu, *rw_w0, *rw_w_up, *rw_a0, *rw_a_up, *rw_k_k, *rw_k_a, *rw_r_k, *rw_ln_g, *rw_ln_b;
    const float *s5_a_re, *s5_a_im, *s5_log_dt, *s5_b_re, *s5_b_im, *s5_c_re, *s5_c_im, *s5_d, *s5_glu_w, *s5_glu_b;
    const float *ml_conv_w, *ml_conv_b, *ml_wq, *ml_wk, *ml_wv, *ml_wi, *ml_bi, *ml_wf, *ml_bf, *ml_norm_g, *ml_skip;
    const float* final_g;
    float* out;
    float* mods;
    float* rstd;
    f16* p;
    float* Y;
    float* qkv;
    float* gates;
    float* bon;
    float* ys5;
    float* ctx1;
    f16* hx;
    f16* wt_in;
    f16* wt_out;
    float* s5par;
    float* s5h;
    f16* yg;
    f16* glut;
    f16* qkv16;
    float* mlC;
    float* mlG;
    Params* gp;
};

DEV float sigmoidf_(float x) { return 1.f / (1.f + expf(-x)); }
DEV float siluf_(float x) { return x / (1.f + expf(-x)); }

DEV int scan_row(int z, int b, int s) {
    if (s < CTX) { int t = z ? CTX - 1 - s : s; return b * CTX + t; }
    int u = s - CTX; int t = z ? SEQ - 1 - u : u; return NCTX + b * SEQ + t;
}
DEV int row_mod(int R) { return R < NCTX ? 2 : (R - NCTX) / SEQ; }
DEV const float* xrow(const Params& P, int l, int R) {
    const float* xl = l == 0 ? P.x : P.out; const float* xc = l == 0 ? P.ctx : P.ctx1;
    return R < NCTX ? xc + (size_t)R * D : xl + (size_t)(R - NCTX) * D;
}
DEV int nbr_row(int R, int c) {
    if (R < NCTX) { int t = R % CTX; if ((c & 1) == 0) return t > 0 ? R - 1 : -1; return t < CTX - 1 ? R + 1 : -1; }
    int t = (R - NCTX) % SEQ; int m = c & 3, col = t & 63;
    if (m == 0) return col > 0 ? R - 1 : -1;
    if (m == 1) return col < 63 ? R + 1 : -1;
    if (m == 2) return t >= 64 ? R - 64 : -1;
    return t < SEQ - 64 ? R + 64 : -1;
}
DEV float shl(const Params& P, int l, int R, int c) {
    float pv = (float)P.p[(size_t)R * INW + c];
    int nb = nbr_row(R, c);
    float nv = nb >= 0 ? (float)P.p[(size_t)nb * INW + c] : 0.f;
    return pv + (nv - pv) * P.rw_mu[l * 1280 + c];
}

DEV void ph_mods(const Params& P, int bid, int nblk) {
    PAR(tid) {
        for (int idx = bid * NT + tid; idx < 2 * 3 * 3072; idx += nblk * NT) {
            int l = idx / 9216, rem = idx % 9216, j = rem / 3072, col = rem % 3072;
            const float* cin = j < 2 ? P.c + j * D : P.c_ctx;
            float acc = P.ada_b[l * 3072 + col];
            for (int k = 0; k < D; ++k) acc += siluf_(cin[k]) * P.ada_w[((size_t)l * D + k) * 3072 + col];
            P.mods[idx] = acc;
        }
    }
}
DEV void ph_rstd(const Params& P, int l, int bid, int nblk) {
    PAR(tid) {
        for (int R = bid * NT + tid; R < NROWS; R += nblk * NT) {
            const float* xr = xrow(P, l, R); float ss = 0.f;
            for (int k = 0; k < D; ++k) ss += xr[k] * xr[k];
            P.rstd[R] = 1.f / sqrtf(ss * (1.f / D) + 1e-6f);
        }
    }
}
DEV float gemm1_a(const Params& P, int l, int R, int k) {
    int j = row_mod(R); const float* m = P.mods + (l * 3 + j) * 3072;
    return xrow(P, l, R)[k] * P.rstd[R] * P.norm_g[l * D + k] * (1.f + m[D + k]) + m[k];
}
DEV int a2col(int k) { return k < 384 ? 1280 + k : (k < 640 ? 1920 + (k - 384) : 2560 + (k - 640)); }
DEV float gemm2_a(const Params& P, int R, int k) { return (float)P.p[(size_t)R * INW + a2col(k)]; }
DEV void gemm1_epi(const Params& P, int R, int n, float acc) { P.p[(size_t)R * INW + n] = (f16)acc; }
DEV void gemm2_epi(const Params& P, int l, int R, int n, float acc) {
    int j = row_mod(R); float g = P.mods[(l * 3 + j) * 3072 + 2 * D + n];
    float xo = xrow(P, l, R)[n];
    float* dst = R < NCTX ? P.ctx1 + (size_t)R * D + n : P.out + (size_t)(R - NCTX) * D + n;
    *dst = xo + g * acc;
}
template <int MODE>
DEV void ph_gemm(const Params& P, int l, int bid, int nblk, float* sm) {
    constexpr int N = MODE == 1 ? INW : D, K = D;
    const float* Bm = MODE == 1 ? P.w_in + (size_t)l * D * INW : P.w_out + (size_t)l * D * D;
    const int tm0 = (MODE == 2 && l == 1) ? NCTX / 128 : 0;
    const int ntm = NROWS / 128 - tm0, ntn = N / 128;
#ifdef CPU_EMU
    for (int t = bid; t < ntm * ntn; t += nblk) {
        int tm = tm0 + t / ntn, tn = t % ntn;
        static float arow[K];
        for (int r = 0; r < 128; ++r) {
            int R = tm * 128 + r;
            for (int k = 0; k < K; ++k) arow[k] = MODE == 1 ? gemm1_a(P, l, R, k) : gemm2_a(P, R, k);
            float acc[128];
            for (int n = 0; n < 128; ++n) acc[n] = 0.f;
            for (int k = 0; k < K; ++k) { float a = arow[k]; const float* br = Bm + (size_t)k * N + tn * 128; for (int n = 0; n < 128; ++n) acc[n] += a * br[n]; }
            for (int n = 0; n < 128; ++n) { if (MODE == 1) gemm1_epi(P, R, tn * 128 + n, acc[n]); else gemm2_epi(P, l, R, tn * 128 + n, acc[n]); }
        }
    }
#else
    float* As = sm;
    float* Bs = sm + 16 * 132;
    const int tid = ltid(), ty = tid >> 4, tx = tid & 15;
    for (int t = bid; t < ntm * ntn; t += nblk) {
        const int tm = tm0 + t / ntn, tn = t % ntn;
        float acc[8][8];
#pragma unroll
        for (int i = 0; i < 8; ++i)
#pragma unroll
            for (int j = 0; j < 8; ++j) acc[i][j] = 0.f;
        const int ar = tid >> 1, ak = (tid & 1) * 8;
        const int bk = tid >> 4, bn = (tid & 15) * 8;
        for (int k0 = 0; k0 < K; k0 += 16) {
            float av[8], bv[8];
#pragma unroll
            for (int i = 0; i < 8; ++i) av[i] = MODE == 1 ? gemm1_a(P, l, tm * 128 + ar, k0 + ak + i) : gemm2_a(P, tm * 128 + ar, k0 + ak + i);
#pragma unroll
            for (int i = 0; i < 8; ++i) bv[i] = Bm[(size_t)(k0 + bk) * N + tn * 128 + bn + i];
            __syncthreads();
#pragma unroll
            for (int i = 0; i < 8; ++i) As[(ak + i) * 132 + ar] = av[i];
#pragma unroll
            for (int i = 0; i < 8; ++i) Bs[bk * 128 + bn + i] = bv[i];
            __syncthreads();
#pragma unroll
            for (int kk = 0; kk < 16; ++kk) {
                float a[8], b[8];
#pragma unroll
                for (int i = 0; i < 8; ++i) a[i] = As[kk * 132 + ty * 8 + i];
#pragma unroll
                for (int j = 0; j < 8; ++j) b[j] = Bs[kk * 128 + tx * 8 + j];
#pragma unroll
                for (int i = 0; i < 8; ++i)
#pragma unroll
                    for (int j = 0; j < 8; ++j) acc[i][j] += a[i] * b[j];
            }
        }
#pragma unroll
        for (int i = 0; i < 8; ++i)
#pragma unroll
            for (int j = 0; j < 8; ++j) {
                int R = tm * 128 + ty * 8 + i, n = tn * 128 + tx * 8 + j;
                if (MODE == 1) gemm1_epi(P, R, n, acc[i][j]); else gemm2_epi(P, l, R, n, acc[i][j]);
            }
    }
#endif
}

constexpr int RW_LDS = 8 * 4096 + 64;
DEV void ph_rwkv_scan(const Params& P, int l, int bid, int nblk, float* sm) {
    float *sw = sm, *sk = sw + 4096, *sb = sk + 4096, *skk = sb + 4096, *sr = skk + 4096, *sv = sr + 4096, *lora = sv + 4096, *sy = lora + 4096, *sinv = sy + 4096;
    PRIV(float, S, 64);
    for (int chain = bid; chain < 24; chain += nblk) {
        const int z = chain / 12, b = (chain / 6) % 2, h = chain % 6;
        PAR(tid) { PRIV_USE(float, S);
#pragma unroll
            for (int j = 0; j < 64; ++j) S[j] = 0.f; }
        for (int ck = 0; ck < NCHUNK; ++ck) {
            const int s0 = ck * 64;
            PAR(tid) {
                for (int idx = tid; idx < 4096; idx += NT) {
                    int t = idx >> 6, q = idx & 63; int R = scan_row(z, b, s0 + t);
                    int ch = q < 32 ? 1152 + z * 32 + q : 1216 + z * 32 + (q - 32);
                    float v = shl(P, l, R, ch);
                    lora[idx] = q < 32 ? tanhf(v) : v;
                }
            }
            SYNC();
            PAR(tid) {
                for (int idx = tid; idx < 4096; idx += NT) {
                    int t = idx >> 6, j = idx & 63, c = h * 64 + j; int R = scan_row(z, b, s0 + t);
                    float r_ = shl(P, l, R, c), k_ = shl(P, l, R, 384 + c), v_ = shl(P, l, R, 768 + c);
                    float wp = P.rw_w0[(l * 2 + z) * 384 + c], ap = P.rw_a0[(l * 2 + z) * 384 + c];
                    for (int rr = 0; rr < 32; ++rr) {
                        wp += lora[t * 64 + rr] * P.rw_w_up[((l * 2 + z) * 32 + rr) * 384 + c];
                        ap += lora[t * 64 + 32 + rr] * P.rw_a_up[((l * 2 + z) * 32 + rr) * 384 + c];
                    }
                    float w = expf(-0.6065306597126334f * sigmoidf_(wp)), a = sigmoidf_(ap);
                    sw[idx] = w; sk[idx] = k_ * (1.f + (a - 1.f) * P.rw_k_a[l * 384 + c]); sb[idx] = a;
                    skk[idx] = k_ * P.rw_k_k[l * 384 + c]; sr[idx] = r_; sv[idx] = v_;
                }
            }
            SYNC();
            PAR(tid) {
                if (tid < 64) {
                    int t = tid; float ss = 0.f, bn = 0.f;
                    for (int j = 0; j < 64; ++j) { float q = skk[t * 64 + j]; ss += q * q; bn += sr[t * 64 + j] * sk[t * 64 + j] * P.rw_r_k[l * 384 + h * 64 + j]; }
                    sinv[t] = 1.f / sqrtf(ss + 1e-6f);
                    int R = scan_row(z, b, s0 + t);
                    P.bon[((size_t)z * NROWS + R) * 6 + h] = bn;
                }
            }
            SYNC();
            PAR(tid) {
                for (int idx = tid; idx < 4096; idx += NT) { int t = idx >> 6; float kn = skk[idx] * sinv[t]; skk[idx] = kn; sb[idx] = sb[idx] * kn; }
            }
            SYNC();
            PAR(tid) { PRIV_USE(float, S);
                if (tid < 64) {
                    for (int t = 0; t < 64; ++t) {
                        float sa = 0.f;
#pragma unroll
                        for (int j = 0; j < 64; ++j) sa += S[j] * skk[t * 64 + j];
                        float vv = sv[t * 64 + tid], y = 0.f;
#pragma unroll
                        for (int j = 0; j < 64; ++j) { S[j] = S[j] * sw[t * 64 + j] - sa * sb[t * 64 + j] + vv * sk[t * 64 + j]; y += S[j] * sr[t * 64 + j]; }
                        sy[t * 64 + tid] = y;
                    }
                }
            }
            SYNC();
            PAR(tid) {
                for (int idx = tid; idx < 4096; idx += NT) { int t = idx >> 6, j = idx & 63; int R = scan_row(z, b, s0 + t); P.Y[((size_t)z * NROWS + R) * 384 + h * 64 + j] = sy[idx]; }
            }
            SYNC();
        }
    }
}
DEV void ph_rwkv_fin(const Params& P, int l, int bid, int nblk) {
    PAR(tid) {
        for (int idx = bid * NT + tid; idx < NROWS * 6; idx += nblk * NT) {
            int R = idx / 6, h = idx % 6;
            const float* y0 = P.Y + (size_t)R * 384 + h * 64; const float* y1 = P.Y + ((size_t)NROWS + R) * 384 + h * 64;
            float mu = 0.f;
            for (int j = 0; j < 64; ++j) mu += y0[j] + y1[j];
            mu *= (1.f / 64.f);
            float var = 0.f;
            for (int j = 0; j < 64; ++j) { float d = y0[j] + y1[j] - mu; var += d * d; }
            float rs = 1.f / sqrtf(var * (1.f / 64.f) + 64e-5f);
            float bonus = P.bon[(size_t)R * 6 + h] + P.bon[((size_t)NROWS + R) * 6 + h];
            for (int j = 0; j < 64; ++j) {
                int c = h * 64 + j;
                float y = (y0[j] + y1[j] - mu) * rs * P.rw_ln_g[l * 384 + c] + P.rw_ln_b[l * 384 + c];
                y += bonus * shl(P, l, R, 768 + c);
                float g = (float)P.p[(size_t)R * INW + 1280 + c];
                P.p[(size_t)R * INW + 1280 + c] = (f16)(y * siluf_(g));
            }
        }
    }
}

constexpr int S5_LDS = 1024 + 8192 + 1024 + 1024;
DEV void ph_s5_scan(const Params& P, int l, int bid, int nblk, float* sm) {
    float *su = sm, *shb = su + 1024, *scre = shb + 8192, *scim = scre + 1024;
    PRIV(float, st, 36);
    for (int item = bid; item < 32; item += nblk) {
        const int b = item / 16, g = item % 16;
        for (int z = 0; z < 2; ++z) {
            PAR(tid) { PRIV_USE(float, st);
                if (tid < 64) {
                    int n = tid; int pi = ((l * 2 + z) * 16 + g) * 64 + n;
                    float are_ = P.s5_a_re[pi], aim_ = P.s5_a_im[pi], dt = expf(P.s5_log_dt[pi]);
                    float mag = expf(are_ * dt), abr = mag * cosf(aim_ * dt), abi = mag * sinf(aim_ * dt);
                    float den = are_ * are_ + aim_ * aim_;
                    float qre = ((abr - 1.f) * are_ + abi * aim_) / den, qim = (abi * are_ - (abr - 1.f) * aim_) / den;
                    st[0] = abr; st[1] = abi;
#pragma unroll
                    for (int pp = 0; pp < 16; ++pp) {
                        float br = P.s5_b_re[(size_t)pi * 16 + pp], bi = P.s5_b_im[(size_t)pi * 16 + pp];
                        st[2 + pp] = qre * br - qim * bi; st[18 + pp] = qre * bi + qim * br;
                    }
                    st[34] = 0.f; st[35] = 0.f;
                }
                for (int idx = tid; idx < 1024; idx += NT) {
                    scre[idx] = P.s5_c_re[(size_t)((l * 2 + z) * 16 + g) * 1024 + idx];
                    scim[idx] = P.s5_c_im[(size_t)((l * 2 + z) * 16 + g) * 1024 + idx];
                }
            }
            SYNC();
            for (int ck = 0; ck < NCHUNK; ++ck) {
                const int s0 = ck * 64;
                PAR(tid) {
                    for (int idx = tid; idx < 1024; idx += NT) { int t = idx >> 4, pp = idx & 15; int R = scan_row(z, b, s0 + t); su[idx] = (float)P.p[(size_t)R * INW + 1664 + g * 16 + pp]; }
                }
                SYNC();
                PAR(tid) { PRIV_USE(float, st);
                    if (tid < 64) {
                        float hre = st[34], him = st[35];
                        for (int t = 0; t < 64; ++t) {
                            float bur = 0.f, bui = 0.f;
#pragma unroll
                            for (int pp = 0; pp < 16; ++pp) { float u = su[t * 16 + pp]; bur += st[2 + pp] * u; bui += st[18 + pp] * u; }
                            float nr = st[0] * hre - st[1] * him + bur, ni = st[0] * him + st[1] * hre + bui;
                            hre = nr; him = ni;
                            shb[t * 128 + tid] = hre; shb[t * 128 + 64 + tid] = him;
                        }
                        st[34] = hre; st[35] = him;
                    }
                }
                SYNC();
                PAR(tid) {
                    for (int idx = tid; idx < 1024; idx += NT) {
                        int t = idx >> 4, pp = idx & 15; float y = 0.f;
                        for (int n = 0; n < 64; ++n) y += scre[pp * 64 + n] * shb[t * 128 + n] - scim[pp * 64 + n] * shb[t * 128 + 64 + n];
                        int R = scan_row(z, b, s0 + t); float* dst = P.ys5 + (size_t)R * 256 + g * 16 + pp;
                        if (z == 0) *dst = y; else *dst += y;
                    }
                }
                SYNC();
            }
        }
    }
}
DEV void ph_s5_gelu(const Params& P, int l, int bid, int nblk) {
    PAR(tid) {
        for (size_t idx = (size_t)bid * NT + tid; idx < (size_t)NROWS * 256; idx += (size_t)nblk * NT) {
            int R = (int)(idx >> 8), j = (int)(idx & 255);
            float u = (float)P.p[(size_t)R * INW + 1664 + j];
            float y = P.ys5[idx] + P.s5_d[l * 256 + j] * u;
            P.ys5[idx] = 0.5f * y * (1.f + tanhf(0.7978845608028654f * (y + 0.044715f * y * y * y)));
        }
    }
}
DEV void ph_s5_glu(const Params& P, int l, int bid, int nblk) {
    PAR(tid) {
        for (size_t idx = (size_t)bid * NT + tid; idx < (size_t)NROWS * 256; idx += (size_t)nblk * NT) {
            int R = (int)(idx >> 8), j = (int)(idx & 255);
            const float* yr = P.ys5 + (size_t)R * 256;
            float acc = P.s5_glu_b[l * 256 + j];
            for (int i = 0; i < 256; ++i) acc += yr[i] * P.s5_glu_w[((size_t)l * 256 + i) * 256 + j];
            float g = (float)P.p[(size_t)R * INW + 1920 + j];
            P.p[(size_t)R * INW + 1920 + j] = (f16)(yr[j] * sigmoidf_(acc) * siluf_(g));
        }
    }
}

DEV float ml_xm(const Params& P, int R, int c) { return (float)P.p[(size_t)R * INW + 2176 + c]; }
DEV float ml_xc(const Params& P, int l, int R, int c) {
    int t, len; if (R < NCTX) { t = R % CTX; len = CTX; } else { t = (R - NCTX) % SEQ; len = SEQ; }
    float a = P.ml_conv_b[l * 384 + c] + P.ml_conv_w[(l * 3 + 1) * 384 + c] * ml_xm(P, R, c);
    if (t > 0) a += P.ml_conv_w[(l * 3 + 0) * 384 + c] * ml_xm(P, R - 1, c);
    if (t < len - 1) a += P.ml_conv_w[(l * 3 + 2) * 384 + c] * ml_xm(P, R + 1, c);
    return siluf_(a);
}
DEV void ph_ml_qkv(const Params& P, int l, int bid, int nblk) {
    PAR(tid) {
        for (int idx = bid * NT + tid; idx < NROWS * 96; idx += nblk * NT) {
            int R = idx / 96, n = idx % 96;
            float xc[4], xm[4];
            for (int j = 0; j < 4; ++j) { xc[j] = ml_xc(P, l, R, 4 * n + j); xm[j] = ml_xm(P, R, 4 * n + j); }
            for (int i = 0; i < 4; ++i) {
                float q = 0.f, k = 0.f, v = 0.f;
                for (int j = 0; j < 4; ++j) {
                    int wi = ((l * 96 + n) * 4 + j) * 4 + i;
                    q += xc[j] * P.ml_wq[wi]; k += xc[j] * P.ml_wk[wi]; v += xm[j] * P.ml_wv[wi];
                }
                float* o = P.qkv + (size_t)R * 1152 + 4 * n + i; o[0] = q; o[384] = k; o[768] = v;
            }
        }
    }
}
DEV void ph_ml_gates(const Params& P, int l, int bid, int nblk) {
    PAR(tid) {
        for (int idx = bid * NT + tid; idx < NROWS * 16; idx += nblk * NT) {
            int R = idx >> 4, o = idx & 15, z = o >> 3, hh = (o >> 1) & 3, which = o & 1;
            const float* W = (which ? P.ml_wf : P.ml_wi) + (size_t)(l * 2 + z) * 1152 * 4;
            float acc = (which ? P.ml_bf : P.ml_bi)[(l * 2 + z) * 4 + hh];
            const float* g = P.qkv + (size_t)R * 1152;
            for (int c = 0; c < 1152; ++c) acc += g[c] * W[c * 4 + hh];
            P.gates[idx] = which ? sigmoidf_(acc) : expf(acc);
        }
    }
}
constexpr int ML_LDS = 3 * 6144 + 64 * 97 + 128;
DEV void ph_ml_scan(const Params& P, int l, int bid, int nblk, float* sm) {
    float *sq = sm, *sk = sq + 6144, *sv = sk + 6144, *snum = sv + 6144, *sf = snum + 64 * 97, *si = sf + 64;
    PRIV(float, C, 96);
    for (int chain = bid; chain < 16; chain += nblk) {
        const int z = chain / 8, b = (chain / 4) % 2, hh = chain % 4;
        PAR(tid) { PRIV_USE(float, C);
#pragma unroll
            for (int j = 0; j < 96; ++j) C[j] = 0.f; }
        for (int ck = 0; ck < NCHUNK; ++ck) {
            const int s0 = ck * 64;
            PAR(tid) {
                for (int idx = tid; idx < 6144; idx += NT) {
                    int t = idx / 96, j = idx % 96; int R = scan_row(z, b, s0 + t);
                    const float* g = P.qkv + (size_t)R * 1152 + hh * 96 + j;
                    sq[idx] = g[0]; sk[idx] = g[384] * 0.10206207261596577f; sv[idx] = g[768];
                }
                if (tid < 64) { int R = scan_row(z, b, s0 + tid); sf[tid] = P.gates[R * 16 + z * 8 + hh * 2 + 1]; si[tid] = P.gates[R * 16 + z * 8 + hh * 2]; }
            }
            SYNC();
            PAR(tid) { PRIV_USE(float, C);
                if (tid < 97) {
                    for (int t = 0; t < 64; ++t) {
                        float f = sf[t], iv = si[t] * (tid < 96 ? sv[t * 96 + (tid < 96 ? tid : 0)] : 1.f), num = 0.f;
#pragma unroll
                        for (int j = 0; j < 96; ++j) { C[j] = C[j] * f + iv * sk[t * 96 + j]; num += C[j] * sq[t * 96 + j]; }
                        snum[t * 97 + tid] = num;
                    }
                }
            }
            SYNC();
            PAR(tid) {
                for (int idx = tid; idx < 6144; idx += NT) {
                    int t = idx / 96, j = idx % 96; int R = scan_row(z, b, s0 + t);
                    float den = snum[t * 97 + 96];
                    P.Y[((size_t)z * NROWS + R) * 384 + hh * 96 + j] = snum[t * 97 + j] / fmaxf(fabsf(den), 1.f);
                }
            }
            SYNC();
        }
    }
}
DEV void ph_ml_fin(const Params& P, int l, int bid, int nblk) {
    PAR(tid) {
        for (int idx = bid * NT + tid; idx < NROWS * 4; idx += nblk * NT) {
            int R = idx >> 2, hh = idx & 3;
            const float* y0 = P.Y + (size_t)R * 384 + hh * 96; const float* y1 = P.Y + ((size_t)NROWS + R) * 384 + hh * 96;
            float mu = 0.f;
            for (int j = 0; j < 96; ++j) mu += y0[j] + y1[j];
            mu *= (1.f / 96.f);
            float var = 0.f;
            for (int j = 0; j < 96; ++j) { float d = y0[j] + y1[j] - mu; var += d * d; }
            float rs = 1.f / sqrtf(var * (1.f / 96.f) + 1e-6f);
            for (int j = 0; j < 96; ++j) {
                int c = hh * 96 + j;
                float hv = (y0[j] + y1[j] - mu) * rs * P.ml_norm_g[l * 384 + c] + P.ml_skip[l * 384 + c] * ml_xc(P, l, R, c);
                float zg = (float)P.p[(size_t)R * INW + 2560 + c];
                P.p[(size_t)R * INW + 2560 + c] = (f16)(hv * siluf_(zg));
            }
        }
    }
}
DEV void ph_final(const Params& P, int bid, int nblk) {
    PAR(tid) {
        for (int r = bid * NT + tid; r < NLAT; r += nblk * NT) {
            float* xr = P.out + (size_t)r * D; float ss = 0.f;
            for (int k = 0; k < D; ++k) ss += xr[k] * xr[k];
            float rs = 1.f / sqrtf(ss * (1.f / D) + 1e-6f);
            for (int k = 0; k < D; ++k) xr[k] = xr[k] * rs * P.final_g[k];
        }
    }
}


#ifndef CPU_EMU
typedef _Float16 half8 __attribute__((ext_vector_type(8)));
typedef _Float16 half4 __attribute__((ext_vector_type(4)));
typedef float floatx16 __attribute__((ext_vector_type(16)));
typedef float floatx4 __attribute__((ext_vector_type(4)));
typedef unsigned uintx4 __attribute__((ext_vector_type(4)));

__device__ __forceinline__ float wave_sum(float v) {
#pragma unroll
    for (int o = 1; o < 64; o <<= 1) v += __shfl_xor(v, o);
    return v;
}
__device__ __forceinline__ void ph_mods2(const Params& P, int bid, int nblk, float* sm) {
    const int tid = ltid(), cl = tid & 15, kq = tid >> 4;
    for (int g = bid; g < 2 * 3 * 3072 / 16; g += nblk) {
        const int idx = g * 16 + cl; const int l = idx / 9216, rem = idx % 9216, j = rem / 3072, col = rem % 3072;
        const float* cin = j < 2 ? P.c + j * D : P.c_ctx;
        float acc = 0.f;
        for (int k = kq * 64; k < kq * 64 + 64; ++k) acc += siluf_(cin[k]) * P.ada_w[((size_t)l * D + k) * 3072 + col];
        sm[kq * 16 + cl] = acc;
        __syncthreads();
        if (tid < 16) { float s = P.ada_b[l * 3072 + col]; for (int q = 0; q < 16; ++q) s += sm[q * 16 + tid]; P.mods[idx] = s; }
        __syncthreads();
    }
}
__device__ __forceinline__ void ph_wprep(const Params& P, int bid, int nblk, float* sm) {
    const int tid = ltid();
    constexpr int T_IN = 16 * 46, T_OUT = 16 * 16, T_GLU = 4 * 4;
    for (int t = bid; t < 2 * (T_IN + T_OUT + T_GLU); t += nblk) {
        int l = t / (T_IN + T_OUT + T_GLU), r = t % (T_IN + T_OUT + T_GLU);
        const float* W; f16* Wt; int N, tk, tn, KW = D;
        if (r < T_IN) { W = P.w_in + (size_t)l * D * INW; Wt = P.wt_in + (size_t)l * INW * D; N = INW; tk = r / 46; tn = r % 46; }
        else if (r < T_IN + T_OUT) { r -= T_IN; W = P.w_out + (size_t)l * D * D; Wt = P.wt_out + (size_t)l * D * D; N = D; tk = r / 16; tn = r % 16; }
        else { r -= T_IN + T_OUT; W = P.s5_glu_w + (size_t)l * 256 * 256; Wt = P.glut + (size_t)l * 256 * 256; N = 256; tk = r / 4; tn = r % 4; KW = 256; }
#pragma unroll
        for (int i = 0; i < 4; ++i) {
            int k = (tid >> 4) + 16 * i, n4 = (tid & 15) * 4;
            floatx4 v = *(const floatx4*)(W + (size_t)(tk * 64 + k) * N + tn * 64 + n4);
            sm[k * 65 + n4] = v[0]; sm[k * 65 + n4 + 1] = v[1]; sm[k * 65 + n4 + 2] = v[2]; sm[k * 65 + n4 + 3] = v[3];
        }
        __syncthreads();
#pragma unroll
        for (int i = 0; i < 2; ++i) {
            int n = (tid >> 3) + 32 * i, k8 = (tid & 7) * 8;
            half8 h;
#pragma unroll
            for (int j = 0; j < 8; ++j) h[j] = (f16)sm[(k8 + j) * 65 + n];
            *(half8*)(Wt + (size_t)(tn * 64 + n) * KW + tk * 64 + k8) = h;
        }
        __syncthreads();
    }
}
__device__ __forceinline__ void ph_hx(const Params& P, int l, int bid, int nblk) {
    const int tid_ = ltid(); const int lane = tid_ & 63, wv = tid_ >> 6;
    for (int R = bid * 4 + wv; R < NROWS; R += nblk * 4) {
        const float* xr = xrow(P, l, R);
        floatx4 v[4]; float ss = 0.f;
#pragma unroll
        for (int i = 0; i < 4; ++i) { v[i] = *(const floatx4*)(xr + i * 256 + lane * 4); ss += v[i][0] * v[i][0] + v[i][1] * v[i][1] + v[i][2] * v[i][2] + v[i][3] * v[i][3]; }
        ss = wave_sum(ss);
        const float rs = 1.f / sqrtf(ss * (1.f / D) + 1e-6f);
        const float* m = P.mods + (l * 3 + row_mod(R)) * 3072; const float* g = P.norm_g + l * D;
#pragma unroll
        for (int i = 0; i < 4; ++i) {
            int k = i * 256 + lane * 4; half4 h;
#pragma unroll
            for (int j = 0; j < 4; ++j) h[j] = (f16)(v[i][j] * rs * g[k + j] * (1.f + m[D + k + j]) + m[k + j]);
            *(half4*)(P.hx + (size_t)R * D + k) = h;
        }
    }
}
template <int MODE>
__device__ __forceinline__ void gemm_epi_tile(const Params& P, int l, const floatx16 acc, int R0, int n0, int lane) {
#pragma unroll
    for (int r = 0; r < 16; ++r) {
        const int R = R0 + (r & 3) + 8 * (r >> 2) + 4 * (lane >> 5), n = n0 + (lane & 31);
        if (MODE == 1) gemm1_epi(P, R, n, acc[r]); else if (MODE == 2) gemm2_epi(P, l, R, n, acc[r]);
        else { const float yv = (float)P.yg[(size_t)R * 256 + n]; const float gt = (float)P.p[(size_t)R * INW + 1920 + n];
               P.p[(size_t)R * INW + 1920 + n] = (f16)(yv * sigmoidf_(acc[r] + P.s5_glu_b[l * 256 + n]) * siluf_(gt)); }
    }
}
constexpr int G_LDA = 72;
constexpr int GEMM_LDS_BYTES = 2 * 2 * 128 * G_LDA * 2;
template <int MODE>
__device__ __forceinline__ void ph_gemm_mfma(const Params& P, int l, int bid, int nblk, unsigned char* smraw) {
    constexpr int N = MODE == 1 ? INW : (MODE == 2 ? D : 256), K = MODE == 3 ? 256 : D;
    const f16* Bt = MODE == 1 ? P.wt_in + (size_t)l * INW * D : (MODE == 2 ? P.wt_out + (size_t)l * D * D : P.glut + (size_t)l * 256 * 256);
    const int tm0 = (MODE != 1 && l == 1) ? NCTX / 128 : 0;
    const int ntm = NROWS / 128 - tm0, ntn = N / 128;
    const int tid = ltid(), lane = tid & 63, wv = tid >> 6, wm = wv & 1, wn = wv >> 1;
    f16* sbase = (f16*)smraw;
    const int ldrow = tid >> 3, ldch = tid & 7;
    constexpr int GM = 16;
    for (int t = bid; t < ntm * ntn; t += nblk) {
        int sg = t / (GM * ntn), rem = t % (GM * ntn);
        int gsz = ntm - sg * GM < GM ? ntm - sg * GM : GM;
        const int tm = tm0 + sg * GM + rem % gsz, tn = rem / gsz;
        floatx16 acc00, acc01, acc10, acc11;
#pragma unroll
        for (int r = 0; r < 16; ++r) { acc00[r] = 0.f; acc01[r] = 0.f; acc10[r] = 0.f; acc11[r] = 0.f; }
        uintx4 ra0, ra1, ra2, ra3, rb0, rb1, rb2, rb3;
        const f16* arow = MODE == 1 ? P.hx + (size_t)(tm * 128 + ldrow) * D + ldch * 8 : (MODE == 2 ? P.p + (size_t)(tm * 128 + ldrow) * INW + ldch * 8 : P.yg + (size_t)(tm * 128 + ldrow) * 256 + ldch * 8);
        const size_t astr = (size_t)32 * (MODE == 1 ? D : (MODE == 2 ? INW : 256));
        const f16* brow = Bt + (size_t)(tn * 128 + ldrow) * K + ldch * 8;
#define GLOAD(kt_) { const int ka = MODE == 2 ? a2col((kt_) * 64) : (kt_) * 64; const int kb = (kt_) * 64; \
            ra0 = *(const uintx4*)(arow + ka); ra1 = *(const uintx4*)(arow + astr + ka); ra2 = *(const uintx4*)(arow + 2 * astr + ka); ra3 = *(const uintx4*)(arow + 3 * astr + ka); \
            rb0 = *(const uintx4*)(brow + kb); rb1 = *(const uintx4*)(brow + (size_t)32 * K + kb); rb2 = *(const uintx4*)(brow + (size_t)64 * K + kb); rb3 = *(const uintx4*)(brow + (size_t)96 * K + kb); }
#define SWRITE(st_) { f16* sA_ = sbase + (st_) * (2 * 128 * G_LDA) + ldrow * G_LDA + ldch * 8; f16* sB_ = sA_ + 128 * G_LDA; \
            *(uintx4*)(sA_) = ra0; *(uintx4*)(sA_ + 32 * G_LDA) = ra1; *(uintx4*)(sA_ + 64 * G_LDA) = ra2; *(uintx4*)(sA_ + 96 * G_LDA) = ra3; \
            *(uintx4*)(sB_) = rb0; *(uintx4*)(sB_ + 32 * G_LDA) = rb1; *(uintx4*)(sB_ + 64 * G_LDA) = rb2; *(uintx4*)(sB_ + 96 * G_LDA) = rb3; }
        __syncthreads();
        GLOAD(0); SWRITE(0);
        __syncthreads();
        for (int kt = 0; kt < K / 64; ++kt) {
            if (kt + 1 < K / 64) GLOAD(kt + 1);
            const f16* sA = sbase + (kt & 1) * (2 * 128 * G_LDA); const f16* sB = sA + 128 * G_LDA;
#pragma unroll
            for (int ks = 0; ks < 4; ++ks) {
                const int kof = ks * 16 + (lane >> 5) * 8;
                const half8 af0 = *(const half8*)(sA + (wm * 64 + (lane & 31)) * G_LDA + kof);
                const half8 af1 = *(const half8*)(sA + (wm * 64 + 32 + (lane & 31)) * G_LDA + kof);
                const half8 bf0 = *(const half8*)(sB + (wn * 64 + (lane & 31)) * G_LDA + kof);
                const half8 bf1 = *(const half8*)(sB + (wn * 64 + 32 + (lane & 31)) * G_LDA + kof);
                acc00 = __builtin_amdgcn_mfma_f32_32x32x16_f16(af0, bf0, acc00, 0, 0, 0);
                acc01 = __builtin_amdgcn_mfma_f32_32x32x16_f16(af0, bf1, acc01, 0, 0, 0);
                acc10 = __builtin_amdgcn_mfma_f32_32x32x16_f16(af1, bf0, acc10, 0, 0, 0);
                acc11 = __builtin_amdgcn_mfma_f32_32x32x16_f16(af1, bf1, acc11, 0, 0, 0);
            }
            if (kt + 1 < K / 64) SWRITE((kt + 1) & 1);
            __syncthreads();
        }
#undef GLOAD
#undef SWRITE
        gemm_epi_tile<MODE>(P, l, acc00, tm * 128 + wm * 64, tn * 128 + wn * 64, lane);
        gemm_epi_tile<MODE>(P, l, acc01, tm * 128 + wm * 64, tn * 128 + wn * 64 + 32, lane);
        gemm_epi_tile<MODE>(P, l, acc10, tm * 128 + wm * 64 + 32, tn * 128 + wn * 64, lane);
        gemm_epi_tile<MODE>(P, l, acc11, tm * 128 + wm * 64 + 32, tn * 128 + wn * 64 + 32, lane);
    }
}
#endif


#ifndef CPU_EMU
typedef __bf16 bf16;
typedef __bf16 bf16x8 __attribute__((ext_vector_type(8)));
typedef __bf16 bf16x4 __attribute__((ext_vector_type(4)));
constexpr int RLD = 72;
constexpr int RSLOT = 64 * RLD;
constexpr int RWP1_LDS_BYTES = 11 * RSLOT * 2 + 2 * 64 * 65 * 4 + 768 * 4 + 64 * 4;

__device__ __forceinline__ bf16x8 ldfrag(const bf16* M, int rowbase, int lane, int ks) {
    return *(const bf16x8*)(M + (rowbase + (lane & 31)) * RLD + ks * 16 + (lane >> 5) * 8);
}
__device__ __forceinline__ floatx16 mm64(const bf16* A, const bf16* Bt, int wm, int wn, int lane) {
    floatx16 acc;
#pragma unroll
    for (int r = 0; r < 16; ++r) acc[r] = 0.f;
#pragma unroll
    for (int ks = 0; ks < 4; ++ks) acc = __builtin_amdgcn_mfma_f32_32x32x16_bf16(ldfrag(A, wm * 32, lane, ks), ldfrag(Bt, wn * 32, lane, ks), acc, 0, 0, 0);
    return acc;
}
__device__ __forceinline__ void storeT(bf16* dst, const floatx16 c, int wm, int wn, int lane) {
    const int n = wn * 32 + (lane & 31);
#pragma unroll
    for (int g = 0; g < 4; ++g) {
        const int m0 = wm * 32 + 8 * g + 4 * (lane >> 5);
        bf16x4 v; v[0] = (bf16)c[4 * g]; v[1] = (bf16)c[4 * g + 1]; v[2] = (bf16)c[4 * g + 2]; v[3] = (bf16)c[4 * g + 3];
        *(bf16x4*)(dst + n * RLD + m0) = v;
    }
}

__device__ __forceinline__ void ph_rw_p1(const Params& P, int l, int bid, int nblk, unsigned char* smraw) {
    bf16* sl = (bf16*)smraw;
    bf16 *Am = sl, *AmT = sl + RSLOT, *Bp = sl + 2 * RSLOT, *Kp = sl + 3 * RSLOT, *Rt = sl + 4 * RSLOT, *VT = sl + 5 * RSLOT,
         *BendT = sl + 6 * RSLOT, *KendT = sl + 7 * RSLOT, *Nak = sl + 8 * RSLOT, *Mrb = sl + 9 * RSLOT, *Mrk = sl + 10 * RSLOT;
    bf16 *Tb = Am, *UtT = AmT, *WmT = Bp, *NVT = Kp;
    float* Nf = (float*)(smraw + 11 * RSLOT * 2); float* Tf = Nf + 64 * 65; float* Wb = Tf + 64 * 65; float* gl = Wb + 768;
    float* lora = Nf; float* lwb = Tf;
    const int tid = ltid(), lane = tid & 63, wv = tid >> 6, wm = wv & 1, wn = wv >> 1;
    f16* PTg = (f16*)P.qkv; f16* RPg = PTg + (size_t)24 * NCHUNK * 4096; f16* Qg = RPg + (size_t)24 * NCHUNK * 4096;
    for (int item = bid; item < 24 * NCHUNK; item += nblk) {
        const int chain = item / NCHUNK, ck = item % NCHUNK;
        const int z = chain / 12, b = (chain / 6) % 2, h = chain % 6, s0 = ck * 64;
        const int j = lane, tq = wv, c = h * 64 + j;
        {
            const int ch = lane < 32 ? 1152 + z * 32 + lane : 1216 + z * 32 + (lane - 32);
#pragma unroll 4
            for (int tt = 0; tt < 16; ++tt) {
                const int t = tq * 16 + tt; const int R = scan_row(z, b, s0 + t);
                const float v = shl(P, l, R, ch);
                lora[t * 64 + lane] = lane < 32 ? tanhf(v) : v;
            }
        }
        __syncthreads();
        {
            float wup[32];
#pragma unroll
            for (int r = 0; r < 32; ++r) wup[r] = P.rw_w_up[((l * 2 + z) * 32 + r) * 384 + c];
            const float w0 = P.rw_w0[(l * 2 + z) * 384 + c];
#pragma unroll 4
            for (int tt = 0; tt < 16; ++tt) {
                const int t = tq * 16 + tt; float wp = w0;
#pragma unroll
                for (int r = 0; r < 32; ++r) wp += lora[t * 64 + r] * wup[r];
                lwb[t * 64 + j] = -0.6065306597126334f * sigmoidf_(wp);
            }
        }
        __syncthreads();
        {
            float aup[32];
#pragma unroll
            for (int r = 0; r < 32; ++r) aup[r] = P.rw_a_up[((l * 2 + z) * 32 + r) * 384 + c];
            const float a0 = P.rw_a0[(l * 2 + z) * 384 + c], kkc = P.rw_k_k[l * 384 + c], kac = P.rw_k_a[l * 384 + c], rkc = P.rw_r_k[l * 384 + c];
            float gpre = 0.f, gtot = 0.f;
            for (int t2 = 0; t2 < 64; ++t2) { const float x = lwb[t2 * 64 + j]; gtot += x; if (t2 < tq * 16) gpre += x; }
            if (tq == 0) gl[j] = expf(gtot);
            float g = gpre;
#pragma unroll 2
            for (int tt = 0; tt < 16; ++tt) {
                const int t = tq * 16 + tt; const int R = scan_row(z, b, s0 + t);
                const float r_ = shl(P, l, R, c), k_ = shl(P, l, R, 384 + c), v_ = shl(P, l, R, 768 + c);
                float ap = a0;
#pragma unroll
                for (int r = 0; r < 32; ++r) ap += lora[t * 64 + 32 + r] * aup[r];
                const float a = sigmoidf_(ap);
                const float kku = k_ * kkc;
                const float ss = wave_sum(kku * kku);
                const float kkn = kku * (1.f / sqrtf(ss + 1e-6f));
                const float kd = k_ * (1.f + (a - 1.f) * kac), bb = a * kkn;
                const float bn = wave_sum(r_ * kd * rkc);
                if (lane == 0) P.bon[((size_t)z * NROWS + R) * 6 + h] = bn;
                const float lw = lwb[t * 64 + j];
                const float gm1 = g; g += lw;
                const float e_m = expf(gm1), e_p = expf(-g), e_t = expf(g), e_e = expf(gtot - g);
                const bf16 am = (bf16)(kkn * e_m);
                Am[t * RLD + j] = am; Bp[t * RLD + j] = (bf16)(bb * e_p); Kp[t * RLD + j] = (bf16)(kd * e_p); Rt[t * RLD + j] = (bf16)(r_ * e_t);
                AmT[j * RLD + t] = am; VT[j * RLD + t] = (bf16)v_; BendT[j * RLD + t] = (bf16)(bb * e_e); KendT[j * RLD + t] = (bf16)(kd * e_e);
            }
        }
        __syncthreads();
        {
            floatx16 cab, cak, crb, crk;
#pragma unroll
            for (int r = 0; r < 16; ++r) { cab[r] = 0.f; cak[r] = 0.f; crb[r] = 0.f; crk[r] = 0.f; }
            if (!(wm == 0 && wn == 1)) {
#pragma unroll
                for (int ks = 0; ks < 4; ++ks) {
                    const bf16x8 a1 = ldfrag(Am, wm * 32, lane, ks), a2 = ldfrag(Rt, wm * 32, lane, ks), b1 = ldfrag(Bp, wn * 32, lane, ks), b2 = ldfrag(Kp, wn * 32, lane, ks);
                    cab = __builtin_amdgcn_mfma_f32_32x32x16_bf16(a1, b1, cab, 0, 0, 0);
                    cak = __builtin_amdgcn_mfma_f32_32x32x16_bf16(a1, b2, cak, 0, 0, 0);
                    crb = __builtin_amdgcn_mfma_f32_32x32x16_bf16(a2, b1, crb, 0, 0, 0);
                    crk = __builtin_amdgcn_mfma_f32_32x32x16_bf16(a2, b2, crk, 0, 0, 0);
                }
            }
#pragma unroll
            for (int r = 0; r < 16; ++r) {
                const int m = wm * 32 + (r & 3) + 8 * (r >> 2) + 4 * (lane >> 5), n = wn * 32 + (lane & 31);
                Nf[m * 65 + n] = n < m ? cab[r] : 0.f;
                Nak[m * RLD + n] = (bf16)(n < m ? cak[r] : 0.f);
                Mrb[m * RLD + n] = (bf16)(n <= m ? crb[r] : 0.f);
                Mrk[m * RLD + n] = (bf16)(n <= m ? crk[r] : 0.f);
            }
        }
        __syncthreads();
        if (tid < 64) {
            const int i = tid >> 4, jc = tid & 15; float x[16];
#pragma unroll
            for (int row = 0; row < 16; ++row) {
                float s = row == jc ? 1.f : 0.f;
#pragma unroll
                for (int m = 0; m < row; ++m) s -= Nf[(16 * i + row) * 65 + 16 * i + m] * x[m];
                x[row] = s;
            }
#pragma unroll
            for (int row = 0; row < 16; ++row) Tf[(16 * i + row) * 65 + 16 * i + jc] = x[row];
        }
        __syncthreads();
        {
            const int a = tid >> 4, cc = tid & 15;
#pragma unroll
            for (int i = 1; i < 4; ++i) {
#pragma unroll
                for (int jb = 0; jb < i; ++jb) {
                    float s = 0.f;
#pragma unroll
                    for (int mb = jb; mb < i; ++mb)
#pragma unroll
                        for (int m = 0; m < 16; ++m) s += Nf[(16 * i + a) * 65 + 16 * mb + m] * Tf[(16 * mb + m) * 65 + 16 * jb + cc];
                    Wb[jb * 256 + a * 16 + cc] = s;
                }
                __syncthreads();
#pragma unroll
                for (int jb = 0; jb < i; ++jb) {
                    float s = 0.f;
#pragma unroll
                    for (int m = 0; m < 16; ++m) s += Tf[(16 * i + a) * 65 + 16 * i + m] * Wb[jb * 256 + m * 16 + cc];
                    Tf[(16 * i + a) * 65 + 16 * jb + cc] = -s;
                }
                __syncthreads();
            }
        }
        for (int idx = tid; idx < 4096; idx += NT) { const int t = idx >> 6, s = idx & 63; Tb[t * RLD + s] = (bf16)(((s >> 4) <= (t >> 4)) ? Tf[t * 65 + s] : 0.f); }
        __syncthreads();
        { const floatx16 c1 = mm64(Tb, AmT, wm, wn, lane); const floatx16 c2 = mm64(Nak, VT, wm, wn, lane); storeT(WmT, c1, wm, wn, lane); storeT(NVT, c2, wm, wn, lane); }
        __syncthreads();
        { const floatx16 c1 = mm64(Tb, NVT, wm, wn, lane); storeT(UtT, c1, wm, wn, lane); }
        __syncthreads();
        {
            const size_t gb = (size_t)item * 4096;
            {
                const floatx16 c1 = mm64(Mrb, WmT, wm, wn, lane);
#pragma unroll
                for (int r = 0; r < 16; ++r) {
                    const int m = wm * 32 + (r & 3) + 8 * (r >> 2) + 4 * (lane >> 5), n = wn * 32 + (lane & 31);
                    RPg[gb + m * 64 + n] = (f16)((float)Rt[m * RLD + n] - c1[r]);
                }
            }
            {
                const floatx16 c2 = mm64(Mrk, VT, wm, wn, lane); const floatx16 c3 = mm64(Mrb, UtT, wm, wn, lane);
#pragma unroll
                for (int r = 0; r < 16; ++r) {
                    const int m = wm * 32 + (r & 3) + 8 * (r >> 2) + 4 * (lane >> 5), n = wn * 32 + (lane & 31);
                    const int R = scan_row(z, b, s0 + m);
                    P.Y[((size_t)z * NROWS + R) * 384 + h * 64 + n] = c2[r] - c3[r];
                }
            }
            {
                const floatx16 c4 = mm64(BendT, WmT, wm, wn, lane);
#pragma unroll
                for (int r = 0; r < 16; ++r) {
                    const int m = wm * 32 + (r & 3) + 8 * (r >> 2) + 4 * (lane >> 5), n = wn * 32 + (lane & 31);
                    PTg[gb + m * 64 + n] = (f16)((m == n ? gl[m] : 0.f) - c4[r]);
                }
            }
            {
                const floatx16 c5 = mm64(KendT, VT, wm, wn, lane); const floatx16 c6 = mm64(BendT, UtT, wm, wn, lane);
                const int n = wn * 32 + (lane & 31);
#pragma unroll
                for (int g = 0; g < 4; ++g) {
                    const int m0 = wm * 32 + 8 * g + 4 * (lane >> 5);
                    half4 v; v[0] = (f16)(c5[4 * g] - c6[4 * g]); v[1] = (f16)(c5[4 * g + 1] - c6[4 * g + 1]); v[2] = (f16)(c5[4 * g + 2] - c6[4 * g + 2]); v[3] = (f16)(c5[4 * g + 3] - c6[4 * g + 3]);
                    *(half4*)(Qg + gb + n * 64 + m0) = v;
                }
            }
        }
        __syncthreads();
    }
}

#define BAR_LDS() asm volatile("s_waitcnt lgkmcnt(0)\n\ts_barrier" ::: "memory")
__device__ __forceinline__ void ph_rw_stream(const Params& P, int l, int bid, int nblk, unsigned char* smraw) {
    f16* S16 = (f16*)smraw;
    const int tid = ltid(), lane = tid & 63, wv = tid >> 6;
    const f16* PTg = (const f16*)P.qkv; const f16* RPg = PTg + (size_t)24 * NCHUNK * 4096; const f16* Qg = RPg + (size_t)24 * NCHUNK * 4096;
    for (int item = bid; item < 96; item += nblk) {
        const int chain = item >> 2, vs = item & 3;
        const int z = chain / 12, b = (chain / 6) % 2, h = chain % 6;
        __syncthreads();
        for (int idx = tid; idx < 16 * 72; idx += NT) S16[idx] = (f16)0.f;
        __syncthreads();
        const size_t cb = (size_t)chain * NCHUNK * 4096;
        const int rowA = 16 * wv + (lane & 15), kof = 8 * (lane >> 4);
        const int qoff = (vs * 16 + (lane & 15)) * 64 + 16 * wv + (lane >> 4) * 4;
        float* ycol = P.Y + (size_t)z * NROWS * 384 + h * 64 + vs * 16 + (lane & 15);
        const int trow = 16 * wv + (lane >> 4) * 4;
        half8 ap0[4], ap1[4], ar0[4], ar1[4]; half4 qv[4]; float yv[4][4];
#define RW_LOAD(slot_, ck_) { const size_t gb_ = cb + (size_t)(ck_) * 4096; \
            ap0[slot_] = *(const half8*)(PTg + gb_ + rowA * 64 + kof); ap1[slot_] = *(const half8*)(PTg + gb_ + rowA * 64 + 32 + kof); \
            ar0[slot_] = *(const half8*)(RPg + gb_ + rowA * 64 + kof); ar1[slot_] = *(const half8*)(RPg + gb_ + rowA * 64 + 32 + kof); \
            qv[slot_] = *(const half4*)(Qg + gb_ + qoff); \
            _Pragma("unroll") for (int r_ = 0; r_ < 4; ++r_) yv[slot_][r_] = ycol[(size_t)scan_row(z, b, (ck_) * 64 + trow + r_) * 384]; }
#define RW_STEP(slot_, ck_) { \
            const half8 b0_ = *(const half8*)(S16 + (lane & 15) * 72 + kof); const half8 b1_ = *(const half8*)(S16 + (lane & 15) * 72 + 32 + kof); \
            floatx4 accY_ = {0.f, 0.f, 0.f, 0.f}; \
            accY_ = __builtin_amdgcn_mfma_f32_16x16x32_f16(ar0[slot_], b0_, accY_, 0, 0, 0); accY_ = __builtin_amdgcn_mfma_f32_16x16x32_f16(ar1[slot_], b1_, accY_, 0, 0, 0); \
            floatx4 accS_; accS_[0] = (float)qv[slot_][0]; accS_[1] = (float)qv[slot_][1]; accS_[2] = (float)qv[slot_][2]; accS_[3] = (float)qv[slot_][3]; \
            accS_ = __builtin_amdgcn_mfma_f32_16x16x32_f16(ap0[slot_], b0_, accS_, 0, 0, 0); accS_ = __builtin_amdgcn_mfma_f32_16x16x32_f16(ap1[slot_], b1_, accS_, 0, 0, 0); \
            _Pragma("unroll") for (int r_ = 0; r_ < 4; ++r_) ycol[(size_t)scan_row(z, b, (ck_) * 64 + trow + r_) * 384] = yv[slot_][r_] + accY_[r_]; \
            BAR_LDS(); \
            half4 sn_; sn_[0] = (f16)accS_[0]; sn_[1] = (f16)accS_[1]; sn_[2] = (f16)accS_[2]; sn_[3] = (f16)accS_[3]; \
            *(half4*)(S16 + (lane & 15) * 72 + trow) = sn_; \
            BAR_LDS(); }
        RW_LOAD(0, 0); RW_LOAD(1, 1); RW_LOAD(2, 2);
        for (int ck = 0; ck < NCHUNK; ck += 4) {
            if (ck + 3 < NCHUNK) RW_LOAD(3, ck + 3);
            RW_STEP(0, ck);
            if (ck + 4 < NCHUNK) RW_LOAD(0, ck + 4);
            RW_STEP(1, ck + 1);
            if (ck + 5 < NCHUNK) RW_LOAD(1, ck + 5);
            RW_STEP(2, ck + 2);
            if (ck + 6 < NCHUNK) RW_LOAD(2, ck + 6);
            RW_STEP(3, ck + 3);
        }
#undef RW_LOAD
#undef RW_STEP
    }
}
#endif


#ifndef CPU_EMU
__device__ __forceinline__ void ph_rwkv_fin2(const Params& P, int l, int bid, int nblk) {
    const int tid_ = ltid(); const int lane = tid_ & 63, wv = tid_ >> 6;
    for (int R = (l == 1 ? NCTX : 0) + bid * 4 + wv; R < NROWS; R += nblk * 4) {
#pragma unroll
        for (int h = 0; h < 6; ++h) {
            const int c = h * 64 + lane;
            const float y = P.Y[(size_t)R * 384 + c] + P.Y[((size_t)NROWS + R) * 384 + c];
            const float mu = wave_sum(y) * (1.f / 64.f); const float d = y - mu;
            const float var = wave_sum(d * d) * (1.f / 64.f);
            const float rs = 1.f / sqrtf(var + 64e-5f);
            const float bonus = P.bon[(size_t)R * 6 + h] + P.bon[((size_t)NROWS + R) * 6 + h];
            const float o = d * rs * P.rw_ln_g[l * 384 + c] + P.rw_ln_b[l * 384 + c] + bonus * shl(P, l, R, 768 + c);
            const float g = (float)P.p[(size_t)R * INW + 1280 + c];
            P.p[(size_t)R * INW + 1280 + c] = (f16)(o * siluf_(g));
        }
    }
}
__device__ __forceinline__ void ph_ml_fin2(const Params& P, int l, int bid, int nblk) {
    const int tid_ = ltid(); const int lane = tid_ & 63, wv = tid_ >> 6;
    for (int R = (l == 1 ? NCTX : 0) + bid * 4 + wv; R < NROWS; R += nblk * 4) {
        float y[6]; float s = 0.f;
#pragma unroll
        for (int i = 0; i < 6; ++i) { const int c = lane * 6 + i; y[i] = P.Y[(size_t)R * 384 + c] + P.Y[((size_t)NROWS + R) * 384 + c]; s += y[i]; }
        s += __shfl_xor(s, 1); s += __shfl_xor(s, 2); s += __shfl_xor(s, 4); s += __shfl_xor(s, 8);
        const float mu = s * (1.f / 96.f); float q = 0.f;
#pragma unroll
        for (int i = 0; i < 6; ++i) { y[i] -= mu; q += y[i] * y[i]; }
        q += __shfl_xor(q, 1); q += __shfl_xor(q, 2); q += __shfl_xor(q, 4); q += __shfl_xor(q, 8);
        const float rs = 1.f / sqrtf(q * (1.f / 96.f) + 1e-6f);
#pragma unroll
        for (int i = 0; i < 6; ++i) {
            const int c = lane * 6 + i;
            const float hv = y[i] * rs * P.ml_norm_g[l * 384 + c] + P.ml_skip[l * 384 + c] * ml_xc(P, l, R, c);
            const float zg = (float)P.p[(size_t)R * INW + 2560 + c];
            P.p[(size_t)R * INW + 2560 + c] = (f16)(hv * siluf_(zg));
        }
    }
}
__device__ __forceinline__ void ph_final2(const Params& P, int bid, int nblk) {
    const int tid_ = ltid(); const int lane = tid_ & 63, wv = tid_ >> 6;
    for (int r = bid * 4 + wv; r < NLAT; r += nblk * 4) {
        float* xr = P.out + (size_t)r * D; floatx4 v[4]; float ss = 0.f;
#pragma unroll
        for (int i = 0; i < 4; ++i) { v[i] = *(const floatx4*)(xr + i * 256 + lane * 4); ss += v[i][0] * v[i][0] + v[i][1] * v[i][1] + v[i][2] * v[i][2] + v[i][3] * v[i][3]; }
        ss = wave_sum(ss);
        const float rs = 1.f / sqrtf(ss * (1.f / D) + 1e-6f);
#pragma unroll
        for (int i = 0; i < 4; ++i) {
            const floatx4 g = *(const floatx4*)(P.final_g + i * 256 + lane * 4); floatx4 o;
#pragma unroll
            for (int j = 0; j < 4; ++j) o[j] = v[i][j] * rs * g[j];
            *(floatx4*)(xr + i * 256 + lane * 4) = o;
        }
    }
}
constexpr int S5PW = 38;
__device__ __forceinline__ void ph_s5_params(const Params& P, int bid, int nblk) {
    for (int idx = bid * NT + ltid(); idx < 2 * 2 * 16 * 64; idx += nblk * NT) {
        const int n = idx & 63, lzg = idx >> 6;
        const int pi = lzg * 64 + n;
        const float are_ = P.s5_a_re[pi], aim_ = P.s5_a_im[pi], dt = expf(P.s5_log_dt[pi]);
        const float mag = expf(are_ * dt), abr = mag * cosf(aim_ * dt), abi = mag * sinf(aim_ * dt);
        const float den = are_ * are_ + aim_ * aim_;
        const float qre = ((abr - 1.f) * are_ + abi * aim_) / den, qim = (abi * are_ - (abr - 1.f) * aim_) / den;
        float* tb = P.s5par + (size_t)lzg * S5PW * 64 + n;
        tb[0] = abr; tb[64] = abi;
        for (int pp = 0; pp < 16; ++pp) {
            const float br = P.s5_b_re[(size_t)pi * 16 + pp], bi = P.s5_b_im[(size_t)pi * 16 + pp];
            tb[(2 + pp) * 64] = qre * br - qim * bi; tb[(18 + pp) * 64] = qre * bi + qim * br;
        }
        const float m64 = expf(64.f * are_ * dt);
        tb[34 * 64] = m64 * cosf(64.f * aim_ * dt); tb[35 * 64] = m64 * sinf(64.f * aim_ * dt);
    }
}
__device__ __forceinline__ void ph_s5_a(const Params& P, int l, int bid, int nblk, float* sm) {
    const int tid_ = ltid(); const int lane = tid_ & 63, wv = tid_ >> 6;
    float* su = sm + wv * 1024;
    for (int item = bid * 4 + wv; item < 2 * 2 * 16 * NCHUNK; item += nblk * 4) {
        const int ck = item % NCHUNK, zbg = item / NCHUNK, g = zbg & 15, b = (zbg >> 4) & 1, z = zbg >> 5;
        const float* tb = P.s5par + (size_t)((l * 2 + z) * 16 + g) * S5PW * 64 + lane;
        const float abr = tb[0], abi = tb[64]; float bbr[16], bbi[16];
#pragma unroll
        for (int pp = 0; pp < 16; ++pp) { bbr[pp] = tb[(2 + pp) * 64]; bbi[pp] = tb[(18 + pp) * 64]; }
#pragma unroll
        for (int i = 0; i < 4; ++i) {
            const int t = 16 * i + (lane >> 2), pq = (lane & 3) * 4; const int R = scan_row(z, b, ck * 64 + t);
            const half4 u4 = *(const half4*)(P.p + (size_t)R * INW + 1664 + g * 16 + pq);
            su[t * 16 + pq] = (float)u4[0]; su[t * 16 + pq + 1] = (float)u4[1]; su[t * 16 + pq + 2] = (float)u4[2]; su[t * 16 + pq + 3] = (float)u4[3];
        }
        float hre = 0.f, him = 0.f;
        for (int t = 0; t < 64; ++t) {
            float bur = 0.f, bui = 0.f;
#pragma unroll
            for (int pp = 0; pp < 16; ++pp) { const float u = su[t * 16 + pp]; bur += bbr[pp] * u; bui += bbi[pp] * u; }
            const float nr = abr * hre - abi * him + bur, ni = abr * him + abi * hre + bui;
            hre = nr; him = ni;
        }
        float* ho = P.s5h + ((size_t)zbg * NCHUNK + ck) * 128;
        ho[lane] = hre; ho[64 + lane] = him;
    }
}
__device__ __forceinline__ void ph_s5_b(const Params& P, int l, int bid, int nblk) {
    for (int idx = bid * NT + ltid(); idx < 2 * 2 * 16 * 64; idx += nblk * NT) {
        const int n = idx & 63, zbg = idx >> 6, g = zbg & 15, z = zbg >> 5;
        const float* tb = P.s5par + (size_t)((l * 2 + z) * 16 + g) * S5PW * 64 + n;
        const float a64r = tb[34 * 64], a64i = tb[35 * 64];
        float hr = 0.f, hi = 0.f;
        float* hp = P.s5h + (size_t)zbg * NCHUNK * 128 + n;
        for (int ck = 0; ck < NCHUNK; ++ck) {
            const float lr = hp[ck * 128], li = hp[ck * 128 + 64];
            hp[ck * 128] = hr; hp[ck * 128 + 64] = hi;
            const float nr = a64r * hr - a64i * hi + lr, ni = a64r * hi + a64i * hr + li;
            hr = nr; hi = ni;
        }
    }
}
constexpr int S5C_LDS = 2 * 64 * 129 + 2 * 1024 + 4 * 1024;
__device__ __forceinline__ void ph_s5_c(const Params& P, int l, int bid, int nblk, float* sm) {
    const int tid = ltid(), lane = tid & 63, wv = tid >> 6;
    float* hb = sm;
    float* su = hb + 2 * 64 * 129;
    float* sc = su + 2 * 1024;
    for (int item = bid; item < 2 * 16 * NCHUNK; item += nblk) {
        const int ck0 = item % NCHUNK, bg = item / NCHUNK, g = bg & 15, b = bg >> 4;
        if (l == 1 && ck0 < CTX / 64) continue;
        __syncthreads();
        for (int idx = tid; idx < 4096; idx += NT) {
            const int z = idx >> 11, ri = (idx >> 10) & 1, r = idx & 1023;
            sc[idx] = (ri ? P.s5_c_im : P.s5_c_re)[(size_t)((l * 2 + z) * 16 + g) * 1024 + r];
        }
        if (wv < 2) {
            const int z = wv; const int ck = z == 0 ? ck0 : (ck0 < CTX / 64 ? CTX / 64 - 1 - ck0 : CTX / 64 + (SEQ / 64 - 1) - (ck0 - CTX / 64));
            const float* tb = P.s5par + (size_t)((l * 2 + z) * 16 + g) * S5PW * 64 + lane;
            const float abr = tb[0], abi = tb[64]; float bbr[16], bbi[16];
#pragma unroll
            for (int pp = 0; pp < 16; ++pp) { bbr[pp] = tb[(2 + pp) * 64]; bbi[pp] = tb[(18 + pp) * 64]; }
            float* suz = su + z * 1024;
#pragma unroll
            for (int i = 0; i < 4; ++i) {
                const int t = 16 * i + (lane >> 2), pq = (lane & 3) * 4; const int R = scan_row(z, b, ck * 64 + t);
                const half4 u4 = *(const half4*)(P.p + (size_t)R * INW + 1664 + g * 16 + pq);
                suz[t * 16 + pq] = (float)u4[0]; suz[t * 16 + pq + 1] = (float)u4[1]; suz[t * 16 + pq + 2] = (float)u4[2]; suz[t * 16 + pq + 3] = (float)u4[3];
            }
            const float* hi_ = P.s5h + ((size_t)((z * 2 + b) * 16 + g) * NCHUNK + ck) * 128;
            float hre = hi_[lane], him = hi_[64 + lane];
            float* hbz = hb + z * 64 * 129;
            for (int t = 0; t < 64; ++t) {
                float bur = 0.f, bui = 0.f;
#pragma unroll
                for (int pp = 0; pp < 16; ++pp) { const float u = suz[t * 16 + pp]; bur += bbr[pp] * u; bui += bbi[pp] * u; }
                const float nr = abr * hre - abi * him + bur, ni = abr * him + abi * hre + bui;
                hre = nr; him = ni;
                const int tt = z == 0 ? t : 63 - t;
                hbz[tt * 129 + lane] = hre; hbz[tt * 129 + 64 + lane] = him;
            }
        }
        __syncthreads();
        {
            const int tt = tid >> 2, p0 = (tid & 3) * 4;
            const int R = scan_row(0, b, ck0 * 64 + tt);
            float acc[4] = {0.f, 0.f, 0.f, 0.f};
#pragma unroll
            for (int z = 0; z < 2; ++z) {
                const float* hrow = hb + z * 64 * 129 + tt * 129; const float* cr = sc + z * 2048; const float* ci = cr + 1024;
                for (int n = 0; n < 64; ++n) {
                    const float hr = hrow[n], hi = hrow[64 + n];
#pragma unroll
                    for (int i = 0; i < 4; ++i) acc[i] += cr[(p0 + i) * 64 + n] * hr - ci[(p0 + i) * 64 + n] * hi;
                }
            }
            half4 o;
#pragma unroll
            for (int i = 0; i < 4; ++i) {
                const int jc = g * 16 + p0 + i;
                const float u = (float)P.p[(size_t)R * INW + 1664 + jc];
                const float y = acc[i] + P.s5_d[l * 256 + jc] * u;
                o[i] = (f16)(0.5f * y * (1.f + tanhf(0.7978845608028654f * (y + 0.044715f * y * y * y))));
            }
            *(half4*)(P.yg + (size_t)R * 256 + g * 16 + p0) = o;
        }
    }
}
#endif


#ifndef CPU_EMU
constexpr int NSC = TSCAN / 256;
constexpr int QLD = 104, SLD = 72;
constexpr int MLE = 97 * 96;
__device__ __forceinline__ float log_sigmoidf_(float x) { return fminf(x, 0.f) - log1pf(expf(-fabsf(x))); }
template <int KSTEPS>
__device__ __forceinline__ floatx16 mmh(const f16* A, int lda, int arow0, const f16* Bt, int ldb, int brow0, int lane, floatx16 acc) {
#pragma unroll
    for (int ks = 0; ks < KSTEPS; ++ks) {
        const half8 a = *(const half8*)(A + (arow0 + (lane & 31)) * lda + ks * 16 + (lane >> 5) * 8);
        const half8 b = *(const half8*)(Bt + (brow0 + (lane & 31)) * ldb + ks * 16 + (lane >> 5) * 8);
        acc = __builtin_amdgcn_mfma_f32_32x32x16_f16(a, b, acc, 0, 0, 0);
    }
    return acc;
}
__device__ __forceinline__ void ph_ml_a(const Params& P, int l, int bid, int nblk) {
    const int tid_ = ltid(); const int lane = tid_ & 63, wv = tid_ >> 6;
    for (int R = bid * 4 + wv; R < NROWS; R += nblk * 4) {
        float acc[16];
#pragma unroll
        for (int o = 0; o < 16; ++o) acc[o] = 0.f;
        if (lane < 48) {
            const int c0 = lane * 8;
            int t, len; if (R < NCTX) { t = R % CTX; len = CTX; } else { t = (R - NCTX) % SEQ; len = SEQ; }
            const half8 x0 = *(const half8*)(P.p + (size_t)R * INW + 2176 + c0);
            half8 xm_, xp_;
#pragma unroll
            for (int i = 0; i < 8; ++i) { xm_[i] = (f16)0.f; xp_[i] = (f16)0.f; }
            if (t > 0) xm_ = *(const half8*)(P.p + (size_t)(R - 1) * INW + 2176 + c0);
            if (t < len - 1) xp_ = *(const half8*)(P.p + (size_t)(R + 1) * INW + 2176 + c0);
            float xc[8], xm[8], q[8], k[8], v[8];
#pragma unroll
            for (int i = 0; i < 8; ++i) {
                const int c = c0 + i; xm[i] = (float)x0[i];
                const float a = P.ml_conv_b[l * 384 + c] + P.ml_conv_w[(l * 3 + 1) * 384 + c] * xm[i] + P.ml_conv_w[(l * 3 + 0) * 384 + c] * (float)xm_[i] + P.ml_conv_w[(l * 3 + 2) * 384 + c] * (float)xp_[i];
                xc[i] = siluf_(a);
            }
#pragma unroll
            for (int blk = 0; blk < 2; ++blk) {
                const int n = lane * 2 + blk;
#pragma unroll
                for (int i = 0; i < 4; ++i) {
                    float qq = 0.f, kk = 0.f, vv = 0.f;
#pragma unroll
                    for (int jj = 0; jj < 4; ++jj) {
                        const int wi = ((l * 96 + n) * 4 + jj) * 4 + i;
                        qq += xc[4 * blk + jj] * P.ml_wq[wi]; kk += xc[4 * blk + jj] * P.ml_wk[wi]; vv += xm[4 * blk + jj] * P.ml_wv[wi];
                    }
                    q[4 * blk + i] = qq; k[4 * blk + i] = kk; v[4 * blk + i] = vv;
                }
                asm volatile("" ::: "memory");
            }
            half8 hq, hk, hv;
#pragma unroll
            for (int i = 0; i < 8; ++i) { hq[i] = (f16)q[i]; hk[i] = (f16)(k[i] * 0.10206207261596577f); hv[i] = (f16)v[i]; }
            f16* o = P.qkv16 + (size_t)R * 1152 + c0;
            *(half8*)o = hq; *(half8*)(o + 384) = hk; *(half8*)(o + 768) = hv;
#pragma unroll
            for (int z = 0; z < 2; ++z) {
                const float* Wi = P.ml_wi + (size_t)(l * 2 + z) * 1152 * 4; const float* Wf = P.ml_wf + (size_t)(l * 2 + z) * 1152 * 4;
#pragma unroll
                for (int i = 0; i < 8; ++i) {
                    const int c = c0 + i;
                    const floatx4 a1 = *(const floatx4*)(Wi + c * 4), a2 = *(const floatx4*)(Wi + (384 + c) * 4), a3 = *(const floatx4*)(Wi + (768 + c) * 4);
                    const floatx4 f1 = *(const floatx4*)(Wf + c * 4), f2 = *(const floatx4*)(Wf + (384 + c) * 4), f3 = *(const floatx4*)(Wf + (768 + c) * 4);
#pragma unroll
                    for (int hh = 0; hh < 4; ++hh) {
                        acc[z * 8 + hh * 2] += q[i] * a1[hh] + k[i] * a2[hh] + v[i] * a3[hh];
                        acc[z * 8 + hh * 2 + 1] += q[i] * f1[hh] + k[i] * f2[hh] + v[i] * f3[hh];
                    }
                    asm volatile("" ::: "memory");
                }
            }
        }
        float mine = 0.f;
#pragma unroll
        for (int o = 0; o < 16; ++o) { const float s = wave_sum(acc[o]); if (lane == o) mine = s; }
        if (lane < 16) {
            const int z = lane >> 3, hh = (lane >> 1) & 3, which = lane & 1;
            const float val = mine + (which ? P.ml_bf : P.ml_bi)[(l * 2 + z) * 4 + hh];
            P.gates[(size_t)R * 16 + lane] = which ? log_sigmoidf_(val) : val;
        }
    }
}
__device__ __forceinline__ void ml_load_T(const Params& P, int z, int b, int hh, int s0, const float* wgt, f16* VT, f16* KeT, int tid) {
#pragma unroll
    for (int i = 0; i < 6; ++i) {
        const int e = tid + NT * i, which = e / 768, rem = e % 768, c8 = rem >> 6, t = rem & 63;
        const int R = scan_row(z, b, s0 + t);
        const half8 x = *(const half8*)(P.qkv16 + (size_t)R * 1152 + (which ? 384 : 768) + hh * 96 + c8 * 8);
        if (which == 0) {
#pragma unroll
            for (int j = 0; j < 8; ++j) VT[(c8 * 8 + j) * SLD + t] = x[j];
        } else {
            const float w = wgt[t];
#pragma unroll
            for (int j = 0; j < 8; ++j) KeT[(c8 * 8 + j) * SLD + t] = (f16)((float)x[j] * w);
        }
    }
}
constexpr int ML_VT_OFF = 0, ML_KE_OFF = 128 * SLD, ML_QS_OFF = ML_KE_OFF + 96 * SLD, ML_KS_OFF = ML_QS_OFF + 64 * QLD, ML_C16_OFF = ML_KS_OFF + 64 * QLD,
              ML_AM_OFF = ML_C16_OFF + 128 * QLD, ML_F_OFF_BYTES = (ML_AM_OFF + 64 * SLD) * 2;
__device__ __forceinline__ void ph_ml_1(const Params& P, int l, int bid, int nblk, unsigned char* smraw) {
    f16* VT = (f16*)smraw + ML_VT_OFF; f16* KeT = (f16*)smraw + ML_KE_OFF; float* fb = (float*)(smraw + ML_F_OFF_BYTES);
    const int tid = ltid(), lane = tid & 63, wv = tid >> 6;
    for (int item = bid; item < 16 * NSC; item += nblk) {
        const int chain = item / NSC, sc = item % NSC, z = chain / 8, b = (chain / 4) % 2, hh = chain % 4;
        __syncthreads();
        for (int idx = tid; idx < 32 * SLD; idx += NT) VT[96 * SLD + idx] = (f16)((idx < SLD) ? 1.f : 0.f);
        const int R = scan_row(z, b, sc * 256 + tid);
        const float li = P.gates[(size_t)R * 16 + z * 8 + hh * 2], lf = P.gates[(size_t)R * 16 + z * 8 + hh * 2 + 1];
        float x = lf;
#pragma unroll
        for (int o = 1; o < 64; o <<= 1) { const float y = __shfl_up(x, o); if (lane >= o) x += y; }
        if (lane == 63) fb[256 + wv] = x;
        __syncthreads();
        float off = 0.f, tot = 0.f;
#pragma unroll
        for (int w = 0; w < 4; ++w) { const float q = fb[256 + w]; tot += q; if (w < wv) off += q; }
        fb[tid] = expf(li + tot - (x + off));
        if (tid == 0) P.mlG[item] = expf(tot);
        floatx16 c0, c1, c2;
#pragma unroll
        for (int r = 0; r < 16; ++r) { c0[r] = 0.f; c1[r] = 0.f; c2[r] = 0.f; }
#pragma unroll 1
        for (int cc = 0; cc < 4; ++cc) {
            __syncthreads();
            ml_load_T(P, z, b, hh, sc * 256 + cc * 64, fb + cc * 64, VT, KeT, tid);
            __syncthreads();
            c0 = mmh<4>(VT, SLD, 32 * wv, KeT, SLD, 0, lane, c0);
            c1 = mmh<4>(VT, SLD, 32 * wv, KeT, SLD, 32, lane, c1);
            c2 = mmh<4>(VT, SLD, 32 * wv, KeT, SLD, 64, lane, c2);
        }
        float* dst = P.mlC + (size_t)item * MLE;
#pragma unroll
        for (int r = 0; r < 16; ++r) {
            const int v = 32 * wv + (r & 3) + 8 * (r >> 2) + 4 * (lane >> 5), k = lane & 31;
            if (v <= 96) { dst[v * 96 + k] = c0[r]; dst[v * 96 + 32 + k] = c1[r]; dst[v * 96 + 64 + k] = c2[r]; }
        }
    }
}
__device__ __forceinline__ void ph_ml_2(const Params& P, int bid, int nblk) {
    for (int idx = bid * NT + ltid(); idx < 16 * MLE; idx += nblk * NT) {
        const int chain = idx / MLE, e = idx % MLE; float run = 0.f;
        for (int sc = 0; sc < NSC; ++sc) {
            float* q = P.mlC + ((size_t)chain * NSC + sc) * MLE + e; const float loc = *q; *q = run;
            run = P.mlG[chain * NSC + sc] * run + loc;
        }
    }
}
__device__ __forceinline__ void ph_ml_3(const Params& P, int l, int bid, int nblk, unsigned char* smraw) {
    f16* sh = (f16*)smraw;
    f16 *VT = sh + ML_VT_OFF, *KeT = sh + ML_KE_OFF, *Qs = sh + ML_QS_OFF, *Ks = sh + ML_KS_OFF, *C16 = sh + ML_C16_OFF, *Am = sh + ML_AM_OFF;
    float* fb = (float*)(smraw + ML_F_OFF_BYTES);
    const int tid = ltid(), lane = tid & 63, wv = tid >> 6, wm = wv & 1, wn = wv >> 1;
    for (int item = bid; item < 16 * NSC; item += nblk) {
        const int chain = item / NSC, sc = item % NSC, z = chain / 8, b = (chain / 4) % 2, hh = chain % 4;
        if (l == 1 && sc == 0) continue;
        __syncthreads();
        for (int idx = tid; idx < 32 * SLD; idx += NT) VT[96 * SLD + idx] = (f16)((idx < SLD) ? 1.f : 0.f);
        floatx16 c0, c1, c2;
        {
            const float* srcC = P.mlC + (size_t)item * MLE;
#pragma unroll
            for (int r = 0; r < 16; ++r) {
                const int v = 32 * wv + (r & 3) + 8 * (r >> 2) + 4 * (lane >> 5), k = lane & 31;
                const bool ok = v <= 96;
                c0[r] = ok ? srcC[v * 96 + k] : 0.f; c1[r] = ok ? srcC[v * 96 + 32 + k] : 0.f; c2[r] = ok ? srcC[v * 96 + 64 + k] : 0.f;
            }
        }
#pragma unroll 1
        for (int cc = 0; cc < 4; ++cc) {
            const int s0 = sc * 256 + cc * 64;
            __syncthreads();
            if (wv == 0) {
                const int R = scan_row(z, b, s0 + lane);
                const float li = P.gates[(size_t)R * 16 + z * 8 + hh * 2], lf = P.gates[(size_t)R * 16 + z * 8 + hh * 2 + 1];
                float F = lf;
#pragma unroll
                for (int o = 1; o < 64; o <<= 1) { const float y = __shfl_up(F, o); if (lane >= o) F += y; }
                const float FL = __shfl(F, 63);
                fb[lane] = expf(F); fb[64 + lane] = expf(fminf(li - F, 10.f)); fb[128 + lane] = expf(li + FL - F);
                if (lane == 63) fb[192] = expf(FL);
            }
#pragma unroll
            for (int r = 0; r < 16; ++r) {
                const int v = 32 * wv + (r & 3) + 8 * (r >> 2) + 4 * (lane >> 5), k = lane & 31;
                C16[v * QLD + k] = (f16)c0[r]; C16[v * QLD + 32 + k] = (f16)c1[r]; C16[v * QLD + 64 + k] = (f16)c2[r];
            }
            __syncthreads();
#pragma unroll
            for (int i = 0; i < 6; ++i) {
                const int e = tid + NT * i, which = e / 768, rem = e % 768, t = rem / 12, c8 = rem % 12;
                const int R = scan_row(z, b, s0 + t);
                const half8 x = *(const half8*)(P.qkv16 + (size_t)R * 1152 + (which ? 384 : 0) + hh * 96 + c8 * 8);
                const float w = which ? fb[64 + t] : fb[t];
                half8 y;
#pragma unroll
                for (int jj = 0; jj < 8; ++jj) y[jj] = (f16)((float)x[jj] * w);
                *(half8*)((which ? Ks : Qs) + t * QLD + c8 * 8) = y;
            }
            ml_load_T(P, z, b, hh, s0, fb + 128, VT, KeT, tid);
            __syncthreads();
            {
                floatx16 a;
#pragma unroll
                for (int r = 0; r < 16; ++r) a[r] = 0.f;
                if (!(wm == 0 && wn == 1)) a = mmh<6>(Qs, QLD, wm * 32, Ks, QLD, wn * 32, lane, a);
#pragma unroll
                for (int r = 0; r < 16; ++r) {
                    const int m = wm * 32 + (r & 3) + 8 * (r >> 2) + 4 * (lane >> 5), n = wn * 32 + (lane & 31);
                    Am[m * SLD + n] = (f16)(n <= m ? a[r] : 0.f);
                }
            }
            {
                const float gL = fb[192];
#pragma unroll
                for (int r = 0; r < 16; ++r) { c0[r] *= gL; c1[r] *= gL; c2[r] *= gL; }
                c0 = mmh<4>(VT, SLD, 32 * wv, KeT, SLD, 0, lane, c0);
                c1 = mmh<4>(VT, SLD, 32 * wv, KeT, SLD, 32, lane, c1);
                c2 = mmh<4>(VT, SLD, 32 * wv, KeT, SLD, 64, lane, c2);
            }
            __syncthreads();
            floatx16 n0, n1;
#pragma unroll
            for (int r = 0; r < 16; ++r) { n0[r] = 0.f; n1[r] = 0.f; }
            n0 = mmh<4>(Am, SLD, 0, VT, SLD, 32 * wv, lane, n0); n0 = mmh<6>(Qs, QLD, 0, C16, QLD, 32 * wv, lane, n0);
            n1 = mmh<4>(Am, SLD, 32, VT, SLD, 32 * wv, lane, n1); n1 = mmh<6>(Qs, QLD, 32, C16, QLD, 32 * wv, lane, n1);
            if (wv == 3 && (lane & 31) == 0) {
#pragma unroll
                for (int r = 0; r < 16; ++r) { const int t = (r & 3) + 8 * (r >> 2) + 4 * (lane >> 5); fb[256 + t] = n0[r]; fb[256 + 32 + t] = n1[r]; }
            }
            __syncthreads();
            if (wv < 3) {
#pragma unroll
                for (int r = 0; r < 16; ++r) {
                    const int t = (r & 3) + 8 * (r >> 2) + 4 * (lane >> 5);
                    const int R0 = scan_row(z, b, s0 + t), R1 = scan_row(z, b, s0 + 32 + t);
                    const float d0 = fmaxf(fabsf(fb[256 + t]), 1.f), d1 = fmaxf(fabsf(fb[256 + 32 + t]), 1.f);
                    P.Y[((size_t)z * NROWS + R0) * 384 + hh * 96 + 32 * wv + (lane & 31)] = n0[r] / d0;
                    P.Y[((size_t)z * NROWS + R1) * 384 + hh * 96 + 32 * wv + (lane & 31)] = n1[r] / d1;
                }
            }
        }
    }
}
constexpr int ML_LDS_BYTES = ML_F_OFF_BYTES + 320 * 4;
#endif

constexpr size_t al256(size_t x) { return (x + 255) & ~(size_t)255; }
constexpr size_t WS_MODS = 0;
constexpr size_t WS_RSTD = al256(WS_MODS + 2 * 3 * 3072 * 4);
constexpr size_t WS_P = al256(WS_RSTD + (size_t)NROWS * 4);
constexpr size_t WS_Y = al256(WS_P + (size_t)NROWS * INW * 2);
constexpr size_t WS_QKV = al256(WS_Y + (size_t)2 * NROWS * 384 * 4);
constexpr size_t WS_GATES = al256(WS_QKV + (size_t)NROWS * 1152 * 4);
constexpr size_t WS_BON = al256(WS_GATES + (size_t)NROWS * 16 * 4);
constexpr size_t WS_YS5 = al256(WS_BON + (size_t)2 * NROWS * 6 * 4);
constexpr size_t WS_CTX1 = al256(WS_YS5 + (size_t)NROWS * 256 * 4);
constexpr size_t WS_WTIN = al256(WS_CTX1 + (size_t)NCTX * D * 4);
constexpr size_t WS_WTOUT = al256(WS_WTIN + (size_t)2 * INW * D * 2);
constexpr size_t WS_GP = al256(WS_WTOUT + (size_t)2 * D * D * 2);
constexpr size_t WS_END = al256(WS_GP + 1024);

static void fill_params(Params& P, void* const* d_in, void* d_out, void* d_ws) {
    const float** pp = (const float**)&P;
    for (int i = 0; i < 41; ++i) pp[i] = (const float*)d_in[i];
    unsigned char* ws = (unsigned char*)d_ws;
    P.out = (float*)d_out;
    P.mods = (float*)(ws + WS_MODS); P.rstd = (float*)(ws + WS_RSTD); P.p = (f16*)(ws + WS_P); P.Y = (float*)(ws + WS_Y);
    P.qkv = (float*)(ws + WS_QKV); P.gates = (float*)(ws + WS_GATES); P.bon = (float*)(ws + WS_BON); P.ys5 = (float*)(ws + WS_YS5);
    P.ctx1 = (float*)(ws + WS_CTX1);
    P.hx = (f16*)(ws + WS_QKV); P.wt_in = (f16*)(ws + WS_WTIN); P.wt_out = (f16*)(ws + WS_WTOUT);
    P.gp = (Params*)(ws + WS_GP);
    P.qkv16 = (f16*)(ws + WS_QKV); P.mlC = (float*)(ws + WS_QKV + al256((size_t)NROWS * 1152 * 2)); P.mlG = (float*)(ws + WS_QKV + al256((size_t)NROWS * 1152 * 2) + al256((size_t)16 * NSC * MLE * 4));
    P.yg = (f16*)(ws + WS_YS5); P.s5h = (float*)(ws + WS_YS5 + al256((size_t)NROWS * 256 * 2));
    P.s5par = (float*)(ws + WS_YS5 + al256((size_t)NROWS * 256 * 2) + al256((size_t)64 * NCHUNK * 128 * 4));
    P.glut = (f16*)(ws + WS_YS5 + al256((size_t)NROWS * 256 * 2) + al256((size_t)64 * NCHUNK * 128 * 4) + al256((size_t)64 * S5PW * 64 * 4));
}

enum { PH_MODS, PH_RSTD, PH_GEMM1, PH_RW_SCAN, PH_RW_FIN, PH_S5_SCAN, PH_S5_GELU, PH_S5_GLU, PH_ML_QKV, PH_ML_GATES, PH_ML_SCAN, PH_ML_FIN, PH_GEMM2, PH_FINAL };
constexpr int lds_floats(int ph) { return ph == PH_GEMM1 || ph == PH_GEMM2 ? 16 * 132 + 16 * 128 : ph == PH_RW_SCAN ? RW_LDS : ph == PH_S5_SCAN ? S5_LDS : ph == PH_ML_SCAN ? ML_LDS : 4; }

template <int PH>
DEV void run_phase(const Params& P, int l, int bid, int nblk, float* sm) {
    if (PH == PH_MODS) ph_mods(P, bid, nblk);
    else if (PH == PH_RSTD) ph_rstd(P, l, bid, nblk);
    else if (PH == PH_GEMM1) ph_gemm<1>(P, l, bid, nblk, sm);
    else if (PH == PH_RW_SCAN) ph_rwkv_scan(P, l, bid, nblk, sm);
    else if (PH == PH_RW_FIN) ph_rwkv_fin(P, l, bid, nblk);
    else if (PH == PH_S5_SCAN) ph_s5_scan(P, l, bid, nblk, sm);
    else if (PH == PH_S5_GELU) ph_s5_gelu(P, l, bid, nblk);
    else if (PH == PH_S5_GLU) ph_s5_glu(P, l, bid, nblk);
    else if (PH == PH_ML_QKV) ph_ml_qkv(P, l, bid, nblk);
    else if (PH == PH_ML_GATES) ph_ml_gates(P, l, bid, nblk);
    else if (PH == PH_ML_SCAN) ph_ml_scan(P, l, bid, nblk, sm);
    else if (PH == PH_ML_FIN) ph_ml_fin(P, l, bid, nblk);
    else if (PH == PH_GEMM2) ph_gemm<2>(P, l, bid, nblk, sm);
    else if (PH == PH_FINAL) ph_final(P, bid, nblk);
}

#ifndef CPU_EMU
constexpr int MEGA_LDS = RWP1_LDS_BYTES / 4 + 16;
static_assert(al256((size_t)NROWS * 256 * 2) + al256((size_t)64 * NCHUNK * 128 * 4) + al256((size_t)64 * S5PW * 64 * 4) + 2 * 256 * 256 * 2 <= (size_t)NROWS * 256 * 4, "s5 region");
static_assert(S5C_LDS <= MEGA_LDS, "lds");
static_assert(ML_LDS_BYTES <= MEGA_LDS * 4, "lds");
static_assert(al256((size_t)NROWS * 1152 * 2) + al256((size_t)16 * NSC * MLE * 4) + 16 * NSC * 4 <= (size_t)NROWS * 1152 * 4, "ml region");
__global__ void __launch_bounds__(NT) mega_fwd(Params Pk) {
    __shared__ __attribute__((aligned(16))) float sm[MEGA_LDS];
    cg::grid_group grid = cg::this_grid();
    const int bid = blockIdx.x, nblk = gridDim.x;
    if (threadIdx.x == 0) *Pk.gp = Pk;
    ph_mods2(Pk, lsgpr(bid), nblk, sm);
    ph_wprep(Pk, lsgpr(bid), nblk, sm);
    ph_s5_params(Pk, lsgpr(bid), nblk);
    grid.sync();
    const Params* pg = Pk.gp;
    asm volatile("" : "+s"(pg) :: "memory");
    const Params& P = *pg;
    for (int l = 0; l < 2; ++l) {
        ph_hx(P, l, lsgpr(bid), nblk); grid.sync();
        ph_gemm_mfma<1>(P, l, lsgpr(bid), nblk, (unsigned char*)sm); grid.sync();
        ph_rw_p1(P, l, lsgpr(bid), nblk, (unsigned char*)sm);
        ph_s5_a(P, l, lsgpr(bid), nblk, sm); grid.sync();
        ph_rw_stream(P, l, lsgpr(bid), nblk, (unsigned char*)sm);
        ph_s5_b(P, l, lsgpr(bid), nblk); grid.sync();
        ph_rwkv_fin2(P, l, lsgpr(bid), nblk);
        ph_s5_c(P, l, lsgpr(bid), nblk, sm); grid.sync();
        ph_gemm_mfma<3>(P, l, lsgpr(bid), nblk, (unsigned char*)sm);
        ph_ml_a(P, l, lsgpr(bid), nblk); grid.sync();
        ph_ml_1(P, l, lsgpr(bid), nblk, (unsigned char*)sm); grid.sync();
        ph_ml_2(P, lsgpr(bid), nblk); grid.sync();
        ph_ml_3(P, l, lsgpr(bid), nblk, (unsigned char*)sm); grid.sync();
        ph_ml_fin2(P, l, lsgpr(bid), nblk); grid.sync();
        ph_gemm_mfma<2>(P, l, lsgpr(bid), nblk, (unsigned char*)sm); grid.sync();
    }
    ph_final2(P, lsgpr(bid), nblk);
}

extern "C" void kernel_launch(void* const* d_in, const int* in_sizes, int n_in, void* d_out, int out_size, void* d_ws, size_t ws_size, hipStream_t stream) {
    if (ws_size < WS_END) { fprintf(stderr, "workspace too small: %zu < %zu\n", ws_size, (size_t)WS_END); return; }
    static int grid_blocks = 0;
    if (!grid_blocks) {
        int dev = 0, cus = 0, per_cu = 0;
        hipGetDevice(&dev);
        hipDeviceGetAttribute(&cus, hipDeviceAttributeMultiprocessorCount, dev);
        hipOccupancyMaxActiveBlocksPerMultiprocessor(&per_cu, mega_fwd, NT, 0);
        if (per_cu < 1) per_cu = 1;
        grid_blocks = cus * per_cu;
        fprintf(stderr, "mega_fwd: %d CUs x %d blocks/CU\n", cus, per_cu);
    }
    Params P{};
    fill_params(P, d_in, d_out, d_ws);
    void* args[] = {&P};
    hipError_t e = hipLaunchCooperativeKernel((void*)mega_fwd, dim3(grid_blocks), dim3(NT), args, 0, stream);
    if (e != hipSuccess) fprintf(stderr, "cooperative launch failed: %s (grid %d)\n", hipGetErrorString(e), grid_blocks);
}
#endif
```

```cpp
#include <hip/hip_runtime.h>
#include <hip/hip_cooperative_groups.h>
#include <cstdint>
#include <cmath>
#include <cstdio>
namespace cg = cooperative_groups;

#ifndef SEQ
#define SEQ 16384
#endif
#ifndef CTX
#define CTX 256
#endif
#ifndef REP_G1
#define REP_G1 1
#endif
#ifndef REP_G2
#define REP_G2 1
#endif
#ifndef REP_P1
#define REP_P1 1
#endif
#ifndef REP_S5A
#define REP_S5A 1
#endif
#ifndef REP_S5C
#define REP_S5C 1
#endif
#ifndef REP_MLA
#define REP_MLA 1
#endif
#ifndef REP_ML1
#define REP_ML1 1
#endif
#ifndef REP_ML3
#define REP_ML3 1
#endif
#ifndef REP_HX
#define REP_HX 1
#endif
#ifndef REP_SYNC
#define REP_SYNC 1
#endif

typedef _Float16 f16;
typedef __bf16 bf16;
typedef _Float16 half8 __attribute__((ext_vector_type(8)));
typedef _Float16 half4 __attribute__((ext_vector_type(4)));
typedef __bf16 bf16x8 __attribute__((ext_vector_type(8)));
typedef __bf16 bf16x4 __attribute__((ext_vector_type(4)));
typedef float floatx16 __attribute__((ext_vector_type(16)));
typedef float floatx4 __attribute__((ext_vector_type(4)));
typedef unsigned uintx4 __attribute__((ext_vector_type(4)));

constexpr int D = 1024, NB = 2, INW = 2944;
constexpr int NCTX = NB * CTX, NLAT = NB * SEQ, NROWS = NCTX + NLAT;
constexpr int TSCAN = CTX + SEQ, NCHUNK = TSCAN / 64;
constexpr int NT = 512, NW = NT / 64;
#define DEV __device__ __forceinline__
#define BAR_LDS() asm volatile("s_waitcnt lgkmcnt(0)\n\ts_barrier" ::: "memory")

DEV int ltid() { int t = threadIdx.x; asm volatile("" : "+v"(t)); return t; }
DEV int lsgpr(int x) { asm volatile("" : "+s"(x)); return x; }

struct Params {
    const float *x, *c, *ctx, *c_ctx, *ada_w, *ada_b, *norm_g, *w_in, *w_out;
    const float *rw_mu, *rw_w0, *rw_w_up, *rw_a0, *rw_a_up, *rw_k_k, *rw_k_a, *rw_r_k, *rw_ln_g, *rw_ln_b;
    const float *s5_a_re, *s5_a_im, *s5_log_dt, *s5_b_re, *s5_b_im, *s5_c_re, *s5_c_im, *s5_d, *s5_glu_w, *s5_glu_b;
    const float *ml_conv_w, *ml_conv_b, *ml_wq, *ml_wk, *ml_wv, *ml_wi, *ml_bi, *ml_wf, *ml_bf, *ml_norm_g, *ml_skip;
    const float* final_g;
    float* out;
    float* mods;
    f16* p;
    float* Y;
    float* gates;
    float* bon;
    float* ctx1;
    f16* hx;
    f16* rwm;
    f16* qkv16;
    float* mlC;
    float* mlG;
    f16* wt_in;
    f16* wt_out;
    f16* glut;
    f16* yg;
    float* s5h;
    float* s5par;
    f16* s5bb;
    f16* s5cc;
    bf16* rwlt;
    Params* gp;
};

DEV float sigmoidf_(float x) { return 1.f / (1.f + expf(-x)); }
DEV float siluf_(float x) { return x / (1.f + expf(-x)); }
DEV float frcp(float x) { return __builtin_amdgcn_rcpf(x); }
DEV float fsigmoid(float x) { return frcp(1.f + __expf(-x)); }
DEV float fsilu(float x) { return x * frcp(1.f + __expf(-x)); }
DEV float ftanh(float x) { x = fminf(fmaxf(x, -15.f), 15.f); const float e = __expf(2.f * x); return (e - 1.f) * frcp(e + 1.f); }
DEV float log_sigmoidf_(float x) { return fminf(x, 0.f) - log1pf(expf(-fabsf(x))); }
DEV float wave_sum(float v) {
#pragma unroll
    for (int o = 1; o < 64; o <<= 1) v += __shfl_xor(v, o);
    return v;
}
DEV int scan_row(int z, int b, int s) {
    if (s < CTX) { int t = z ? CTX - 1 - s : s; return b * CTX + t; }
    int u = s - CTX; int t = z ? SEQ - 1 - u : u; return NCTX + b * SEQ + t;
}
DEV int mirror_chunk(int tc) { return tc < CTX / 64 ? CTX / 64 - 1 - tc : CTX / 64 + (SEQ / 64 - 1) - (tc - CTX / 64); }
DEV int row_mod(int R) { return R < NCTX ? 2 : (R - NCTX) / SEQ; }
DEV const float* xrow(const Params& P, int l, int R) {
    const float* xl = l == 0 ? P.x : P.out; const float* xc = l == 0 ? P.ctx : P.ctx1;
    return R < NCTX ? xc + (size_t)R * D : xl + (size_t)(R - NCTX) * D;
}
DEV int nbr_row(int R, int c) {
    if (R < NCTX) { int t = R % CTX; if ((c & 1) == 0) return t > 0 ? R - 1 : -1; return t < CTX - 1 ? R + 1 : -1; }
    int t = (R - NCTX) % SEQ; int m = c & 3, col = t & 63;
    if (m == 0) return col > 0 ? R - 1 : -1;
    if (m == 1) return col < 63 ? R + 1 : -1;
    if (m == 2) return t >= 64 ? R - 64 : -1;
    return t < SEQ - 64 ? R + 64 : -1;
}
DEV float shl(const Params& P, int l, int R, int c) {
    float pv = (float)P.p[(size_t)R * INW + c];
    int nb = nbr_row(R, c);
    float nv = nb >= 0 ? (float)P.p[(size_t)nb * INW + c] : 0.f;
    return pv + (nv - pv) * P.rw_mu[l * 1280 + c];
}
DEV int a2col(int k) { return k < 384 ? 1280 + k : (k < 640 ? 1920 + (k - 384) : 2560 + (k - 640)); }
DEV float ml_xm(const Params& P, int R, int c) { return (float)P.p[(size_t)R * INW + 2176 + c]; }
DEV float ml_xc(const Params& P, int l, int R, int c) {
    int t, len; if (R < NCTX) { t = R % CTX; len = CTX; } else { t = (R - NCTX) % SEQ; len = SEQ; }
    float a = P.ml_conv_b[l * 384 + c] + P.ml_conv_w[(l * 3 + 1) * 384 + c] * ml_xm(P, R, c);
    if (t > 0) a += P.ml_conv_w[(l * 3 + 0) * 384 + c] * ml_xm(P, R - 1, c);
    if (t < len - 1) a += P.ml_conv_w[(l * 3 + 2) * 384 + c] * ml_xm(P, R + 1, c);
    return fsilu(a);
}

DEV void ph_mods2(const Params& P, int bid, int nblk, float* sm) {
    const int tid = ltid(), cl = tid & 15, kq = tid >> 4;
    for (int g = bid; g < 2 * 3 * 3072 / 16; g += nblk) {
        const int idx = g * 16 + cl; const int l = idx / 9216, rem = idx % 9216, j = rem / 3072, col = rem % 3072;
        const float* cin = j < 2 ? P.c + j * D : P.c_ctx;
        float acc = 0.f;
        for (int k = kq * 32; k < kq * 32 + 32; ++k) acc += siluf_(cin[k]) * P.ada_w[((size_t)l * D + k) * 3072 + col];
        sm[kq * 16 + cl] = acc;
        __syncthreads();
        if (tid < 16) { float s = P.ada_b[l * 3072 + col]; for (int q = 0; q < 32; ++q) s += sm[q * 16 + tid]; P.mods[idx] = s; }
        __syncthreads();
    }
}
DEV void ph_wprep(const Params& P, int bid, int nblk, float* sm) {
    const int tid = ltid();
    constexpr int T_IN = 16 * 46, T_OUT = 16 * 16, T_GLU = 4 * 4;
    for (int t = bid; t < 2 * (T_IN + T_OUT + T_GLU); t += nblk) {
        int l = t / (T_IN + T_OUT + T_GLU), r = t % (T_IN + T_OUT + T_GLU);
        const float* W; f16* Wt; int N, tk, tn, KW = D;
        if (r < T_IN) { W = P.w_in + (size_t)l * D * INW; Wt = P.wt_in + (size_t)l * INW * D; N = INW; tk = r / 46; tn = r % 46; }
        else if (r < T_IN + T_OUT) { r -= T_IN; W = P.w_out + (size_t)l * D * D; Wt = P.wt_out + (size_t)l * D * D; N = D; tk = r / 16; tn = r % 16; }
        else { r -= T_IN + T_OUT; W = P.s5_glu_w + (size_t)l * 256 * 256; Wt = P.glut + (size_t)l * 256 * 256; N = 256; tk = r / 4; tn = r % 4; KW = 256; }
#pragma unroll
        for (int i = 0; i < 2; ++i) {
            int k = (tid >> 4) + 32 * i, n4 = (tid & 15) * 4;
            floatx4 v = *(const floatx4*)(W + (size_t)(tk * 64 + k) * N + tn * 64 + n4);
            sm[k * 65 + n4] = v[0]; sm[k * 65 + n4 + 1] = v[1]; sm[k * 65 + n4 + 2] = v[2]; sm[k * 65 + n4 + 3] = v[3];
        }
        __syncthreads();
        {
            int n = tid >> 3, k8 = (tid & 7) * 8;
            half8 h;
#pragma unroll
            for (int j = 0; j < 8; ++j) h[j] = (f16)sm[(k8 + j) * 65 + n];
            *(half8*)(Wt + (size_t)(tn * 64 + n) * KW + tk * 64 + k8) = h;
        }
        __syncthreads();
    }
}
constexpr int S5PW = 38;
DEV void ph_tables(const Params& P, int bid, int nblk) {
    for (int idx = bid * NT + ltid(); idx < 2 * 2 * 16 * 64; idx += nblk * NT) {
        const int n = idx & 63, lzg = idx >> 6;
        const int pi = lzg * 64 + n;
        const float are_ = P.s5_a_re[pi], aim_ = P.s5_a_im[pi], dt = expf(P.s5_log_dt[pi]);
        const float mag = expf(are_ * dt), abr = mag * cosf(aim_ * dt), abi = mag * sinf(aim_ * dt);
        const float den = are_ * are_ + aim_ * aim_;
        const float qre = ((abr - 1.f) * are_ + abi * aim_) / den, qim = (abi * are_ - (abr - 1.f) * aim_) / den;
        float* tb = P.s5par + (size_t)lzg * S5PW * 64 + n;
        tb[0] = abr; tb[64] = abi;
        for (int pp = 0; pp < 16; ++pp) {
            const float br = P.s5_b_re[(size_t)pi * 16 + pp], bi = P.s5_b_im[(size_t)pi * 16 + pp];
            P.s5bb[((size_t)lzg * 128 + n) * 16 + pp] = (f16)(qre * br - qim * bi);
            P.s5bb[((size_t)lzg * 128 + 64 + n) * 16 + pp] = (f16)(qre * bi + qim * br);
            P.s5cc[((size_t)lzg * 16 + pp) * 128 + n] = (f16)P.s5_c_re[((size_t)lzg * 16 + pp) * 64 + n];
            P.s5cc[((size_t)lzg * 16 + pp) * 128 + 64 + n] = (f16)(-P.s5_c_im[((size_t)lzg * 16 + pp) * 64 + n]);
        }
        const float m64 = expf(64.f * are_ * dt);
        tb[34 * 64] = m64 * cosf(64.f * aim_ * dt); tb[35 * 64] = m64 * sinf(64.f * aim_ * dt);
    }
    for (int idx = bid * NT + ltid(); idx < 2 * 2 * 2 * 384 * 32; idx += nblk * NT) {
        const int r = idx & 31, c = (idx >> 5) % 384, wa = (idx / (32 * 384)) & 1, lz = idx / (2 * 32 * 384);
        const float* src_ = wa ? P.rw_a_up : P.rw_w_up;
        P.rwlt[idx] = (bf16)src_[((size_t)lz * 32 + r) * 384 + c];
    }
}
DEV void ph_hx(const Params& P, int l, int bid, int nblk) {
    const int tid_ = ltid(); const int lane = tid_ & 63, wv = tid_ >> 6;
    for (int R = bid * NW + wv; R < NROWS; R += nblk * NW) {
        const float* xr = xrow(P, l, R);
        floatx4 v[4]; float ss = 0.f;
#pragma unroll
        for (int i = 0; i < 4; ++i) { v[i] = *(const floatx4*)(xr + i * 256 + lane * 4); ss += v[i][0] * v[i][0] + v[i][1] * v[i][1] + v[i][2] * v[i][2] + v[i][3] * v[i][3]; }
        ss = wave_sum(ss);
        const float rs = 1.f / sqrtf(ss * (1.f / D) + 1e-6f);
        const float* m = P.mods + (l * 3 + row_mod(R)) * 3072; const float* g = P.norm_g + l * D;
#pragma unroll
        for (int i = 0; i < 4; ++i) {
            int k = i * 256 + lane * 4; half4 h;
#pragma unroll
            for (int j = 0; j < 4; ++j) h[j] = (f16)(v[i][j] * rs * g[k + j] * (1.f + m[D + k + j]) + m[k + j]);
            *(half4*)(P.hx + (size_t)R * D + k) = h;
        }
    }
}
DEV void ph_final2(const Params& P, int bid, int nblk) {
    const int tid_ = ltid(); const int lane = tid_ & 63, wv = tid_ >> 6;
    for (int r = bid * NW + wv; r < NLAT; r += nblk * NW) {
        float* xr = P.out + (size_t)r * D; floatx4 v[4]; float ss = 0.f;
#pragma unroll
        for (int i = 0; i < 4; ++i) { v[i] = *(const floatx4*)(xr + i * 256 + lane * 4); ss += v[i][0] * v[i][0] + v[i][1] * v[i][1] + v[i][2] * v[i][2] + v[i][3] * v[i][3]; }
        ss = wave_sum(ss);
        const float rs = 1.f / sqrtf(ss * (1.f / D) + 1e-6f);
#pragma unroll
        for (int i = 0; i < 4; ++i) {
            const floatx4 g = *(const floatx4*)(P.final_g + i * 256 + lane * 4); floatx4 o;
#pragma unroll
            for (int j = 0; j < 4; ++j) o[j] = v[i][j] * rs * g[j];
            *(floatx4*)(xr + i * 256 + lane * 4) = o;
        }
    }
}

constexpr int G_LDA = 72;
constexpr int G_STAGE = (256 + 128) * G_LDA;
constexpr int GEMM_LDS_BYTES = 2 * G_STAGE * 2;
template <int MODE>
DEV void gemm_epi_tile(const Params& P, int l, const floatx16 acc, int R0, int n0, int lane) {
#pragma unroll
    for (int r = 0; r < 16; ++r) {
        const int R = R0 + (r & 3) + 8 * (r >> 2) + 4 * (lane >> 5), n = n0 + (lane & 31);
        if (MODE == 1) P.p[(size_t)R * INW + n] = (f16)acc[r];
        else if (MODE == 2) {
            const int j = row_mod(R); const float g = P.mods[(l * 3 + j) * 3072 + 2 * D + n];
            const float xo = xrow(P, l, R)[n];
            float* dst = R < NCTX ? P.ctx1 + (size_t)R * D + n : P.out + (size_t)(R - NCTX) * D + n;
            *dst = xo + g * acc[r];
        } else {
            const float yv = (float)P.yg[(size_t)R * 256 + n]; const float gt = (float)P.p[(size_t)R * INW + 1920 + n];
            P.p[(size_t)R * INW + 1920 + n] = (f16)(yv * fsigmoid(acc[r] + P.s5_glu_b[l * 256 + n]) * fsilu(gt));
        }
    }
}
template <int MODE>
DEV void ph_gemm_mfma(const Params& P, int l, int bid, int nblk, unsigned char* smraw) {
    constexpr int N = MODE == 1 ? INW : (MODE == 2 ? D : 256), K = MODE == 3 ? 256 : D;
    const f16* Bt = MODE == 1 ? P.wt_in + (size_t)l * INW * D : (MODE == 2 ? P.wt_out + (size_t)l * D * D : P.glut + (size_t)l * 256 * 256);
    const int tm0 = (MODE != 1 && l == 1) ? NCTX / 256 : 0;
    const int ntm = NROWS / 256 - tm0, ntn = N / 128;
    const int tid = ltid(), lane = tid & 63, wv = tid >> 6, wm = wv & 3, wn = wv >> 2;
    f16* sbase = (f16*)smraw;
    const int ldrow = tid >> 3, ldch = tid & 7;
    constexpr int GM = 8;
    for (int t = bid; t < ntm * ntn; t += nblk) {
        int sg = t / (GM * ntn), rem = t % (GM * ntn);
        int gsz = ntm - sg * GM < GM ? ntm - sg * GM : GM;
        const int tm = tm0 + sg * GM + rem % gsz, tn = rem / gsz;
        floatx16 acc00, acc01, acc10, acc11;
#pragma unroll
        for (int r = 0; r < 16; ++r) { acc00[r] = 0.f; acc01[r] = 0.f; acc10[r] = 0.f; acc11[r] = 0.f; }
        uintx4 ra0, ra1, ra2, ra3, rb0, rb1;
        const f16* arow = MODE == 1 ? P.hx + (size_t)(tm * 256 + ldrow) * D + ldch * 8 : (MODE == 2 ? P.p + (size_t)(tm * 256 + ldrow) * INW + ldch * 8 : P.yg + (size_t)(tm * 256 + ldrow) * 256 + ldch * 8);
        const size_t astr = (size_t)64 * (MODE == 1 ? D : (MODE == 2 ? INW : 256));
        const f16* brow = Bt + (size_t)(tn * 128 + ldrow) * K + ldch * 8;
#define GLOAD(kt_) { const int ka = MODE == 2 ? a2col((kt_) * 64) : (kt_) * 64; const int kb = (kt_) * 64; \
            ra0 = *(const uintx4*)(arow + ka); ra1 = *(const uintx4*)(arow + astr + ka); ra2 = *(const uintx4*)(arow + 2 * astr + ka); ra3 = *(const uintx4*)(arow + 3 * astr + ka); \
            rb0 = *(const uintx4*)(brow + kb); rb1 = *(const uintx4*)(brow + (size_t)64 * K + kb); }
#define SWRITE(st_) { f16* sA_ = sbase + (st_) * G_STAGE + ldrow * G_LDA + ldch * 8; f16* sB_ = sbase + (st_) * G_STAGE + 256 * G_LDA + ldrow * G_LDA + ldch * 8; \
            *(uintx4*)(sA_) = ra0; *(uintx4*)(sA_ + 64 * G_LDA) = ra1; *(uintx4*)(sA_ + 128 * G_LDA) = ra2; *(uintx4*)(sA_ + 192 * G_LDA) = ra3; \
            *(uintx4*)(sB_) = rb0; *(uintx4*)(sB_ + 64 * G_LDA) = rb1; }
        __syncthreads();
        GLOAD(0); SWRITE(0);
        __syncthreads();
        for (int kt = 0; kt < K / 64; ++kt) {
            if (kt + 1 < K / 64) GLOAD(kt + 1);
            const f16* sA = sbase + (kt & 1) * G_STAGE; const f16* sB = sA + 256 * G_LDA;
#pragma unroll
            for (int ks = 0; ks < 4; ++ks) {
                const int kof = ks * 16 + (lane >> 5) * 8;
                const half8 af0 = *(const half8*)(sA + (wm * 64 + (lane & 31)) * G_LDA + kof);
                const half8 af1 = *(const half8*)(sA + (wm * 64 + 32 + (lane & 31)) * G_LDA + kof);
                const half8 bf0 = *(const half8*)(sB + (wn * 64 + (lane & 31)) * G_LDA + kof);
                const half8 bf1 = *(const half8*)(sB + (wn * 64 + 32 + (lane & 31)) * G_LDA + kof);
                acc00 = __builtin_amdgcn_mfma_f32_32x32x16_f16(af0, bf0, acc00, 0, 0, 0);
                acc01 = __builtin_amdgcn_mfma_f32_32x32x16_f16(af0, bf1, acc01, 0, 0, 0);
                acc10 = __builtin_amdgcn_mfma_f32_32x32x16_f16(af1, bf0, acc10, 0, 0, 0);
                acc11 = __builtin_amdgcn_mfma_f32_32x32x16_f16(af1, bf1, acc11, 0, 0, 0);
            }
            if (kt + 1 < K / 64) SWRITE((kt + 1) & 1);
            __syncthreads();
        }
#undef GLOAD
#undef SWRITE
        gemm_epi_tile<MODE>(P, l, acc00, tm * 256 + wm * 64, tn * 128 + wn * 64, lane);
        gemm_epi_tile<MODE>(P, l, acc01, tm * 256 + wm * 64, tn * 128 + wn * 64 + 32, lane);
        gemm_epi_tile<MODE>(P, l, acc10, tm * 256 + wm * 64 + 32, tn * 128 + wn * 64, lane);
        gemm_epi_tile<MODE>(P, l, acc11, tm * 256 + wm * 64 + 32, tn * 128 + wn * 64 + 32, lane);
    }
}

constexpr int RLD = 72;
constexpr int RSLOT = 64 * RLD;
constexpr int RWP1_LDS_BYTES = 11 * RSLOT * 2 + 2 * 64 * 65 * 4 + 1536 * 4 + 128 * 4;
constexpr size_t RWM_STRIDE = (size_t)24 * NCHUNK * 4096;

DEV bf16x8 ldfrag(const bf16* M, int rowbase, int lane, int ks) {
    return *(const bf16x8*)(M + (rowbase + (lane & 31)) * RLD + ks * 16 + (lane >> 5) * 8);
}
DEV floatx16 mm64(const bf16* A, const bf16* Bt, int wm, int wn, int lane) {
    floatx16 acc;
#pragma unroll
    for (int r = 0; r < 16; ++r) acc[r] = 0.f;
#pragma unroll
    for (int ks = 0; ks < 4; ++ks) acc = __builtin_amdgcn_mfma_f32_32x32x16_bf16(ldfrag(A, wm * 32, lane, ks), ldfrag(Bt, wn * 32, lane, ks), acc, 0, 0, 0);
    return acc;
}
DEV void storeT(bf16* dst, const floatx16 c, int wm, int wn, int lane) {
    const int n = wn * 32 + (lane & 31);
#pragma unroll
    for (int g = 0; g < 4; ++g) {
        const int m0 = wm * 32 + 8 * g + 4 * (lane >> 5);
        bf16x4 v; v[0] = (bf16)c[4 * g]; v[1] = (bf16)c[4 * g + 1]; v[2] = (bf16)c[4 * g + 2]; v[3] = (bf16)c[4 * g + 3];
        *(bf16x4*)(dst + n * RLD + m0) = v;
    }
}

DEV void ph_rw_p1(const Params& P, int l, int bid, int nblk, unsigned char* smraw) {
    bf16* sl = (bf16*)smraw;
    bf16 *Am = sl, *AmT = sl + RSLOT, *Bp = sl + 2 * RSLOT, *Kp = sl + 3 * RSLOT, *Rt = sl + 4 * RSLOT, *VT = sl + 5 * RSLOT,
         *BendT = sl + 6 * RSLOT, *KendT = sl + 7 * RSLOT, *Nak = sl + 8 * RSLOT, *Mrb = sl + 9 * RSLOT, *Mrk = sl + 10 * RSLOT;
    bf16 *Tb = Am, *UtT = AmT, *WmT = Bp, *NVT = Kp;
    float* Nf = (float*)(smraw + 11 * RSLOT * 2); float* Tf = Nf + 64 * 65; float* Wb = Tf + 64 * 65; float* gl = Wb + 1536;
    float* av = Nf; float* lwb = Tf;
    f16* Sr = (f16*)Nak; f16* Sk = (f16*)Mrb; f16* Sv = (f16*)Mrk; bf16* lt = KendT;
    float* part = Wb;
    const int tid = ltid(), lane = tid & 63, wv = tid >> 6, q4 = wv & 3, wm = q4 & 1, wn = q4 >> 1, hs = wv >> 2;
    f16* PTg = P.rwm; f16* RPg = PTg + RWM_STRIDE; f16* Qg = RPg + RWM_STRIDE;
    for (int item = bid; item < 24 * NCHUNK; item += nblk) {
        const int chain = item / NCHUNK, ck = item % NCHUNK;
        const int z = chain / 12, b = (chain / 6) % 2, h = chain % 6, s0 = ck * 64;
        const int j = lane, tq = wv, c = h * 64 + j;
#pragma unroll 1
        for (int i = 0; i < 4; ++i) {
            const int task = tid + NT * i, c8 = task & 7, t = (task >> 3) & 63, q = task >> 9;
            const int col0 = q < 3 ? q * 384 + h * 64 + c8 * 8 : (c8 < 4 ? 1152 + z * 32 + c8 * 8 : 1216 + z * 32 + (c8 - 4) * 8);
            const int R = scan_row(z, b, s0 + t);
            const f16* pr = P.p + (size_t)R * INW + col0;
            const half8 own = *(const half8*)pr;
            half8 n0, n1, n2, n3;
#pragma unroll
            for (int e = 0; e < 8; ++e) { n0[e] = (f16)0.f; n1[e] = (f16)0.f; n2[e] = (f16)0.f; n3[e] = (f16)0.f; }
            if (R < NCTX) {
                const int tt = R % CTX;
                if (tt > 0) n0 = *(const half8*)(pr - INW);
                if (tt < CTX - 1) n1 = *(const half8*)(pr + INW);
                n2 = n0; n3 = n1;
            } else {
                const int tt = (R - NCTX) % SEQ, col = tt & 63;
                if (col > 0) n0 = *(const half8*)(pr - INW);
                if (col < 63) n1 = *(const half8*)(pr + INW);
                if (tt >= 64) n2 = *(const half8*)(pr - 64 * INW);
                if (tt < SEQ - 64) n3 = *(const half8*)(pr + 64 * INW);
            }
            const floatx4 mu0 = *(const floatx4*)(P.rw_mu + l * 1280 + col0), mu1 = *(const floatx4*)(P.rw_mu + l * 1280 + col0 + 4);
            float s[8];
#pragma unroll
            for (int e = 0; e < 8; ++e) {
                const float pv = (float)own[e];
                const float nv = (float)((e & 3) == 0 ? n0[e] : (e & 3) == 1 ? n1[e] : (e & 3) == 2 ? n2[e] : n3[e]);
                s[e] = pv + (nv - pv) * (e < 4 ? mu0[e] : mu1[e - 4]);
            }
            if (q < 3) {
                half8 o;
#pragma unroll
                for (int e = 0; e < 8; ++e) o[e] = (f16)s[e];
                *(half8*)((q == 0 ? Sr : q == 1 ? Sk : Sv) + t * RLD + c8 * 8) = o;
            } else {
                bf16x8 o;
#pragma unroll
                for (int e = 0; e < 8; ++e) o[e] = (bf16)(c8 < 4 ? ftanh(s[e]) : s[e]);
                *(bf16x8*)(lt + t * RLD + c8 * 8) = o;
            }
        }
        BAR_LDS();
        {
            const bf16* tab = P.rwlt + ((size_t)((l * 2 + z) * 2 + hs) * 384 + h * 64 + wn * 32 + (lane & 31)) * 32 + (lane >> 5) * 8;
            floatx16 aw;
#pragma unroll
            for (int r = 0; r < 16; ++r) aw[r] = 0.f;
#pragma unroll
            for (int ks = 0; ks < 2; ++ks) aw = __builtin_amdgcn_mfma_f32_32x32x16_bf16(ldfrag(lt + hs * 32, wm * 32, lane, ks), *(const bf16x8*)(tab + ks * 16), aw, 0, 0, 0);
            const int cc = h * 64 + wn * 32 + (lane & 31);
            const float bias = hs ? P.rw_a0[(l * 2 + z) * 384 + cc] : P.rw_w0[(l * 2 + z) * 384 + cc];
#pragma unroll
            for (int r = 0; r < 16; ++r) {
                const int m = wm * 32 + (r & 3) + 8 * (r >> 2) + 4 * (lane >> 5), n = wn * 32 + (lane & 31);
                const float sg = fsigmoid(aw[r] + bias);
                if (hs) av[m * 65 + n] = sg; else lwb[m * 65 + n] = -0.6065306597126334f * sg;
            }
        }
        BAR_LDS();
        float gpre, gtot;
        {
            float run = 0.f, gv[8];
#pragma unroll
            for (int tt = 0; tt < 8; ++tt) { run += lwb[(tq * 8 + tt) * 65 + j]; gv[tt] = run; }
            part[tq * 64 + j] = run;
            const int t = lane, q8 = wv;
            float ss = 0.f, bn = 0.f;
#pragma unroll
            for (int e = 0; e < 8; ++e) {
                const int jj = q8 * 8 + e, c2 = h * 64 + jj;
                const float k_ = (float)Sk[t * RLD + jj], r_ = (float)Sr[t * RLD + jj], a = av[t * 65 + jj];
                const float kku = k_ * P.rw_k_k[l * 384 + c2];
                ss += kku * kku; bn += r_ * k_ * (1.f + (a - 1.f) * P.rw_k_a[l * 384 + c2]) * P.rw_r_k[l * 384 + c2];
            }
            part[512 + q8 * 64 + t] = ss; part[1024 + q8 * 64 + t] = bn;
            BAR_LDS();
            gpre = 0.f; gtot = 0.f;
#pragma unroll
            for (int q = 0; q < 8; ++q) { const float x = part[q * 64 + j]; gtot += x; if (q < tq) gpre += x; }
#pragma unroll
            for (int tt = 0; tt < 8; ++tt) lwb[(tq * 8 + tt) * 65 + j] = gv[tt] + gpre;
            if (tq == 0) {
                gl[j] = __expf(gtot);
                float sst = 0.f, bnt = 0.f;
#pragma unroll
                for (int q = 0; q < 8; ++q) { sst += part[512 + q * 64 + lane]; bnt += part[1024 + q * 64 + lane]; }
                gl[64 + lane] = __builtin_amdgcn_rsqf(sst + 1e-6f);
                P.bon[((size_t)z * NROWS + scan_row(z, b, s0 + lane)) * 6 + h] = bnt;
            }
        }
        BAR_LDS();
        {
            const float kkc = P.rw_k_k[l * 384 + c], kac = P.rw_k_a[l * 384 + c];
            const float Gt = __expf(gtot);
            float e_prev = __expf(gpre);
            bf16x8 amT, vT, beT, keT;
#pragma unroll
            for (int tt = 0; tt < 8; ++tt) {
                const int t = tq * 8 + tt;
                const float r_ = (float)Sr[t * RLD + j], k_ = (float)Sk[t * RLD + j], v_ = (float)Sv[t * RLD + j];
                const float a = av[t * 65 + j], g = lwb[t * 65 + j], sinv = gl[64 + t];
                const float e_t = __expf(g), e_p = frcp(e_t), e_m = e_prev, e_e = Gt * e_p;
                e_prev = e_t;
                const float kkn = k_ * kkc * sinv, kd = k_ * (1.f + (a - 1.f) * kac), bb = a * kkn;
                const bf16 am = (bf16)(kkn * e_m);
                Am[t * RLD + j] = am; Bp[t * RLD + j] = (bf16)(bb * e_p); Kp[t * RLD + j] = (bf16)(kd * e_p); Rt[t * RLD + j] = (bf16)(r_ * e_t);
                amT[tt] = am; vT[tt] = (bf16)v_; beT[tt] = (bf16)(bb * e_e); keT[tt] = (bf16)(kd * e_e);
            }
            BAR_LDS();
            const int to = j * RLD + tq * 8;
            *(bf16x8*)(AmT + to) = amT; *(bf16x8*)(VT + to) = vT; *(bf16x8*)(BendT + to) = beT; *(bf16x8*)(KendT + to) = keT;
        }
        BAR_LDS();
        {
            floatx16 c1, c2;
#pragma unroll
            for (int r = 0; r < 16; ++r) { c1[r] = 0.f; c2[r] = 0.f; }
            if (!(wm == 0 && wn == 1)) {
                const bf16* Aop = hs ? Rt : Am;
#pragma unroll
                for (int ks = 0; ks < 4; ++ks) {
                    const bf16x8 a1 = ldfrag(Aop, wm * 32, lane, ks), b1 = ldfrag(Bp, wn * 32, lane, ks), b2 = ldfrag(Kp, wn * 32, lane, ks);
                    c1 = __builtin_amdgcn_mfma_f32_32x32x16_bf16(a1, b1, c1, 0, 0, 0);
                    c2 = __builtin_amdgcn_mfma_f32_32x32x16_bf16(a1, b2, c2, 0, 0, 0);
                }
            }
#pragma unroll
            for (int r = 0; r < 16; ++r) {
                const int m = wm * 32 + (r & 3) + 8 * (r >> 2) + 4 * (lane >> 5), n = wn * 32 + (lane & 31);
                if (hs == 0) { Nf[m * 65 + n] = n < m ? c1[r] : 0.f; Nak[m * RLD + n] = (bf16)(n < m ? c2[r] : 0.f); }
                else { Mrb[m * RLD + n] = (bf16)(n <= m ? c1[r] : 0.f); Mrk[m * RLD + n] = (bf16)(n <= m ? c2[r] : 0.f); }
            }
        }
        BAR_LDS();
        if (tid < 64) {
            const int i = tid >> 4, jc = tid & 15; float x[16];
#pragma unroll
            for (int row = 0; row < 16; ++row) {
                float s = row == jc ? 1.f : 0.f;
#pragma unroll
                for (int m = 0; m < row; ++m) s -= Nf[(16 * i + row) * 65 + 16 * i + m] * x[m];
                x[row] = s;
            }
#pragma unroll
            for (int row = 0; row < 16; ++row) Tf[(16 * i + row) * 65 + 16 * i + jc] = x[row];
        }
        BAR_LDS();
        {
            const int a = (tid >> 4) & 15, cc = tid & 15;
#pragma unroll
            for (int i = 1; i < 4; ++i) {
                if (tid < 256) {
#pragma unroll
                    for (int jb = 0; jb < i; ++jb) {
                        float s = 0.f;
#pragma unroll
                        for (int mb = jb; mb < i; ++mb)
#pragma unroll
                            for (int m = 0; m < 16; ++m) s += Nf[(16 * i + a) * 65 + 16 * mb + m] * Tf[(16 * mb + m) * 65 + 16 * jb + cc];
                        Wb[jb * 256 + a * 16 + cc] = s;
                        __builtin_amdgcn_sched_barrier(0);
                    }
                }
                BAR_LDS();
                if (tid < 256) {
#pragma unroll
                    for (int jb = 0; jb < i; ++jb) {
                        float s = 0.f;
#pragma unroll
                        for (int m = 0; m < 16; ++m) s += Tf[(16 * i + a) * 65 + 16 * i + m] * Wb[jb * 256 + m * 16 + cc];
                        Tf[(16 * i + a) * 65 + 16 * jb + cc] = -s;
                    }
                }
                BAR_LDS();
            }
        }
        for (int idx = tid; idx < 4096; idx += NT) { const int t = idx >> 6, s = idx & 63; Tb[t * RLD + s] = (bf16)(((s >> 4) <= (t >> 4)) ? Tf[t * 65 + s] : 0.f); }
        BAR_LDS();
        if (hs == 0) { const floatx16 c1 = mm64(Tb, AmT, wm, wn, lane); storeT(WmT, c1, wm, wn, lane); }
        else { const floatx16 c2 = mm64(Nak, VT, wm, wn, lane); storeT(NVT, c2, wm, wn, lane); }
        BAR_LDS();
        if (hs == 0) { const floatx16 c1 = mm64(Tb, NVT, wm, wn, lane); storeT(UtT, c1, wm, wn, lane); }
        BAR_LDS();
        {
            const size_t gb = (size_t)item * 4096;
            if (hs == 0) {
                {
                    const floatx16 c1 = mm64(Mrb, WmT, wm, wn, lane);
#pragma unroll
                    for (int r = 0; r < 16; ++r) {
                        const int m = wm * 32 + (r & 3) + 8 * (r >> 2) + 4 * (lane >> 5), n = wn * 32 + (lane & 31);
                        RPg[gb + m * 64 + n] = (f16)((float)Rt[m * RLD + n] - c1[r]);
                    }
                }
                {
                    const floatx16 c2 = mm64(Mrk, VT, wm, wn, lane); __builtin_amdgcn_sched_barrier(0); const floatx16 c3 = mm64(Mrb, UtT, wm, wn, lane); __builtin_amdgcn_sched_barrier(0);
#pragma unroll
                    for (int r = 0; r < 16; ++r) {
                        const int m = wm * 32 + (r & 3) + 8 * (r >> 2) + 4 * (lane >> 5), n = wn * 32 + (lane & 31);
                        const int R = scan_row(z, b, s0 + m);
                        P.Y[((size_t)z * NROWS + R) * 384 + h * 64 + n] = c2[r] - c3[r];
                    }
                }
            } else {
                {
                    const floatx16 c4 = mm64(BendT, WmT, wm, wn, lane);
#pragma unroll
                    for (int r = 0; r < 16; ++r) {
                        const int m = wm * 32 + (r & 3) + 8 * (r >> 2) + 4 * (lane >> 5), n = wn * 32 + (lane & 31);
                        PTg[gb + m * 64 + n] = (f16)((m == n ? gl[m] : 0.f) - c4[r]);
                    }
                }
                {
                    const floatx16 c5 = mm64(KendT, VT, wm, wn, lane); __builtin_amdgcn_sched_barrier(0); const floatx16 c6 = mm64(BendT, UtT, wm, wn, lane); __builtin_amdgcn_sched_barrier(0);
                    const int n = wn * 32 + (lane & 31);
#pragma unroll
                    for (int g = 0; g < 4; ++g) {
                        const int m0 = wm * 32 + 8 * g + 4 * (lane >> 5);
                        half4 v; v[0] = (f16)(c5[4 * g] - c6[4 * g]); v[1] = (f16)(c5[4 * g + 1] - c6[4 * g + 1]); v[2] = (f16)(c5[4 * g + 2] - c6[4 * g + 2]); v[3] = (f16)(c5[4 * g + 3] - c6[4 * g + 3]);
                        *(half4*)(Qg + gb + n * 64 + m0) = v;
                    }
                }
            }
        }
        BAR_LDS();
    }
}

DEV void ph_rw_stream(const Params& P, int l, int bid, int nblk, unsigned char* smraw) {
    const int tid = ltid(), lane = tid & 63, wv = tid >> 6, w4 = wv & 3, half = wv >> 2;
    f16* S16 = (f16*)smraw + half * 16 * 72;
    const f16* PTg = P.rwm; const f16* RPg = PTg + RWM_STRIDE; const f16* Qg = RPg + RWM_STRIDE;
    for (int it = bid; it < 48; it += nblk) {
        const int item = it * 2 + half, chain = item >> 2, vs = item & 3;
        const int z = chain / 12, b = (chain / 6) % 2, h = chain % 6;
        __syncthreads();
        for (int idx = tid & 255; idx < 16 * 72; idx += 256) S16[idx] = (f16)0.f;
        __syncthreads();
        const size_t cb = (size_t)chain * NCHUNK * 4096;
        const int rowA = 16 * w4 + (lane & 15), kof = 8 * (lane >> 4);
        const int qoff = (vs * 16 + (lane & 15)) * 64 + 16 * w4 + (lane >> 4) * 4;
        float* ycol = P.Y + (size_t)z * NROWS * 384 + h * 64 + vs * 16 + (lane & 15);
        const int trow = 16 * w4 + (lane >> 4) * 4;
        half8 ap0[4], ap1[4], ar0[4], ar1[4]; half4 qv[4]; float yv[4][4];
#define RW_LOAD(slot_, ck_) { const size_t gb_ = cb + (size_t)(ck_) * 4096; \
            ap0[slot_] = *(const half8*)(PTg + gb_ + rowA * 64 + kof); ap1[slot_] = *(const half8*)(PTg + gb_ + rowA * 64 + 32 + kof); \
            ar0[slot_] = *(const half8*)(RPg + gb_ + rowA * 64 + kof); ar1[slot_] = *(const half8*)(RPg + gb_ + rowA * 64 + 32 + kof); \
            qv[slot_] = *(const half4*)(Qg + gb_ + qoff); \
            _Pragma("unroll") for (int r_ = 0; r_ < 4; ++r_) yv[slot_][r_] = ycol[(size_t)scan_row(z, b, (ck_) * 64 + trow + r_) * 384]; }
#define RW_STEP(slot_, ck_) { \
            const half8 b0_ = *(const half8*)(S16 + (lane & 15) * 72 + kof); const half8 b1_ = *(const half8*)(S16 + (lane & 15) * 72 + 32 + kof); \
            floatx4 accY_ = {0.f, 0.f, 0.f, 0.f}; \
            accY_ = __builtin_amdgcn_mfma_f32_16x16x32_f16(ar0[slot_], b0_, accY_, 0, 0, 0); accY_ = __builtin_amdgcn_mfma_f32_16x16x32_f16(ar1[slot_], b1_, accY_, 0, 0, 0); \
            floatx4 accS_; accS_[0] = (float)qv[slot_][0]; accS_[1] = (float)qv[slot_][1]; accS_[2] = (float)qv[slot_][2]; accS_[3] = (float)qv[slot_][3]; \
            accS_ = __builtin_amdgcn_mfma_f32_16x16x32_f16(ap0[slot_], b0_, accS_, 0, 0, 0); accS_ = __builtin_amdgcn_mfma_f32_16x16x32_f16(ap1[slot_], b1_, accS_, 0, 0, 0); \
            _Pragma("unroll") for (int r_ = 0; r_ < 4; ++r_) ycol[(size_t)scan_row(z, b, (ck_) * 64 + trow + r_) * 384] = yv[slot_][r_] + accY_[r_]; \
            BAR_LDS(); \
            half4 sn_; sn_[0] = (f16)accS_[0]; sn_[1] = (f16)accS_[1]; sn_[2] = (f16)accS_[2]; sn_[3] = (f16)accS_[3]; \
            *(half4*)(S16 + (lane & 15) * 72 + trow) = sn_; \
            BAR_LDS(); }
        RW_LOAD(0, 0); RW_LOAD(1, 1); RW_LOAD(2, 2);
        for (int ck = 0; ck < NCHUNK; ck += 4) {
            if (ck + 3 < NCHUNK) RW_LOAD(3, ck + 3);
            RW_STEP(0, ck);
            if (ck + 4 < NCHUNK) RW_LOAD(0, ck + 4);
            RW_STEP(1, ck + 1);
            if (ck + 5 < NCHUNK) RW_LOAD(1, ck + 5);
            RW_STEP(2, ck + 2);
            if (ck + 6 < NCHUNK) RW_LOAD(2, ck + 6);
            RW_STEP(3, ck + 3);
        }
#undef RW_LOAD
#undef RW_STEP
    }
}
DEV void ph_rwkv_fin2(const Params& P, int l, int bid, int nblk) {
    const int tid_ = ltid(); const int lane = tid_ & 63, wv = tid_ >> 6;
    for (int R = (l == 1 ? NCTX : 0) + bid * NW + wv; R < NROWS; R += nblk * NW) {
#pragma unroll
        for (int h = 0; h < 6; ++h) {
            const int c = h * 64 + lane;
            const float y = P.Y[(size_t)R * 384 + c] + P.Y[((size_t)NROWS + R) * 384 + c];
            const float mu = wave_sum(y) * (1.f / 64.f); const float d = y - mu;
            const float var = wave_sum(d * d) * (1.f / 64.f);
            const float rs = __builtin_amdgcn_rsqf(var + 64e-5f);
            const float bonus = P.bon[(size_t)R * 6 + h] + P.bon[((size_t)NROWS + R) * 6 + h];
            const float o = d * rs * P.rw_ln_g[l * 384 + c] + P.rw_ln_b[l * 384 + c] + bonus * shl(P, l, R, 768 + c);
            const float g = (float)P.p[(size_t)R * INW + 1280 + c];
            P.p[(size_t)R * INW + 1280 + c] = (f16)(o * fsilu(g));
        }
    }
}

constexpr int HLD = 136;
constexpr int S5_LDS_BYTES = NW * 64 * HLD * 2;
DEV void s5_wave_scan(const Params& P, int l, int z, int b, int g, int tc, float& hre, float& him, f16* hb, int lane, bool store) {
    const int lzg = (l * 2 + z) * 16 + g;
    half8 au[2];
#pragma unroll
    for (int mt = 0; mt < 2; ++mt) {
        const int R = scan_row(0, b, tc * 64 + 32 * mt + (lane & 31));
        au[mt] = *(const half8*)(P.p + (size_t)R * INW + 1664 + g * 16 + (lane >> 5) * 8);
    }
#pragma unroll
    for (int nt = 0; nt < 4; ++nt) {
        const half8 bb = *(const half8*)(P.s5bb + ((size_t)lzg * 128 + 32 * nt + (lane & 31)) * 16 + (lane >> 5) * 8);
#pragma unroll
        for (int mt = 0; mt < 2; ++mt) {
            floatx16 acc;
#pragma unroll
            for (int r = 0; r < 16; ++r) acc[r] = 0.f;
            acc = __builtin_amdgcn_mfma_f32_32x32x16_f16(au[mt], bb, acc, 0, 0, 0);
#pragma unroll
            for (int r = 0; r < 16; ++r) hb[(32 * mt + (r & 3) + 8 * (r >> 2) + 4 * (lane >> 5)) * HLD + 32 * nt + (lane & 31)] = (f16)acc[r];
        }
    }
    const float* tb = P.s5par + (size_t)lzg * S5PW * 64 + lane;
    const float abr = tb[0], abi = tb[64];
#pragma unroll 4
    for (int s = 0; s < 64; ++s) {
        const int tt = z ? 63 - s : s;
        const float bur = (float)hb[tt * HLD + lane], bui = (float)hb[tt * HLD + 64 + lane];
        const float nr = abr * hre - abi * him + bur, ni = abr * him + abi * hre + bui;
        hre = nr; him = ni;
        if (store) { hb[tt * HLD + lane] = (f16)hre; hb[tt * HLD + 64 + lane] = (f16)him; }
    }
}
DEV void ph_s5_a(const Params& P, int l, int bid, int nblk, unsigned char* smraw) {
    const int tid_ = ltid(); const int lane = tid_ & 63, wv = tid_ >> 6;
    f16* hb = (f16*)smraw + wv * 64 * HLD;
    for (int item = bid * NW + wv; item < 2 * 2 * 16 * NCHUNK; item += nblk * NW) {
        const int tc = item % NCHUNK, zbg = item / NCHUNK, g = zbg & 15, b = (zbg >> 4) & 1, z = zbg >> 5;
        float hre = 0.f, him = 0.f;
        s5_wave_scan(P, l, z, b, g, tc, hre, him, hb, lane, false);
        const int ck = z ? mirror_chunk(tc) : tc;
        float* ho = P.s5h + ((size_t)zbg * NCHUNK + ck) * 128;
        ho[lane] = hre; ho[64 + lane] = him;
    }
}
DEV void ph_s5_b(const Params& P, int l, int bid, int nblk) {
    for (int idx = bid * NT + ltid(); idx < 2 * 2 * 16 * 64; idx += nblk * NT) {
        const int n = idx & 63, zbg = idx >> 6, g = zbg & 15, z = zbg >> 5;
        const float* tb = P.s5par + (size_t)((l * 2 + z) * 16 + g) * S5PW * 64 + n;
        const float a64r = tb[34 * 64], a64i = tb[35 * 64];
        float hr = 0.f, hi = 0.f;
        float* hp = P.s5h + (size_t)zbg * NCHUNK * 128 + n;
        for (int c0 = 0; c0 < NCHUNK; c0 += 20) {
            float lr[20], li[20];
#pragma unroll
            for (int i = 0; i < 20; ++i) { lr[i] = hp[(c0 + i) * 128]; li[i] = hp[(c0 + i) * 128 + 64]; }
#pragma unroll
            for (int i = 0; i < 20; ++i) {
                hp[(c0 + i) * 128] = hr; hp[(c0 + i) * 128 + 64] = hi;
                const float nr = a64r * hr - a64i * hi + lr[i], ni = a64r * hi + a64i * hr + li[i];
                hr = nr; hi = ni;
            }
        }
    }
}
DEV void ph_s5_c(const Params& P, int l, int bid, int nblk, unsigned char* smraw) {
    const int tid = ltid(), lane = tid & 63, wv = tid >> 6, ci = wv >> 1, z = wv & 1;
    f16* base = (f16*)smraw;
    for (int it = bid; it < 2 * 16 * (NCHUNK / 4); it += nblk) {
        const int grp = it % (NCHUNK / 4), bg = it / (NCHUNK / 4), g = bg & 15, b = bg >> 4;
        if (l == 1 && grp == 0) continue;
        BAR_LDS();
        const int tc = grp * 4 + ci;
        {
            const int ck = z ? mirror_chunk(tc) : tc;
            const float* hi_ = P.s5h + ((size_t)((z * 2 + b) * 16 + g) * NCHUNK + ck) * 128;
            float hre = hi_[lane], him = hi_[64 + lane];
            s5_wave_scan(P, l, z, b, g, tc, hre, him, base + wv * 64 * HLD, lane, true);
        }
        BAR_LDS();
        {
            half8 bf[2][4];
#pragma unroll
            for (int z2 = 0; z2 < 2; ++z2)
#pragma unroll
                for (int ks = 0; ks < 4; ++ks) bf[z2][ks] = *(const half8*)(P.s5cc + ((size_t)((l * 2 + z2) * 16 + g) * 16 + (lane & 15)) * 128 + 32 * ks + 8 * (lane >> 4));
            const int pch = g * 16 + (lane & 15);
            const float dsk = P.s5_d[l * 256 + pch];
#pragma unroll
            for (int mi = 0; mi < 2; ++mi) {
                const int mt = 2 * z + mi;
                floatx4 acc = {0.f, 0.f, 0.f, 0.f};
#pragma unroll
                for (int z2 = 0; z2 < 2; ++z2) {
                    const f16* hbz = base + (2 * ci + z2) * 64 * HLD;
#pragma unroll
                    for (int ks = 0; ks < 4; ++ks) {
                        const half8 a = *(const half8*)(hbz + (16 * mt + (lane & 15)) * HLD + 32 * ks + 8 * (lane >> 4));
                        acc = __builtin_amdgcn_mfma_f32_16x16x32_f16(a, bf[z2][ks], acc, 0, 0, 0);
                    }
                }
#pragma unroll
                for (int r = 0; r < 4; ++r) {
                    const int tt = 16 * mt + (lane >> 4) * 4 + r; const int R = scan_row(0, b, tc * 64 + tt);
                    const float u = (float)P.p[(size_t)R * INW + 1664 + pch];
                    const float y = acc[r] + dsk * u;
                    P.yg[(size_t)R * 256 + pch] = (f16)(0.5f * y * (1.f + ftanh(0.7978845608028654f * (y + 0.044715f * y * y * y))));
                }
            }
        }
    }
}

constexpr int NSC = TSCAN / 256;
constexpr int QLD = 104, SLD = 72;
constexpr int MLE = 97 * 96;
template <int KSTEPS>
DEV floatx16 mmh(const f16* A, int lda, int arow0, const f16* Bt, int ldb, int brow0, int lane, floatx16 acc) {
#pragma unroll
    for (int ks = 0; ks < KSTEPS; ++ks) {
        const half8 a = *(const half8*)(A + (arow0 + (lane & 31)) * lda + ks * 16 + (lane >> 5) * 8);
        const half8 b = *(const half8*)(Bt + (brow0 + (lane & 31)) * ldb + ks * 16 + (lane >> 5) * 8);
        acc = __builtin_amdgcn_mfma_f32_32x32x16_f16(a, b, acc, 0, 0, 0);
    }
    return acc;
}
DEV void ph_ml_a(const Params& P, int l, int bid, int nblk, float* sm) {
    const int tid_ = ltid(); const int lane = tid_ & 63, wv = tid_ >> 6;
    float* gin = sm + 1152 * 20 + wv * 1152;
    __syncthreads();
    for (int idx = tid_; idx < 1152 * 16; idx += NT) {
        const int c = idx >> 4, o = idx & 15, z = o >> 3, hh = (o >> 1) & 3, which = o & 1;
        sm[c * 20 + o] = (which ? P.ml_wf : P.ml_wi)[((size_t)(l * 2 + z) * 1152 + c) * 4 + hh];
    }
    __syncthreads();
    for (int R = bid * NW + wv; R < NROWS; R += nblk * NW) {
        if (lane < 48) {
            const int c0 = lane * 8;
            int t, len; if (R < NCTX) { t = R % CTX; len = CTX; } else { t = (R - NCTX) % SEQ; len = SEQ; }
            const half8 x0 = *(const half8*)(P.p + (size_t)R * INW + 2176 + c0);
            half8 xm_, xp_;
#pragma unroll
            for (int i = 0; i < 8; ++i) { xm_[i] = (f16)0.f; xp_[i] = (f16)0.f; }
            if (t > 0) xm_ = *(const half8*)(P.p + (size_t)(R - 1) * INW + 2176 + c0);
            if (t < len - 1) xp_ = *(const half8*)(P.p + (size_t)(R + 1) * INW + 2176 + c0);
            half8 hq, hk, hv;
#pragma unroll
            for (int blk = 0; blk < 2; ++blk) {
                float xc[4], xm[4];
#pragma unroll
                for (int i = 0; i < 4; ++i) {
                    const int c = c0 + 4 * blk + i; xm[i] = (float)x0[4 * blk + i];
                    const float a = P.ml_conv_b[l * 384 + c] + P.ml_conv_w[(l * 3 + 1) * 384 + c] * xm[i] + P.ml_conv_w[(l * 3 + 0) * 384 + c] * (float)xm_[4 * blk + i] + P.ml_conv_w[(l * 3 + 2) * 384 + c] * (float)xp_[4 * blk + i];
                    xc[i] = fsilu(a);
                }
                const int n = lane * 2 + blk;
#pragma unroll
                for (int i = 0; i < 4; ++i) {
                    float qq = 0.f, kk = 0.f, vv = 0.f;
#pragma unroll
                    for (int jj = 0; jj < 4; ++jj) {
                        const int wi = ((l * 96 + n) * 4 + jj) * 4 + i;
                        qq += xc[jj] * P.ml_wq[wi]; kk += xc[jj] * P.ml_wk[wi]; vv += xm[jj] * P.ml_wv[wi];
                    }
                    const int c = c0 + 4 * blk + i;
                    gin[c] = qq; gin[384 + c] = kk; gin[768 + c] = vv;
                    hq[4 * blk + i] = (f16)qq; hk[4 * blk + i] = (f16)(kk * 0.10206207261596577f); hv[4 * blk + i] = (f16)vv;
                }
            }
            f16* o = P.qkv16 + (size_t)R * 1152 + c0;
            *(half8*)o = hq; *(half8*)(o + 384) = hk; *(half8*)(o + 768) = hv;
        }
        float acc[16];
#pragma unroll
        for (int o = 0; o < 16; ++o) acc[o] = 0.f;
#pragma unroll 3
        for (int i = 0; i < 18; ++i) {
            const int c = lane + 64 * i;
            const float gval = gin[c];
            const float* wr = sm + c * 20;
            const floatx4 w0 = *(const floatx4*)wr, w1 = *(const floatx4*)(wr + 4), w2 = *(const floatx4*)(wr + 8), w3 = *(const floatx4*)(wr + 12);
#pragma unroll
            for (int o2 = 0; o2 < 4; ++o2) { acc[o2] += gval * w0[o2]; acc[4 + o2] += gval * w1[o2]; acc[8 + o2] += gval * w2[o2]; acc[12 + o2] += gval * w3[o2]; }
        }
        float mine = 0.f;
#pragma unroll
        for (int o = 0; o < 16; ++o) { const float s = wave_sum(acc[o]); if (lane == o) mine = s; }
        if (lane < 16) {
            const int z = lane >> 3, hh = (lane >> 1) & 3, which = lane & 1;
            const float val = mine + (which ? P.ml_bf : P.ml_bi)[(l * 2 + z) * 4 + hh];
            P.gates[(size_t)R * 16 + lane] = which ? log_sigmoidf_(val) : val;
        }
    }
}
DEV void ml_load_T(const Params& P, int z, int b, int hh, int s0, const float* wgt, f16* VT, f16* KeT, int tid) {
#pragma unroll
    for (int i = 0; i < 3; ++i) {
        const int e = tid + NT * i, which = e / 768, rem = e % 768, c8 = rem >> 6, t = rem & 63;
        const int R = scan_row(z, b, s0 + t);
        const half8 x = *(const half8*)(P.qkv16 + (size_t)R * 1152 + (which ? 384 : 768) + hh * 96 + c8 * 8);
        if (which == 0) {
#pragma unroll
            for (int j = 0; j < 8; ++j) VT[(c8 * 8 + j) * SLD + t] = x[j];
        } else {
            const float w = wgt[t];
#pragma unroll
            for (int j = 0; j < 8; ++j) KeT[(c8 * 8 + j) * SLD + t] = (f16)((float)x[j] * w);
        }
    }
}
constexpr int ML_VT_OFF = 0, ML_KE_OFF = 128 * SLD, ML_QS_OFF = ML_KE_OFF + 96 * SLD, ML_KS_OFF = ML_QS_OFF + 64 * QLD, ML_C16_OFF = ML_KS_OFF + 64 * QLD,
              ML_AM_OFF = ML_C16_OFF + 128 * QLD, ML_F_OFF_BYTES = (ML_AM_OFF + 64 * SLD) * 2;
constexpr int ML_LDS_BYTES = ML_F_OFF_BYTES + 320 * 4;
DEV void ph_ml_1(const Params& P, int l, int bid, int nblk, unsigned char* smraw) {
    f16* VT = (f16*)smraw + ML_VT_OFF; f16* KeT = (f16*)smraw + ML_KE_OFF; float* fb = (float*)(smraw + ML_F_OFF_BYTES);
    const int tid = ltid(), lane = tid & 63, wv = tid >> 6;
    for (int item = bid; item < 16 * NSC; item += nblk) {
        const int chain = item / NSC, sc = item % NSC, z = chain / 8, b = (chain / 4) % 2, hh = chain % 4;
        BAR_LDS();
        for (int idx = tid; idx < 32 * SLD; idx += NT) VT[96 * SLD + idx] = (f16)((idx < SLD) ? 1.f : 0.f);
        float x = 0.f, li = 0.f;
        if (tid < 256) {
            const int R = scan_row(z, b, sc * 256 + tid);
            li = P.gates[(size_t)R * 16 + z * 8 + hh * 2]; x = P.gates[(size_t)R * 16 + z * 8 + hh * 2 + 1];
#pragma unroll
            for (int o = 1; o < 64; o <<= 1) { const float y = __shfl_up(x, o); if (lane >= o) x += y; }
            if (lane == 63) fb[256 + wv] = x;
        }
        BAR_LDS();
        if (tid < 256) {
            float off = 0.f, tot = 0.f;
#pragma unroll
            for (int w = 0; w < 4; ++w) { const float q = fb[256 + w]; tot += q; if (w < wv) off += q; }
            fb[tid] = __expf(li + tot - (x + off));
            if (tid == 0) P.mlG[item] = __expf(tot);
        }
        floatx16 c0, c1, c2;
#pragma unroll
        for (int r = 0; r < 16; ++r) { c0[r] = 0.f; c1[r] = 0.f; c2[r] = 0.f; }
#pragma unroll 1
        for (int cc = 0; cc < 4; ++cc) {
            BAR_LDS();
            ml_load_T(P, z, b, hh, sc * 256 + cc * 64, fb + cc * 64, VT, KeT, tid);
            BAR_LDS();
            if (wv < 4) {
                c0 = mmh<4>(VT, SLD, 32 * wv, KeT, SLD, 0, lane, c0);
                c1 = mmh<4>(VT, SLD, 32 * wv, KeT, SLD, 32, lane, c1);
                c2 = mmh<4>(VT, SLD, 32 * wv, KeT, SLD, 64, lane, c2);
            }
        }
        if (wv < 4) {
            float* dst = P.mlC + (size_t)item * MLE;
#pragma unroll
            for (int r = 0; r < 16; ++r) {
                const int v = 32 * wv + (r & 3) + 8 * (r >> 2) + 4 * (lane >> 5), k = lane & 31;
                if (v <= 96) { dst[v * 96 + k] = c0[r]; dst[v * 96 + 32 + k] = c1[r]; dst[v * 96 + 64 + k] = c2[r]; }
            }
        }
    }
}
DEV void ph_ml_2(const Params& P, int bid, int nblk) {
    for (int idx = bid * NT + ltid(); idx < 16 * MLE; idx += nblk * NT) {
        const int chain = idx / MLE, e = idx % MLE; float run = 0.f;
        for (int s0 = 0; s0 < NSC; s0 += 13) {
            float loc[13], gg[13];
#pragma unroll
            for (int i = 0; i < 13; ++i) { loc[i] = P.mlC[((size_t)chain * NSC + s0 + i) * MLE + e]; gg[i] = P.mlG[chain * NSC + s0 + i]; }
#pragma unroll
            for (int i = 0; i < 13; ++i) { P.mlC[((size_t)chain * NSC + s0 + i) * MLE + e] = run; run = gg[i] * run + loc[i]; }
        }
    }
}
DEV void ph_ml_3(const Params& P, int l, int bid, int nblk, unsigned char* smraw) {
    f16* sh = (f16*)smraw;
    f16 *VT = sh + ML_VT_OFF, *KeT = sh + ML_KE_OFF, *Qs = sh + ML_QS_OFF, *Ks = sh + ML_KS_OFF, *C16 = sh + ML_C16_OFF, *Am = sh + ML_AM_OFF;
    float* fb = (float*)(smraw + ML_F_OFF_BYTES);
    const int tid = ltid(), lane = tid & 63, wv = tid >> 6, w4 = wv & 3, wm = w4 & 1, wn = w4 >> 1;
    for (int item = bid; item < 16 * NSC; item += nblk) {
        const int chain = item / NSC, sc = item % NSC, z = chain / 8, b = (chain / 4) % 2, hh = chain % 4;
        if (l == 1 && sc == 0) continue;
        BAR_LDS();
        for (int idx = tid; idx < 32 * SLD; idx += NT) VT[96 * SLD + idx] = (f16)((idx < SLD) ? 1.f : 0.f);
        floatx16 c0, c1, c2;
#pragma unroll
        for (int r = 0; r < 16; ++r) { c0[r] = 0.f; c1[r] = 0.f; c2[r] = 0.f; }
        if (wv < 4) {
            const float* srcC = P.mlC + (size_t)item * MLE;
#pragma unroll
            for (int r = 0; r < 16; ++r) {
                const int v = 32 * wv + (r & 3) + 8 * (r >> 2) + 4 * (lane >> 5), k = lane & 31;
                const bool ok = v <= 96;
                c0[r] = ok ? srcC[v * 96 + k] : 0.f; c1[r] = ok ? srcC[v * 96 + 32 + k] : 0.f; c2[r] = ok ? srcC[v * 96 + 64 + k] : 0.f;
            }
        }
#pragma unroll 1
        for (int cc = 0; cc < 4; ++cc) {
            const int s0 = sc * 256 + cc * 64;
            BAR_LDS();
            if (wv == 7) {
                const int R = scan_row(z, b, s0 + lane);
                const float li = P.gates[(size_t)R * 16 + z * 8 + hh * 2], lf = P.gates[(size_t)R * 16 + z * 8 + hh * 2 + 1];
                float F = lf;
#pragma unroll
                for (int o = 1; o < 64; o <<= 1) { const float y = __shfl_up(F, o); if (lane >= o) F += y; }
                const float FL = __shfl(F, 63);
                fb[lane] = __expf(F); fb[64 + lane] = __expf(fminf(li - F, 10.f)); fb[128 + lane] = __expf(li + FL - F);
                if (lane == 63) fb[192] = __expf(FL);
            }
            if (wv < 4) {
#pragma unroll
                for (int r = 0; r < 16; ++r) {
                    const int v = 32 * wv + (r & 3) + 8 * (r >> 2) + 4 * (lane >> 5), k = lane & 31;
                    C16[v * QLD + k] = (f16)c0[r]; C16[v * QLD + 32 + k] = (f16)c1[r]; C16[v * QLD + 64 + k] = (f16)c2[r];
                }
            }
            BAR_LDS();
#pragma unroll
            for (int i = 0; i < 3; ++i) {
                const int e = tid + NT * i, which = e / 768, rem = e % 768, t = rem / 12, c8 = rem % 12;
                const int R = scan_row(z, b, s0 + t);
                const half8 x = *(const half8*)(P.qkv16 + (size_t)R * 1152 + (which ? 384 : 0) + hh * 96 + c8 * 8);
                const float w = which ? fb[64 + t] : fb[t];
                half8 y;
#pragma unroll
                for (int jj = 0; jj < 8; ++jj) y[jj] = (f16)((float)x[jj] * w);
                *(half8*)((which ? Ks : Qs) + t * QLD + c8 * 8) = y;
            }
            ml_load_T(P, z, b, hh, s0, fb + 128, VT, KeT, tid);
            BAR_LDS();
            if (wv >= 4) {
#pragma unroll
                for (int r = 0; r < 16; ++r) c2[r] = 0.f;
                if (!(wm == 0 && wn == 1)) c2 = mmh<6>(Qs, QLD, wm * 32, Ks, QLD, wn * 32, lane, c2);
#pragma unroll
                for (int r = 0; r < 16; ++r) {
                    const int m = wm * 32 + (r & 3) + 8 * (r >> 2) + 4 * (lane >> 5), n = wn * 32 + (lane & 31);
                    Am[m * SLD + n] = (f16)(n <= m ? c2[r] : 0.f);
                }
            } else {
                const float gL = fb[192];
#pragma unroll
                for (int r = 0; r < 16; ++r) { c0[r] *= gL; c1[r] *= gL; c2[r] *= gL; }
                c0 = mmh<4>(VT, SLD, 32 * wv, KeT, SLD, 0, lane, c0); __builtin_amdgcn_sched_barrier(0);
                c1 = mmh<4>(VT, SLD, 32 * wv, KeT, SLD, 32, lane, c1); __builtin_amdgcn_sched_barrier(0);
                c2 = mmh<4>(VT, SLD, 32 * wv, KeT, SLD, 64, lane, c2);
            }
            BAR_LDS();
            if (wv >= 4) {
#pragma unroll
                for (int r = 0; r < 16; ++r) { c0[r] = 0.f; c1[r] = 0.f; }
                c0 = mmh<4>(Am, SLD, 0, VT, SLD, 32 * w4, lane, c0); __builtin_amdgcn_sched_barrier(0); c0 = mmh<6>(Qs, QLD, 0, C16, QLD, 32 * w4, lane, c0); __builtin_amdgcn_sched_barrier(0);
                c1 = mmh<4>(Am, SLD, 32, VT, SLD, 32 * w4, lane, c1); __builtin_amdgcn_sched_barrier(0); c1 = mmh<6>(Qs, QLD, 32, C16, QLD, 32 * w4, lane, c1); __builtin_amdgcn_sched_barrier(0);
                if (wv == 7 && (lane & 31) == 0) {
#pragma unroll
                    for (int r = 0; r < 16; ++r) { const int t = (r & 3) + 8 * (r >> 2) + 4 * (lane >> 5); fb[256 + t] = c0[r]; fb[256 + 32 + t] = c1[r]; }
                }
            }
            BAR_LDS();
            if (wv >= 4 && wv < 7) {
#pragma unroll
                for (int r = 0; r < 16; ++r) {
                    const int t = (r & 3) + 8 * (r >> 2) + 4 * (lane >> 5);
                    const int R0 = scan_row(z, b, s0 + t), R1 = scan_row(z, b, s0 + 32 + t);
                    const float d0 = fmaxf(fabsf(fb[256 + t]), 1.f), d1 = fmaxf(fabsf(fb[256 + 32 + t]), 1.f);
                    P.Y[((size_t)z * NROWS + R0) * 384 + hh * 96 + 32 * w4 + (lane & 31)] = c0[r] * frcp(d0);
                    P.Y[((size_t)z * NROWS + R1) * 384 + hh * 96 + 32 * w4 + (lane & 31)] = c1[r] * frcp(d1);
                    if ((r & 3) == 3) __builtin_amdgcn_sched_barrier(0);
                }
            }
        }
    }
}
DEV void ph_ml_fin2(const Params& P, int l, int bid, int nblk) {
    const int tid_ = ltid(); const int lane = tid_ & 63, wv = tid_ >> 6;
    for (int R = (l == 1 ? NCTX : 0) + bid * NW + wv; R < NROWS; R += nblk * NW) {
        float y[6]; float s = 0.f;
#pragma unroll
        for (int i = 0; i < 6; ++i) { const int c = lane * 6 + i; y[i] = P.Y[(size_t)R * 384 + c] + P.Y[((size_t)NROWS + R) * 384 + c]; s += y[i]; }
        s += __shfl_xor(s, 1); s += __shfl_xor(s, 2); s += __shfl_xor(s, 4); s += __shfl_xor(s, 8);
        const float mu = s * (1.f / 96.f); float q = 0.f;
#pragma unroll
        for (int i = 0; i < 6; ++i) { y[i] -= mu; q += y[i] * y[i]; }
        q += __shfl_xor(q, 1); q += __shfl_xor(q, 2); q += __shfl_xor(q, 4); q += __shfl_xor(q, 8);
        const float rs = __builtin_amdgcn_rsqf(q * (1.f / 96.f) + 1e-6f);
#pragma unroll
        for (int i = 0; i < 6; ++i) {
            const int c = lane * 6 + i;
            const float hv = y[i] * rs * P.ml_norm_g[l * 384 + c] + P.ml_skip[l * 384 + c] * ml_xc(P, l, R, c);
            const float zg = (float)P.p[(size_t)R * INW + 2560 + c];
            P.p[(size_t)R * INW + 2560 + c] = (f16)(hv * fsilu(zg));
        }
    }
}

constexpr size_t al256(size_t x) { return (x + 255) & ~(size_t)255; }
constexpr size_t WS_MODS = 0;
constexpr size_t WS_P = al256(WS_MODS + 2 * 3 * 3072 * 4);
constexpr size_t WS_Y = al256(WS_P + (size_t)NROWS * INW * 2);
constexpr size_t WS_Q = al256(WS_Y + (size_t)2 * NROWS * 384 * 4);
constexpr size_t WS_Q_BYTES = (size_t)NROWS * 1152 * 4;
constexpr size_t WS_GATES = al256(WS_Q + WS_Q_BYTES);
constexpr size_t WS_BON = al256(WS_GATES + (size_t)NROWS * 16 * 4);
constexpr size_t WS_YG = al256(WS_BON + (size_t)2 * NROWS * 6 * 4);
constexpr size_t WS_S5H = al256(WS_YG + (size_t)NROWS * 256 * 2);
constexpr size_t WS_S5PAR = al256(WS_S5H + (size_t)64 * NCHUNK * 128 * 4);
constexpr size_t WS_S5BB = al256(WS_S5PAR + (size_t)64 * S5PW * 64 * 4);
constexpr size_t WS_S5CC = al256(WS_S5BB + (size_t)64 * 128 * 16 * 2);
constexpr size_t WS_GLUT = al256(WS_S5CC + (size_t)64 * 16 * 128 * 2);
constexpr size_t WS_CTX1 = al256(WS_GLUT + (size_t)2 * 256 * 256 * 2);
constexpr size_t WS_WTIN = al256(WS_CTX1 + (size_t)NCTX * D * 4);
constexpr size_t WS_WTOUT = al256(WS_WTIN + (size_t)2 * INW * D * 2);
constexpr size_t WS_RWLT = al256(WS_WTOUT + (size_t)2 * D * D * 2);
constexpr size_t WS_GP = al256(WS_RWLT + (size_t)2 * 2 * 2 * 384 * 32 * 2);
constexpr size_t WS_END = al256(WS_GP + 1024);
static_assert(3 * RWM_STRIDE * 2 <= WS_Q_BYTES, "rwkv chunk matrices");
static_assert(al256((size_t)NROWS * 1152 * 2) + al256((size_t)16 * NSC * MLE * 4) + 16 * NSC * 4 <= WS_Q_BYTES, "ml region");

static void fill_params(Params& P, void* const* d_in, void* d_out, void* d_ws) {
    const float** pp = (const float**)&P;
    for (int i = 0; i < 41; ++i) pp[i] = (const float*)d_in[i];
    unsigned char* ws = (unsigned char*)d_ws;
    P.out = (float*)d_out;
    P.mods = (float*)(ws + WS_MODS); P.p = (f16*)(ws + WS_P); P.Y = (float*)(ws + WS_Y);
    P.gates = (float*)(ws + WS_GATES); P.bon = (float*)(ws + WS_BON); P.ctx1 = (float*)(ws + WS_CTX1);
    P.hx = (f16*)(ws + WS_Q); P.rwm = (f16*)(ws + WS_Q); P.qkv16 = (f16*)(ws + WS_Q);
    P.mlC = (float*)(ws + WS_Q + al256((size_t)NROWS * 1152 * 2)); P.mlG = (float*)(ws + WS_Q + al256((size_t)NROWS * 1152 * 2) + al256((size_t)16 * NSC * MLE * 4));
    P.wt_in = (f16*)(ws + WS_WTIN); P.wt_out = (f16*)(ws + WS_WTOUT); P.glut = (f16*)(ws + WS_GLUT);
    P.yg = (f16*)(ws + WS_YG); P.s5h = (float*)(ws + WS_S5H); P.s5par = (float*)(ws + WS_S5PAR); P.s5bb = (f16*)(ws + WS_S5BB); P.s5cc = (f16*)(ws + WS_S5CC);
    P.rwlt = (bf16*)(ws + WS_RWLT); P.gp = (Params*)(ws + WS_GP);
}

constexpr int cmax(int a, int b) { return a > b ? a : b; }
constexpr int MEGA_LDS_BYTES = cmax(cmax(RWP1_LDS_BYTES, S5_LDS_BYTES), cmax(cmax(GEMM_LDS_BYTES, ML_LDS_BYTES), (1152 * 20 + NW * 1152) * 4));

__global__ void __launch_bounds__(NT) mega_fwd(Params Pk) {
    __shared__ __attribute__((aligned(16))) unsigned char smraw[MEGA_LDS_BYTES];
    float* sm = (float*)smraw;
    cg::grid_group grid = cg::this_grid();
    const int bid = blockIdx.x, nblk = gridDim.x;
    if (threadIdx.x == 0) *Pk.gp = Pk;
    ph_mods2(Pk, lsgpr(bid), nblk, sm);
    ph_wprep(Pk, lsgpr(bid), nblk, sm);
    ph_tables(Pk, lsgpr(bid), nblk);
    grid.sync();
    const Params* pg = Pk.gp;
    asm volatile("" : "+s"(pg) :: "memory");
    const Params& P = *pg;
    for (int l = 0; l < 2; ++l) {
        for (int rep = 0; rep < REP_HX; ++rep) ph_hx(P, l, lsgpr(bid), nblk);
        grid.sync();
        for (int rep = 0; rep < REP_G1; ++rep) ph_gemm_mfma<1>(P, l, lsgpr(bid), nblk, smraw);
        for (int rep = 0; rep < REP_SYNC; ++rep) grid.sync();
        for (int rep = 0; rep < REP_P1; ++rep) ph_rw_p1(P, l, lsgpr(bid), nblk, smraw);
        for (int rep = 0; rep < REP_S5A; ++rep) ph_s5_a(P, l, lsgpr(bid), nblk, smraw);
        grid.sync();
        ph_rw_stream(P, l, lsgpr(bid), nblk, smraw);
        ph_s5_b(P, l, lsgpr(bid), nblk);
        grid.sync();
        ph_rwkv_fin2(P, l, lsgpr(bid), nblk);
        for (int rep = 0; rep < REP_S5C; ++rep) ph_s5_c(P, l, lsgpr(bid), nblk, smraw);
        grid.sync();
        ph_gemm_mfma<3>(P, l, lsgpr(bid), nblk, smraw);
        for (int rep = 0; rep < REP_MLA; ++rep) ph_ml_a(P, l, lsgpr(bid), nblk, sm);
        grid.sync();
        for (int rep = 0; rep < REP_ML1; ++rep) ph_ml_1(P, l, lsgpr(bid), nblk, smraw);
        grid.sync();
        ph_ml_2(P, lsgpr(bid), nblk);
        grid.sync();
        for (int rep = 0; rep < REP_ML3; ++rep) ph_ml_3(P, l, lsgpr(bid), nblk, smraw);
        grid.sync();
        ph_ml_fin2(P, l, lsgpr(bid), nblk);
        grid.sync();
        for (int rep = 0; rep < REP_G2; ++rep) ph_gemm_mfma<2>(P, l, lsgpr(bid), nblk, smraw);
        grid.sync();
    }
    ph_final2(P, lsgpr(bid), nblk);
}

extern "C" void kernel_launch(void* const* d_in, const int* in_sizes, int n_in, void* d_out, int out_size, void* d_ws, size_t ws_size, hipStream_t stream) {
    if (ws_size < WS_END) { fprintf(stderr, "workspace too small: %zu < %zu\n", ws_size, (size_t)WS_END); return; }
    static int grid_blocks = 0;
    if (!grid_blocks) {
        int dev = 0, cus = 0, per_cu = 0;
        hipGetDevice(&dev);
        hipDeviceGetAttribute(&cus, hipDeviceAttributeMultiprocessorCount, dev);
        hipOccupancyMaxActiveBlocksPerMultiprocessor(&per_cu, mega_fwd, NT, 0);
        if (per_cu < 1) per_cu = 1;
        grid_blocks = cus * per_cu;
        fprintf(stderr, "mega_fwd: %d CUs x %d blocks/CU\n", cus, per_cu);
    }
    Params P{};
    fill_params(P, d_in, d_out, d_ws);
    void* args[] = {&P};
    hipError_t e = hipLaunchCooperativeKernel((void*)mega_fwd, dim3(grid_blocks), dim3(NT), args, 0, stream);
    if (e != hipSuccess) fprintf(stderr, "cooperative launch failed: %s (grid %d)\n", hipGetErrorString(e), grid_blocks);
}
```

```cpp
#include <hip/hip_runtime.h>
#include <hip/hip_cooperative_groups.h>
#include <cstdint>
#include <cmath>
#include <cstdio>
namespace cg = cooperative_groups;

#ifndef SEQ
#define SEQ 16384
#endif
#ifndef CTX
#define CTX 256
#endif
#ifndef REP_G1
#define REP_G1 1
#endif
#ifndef REP_G2
#define REP_G2 1
#endif
#ifndef REP_P1
#define REP_P1 1
#endif
#ifndef REP_S5A
#define REP_S5A 1
#endif
#ifndef REP_S5C
#define REP_S5C 1
#endif
#ifndef REP_MLA
#define REP_MLA 1
#endif
#ifndef REP_ML1
#define REP_ML1 1
#endif
#ifndef REP_ML3
#define REP_ML3 1
#endif
#ifndef REP_HX
#define REP_HX 1
#endif
#ifndef REP_SYNC
#define REP_SYNC 1
#endif

typedef _Float16 f16;
typedef __bf16 bf16;
typedef _Float16 half8 __attribute__((ext_vector_type(8)));
typedef _Float16 half4 __attribute__((ext_vector_type(4)));
typedef __bf16 bf16x8 __attribute__((ext_vector_type(8)));
typedef __bf16 bf16x4 __attribute__((ext_vector_type(4)));
typedef float floatx16 __attribute__((ext_vector_type(16)));
typedef float floatx4 __attribute__((ext_vector_type(4)));
typedef unsigned uintx4 __attribute__((ext_vector_type(4)));

constexpr int D = 1024, NB = 2, INW = 2944;
constexpr int NCTX = NB * CTX, NLAT = NB * SEQ, NROWS = NCTX + NLAT;
constexpr int TSCAN = CTX + SEQ, NCHUNK = TSCAN / 64;
constexpr int NT = 512, NW = NT / 64;
#define DEV __device__ __forceinline__
#define GAS __attribute__((address_space(1)))
#define BAR_LDS() asm volatile("s_waitcnt lgkmcnt(0)\n\ts_barrier" ::: "memory")

DEV int ltid() { int t = threadIdx.x; asm volatile("" : "+v"(t)); return t; }
DEV int lsgpr(int x) { asm volatile("" : "+s"(x)); return x; }

struct Params;
typedef const GAS Params& PRef;
struct Params {
    const GAS float *x, *c, *ctx, *c_ctx, *ada_w, *ada_b, *norm_g, *w_in, *w_out;
    const GAS float *rw_mu, *rw_w0, *rw_w_up, *rw_a0, *rw_a_up, *rw_k_k, *rw_k_a, *rw_r_k, *rw_ln_g, *rw_ln_b;
    const GAS float *s5_a_re, *s5_a_im, *s5_log_dt, *s5_b_re, *s5_b_im, *s5_c_re, *s5_c_im, *s5_d, *s5_glu_w, *s5_glu_b;
    const GAS float *ml_conv_w, *ml_conv_b, *ml_wq, *ml_wk, *ml_wv, *ml_wi, *ml_bi, *ml_wf, *ml_bf, *ml_norm_g, *ml_skip;
    const GAS float* final_g;
    GAS float* out;
    GAS float* mods;
    GAS f16* p;
    GAS float* Y;
    GAS float* gates;
    GAS float* bon;
    GAS float* ctx1;
    GAS f16* hx;
    GAS f16* rwm;
    GAS f16* qkv16;
    GAS float* mlC;
    GAS float* mlG;
    GAS f16* wt_in;
    GAS f16* wt_out;
    GAS f16* glut;
    GAS f16* yg;
    GAS float* s5h;
    GAS float* s5par;
    GAS f16* s5bb;
    GAS f16* s5cc;
    GAS bf16* rwlt;
    GAS unsigned* xbar;
    GAS Params* gp;
};

DEV float sigmoidf_(float x) { return 1.f / (1.f + expf(-x)); }
DEV float siluf_(float x) { return x / (1.f + expf(-x)); }
DEV float frcp(float x) { return __builtin_amdgcn_rcpf(x); }
DEV float fsigmoid(float x) { return frcp(1.f + __expf(-x)); }
DEV float fsilu(float x) { return x * frcp(1.f + __expf(-x)); }
DEV float ftanh(float x) { x = fminf(fmaxf(x, -15.f), 15.f); const float e = __expf(2.f * x); return (e - 1.f) * frcp(e + 1.f); }
DEV float log_sigmoidf_(float x) { return fminf(x, 0.f) - log1pf(expf(-fabsf(x))); }
DEV float wave_sum(float v) {
#pragma unroll
    for (int o = 1; o < 64; o <<= 1) v += __shfl_xor(v, o);
    return v;
}
DEV int scan_row(int z, int b, int s) {
    if (s < CTX) { int t = z ? CTX - 1 - s : s; return b * CTX + t; }
    int u = s - CTX; int t = z ? SEQ - 1 - u : u; return NCTX + b * SEQ + t;
}
DEV int mirror_chunk(int tc) { return tc < CTX / 64 ? CTX / 64 - 1 - tc : CTX / 64 + (SEQ / 64 - 1) - (tc - CTX / 64); }
DEV int row_mod(int R) { return R < NCTX ? 2 : (R - NCTX) / SEQ; }
DEV const GAS float* xrow(PRef P, int l, int R) {
    const GAS float* xl = l == 0 ? P.x : P.out; const GAS float* xc = l == 0 ? P.ctx : P.ctx1;
    return R < NCTX ? xc + (size_t)R * D : xl + (size_t)(R - NCTX) * D;
}
DEV int nbr_row(int R, int c) {
    if (R < NCTX) { int t = R % CTX; if ((c & 1) == 0) return t > 0 ? R - 1 : -1; return t < CTX - 1 ? R + 1 : -1; }
    int t = (R - NCTX) % SEQ; int m = c & 3, col = t & 63;
    if (m == 0) return col > 0 ? R - 1 : -1;
    if (m == 1) return col < 63 ? R + 1 : -1;
    if (m == 2) return t >= 64 ? R - 64 : -1;
    return t < SEQ - 64 ? R + 64 : -1;
}
DEV float shl(PRef P, int l, int R, int c) {
    float pv = (float)P.p[(size_t)R * INW + c];
    int nb = nbr_row(R, c);
    float nv = nb >= 0 ? (float)P.p[(size_t)nb * INW + c] : 0.f;
    return pv + (nv - pv) * P.rw_mu[l * 1280 + c];
}
DEV int a2col(int k) { return k < 384 ? 1280 + k : (k < 640 ? 1920 + (k - 384) : 2560 + (k - 640)); }
DEV float ml_xm(PRef P, int R, int c) { return (float)P.p[(size_t)R * INW + 2176 + c]; }
DEV float ml_xc(PRef P, int l, int R, int c) {
    int t, len; if (R < NCTX) { t = R % CTX; len = CTX; } else { t = (R - NCTX) % SEQ; len = SEQ; }
    float a = P.ml_conv_b[l * 384 + c] + P.ml_conv_w[(l * 3 + 1) * 384 + c] * ml_xm(P, R, c);
    if (t > 0) a += P.ml_conv_w[(l * 3 + 0) * 384 + c] * ml_xm(P, R - 1, c);
    if (t < len - 1) a += P.ml_conv_w[(l * 3 + 2) * 384 + c] * ml_xm(P, R + 1, c);
    return fsilu(a);
}

DEV void ph_mods2(PRef P, int bid, int nblk, float* sm) {
    const int tid = ltid(), cl = tid & 15, kq = tid >> 4;
    for (int g = bid; g < 2 * 3 * 3072 / 16; g += nblk) {
        const int idx = g * 16 + cl; const int l = idx / 9216, rem = idx % 9216, j = rem / 3072, col = rem % 3072;
        const GAS float* cin = j < 2 ? P.c + j * D : P.c_ctx;
        float acc = 0.f;
        for (int k = kq * 32; k < kq * 32 + 32; ++k) acc += siluf_(cin[k]) * P.ada_w[((size_t)l * D + k) * 3072 + col];
        sm[kq * 16 + cl] = acc;
        __syncthreads();
        if (tid < 16) { float s = P.ada_b[l * 3072 + col]; for (int q = 0; q < 32; ++q) s += sm[q * 16 + tid]; P.mods[idx] = s; }
        __syncthreads();
    }
}
DEV void ph_wprep(PRef P, int bid, int nblk, float* sm) {
    const int tid = ltid();
    constexpr int T_IN = 16 * 46, T_OUT = 16 * 16, T_GLU = 4 * 4;
    for (int t = bid; t < 2 * (T_IN + T_OUT + T_GLU); t += nblk) {
        int l = t / (T_IN + T_OUT + T_GLU), r = t % (T_IN + T_OUT + T_GLU);
        const GAS float* W; GAS f16* Wt; int N, tk, tn, KW = D;
        if (r < T_IN) { W = P.w_in + (size_t)l * D * INW; Wt = P.wt_in + (size_t)l * INW * D; N = INW; tk = r / 46; tn = r % 46; }
        else if (r < T_IN + T_OUT) { r -= T_IN; W = P.w_out + (size_t)l * D * D; Wt = P.wt_out + (size_t)l * D * D; N = D; tk = r / 16; tn = r % 16; }
        else { r -= T_IN + T_OUT; W = P.s5_glu_w + (size_t)l * 256 * 256; Wt = P.glut + (size_t)l * 256 * 256; N = 256; tk = r / 4; tn = r % 4; KW = 256; }
#pragma unroll
        for (int i = 0; i < 2; ++i) {
            int k = (tid >> 4) + 32 * i, n4 = (tid & 15) * 4;
            floatx4 v = *(const floatx4*)(W + (size_t)(tk * 64 + k) * N + tn * 64 + n4);
            sm[k * 65 + n4] = v[0]; sm[k * 65 + n4 + 1] = v[1]; sm[k * 65 + n4 + 2] = v[2]; sm[k * 65 + n4 + 3] = v[3];
        }
        __syncthreads();
        {
            int n = tid >> 3, k8 = (tid & 7) * 8;
            half8 h;
#pragma unroll
            for (int j = 0; j < 8; ++j) h[j] = (f16)sm[(k8 + j) * 65 + n];
            *(half8*)(Wt + (size_t)(tn * 64 + n) * KW + tk * 64 + k8) = h;
        }
        __syncthreads();
    }
}
constexpr int S5PW = 38;
DEV void ph_tables(PRef P, int bid, int nblk) {
    for (int idx = bid * NT + ltid(); idx < 2 * 2 * 16 * 64; idx += nblk * NT) {
        const int n = idx & 63, lzg = idx >> 6;
        const int pi = lzg * 64 + n;
        const float are_ = P.s5_a_re[pi], aim_ = P.s5_a_im[pi], dt = expf(P.s5_log_dt[pi]);
        const float mag = expf(are_ * dt), abr = mag * cosf(aim_ * dt), abi = mag * sinf(aim_ * dt);
        const float den = are_ * are_ + aim_ * aim_;
        const float qre = ((abr - 1.f) * are_ + abi * aim_) / den, qim = (abi * are_ - (abr - 1.f) * aim_) / den;
        GAS float* tb = P.s5par + (size_t)lzg * S5PW * 64 + n;
        tb[0] = abr; tb[64] = abi;
        for (int pp = 0; pp < 16; ++pp) {
            const float br = P.s5_b_re[(size_t)pi * 16 + pp], bi = P.s5_b_im[(size_t)pi * 16 + pp];
            P.s5bb[((size_t)lzg * 128 + n) * 16 + pp] = (f16)(qre * br - qim * bi);
            P.s5bb[((size_t)lzg * 128 + 64 + n) * 16 + pp] = (f16)(qre * bi + qim * br);
            P.s5cc[((size_t)lzg * 16 + pp) * 128 + n] = (f16)P.s5_c_re[((size_t)lzg * 16 + pp) * 64 + n];
            P.s5cc[((size_t)lzg * 16 + pp) * 128 + 64 + n] = (f16)(-P.s5_c_im[((size_t)lzg * 16 + pp) * 64 + n]);
        }
        const float m64 = expf(64.f * are_ * dt);
        tb[34 * 64] = m64 * cosf(64.f * aim_ * dt); tb[35 * 64] = m64 * sinf(64.f * aim_ * dt);
    }
    for (int idx = bid * NT + ltid(); idx < 2 * 2 * 2 * 384 * 32; idx += nblk * NT) {
        const int r = idx & 31, c = (idx >> 5) % 384, wa = (idx / (32 * 384)) & 1, lz = idx / (2 * 32 * 384);
        const GAS float* src_ = wa ? P.rw_a_up : P.rw_w_up;
        P.rwlt[idx] = (bf16)src_[((size_t)lz * 32 + r) * 384 + c];
    }
}
DEV void ph_hx(PRef P, int l, int bid, int nblk) {
    const int tid_ = ltid(); const int lane = tid_ & 63, wv = tid_ >> 6;
    for (int R = bid * NW + wv; R < NROWS; R += nblk * NW) {
        const GAS float* xr = xrow(P, l, R);
        floatx4 v[4]; float ss = 0.f;
#pragma unroll
        for (int i = 0; i < 4; ++i) { v[i] = *(const floatx4*)(xr + i * 256 + lane * 4); ss += v[i][0] * v[i][0] + v[i][1] * v[i][1] + v[i][2] * v[i][2] + v[i][3] * v[i][3]; }
        ss = wave_sum(ss);
        const float rs = 1.f / sqrtf(ss * (1.f / D) + 1e-6f);
        const GAS float* m = P.mods + (l * 3 + row_mod(R)) * 3072; const GAS float* g = P.norm_g + l * D;
#pragma unroll
        for (int i = 0; i < 4; ++i) {
            int k = i * 256 + lane * 4; half4 h;
#pragma unroll
            for (int j = 0; j < 4; ++j) h[j] = (f16)(v[i][j] * rs * g[k + j] * (1.f + m[D + k + j]) + m[k + j]);
            *(half4*)(P.hx + (size_t)R * D + k) = h;
        }
    }
}
DEV void ph_final2(PRef P, int bid, int nblk) {
    const int tid_ = ltid(); const int lane = tid_ & 63, wv = tid_ >> 6;
    for (int r = bid * NW + wv; r < NLAT; r += nblk * NW) {
        GAS float* xr = P.out + (size_t)r * D; floatx4 v[4]; float ss = 0.f;
#pragma unroll
        for (int i = 0; i < 4; ++i) { v[i] = *(const floatx4*)(xr + i * 256 + lane * 4); ss += v[i][0] * v[i][0] + v[i][1] * v[i][1] + v[i][2] * v[i][2] + v[i][3] * v[i][3]; }
        ss = wave_sum(ss);
        const float rs = 1.f / sqrtf(ss * (1.f / D) + 1e-6f);
#pragma unroll
        for (int i = 0; i < 4; ++i) {
            const floatx4 g = *(const floatx4*)(P.final_g + i * 256 + lane * 4); floatx4 o;
#pragma unroll
            for (int j = 0; j < 4; ++j) o[j] = v[i][j] * rs * g[j];
            *(floatx4*)(xr + i * 256 + lane * 4) = o;
        }
    }
}

constexpr int G_LDA = 72;
constexpr int G_STAGE = (256 + 128) * G_LDA;
constexpr int GEMM_LDS_BYTES = 2 * G_STAGE * 2;
template <int MODE>
DEV void gemm_epi_tile(PRef P, int l, const floatx16 acc, int R0, int n0, int lane) {
#pragma unroll
    for (int r = 0; r < 16; ++r) {
        const int R = R0 + (r & 3) + 8 * (r >> 2) + 4 * (lane >> 5), n = n0 + (lane & 31);
        if (MODE == 1) P.p[(size_t)R * INW + n] = (f16)acc[r];
        else if (MODE == 2) {
            const int j = row_mod(R); const float g = P.mods[(l * 3 + j) * 3072 + 2 * D + n];
            const float xo = xrow(P, l, R)[n];
            GAS float* dst = R < NCTX ? P.ctx1 + (size_t)R * D + n : P.out + (size_t)(R - NCTX) * D + n;
            *dst = xo + g * acc[r];
        } else {
            const float yv = (float)P.yg[(size_t)R * 256 + n]; const float gt = (float)P.p[(size_t)R * INW + 1920 + n];
            P.p[(size_t)R * INW + 1920 + n] = (f16)(yv * fsigmoid(acc[r] + P.s5_glu_b[l * 256 + n]) * fsilu(gt));
        }
    }
}
template <int MODE>
DEV void ph_gemm_mfma(PRef P, int l, int bid, int nblk, unsigned char* smraw) {
    constexpr int N = MODE == 1 ? INW : (MODE == 2 ? D : 256), K = MODE == 3 ? 256 : D;
    const GAS f16* Bt = MODE == 1 ? P.wt_in + (size_t)l * INW * D : (MODE == 2 ? P.wt_out + (size_t)l * D * D : P.glut + (size_t)l * 256 * 256);
    const int tm0 = (MODE != 1 && l == 1) ? NCTX / 256 : 0;
    const int ntm = NROWS / 256 - tm0, ntn = N / 128;
    const int tid = ltid(), lane = tid & 63, wv = tid >> 6, wm = wv & 3, wn = wv >> 2;
    f16* sbase = (f16*)smraw;
    const int ldrow = tid >> 3, ldch = tid & 7;
    constexpr int GM = 8;
    for (int t = bid; t < ntm * ntn; t += nblk) {
        int sg = t / (GM * ntn), rem = t % (GM * ntn);
        int gsz = ntm - sg * GM < GM ? ntm - sg * GM : GM;
        const int tm = tm0 + sg * GM + rem % gsz, tn = rem / gsz;
        floatx16 acc00, acc01, acc10, acc11;
#pragma unroll
        for (int r = 0; r < 16; ++r) { acc00[r] = 0.f; acc01[r] = 0.f; acc10[r] = 0.f; acc11[r] = 0.f; }
        uintx4 pa0, pa1, pa2, pa3, pb0, pb1, qa0, qa1, qa2, qa3, qb0, qb1;
        const GAS f16* arow = MODE == 1 ? P.hx + (size_t)(tm * 256 + ldrow) * D + ldch * 8 : (MODE == 2 ? P.p + (size_t)(tm * 256 + ldrow) * INW + ldch * 8 : P.yg + (size_t)(tm * 256 + ldrow) * 256 + ldch * 8);
        const size_t astr = (size_t)64 * (MODE == 1 ? D : (MODE == 2 ? INW : 256));
        const GAS f16* brow = Bt + (size_t)(tn * 128 + ldrow) * K + ldch * 8;
#define GLOAD(S, kt_) { const int ka = MODE == 2 ? a2col((kt_) * 64) : (kt_) * 64; const int kb = (kt_) * 64; \
            S##a0 = *(const uintx4*)(arow + ka); S##a1 = *(const uintx4*)(arow + astr + ka); S##a2 = *(const uintx4*)(arow + 2 * astr + ka); S##a3 = *(const uintx4*)(arow + 3 * astr + ka); \
            S##b0 = *(const uintx4*)(brow + kb); S##b1 = *(const uintx4*)(brow + (size_t)64 * K + kb); }
#define SWRITE(S, st_) { f16* sA_ = sbase + (st_) * G_STAGE + ldrow * G_LDA + ldch * 8; f16* sB_ = sbase + (st_) * G_STAGE + 256 * G_LDA + ldrow * G_LDA + ldch * 8; \
            *(uintx4*)(sA_) = S##a0; *(uintx4*)(sA_ + 64 * G_LDA) = S##a1; *(uintx4*)(sA_ + 128 * G_LDA) = S##a2; *(uintx4*)(sA_ + 192 * G_LDA) = S##a3; \
            *(uintx4*)(sB_) = S##b0; *(uintx4*)(sB_ + 64 * G_LDA) = S##b1; }
#define GCOMPUTE(st_) { const f16* sA = sbase + (st_) * G_STAGE; const f16* sB = sA + 256 * G_LDA; \
            _Pragma("unroll") for (int ks = 0; ks < 4; ++ks) { \
                const int kof = ks * 16 + (lane >> 5) * 8; \
                const half8 af0 = *(const half8*)(sA + (wm * 64 + (lane & 31)) * G_LDA + kof); \
                const half8 af1 = *(const half8*)(sA + (wm * 64 + 32 + (lane & 31)) * G_LDA + kof); \
                const half8 bf0 = *(const half8*)(sB + (wn * 64 + (lane & 31)) * G_LDA + kof); \
                const half8 bf1 = *(const half8*)(sB + (wn * 64 + 32 + (lane & 31)) * G_LDA + kof); \
                acc00 = __builtin_amdgcn_mfma_f32_32x32x16_f16(af0, bf0, acc00, 0, 0, 0); \
                acc01 = __builtin_amdgcn_mfma_f32_32x32x16_f16(af0, bf1, acc01, 0, 0, 0); \
                acc10 = __builtin_amdgcn_mfma_f32_32x32x16_f16(af1, bf0, acc10, 0, 0, 0); \
                acc11 = __builtin_amdgcn_mfma_f32_32x32x16_f16(af1, bf1, acc11, 0, 0, 0); } }
        constexpr int NK = K / 64;
        BAR_LDS();
        GLOAD(p, 0); SWRITE(p, 0); GLOAD(q, 1);
        BAR_LDS();
        for (int kt = 0; kt < NK; kt += 2) {
            if (kt + 2 < NK) GLOAD(p, kt + 2);
            GCOMPUTE(0);
            SWRITE(q, 1);
            BAR_LDS();
            if (kt + 3 < NK) GLOAD(q, kt + 3);
            GCOMPUTE(1);
            if (kt + 2 < NK) SWRITE(p, 0);
            BAR_LDS();
        }
#undef GLOAD
#undef SWRITE
#undef GCOMPUTE
        gemm_epi_tile<MODE>(P, l, acc00, tm * 256 + wm * 64, tn * 128 + wn * 64, lane);
        gemm_epi_tile<MODE>(P, l, acc01, tm * 256 + wm * 64, tn * 128 + wn * 64 + 32, lane);
        gemm_epi_tile<MODE>(P, l, acc10, tm * 256 + wm * 64 + 32, tn * 128 + wn * 64, lane);
        gemm_epi_tile<MODE>(P, l, acc11, tm * 256 + wm * 64 + 32, tn * 128 + wn * 64 + 32, lane);
    }
}

constexpr int RLD = 72;
constexpr int RSLOT = 64 * RLD;
constexpr int RWP1_LDS_BYTES = 11 * RSLOT * 2 + 2 * 64 * 65 * 4 + 1536 * 4 + 128 * 4;
constexpr size_t RWM_STRIDE = (size_t)24 * NCHUNK * 4096;

DEV bf16x8 ldfrag(const bf16* M, int rowbase, int lane, int ks) {
    return *(const bf16x8*)(M + (rowbase + (lane & 31)) * RLD + ks * 16 + (lane >> 5) * 8);
}
DEV floatx16 mm64(const bf16* A, const bf16* Bt, int wm, int wn, int lane) {
    floatx16 acc;
#pragma unroll
    for (int r = 0; r < 16; ++r) acc[r] = 0.f;
#pragma unroll
    for (int ks = 0; ks < 4; ++ks) acc = __builtin_amdgcn_mfma_f32_32x32x16_bf16(ldfrag(A, wm * 32, lane, ks), ldfrag(Bt, wn * 32, lane, ks), acc, 0, 0, 0);
    return acc;
}
DEV void storeT(bf16* dst, const floatx16 c, int wm, int wn, int lane) {
    const int n = wn * 32 + (lane & 31);
#pragma unroll
    for (int g = 0; g < 4; ++g) {
        const int m0 = wm * 32 + 8 * g + 4 * (lane >> 5);
        bf16x4 v; v[0] = (bf16)c[4 * g]; v[1] = (bf16)c[4 * g + 1]; v[2] = (bf16)c[4 * g + 2]; v[3] = (bf16)c[4 * g + 3];
        *(bf16x4*)(dst + n * RLD + m0) = v;
    }
}

DEV void ph_rw_p1(PRef P, int l, int bid, int nblk, unsigned char* smraw) {
    bf16* sl = (bf16*)smraw;
    bf16 *Am = sl, *AmT = sl + RSLOT, *Bp = sl + 2 * RSLOT, *Kp = sl + 3 * RSLOT, *Rt = sl + 4 * RSLOT, *VT = sl + 5 * RSLOT,
         *BendT = sl + 6 * RSLOT, *KendT = sl + 7 * RSLOT, *Nak = sl + 8 * RSLOT, *Mrb = sl + 9 * RSLOT, *Mrk = sl + 10 * RSLOT;
    bf16 *Tb = Am, *UtT = AmT, *WmT = Bp, *NVT = Kp;
    float* Nf = (float*)(smraw + 11 * RSLOT * 2); float* Tf = Nf + 64 * 65; float* Wb = Tf + 64 * 65; float* gl = Wb + 1536;
    float* av = Nf; float* lwb = Tf;
    f16* Sr = (f16*)Nak; f16* Sk = (f16*)Mrb; f16* Sv = (f16*)Mrk; bf16* lt = KendT;
    float* part = Wb;
    const int tid = ltid(), lane = tid & 63, wv = tid >> 6, q4 = wv & 3, wm = q4 & 1, wn = q4 >> 1, hs = wv >> 2;
    GAS f16* PTg = P.rwm; GAS f16* RPg = PTg + RWM_STRIDE; GAS f16* Qg = RPg + RWM_STRIDE;
    for (int item = bid; item < 24 * NCHUNK; item += nblk) {
        const int chain = item / NCHUNK, ck = item % NCHUNK;
        const int z = chain / 12, b = (chain / 6) % 2, h = chain % 6, s0 = ck * 64;
        const int j = lane, tq = wv, c = h * 64 + j;
#pragma unroll 1
        for (int i = 0; i < 4; ++i) {
            const int task = tid + NT * i, c8 = task & 7, t = (task >> 3) & 63, q = task >> 9;
            const int col0 = q < 3 ? q * 384 + h * 64 + c8 * 8 : (c8 < 4 ? 1152 + z * 32 + c8 * 8 : 1216 + z * 32 + (c8 - 4) * 8);
            const int R = scan_row(z, b, s0 + t);
            const GAS f16* pr = P.p + (size_t)R * INW + col0;
            const half8 own = *(const half8*)pr;
            half8 n0, n1, n2, n3;
#pragma unroll
            for (int e = 0; e < 8; ++e) { n0[e] = (f16)0.f; n1[e] = (f16)0.f; n2[e] = (f16)0.f; n3[e] = (f16)0.f; }
            if (R < NCTX) {
                const int tt = R % CTX;
                if (tt > 0) n0 = *(const half8*)(pr - INW);
                if (tt < CTX - 1) n1 = *(const half8*)(pr + INW);
                n2 = n0; n3 = n1;
            } else {
                const int tt = (R - NCTX) % SEQ, col = tt & 63;
                if (col > 0) n0 = *(const half8*)(pr - INW);
                if (col < 63) n1 = *(const half8*)(pr + INW);
                if (tt >= 64) n2 = *(const half8*)(pr - 64 * INW);
                if (tt < SEQ - 64) n3 = *(const half8*)(pr + 64 * INW);
            }
            const floatx4 mu0 = *(const floatx4*)(P.rw_mu + l * 1280 + col0), mu1 = *(const floatx4*)(P.rw_mu + l * 1280 + col0 + 4);
            float s[8];
#pragma unroll
            for (int e = 0; e < 8; ++e) {
                const float pv = (float)own[e];
                const float nv = (float)((e & 3) == 0 ? n0[e] : (e & 3) == 1 ? n1[e] : (e & 3) == 2 ? n2[e] : n3[e]);
                s[e] = pv + (nv - pv) * (e < 4 ? mu0[e] : mu1[e - 4]);
            }
            if (q < 3) {
                half8 o;
#pragma unroll
                for (int e = 0; e < 8; ++e) o[e] = (f16)s[e];
                *(half8*)((q == 0 ? Sr : q == 1 ? Sk : Sv) + t * RLD + c8 * 8) = o;
            } else {
                bf16x8 o;
#pragma unroll
                for (int e = 0; e < 8; ++e) o[e] = (bf16)(c8 < 4 ? ftanh(s[e]) : s[e]);
                *(bf16x8*)(lt + t * RLD + c8 * 8) = o;
            }
        }
        BAR_LDS();
        {
            const GAS bf16* tab = P.rwlt + ((size_t)((l * 2 + z) * 2 + hs) * 384 + h * 64 + wn * 32 + (lane & 31)) * 32 + (lane >> 5) * 8;
            floatx16 aw;
#pragma unroll
            for (int r = 0; r < 16; ++r) aw[r] = 0.f;
#pragma unroll
            for (int ks = 0; ks < 2; ++ks) aw = __builtin_amdgcn_mfma_f32_32x32x16_bf16(ldfrag(lt + hs * 32, wm * 32, lane, ks), *(const bf16x8*)(tab + ks * 16), aw, 0, 0, 0);
            const int cc = h * 64 + wn * 32 + (lane & 31);
            const float bias = hs ? P.rw_a0[(l * 2 + z) * 384 + cc] : P.rw_w0[(l * 2 + z) * 384 + cc];
#pragma unroll
            for (int r = 0; r < 16; ++r) {
                const int m = wm * 32 + (r & 3) + 8 * (r >> 2) + 4 * (lane >> 5), n = wn * 32 + (lane & 31);
                const float sg = fsigmoid(aw[r] + bias);
                if (hs) av[m * 65 + n] = sg; else lwb[m * 65 + n] = -0.6065306597126334f * sg;
            }
        }
        BAR_LDS();
        float gpre, gtot;
        {
            float run = 0.f, gv[8];
#pragma unroll
            for (int tt = 0; tt < 8; ++tt) { run += lwb[(tq * 8 + tt) * 65 + j]; gv[tt] = run; }
            part[tq * 64 + j] = run;
            const int t = lane, q8 = wv;
            float ss = 0.f, bn = 0.f;
#pragma unroll
            for (int e = 0; e < 8; ++e) {
                const int jj = q8 * 8 + e, c2 = h * 64 + jj;
                const float k_ = (float)Sk[t * RLD + jj], r_ = (float)Sr[t * RLD + jj], a = av[t * 65 + jj];
                const float kku = k_ * P.rw_k_k[l * 384 + c2];
                ss += kku * kku; bn += r_ * k_ * (1.f + (a - 1.f) * P.rw_k_a[l * 384 + c2]) * P.rw_r_k[l * 384 + c2];
            }
            part[512 + q8 * 64 + t] = ss; part[1024 + q8 * 64 + t] = bn;
            BAR_LDS();
            gpre = 0.f; gtot = 0.f;
#pragma unroll
            for (int q = 0; q < 8; ++q) { const float x = part[q * 64 + j]; gtot += x; if (q < tq) gpre += x; }
#pragma unroll
            for (int tt = 0; tt < 8; ++tt) lwb[(tq * 8 + tt) * 65 + j] = gv[tt] + gpre;
            if (tq == 0) {
                gl[j] = __expf(gtot);
                float sst = 0.f, bnt = 0.f;
#pragma unroll
                for (int q = 0; q < 8; ++q) { sst += part[512 + q * 64 + lane]; bnt += part[1024 + q * 64 + lane]; }
                gl[64 + lane] = __builtin_amdgcn_rsqf(sst + 1e-6f);
                P.bon[((size_t)z * NROWS + scan_row(z, b, s0 + lane)) * 6 + h] = bnt;
            }
        }
        BAR_LDS();
        {
            const float kkc = P.rw_k_k[l * 384 + c], kac = P.rw_k_a[l * 384 + c];
            const float Gt = __expf(gtot);
            float e_prev = __expf(gpre);
            bf16x8 amT, vT, beT, keT;
#pragma unroll
            for (int tt = 0; tt < 8; ++tt) {
                const int t = tq * 8 + tt;
                const float r_ = (float)Sr[t * RLD + j], k_ = (float)Sk[t * RLD + j], v_ = (float)Sv[t * RLD + j];
                const float a = av[t * 65 + j], g = lwb[t * 65 + j], sinv = gl[64 + t];
                const float e_t = __expf(g), e_p = frcp(e_t), e_m = e_prev, e_e = Gt * e_p;
                e_prev = e_t;
                const float kkn = k_ * kkc * sinv, kd = k_ * (1.f + (a - 1.f) * kac), bb = a * kkn;
                const bf16 am = (bf16)(kkn * e_m);
                Am[t * RLD + j] = am; Bp[t * RLD + j] = (bf16)(bb * e_p); Kp[t * RLD + j] = (bf16)(kd * e_p); Rt[t * RLD + j] = (bf16)(r_ * e_t);
                amT[tt] = am; vT[tt] = (bf16)v_; beT[tt] = (bf16)(bb * e_e); keT[tt] = (bf16)(kd * e_e);
            }
            BAR_LDS();
            const int to = j * RLD + tq * 8;
            *(bf16x8*)(AmT + to) = amT; *(bf16x8*)(VT + to) = vT; *(bf16x8*)(BendT + to) = beT; *(bf16x8*)(KendT + to) = keT;
        }
        BAR_LDS();
        {
            floatx16 c1, c2;
#pragma unroll
            for (int r = 0; r < 16; ++r) { c1[r] = 0.f; c2[r] = 0.f; }
            if (!(wm == 0 && wn == 1)) {
                const bf16* Aop = hs ? Rt : Am;
#pragma unroll
                for (int ks = 0; ks < 4; ++ks) {
                    const bf16x8 a1 = ldfrag(Aop, wm * 32, lane, ks), b1 = ldfrag(Bp, wn * 32, lane, ks), b2 = ldfrag(Kp, wn * 32, lane, ks);
                    c1 = __builtin_amdgcn_mfma_f32_32x32x16_bf16(a1, b1, c1, 0, 0, 0);
                    c2 = __builtin_amdgcn_mfma_f32_32x32x16_bf16(a1, b2, c2, 0, 0, 0);
                }
            }
#pragma unroll
            for (int r = 0; r < 16; ++r) {
                const int m = wm * 32 + (r & 3) + 8 * (r >> 2) + 4 * (lane >> 5), n = wn * 32 + (lane & 31);
                if (hs == 0) { Nf[m * 65 + n] = n < m ? c1[r] : 0.f; Nak[m * RLD + n] = (bf16)(n < m ? c2[r] : 0.f); }
                else { Mrb[m * RLD + n] = (bf16)(n <= m ? c1[r] : 0.f); Mrk[m * RLD + n] = (bf16)(n <= m ? c2[r] : 0.f); }
            }
        }
        BAR_LDS();
        if (tid < 64) {
            const int i = tid >> 4, jc = tid & 15; float x[16];
#pragma unroll
            for (int row = 0; row < 16; ++row) {
                float s = row == jc ? 1.f : 0.f;
#pragma unroll
                for (int m = 0; m < row; ++m) s -= Nf[(16 * i + row) * 65 + 16 * i + m] * x[m];
                x[row] = s;
            }
#pragma unroll
            for (int row = 0; row < 16; ++row) Tf[(16 * i + row) * 65 + 16 * i + jc] = x[row];
        }
        BAR_LDS();
        {
            const int a = (tid >> 4) & 15, cc = tid & 15;
#pragma unroll
            for (int i = 1; i < 4; ++i) {
                if (tid < 256) {
#pragma unroll
                    for (int jb = 0; jb < i; ++jb) {
                        float s = 0.f;
#pragma unroll
                        for (int mb = jb; mb < i; ++mb)
#pragma unroll
                            for (int m = 0; m < 16; ++m) s += Nf[(16 * i + a) * 65 + 16 * mb + m] * Tf[(16 * mb + m) * 65 + 16 * jb + cc];
                        Wb[jb * 256 + a * 16 + cc] = s;
                        __builtin_amdgcn_sched_barrier(0);
                    }
                }
                BAR_LDS();
                if (tid < 256) {
#pragma unroll
                    for (int jb = 0; jb < i; ++jb) {
                        float s = 0.f;
#pragma unroll
                        for (int m = 0; m < 16; ++m) s += Tf[(16 * i + a) * 65 + 16 * i + m] * Wb[jb * 256 + m * 16 + cc];
                        Tf[(16 * i + a) * 65 + 16 * jb + cc] = -s;
                    }
                }
                BAR_LDS();
            }
        }
        for (int idx = tid; idx < 4096; idx += NT) { const int t = idx >> 6, s = idx & 63; Tb[t * RLD + s] = (bf16)(((s >> 4) <= (t >> 4)) ? Tf[t * 65 + s] : 0.f); }
        BAR_LDS();
        if (hs == 0) { const floatx16 c1 = mm64(Tb, AmT, wm, wn, lane); storeT(WmT, c1, wm, wn, lane); }
        else { const floatx16 c2 = mm64(Nak, VT, wm, wn, lane); storeT(NVT, c2, wm, wn, lane); }
        BAR_LDS();
        if (hs == 0) { const floatx16 c1 = mm64(Tb, NVT, wm, wn, lane); storeT(UtT, c1, wm, wn, lane); }
        BAR_LDS();
        {
            const size_t gb = (size_t)item * 4096;
            if (hs == 0) {
                {
                    const floatx16 c1 = mm64(Mrb, WmT, wm, wn, lane);
#pragma unroll
                    for (int r = 0; r < 16; ++r) {
                        const int m = wm * 32 + (r & 3) + 8 * (r >> 2) + 4 * (lane >> 5), n = wn * 32 + (lane & 31);
                        RPg[gb + m * 64 + n] = (f16)((float)Rt[m * RLD + n] - c1[r]);
                    }
                }
                {
                    const floatx16 c2 = mm64(Mrk, VT, wm, wn, lane); __builtin_amdgcn_sched_barrier(0); const floatx16 c3 = mm64(Mrb, UtT, wm, wn, lane); __builtin_amdgcn_sched_barrier(0);
#pragma unroll
                    for (int r = 0; r < 16; ++r) {
                        const int m = wm * 32 + (r & 3) + 8 * (r >> 2) + 4 * (lane >> 5), n = wn * 32 + (lane & 31);
                        const int R = scan_row(z, b, s0 + m);
                        P.Y[((size_t)z * NROWS + R) * 384 + h * 64 + n] = c2[r] - c3[r];
                    }
                }
            } else {
                {
                    const floatx16 c4 = mm64(BendT, WmT, wm, wn, lane);
#pragma unroll
                    for (int r = 0; r < 16; ++r) {
                        const int m = wm * 32 + (r & 3) + 8 * (r >> 2) + 4 * (lane >> 5), n = wn * 32 + (lane & 31);
                        PTg[gb + m * 64 + n] = (f16)((m == n ? gl[m] : 0.f) - c4[r]);
                    }
                }
                {
                    const floatx16 c5 = mm64(KendT, VT, wm, wn, lane); __builtin_amdgcn_sched_barrier(0); const floatx16 c6 = mm64(BendT, UtT, wm, wn, lane); __builtin_amdgcn_sched_barrier(0);
                    const int n = wn * 32 + (lane & 31);
#pragma unroll
                    for (int g = 0; g < 4; ++g) {
                        const int m0 = wm * 32 + 8 * g + 4 * (lane >> 5);
                        half4 v; v[0] = (f16)(c5[4 * g] - c6[4 * g]); v[1] = (f16)(c5[4 * g + 1] - c6[4 * g + 1]); v[2] = (f16)(c5[4 * g + 2] - c6[4 * g + 2]); v[3] = (f16)(c5[4 * g + 3] - c6[4 * g + 3]);
                        *(half4*)(Qg + gb + n * 64 + m0) = v;
                    }
                }
            }
        }
        BAR_LDS();
    }
}

DEV void ph_rw_stream(PRef P, int l, int bid, int nblk, unsigned char* smraw) {
    const int tid = ltid(), lane = tid & 63, wv = tid >> 6, w4 = wv & 3, half = wv >> 2;
    f16* S16 = (f16*)smraw + half * 16 * 72;
    const GAS f16* PTg = P.rwm; const GAS f16* RPg = PTg + RWM_STRIDE; const GAS f16* Qg = RPg + RWM_STRIDE;
    for (int it = bid; it < 48; it += nblk) {
        const int item = it * 2 + half, chain = item >> 2, vs = item & 3;
        const int z = chain / 12, b = (chain / 6) % 2, h = chain % 6;
        __syncthreads();
        for (int idx = tid & 255; idx < 16 * 72; idx += 256) S16[idx] = (f16)0.f;
        __syncthreads();
        const size_t cb = (size_t)chain * NCHUNK * 4096;
        const int rowA = 16 * w4 + (lane & 15), kof = 8 * (lane >> 4);
        const int qoff = (vs * 16 + (lane & 15)) * 64 + 16 * w4 + (lane >> 4) * 4;
        GAS float* ycol = P.Y + (size_t)z * NROWS * 384 + h * 64 + vs * 16 + (lane & 15);
        const int trow = 16 * w4 + (lane >> 4) * 4;
        half8 ap0[4], ap1[4], ar0[4], ar1[4]; half4 qv[4]; float yv[4][4];
#define RW_LOAD(slot_, ck_) { const size_t gb_ = cb + (size_t)(ck_) * 4096; \
            ap0[slot_] = *(const half8*)(PTg + gb_ + rowA * 64 + kof); ap1[slot_] = *(const half8*)(PTg + gb_ + rowA * 64 + 32 + kof); \
            ar0[slot_] = *(const half8*)(RPg + gb_ + rowA * 64 + kof); ar1[slot_] = *(const half8*)(RPg + gb_ + rowA * 64 + 32 + kof); \
            qv[slot_] = *(const half4*)(Qg + gb_ + qoff); \
            _Pragma("unroll") for (int r_ = 0; r_ < 4; ++r_) yv[slot_][r_] = ycol[(size_t)scan_row(z, b, (ck_) * 64 + trow + r_) * 384]; }
#define RW_STEP(slot_, ck_) { \
            const half8 b0_ = *(const half8*)(S16 + (lane & 15) * 72 + kof); const half8 b1_ = *(const half8*)(S16 + (lane & 15) * 72 + 32 + kof); \
            floatx4 accY_ = {0.f, 0.f, 0.f, 0.f}; \
            accY_ = __builtin_amdgcn_mfma_f32_16x16x32_f16(ar0[slot_], b0_, accY_, 0, 0, 0); accY_ = __builtin_amdgcn_mfma_f32_16x16x32_f16(ar1[slot_], b1_, accY_, 0, 0, 0); \
            floatx4 accS_; accS_[0] = (float)qv[slot_][0]; accS_[1] = (float)qv[slot_][1]; accS_[2] = (float)qv[slot_][2]; accS_[3] = (float)qv[slot_][3]; \
            accS_ = __builtin_amdgcn_mfma_f32_16x16x32_f16(ap0[slot_], b0_, accS_, 0, 0, 0); accS_ = __builtin_amdgcn_mfma_f32_16x16x32_f16(ap1[slot_], b1_, accS_, 0, 0, 0); \
            _Pragma("unroll") for (int r_ = 0; r_ < 4; ++r_) ycol[(size_t)scan_row(z, b, (ck_) * 64 + trow + r_) * 384] = yv[slot_][r_] + accY_[r_]; \
            BAR_LDS(); \
            half4 sn_; sn_[0] = (f16)accS_[0]; sn_[1] = (f16)accS_[1]; sn_[2] = (f16)accS_[2]; sn_[3] = (f16)accS_[3]; \
            *(half4*)(S16 + (lane & 15) * 72 + trow) = sn_; \
            BAR_LDS(); }
        RW_LOAD(0, 0); RW_LOAD(1, 1); RW_LOAD(2, 2);
        for (int ck = 0; ck < NCHUNK; ck += 4) {
            if (ck + 3 < NCHUNK) RW_LOAD(3, ck + 3);
            RW_STEP(0, ck);
            if (ck + 4 < NCHUNK) RW_LOAD(0, ck + 4);
            RW_STEP(1, ck + 1);
            if (ck + 5 < NCHUNK) RW_LOAD(1, ck + 5);
            RW_STEP(2, ck + 2);
            if (ck + 6 < NCHUNK) RW_LOAD(2, ck + 6);
            RW_STEP(3, ck + 3);
        }
#undef RW_LOAD
#undef RW_STEP
    }
}
DEV void ph_rwkv_fin2(PRef P, int l, int bid, int nblk) {
    const int tid_ = ltid(); const int lane = tid_ & 63, wv = tid_ >> 6;
    for (int R = (l == 1 ? NCTX : 0) + bid * NW + wv; R < NROWS; R += nblk * NW) {
#pragma unroll
        for (int h = 0; h < 6; ++h) {
            const int c = h * 64 + lane;
            const float y = P.Y[(size_t)R * 384 + c] + P.Y[((size_t)NROWS + R) * 384 + c];
            const float mu = wave_sum(y) * (1.f / 64.f); const float d = y - mu;
            const float var = wave_sum(d * d) * (1.f / 64.f);
            const float rs = __builtin_amdgcn_rsqf(var + 64e-5f);
            const float bonus = P.bon[(size_t)R * 6 + h] + P.bon[((size_t)NROWS + R) * 6 + h];
            const float o = d * rs * P.rw_ln_g[l * 384 + c] + P.rw_ln_b[l * 384 + c] + bonus * shl(P, l, R, 768 + c);
            const float g = (float)P.p[(size_t)R * INW + 1280 + c];
            P.p[(size_t)R * INW + 1280 + c] = (f16)(o * fsilu(g));
        }
    }
}

constexpr int HLD = 136;
constexpr int S5_LDS_BYTES = NW * 64 * HLD * 2;
DEV void s5_wave_scan(PRef P, int l, int z, int b, int g, int tc, float& hre, float& him, f16* hb, int lane, bool store) {
    const int lzg = (l * 2 + z) * 16 + g;
    half8 au[2];
#pragma unroll
    for (int mt = 0; mt < 2; ++mt) {
        const int R = scan_row(0, b, tc * 64 + 32 * mt + (lane & 31));
        au[mt] = *(const half8*)(P.p + (size_t)R * INW + 1664 + g * 16 + (lane >> 5) * 8);
    }
#pragma unroll
    for (int nt = 0; nt < 4; ++nt) {
        const half8 bb = *(const half8*)(P.s5bb + ((size_t)lzg * 128 + 32 * nt + (lane & 31)) * 16 + (lane >> 5) * 8);
#pragma unroll
        for (int mt = 0; mt < 2; ++mt) {
            floatx16 acc;
#pragma unroll
            for (int r = 0; r < 16; ++r) acc[r] = 0.f;
            acc = __builtin_amdgcn_mfma_f32_32x32x16_f16(au[mt], bb, acc, 0, 0, 0);
#pragma unroll
            for (int r = 0; r < 16; ++r) hb[(32 * mt + (r & 3) + 8 * (r >> 2) + 4 * (lane >> 5)) * HLD + 32 * nt + (lane & 31)] = (f16)acc[r];
        }
    }
    const GAS float* tb = P.s5par + (size_t)lzg * S5PW * 64 + lane;
    const float abr = tb[0], abi = tb[64];
#pragma unroll 4
    for (int s = 0; s < 64; ++s) {
        const int tt = z ? 63 - s : s;
        const float bur = (float)hb[tt * HLD + lane], bui = (float)hb[tt * HLD + 64 + lane];
        const float nr = abr * hre - abi * him + bur, ni = abr * him + abi * hre + bui;
        hre = nr; him = ni;
        if (store) { hb[tt * HLD + lane] = (f16)hre; hb[tt * HLD + 64 + lane] = (f16)him; }
    }
}
DEV void ph_s5_a(PRef P, int l, int bid, int nblk, unsigned char* smraw) {
    const int tid_ = ltid(); const int lane = tid_ & 63, wv = tid_ >> 6;
    f16* hb = (f16*)smraw + wv * 64 * HLD;
    for (int item = bid * NW + wv; item < 2 * 2 * 16 * NCHUNK; item += nblk * NW) {
        const int tc = item % NCHUNK, zbg = item / NCHUNK, g = zbg & 15, b = (zbg >> 4) & 1, z = zbg >> 5;
        float hre = 0.f, him = 0.f;
        s5_wave_scan(P, l, z, b, g, tc, hre, him, hb, lane, false);
        const int ck = z ? mirror_chunk(tc) : tc;
        GAS float* ho = P.s5h + ((size_t)zbg * NCHUNK + ck) * 128;
        ho[lane] = hre; ho[64 + lane] = him;
    }
}
DEV void ph_s5_b(PRef P, int l, int bid, int nblk) {
    for (int idx = bid * NT + ltid(); idx < 2 * 2 * 16 * 64; idx += nblk * NT) {
        const int n = idx & 63, zbg = idx >> 6, g = zbg & 15, z = zbg >> 5;
        const GAS float* tb = P.s5par + (size_t)((l * 2 + z) * 16 + g) * S5PW * 64 + n;
        const float a64r = tb[34 * 64], a64i = tb[35 * 64];
        float hr = 0.f, hi = 0.f;
        GAS float* hp = P.s5h + (size_t)zbg * NCHUNK * 128 + n;
        for (int c0 = 0; c0 < NCHUNK; c0 += 20) {
            float lr[20], li[20];
#pragma unroll
            for (int i = 0; i < 20; ++i) { lr[i] = hp[(c0 + i) * 128]; li[i] = hp[(c0 + i) * 128 + 64]; }
#pragma unroll
            for (int i = 0; i < 20; ++i) {
                hp[(c0 + i) * 128] = hr; hp[(c0 + i) * 128 + 64] = hi;
                const float nr = a64r * hr - a64i * hi + lr[i], ni = a64r * hi + a64i * hr + li[i];
                hr = nr; hi = ni;
            }
        }
    }
}
DEV void ph_s5_c(PRef P, int l, int bid, int nblk, unsigned char* smraw) {
    const int tid = ltid(), lane = tid & 63, wv = tid >> 6, ci = wv >> 1, z = wv & 1;
    f16* base = (f16*)smraw;
    for (int it = bid; it < 2 * 16 * (NCHUNK / 4); it += nblk) {
        const int grp = it % (NCHUNK / 4), bg = it / (NCHUNK / 4), g = bg & 15, b = bg >> 4;
        if (l == 1 && grp == 0) continue;
        BAR_LDS();
        const int tc = grp * 4 + ci;
        {
            const int ck = z ? mirror_chunk(tc) : tc;
            const GAS float* hi_ = P.s5h + ((size_t)((z * 2 + b) * 16 + g) * NCHUNK + ck) * 128;
            float hre = hi_[lane], him = hi_[64 + lane];
            s5_wave_scan(P, l, z, b, g, tc, hre, him, base + wv * 64 * HLD, lane, true);
        }
        BAR_LDS();
        {
            half8 bf[2][4];
#pragma unroll
            for (int z2 = 0; z2 < 2; ++z2)
#pragma unroll
                for (int ks = 0; ks < 4; ++ks) bf[z2][ks] = *(const half8*)(P.s5cc + ((size_t)((l * 2 + z2) * 16 + g) * 16 + (lane & 15)) * 128 + 32 * ks + 8 * (lane >> 4));
            const int pch = g * 16 + (lane & 15);
            const float dsk = P.s5_d[l * 256 + pch];
#pragma unroll
            for (int mi = 0; mi < 2; ++mi) {
                const int mt = 2 * z + mi;
                floatx4 acc = {0.f, 0.f, 0.f, 0.f};
#pragma unroll
                for (int z2 = 0; z2 < 2; ++z2) {
                    const f16* hbz = base + (2 * ci + z2) * 64 * HLD;
#pragma unroll
                    for (int ks = 0; ks < 4; ++ks) {
                        const half8 a = *(const half8*)(hbz + (16 * mt + (lane & 15)) * HLD + 32 * ks + 8 * (lane >> 4));
                        acc = __builtin_amdgcn_mfma_f32_16x16x32_f16(a, bf[z2][ks], acc, 0, 0, 0);
                    }
                }
#pragma unroll
                for (int r = 0; r < 4; ++r) {
                    const int tt = 16 * mt + (lane >> 4) * 4 + r; const int R = scan_row(0, b, tc * 64 + tt);
                    const float u = (float)P.p[(size_t)R * INW + 1664 + pch];
                    const float y = acc[r] + dsk * u;
                    P.yg[(size_t)R * 256 + pch] = (f16)(0.5f * y * (1.f + ftanh(0.7978845608028654f * (y + 0.044715f * y * y * y))));
                }
            }
        }
    }
}

constexpr int NSC = TSCAN / 256;
constexpr int QLD = 104, SLD = 72;
constexpr int MLE = 97 * 96;
template <int KSTEPS>
DEV floatx16 mmh(const f16* A, int lda, int arow0, const f16* Bt, int ldb, int brow0, int lane, floatx16 acc) {
#pragma unroll
    for (int ks = 0; ks < KSTEPS; ++ks) {
        const half8 a = *(const half8*)(A + (arow0 + (lane & 31)) * lda + ks * 16 + (lane >> 5) * 8);
        const half8 b = *(const half8*)(Bt + (brow0 + (lane & 31)) * ldb + ks * 16 + (lane >> 5) * 8);
        acc = __builtin_amdgcn_mfma_f32_32x32x16_f16(a, b, acc, 0, 0, 0);
    }
    return acc;
}
DEV void ph_ml_a(PRef P, int l, int bid, int nblk, float* sm) {
    const int tid_ = ltid(); const int lane = tid_ & 63, wv = tid_ >> 6;
    float* gin = sm + 1152 * 20 + wv * 1152;
    __syncthreads();
    for (int idx = tid_; idx < 1152 * 16; idx += NT) {
        const int c = idx >> 4, o = idx & 15, z = o >> 3, hh = (o >> 1) & 3, which = o & 1;
        sm[c * 20 + o] = (which ? P.ml_wf : P.ml_wi)[((size_t)(l * 2 + z) * 1152 + c) * 4 + hh];
    }
    __syncthreads();
    const int lc = lane < 48 ? lane : 0;
    float cvb[8], cv0[8], cv1[8], cv2[8], bq[2][16], bk[2][16], bv[2][16];
#pragma unroll
    for (int i = 0; i < 8; ++i) { const int c = lc * 8 + i; cvb[i] = P.ml_conv_b[l * 384 + c]; cv0[i] = P.ml_conv_w[(l * 3 + 0) * 384 + c]; cv1[i] = P.ml_conv_w[(l * 3 + 1) * 384 + c]; cv2[i] = P.ml_conv_w[(l * 3 + 2) * 384 + c]; }
#pragma unroll
    for (int blk = 0; blk < 2; ++blk)
#pragma unroll
        for (int e = 0; e < 16; ++e) { const int wi = (l * 96 + lc * 2 + blk) * 16 + e; bq[blk][e] = P.ml_wq[wi]; bk[blk][e] = P.ml_wk[wi]; bv[blk][e] = P.ml_wv[wi]; }
    for (int R = bid * NW + wv; R < NROWS; R += nblk * NW) {
        if (lane < 48) {
            const int c0 = lane * 8;
            int t, len; if (R < NCTX) { t = R % CTX; len = CTX; } else { t = (R - NCTX) % SEQ; len = SEQ; }
            const half8 x0 = *(const half8*)(P.p + (size_t)R * INW + 2176 + c0);
            half8 xm_, xp_;
#pragma unroll
            for (int i = 0; i < 8; ++i) { xm_[i] = (f16)0.f; xp_[i] = (f16)0.f; }
            if (t > 0) xm_ = *(const half8*)(P.p + (size_t)(R - 1) * INW + 2176 + c0);
            if (t < len - 1) xp_ = *(const half8*)(P.p + (size_t)(R + 1) * INW + 2176 + c0);
            half8 hq, hk, hv;
#pragma unroll
            for (int blk = 0; blk < 2; ++blk) {
                float xc[4], xm[4];
#pragma unroll
                for (int i = 0; i < 4; ++i) {
                    xm[i] = (float)x0[4 * blk + i];
                    const float a = cvb[4 * blk + i] + cv1[4 * blk + i] * xm[i] + cv0[4 * blk + i] * (float)xm_[4 * blk + i] + cv2[4 * blk + i] * (float)xp_[4 * blk + i];
                    xc[i] = fsilu(a);
                }
#pragma unroll
                for (int i = 0; i < 4; ++i) {
                    float qq = 0.f, kk = 0.f, vv = 0.f;
#pragma unroll
                    for (int jj = 0; jj < 4; ++jj) {
                        qq += xc[jj] * bq[blk][jj * 4 + i]; kk += xc[jj] * bk[blk][jj * 4 + i]; vv += xm[jj] * bv[blk][jj * 4 + i];
                    }
                    const int c = c0 + 4 * blk + i;
                    gin[c] = qq; gin[384 + c] = kk; gin[768 + c] = vv;
                    hq[4 * blk + i] = (f16)qq; hk[4 * blk + i] = (f16)(kk * 0.10206207261596577f); hv[4 * blk + i] = (f16)vv;
                }
            }
            GAS f16* o = P.qkv16 + (size_t)R * 1152 + c0;
            *(half8*)o = hq; *(half8*)(o + 384) = hk; *(half8*)(o + 768) = hv;
        }
        float acc[16];
#pragma unroll
        for (int o = 0; o < 16; ++o) acc[o] = 0.f;
#pragma unroll 3
        for (int i = 0; i < 18; ++i) {
            const int c = lane + 64 * i;
            const float gval = gin[c];
            const float* wr = sm + c * 20;
            const floatx4 w0 = *(const floatx4*)wr, w1 = *(const floatx4*)(wr + 4), w2 = *(const floatx4*)(wr + 8), w3 = *(const floatx4*)(wr + 12);
#pragma unroll
            for (int o2 = 0; o2 < 4; ++o2) { acc[o2] += gval * w0[o2]; acc[4 + o2] += gval * w1[o2]; acc[8 + o2] += gval * w2[o2]; acc[12 + o2] += gval * w3[o2]; }
        }
        float mine = 0.f;
#pragma unroll
        for (int o = 0; o < 16; ++o) { const float s = wave_sum(acc[o]); if (lane == o) mine = s; }
        if (lane < 16) {
            const int z = lane >> 3, hh = (lane >> 1) & 3, which = lane & 1;
            const float val = mine + (which ? P.ml_bf : P.ml_bi)[(l * 2 + z) * 4 + hh];
            P.gates[(size_t)R * 16 + lane] = which ? log_sigmoidf_(val) : val;
        }
    }
}
DEV void ml_load_T(PRef P, int z, int b, int hh, int s0, const float* wgt, f16* VT, f16* KeT, int tid) {
#pragma unroll
    for (int i = 0; i < 3; ++i) {
        const int e = tid + NT * i, which = e / 768, rem = e % 768, c8 = rem >> 6, t = rem & 63;
        const int R = scan_row(z, b, s0 + t);
        const half8 x = *(const half8*)(P.qkv16 + (size_t)R * 1152 + (which ? 384 : 768) + hh * 96 + c8 * 8);
        if (which == 0) {
#pragma unroll
            for (int j = 0; j < 8; ++j) VT[(c8 * 8 + j) * SLD + t] = x[j];
        } else {
            const float w = wgt[t];
#pragma unroll
            for (int j = 0; j < 8; ++j) KeT[(c8 * 8 + j) * SLD + t] = (f16)((float)x[j] * w);
        }
    }
}
constexpr int ML_VT_OFF = 0, ML_KE_OFF = 128 * SLD, ML_QS_OFF = ML_KE_OFF + 96 * SLD, ML_KS_OFF = ML_QS_OFF + 64 * QLD, ML_C16_OFF = ML_KS_OFF + 64 * QLD,
              ML_AM_OFF = ML_C16_OFF + 128 * QLD, ML_F_OFF_BYTES = (ML_AM_OFF + 64 * SLD) * 2;
constexpr int ML_LDS_BYTES = ML_F_OFF_BYTES + 320 * 4;
DEV void ph_ml_1(PRef P, int l, int bid, int nblk, unsigned char* smraw) {
    f16* VT = (f16*)smraw + ML_VT_OFF; f16* KeT = (f16*)smraw + ML_KE_OFF; float* fb = (float*)(smraw + ML_F_OFF_BYTES);
    const int tid = ltid(), lane = tid & 63, wv = tid >> 6;
    for (int item = bid; item < 16 * NSC; item += nblk) {
        const int chain = item / NSC, sc = item % NSC, z = chain / 8, b = (chain / 4) % 2, hh = chain % 4;
        BAR_LDS();
        for (int idx = tid; idx < 32 * SLD; idx += NT) VT[96 * SLD + idx] = (f16)((idx < SLD) ? 1.f : 0.f);
        float x = 0.f, li = 0.f;
        if (tid < 256) {
            const int R = scan_row(z, b, sc * 256 + tid);
            li = P.gates[(size_t)R * 16 + z * 8 + hh * 2]; x = P.gates[(size_t)R * 16 + z * 8 + hh * 2 + 1];
#pragma unroll
            for (int o = 1; o < 64; o <<= 1) { const float y = __shfl_up(x, o); if (lane >= o) x += y; }
            if (lane == 63) fb[256 + wv] = x;
        }
        BAR_LDS();
        if (tid < 256) {
            float off = 0.f, tot = 0.f;
#pragma unroll
            for (int w = 0; w < 4; ++w) { const float q = fb[256 + w]; tot += q; if (w < wv) off += q; }
            fb[tid] = __expf(li + tot - (x + off));
            if (tid == 0) P.mlG[item] = __expf(tot);
        }
        floatx16 c0, c1, c2;
#pragma unroll
        for (int r = 0; r < 16; ++r) { c0[r] = 0.f; c1[r] = 0.f; c2[r] = 0.f; }
#pragma unroll 1
        for (int cc = 0; cc < 4; ++cc) {
            BAR_LDS();
            ml_load_T(P, z, b, hh, sc * 256 + cc * 64, fb + cc * 64, VT, KeT, tid);
            BAR_LDS();
            if (wv < 4) {
                c0 = mmh<4>(VT, SLD, 32 * wv, KeT, SLD, 0, lane, c0);
                c1 = mmh<4>(VT, SLD, 32 * wv, KeT, SLD, 32, lane, c1);
                c2 = mmh<4>(VT, SLD, 32 * wv, KeT, SLD, 64, lane, c2);
            }
        }
        if (wv < 4) {
            GAS float* dst = P.mlC + (size_t)item * MLE;
#pragma unroll
            for (int r = 0; r < 16; ++r) {
                const int v = 32 * wv + (r & 3) + 8 * (r >> 2) + 4 * (lane >> 5), k = lane & 31;
                if (v <= 96) { dst[v * 96 + k] = c0[r]; dst[v * 96 + 32 + k] = c1[r]; dst[v * 96 + 64 + k] = c2[r]; }
            }
        }
    }
}
DEV void ph_ml_2(PRef P, int bid, int nblk) {
    for (int idx = bid * NT + ltid(); idx < 16 * MLE; idx += nblk * NT) {
        const int chain = idx / MLE, e = idx % MLE; float run = 0.f;
        for (int s0 = 0; s0 < NSC; s0 += 13) {
            float loc[13], gg[13];
#pragma unroll
            for (int i = 0; i < 13; ++i) { loc[i] = P.mlC[((size_t)chain * NSC + s0 + i) * MLE + e]; gg[i] = P.mlG[chain * NSC + s0 + i]; }
#pragma unroll
            for (int i = 0; i < 13; ++i) { P.mlC[((size_t)chain * NSC + s0 + i) * MLE + e] = run; run = gg[i] * run + loc[i]; }
        }
    }
}
DEV void ph_ml_3(PRef P, int l, int bid, int nblk, unsigned char* smraw) {
    f16* sh = (f16*)smraw;
    f16 *VT = sh + ML_VT_OFF, *KeT = sh + ML_KE_OFF, *Qs = sh + ML_QS_OFF, *Ks = sh + ML_KS_OFF, *C16 = sh + ML_C16_OFF, *Am = sh + ML_AM_OFF;
    float* fb = (float*)(smraw + ML_F_OFF_BYTES);
    const int tid = ltid(), lane = tid & 63, wv = tid >> 6, w4 = wv & 3, wm = w4 & 1, wn = w4 >> 1;
    for (int item = bid; item < 16 * NSC; item += nblk) {
        const int chain = item / NSC, sc = item % NSC, z = chain / 8, b = (chain / 4) % 2, hh = chain % 4;
        if (l == 1 && sc == 0) continue;
        BAR_LDS();
        for (int idx = tid; idx < 32 * SLD; idx += NT) VT[96 * SLD + idx] = (f16)((idx < SLD) ? 1.f : 0.f);
        floatx16 c0, c1, c2;
#pragma unroll
        for (int r = 0; r < 16; ++r) { c0[r] = 0.f; c1[r] = 0.f; c2[r] = 0.f; }
        if (wv < 4) {
            const GAS float* srcC = P.mlC + (size_t)item * MLE;
#pragma unroll
            for (int r = 0; r < 16; ++r) {
                const int v = 32 * wv + (r & 3) + 8 * (r >> 2) + 4 * (lane >> 5), k = lane & 31;
                const bool ok = v <= 96;
                c0[r] = ok ? srcC[v * 96 + k] : 0.f; c1[r] = ok ? srcC[v * 96 + 32 + k] : 0.f; c2[r] = ok ? srcC[v * 96 + 64 + k] : 0.f;
            }
        }
#pragma unroll 1
        for (int cc = 0; cc < 4; ++cc) {
            const int s0 = sc * 256 + cc * 64;
            BAR_LDS();
            if (wv == 7) {
                const int R = scan_row(z, b, s0 + lane);
                const float li = P.gates[(size_t)R * 16 + z * 8 + hh * 2], lf = P.gates[(size_t)R * 16 + z * 8 + hh * 2 + 1];
                float F = lf;
#pragma unroll
                for (int o = 1; o < 64; o <<= 1) { const float y = __shfl_up(F, o); if (lane >= o) F += y; }
                const float FL = __shfl(F, 63);
                fb[lane] = __expf(F); fb[64 + lane] = __expf(fminf(li - F, 10.f)); fb[128 + lane] = __expf(li + FL - F);
                if (lane == 63) fb[192] = __expf(FL);
            }
            if (wv < 4) {
#pragma unroll
                for (int r = 0; r < 16; ++r) {
                    const int v = 32 * wv + (r & 3) + 8 * (r >> 2) + 4 * (lane >> 5), k = lane & 31;
                    C16[v * QLD + k] = (f16)c0[r]; C16[v * QLD + 32 + k] = (f16)c1[r]; C16[v * QLD + 64 + k] = (f16)c2[r];
                }
            }
            BAR_LDS();
#pragma unroll
            for (int i = 0; i < 3; ++i) {
                const int e = tid + NT * i, which = e / 768, rem = e % 768, t = rem / 12, c8 = rem % 12;
                const int R = scan_row(z, b, s0 + t);
                const half8 x = *(const half8*)(P.qkv16 + (size_t)R * 1152 + (which ? 384 : 0) + hh * 96 + c8 * 8);
                const float w = which ? fb[64 + t] : fb[t];
                half8 y;
#pragma unroll
                for (int jj = 0; jj < 8; ++jj) y[jj] = (f16)((float)x[jj] * w);
                *(half8*)((which ? Ks : Qs) + t * QLD + c8 * 8) = y;
            }
            ml_load_T(P, z, b, hh, s0, fb + 128, VT, KeT, tid);
            BAR_LDS();
            if (wv >= 4) {
#pragma unroll
                for (int r = 0; r < 16; ++r) c2[r] = 0.f;
                if (!(wm == 0 && wn == 1)) c2 = mmh<6>(Qs, QLD, wm * 32, Ks, QLD, wn * 32, lane, c2);
#pragma unroll
                for (int r = 0; r < 16; ++r) {
                    const int m = wm * 32 + (r & 3) + 8 * (r >> 2) + 4 * (lane >> 5), n = wn * 32 + (lane & 31);
                    Am[m * SLD + n] = (f16)(n <= m ? c2[r] : 0.f);
                }
            } else {
                const float gL = fb[192];
#pragma unroll
                for (int r = 0; r < 16; ++r) { c0[r] *= gL; c1[r] *= gL; c2[r] *= gL; }
                c0 = mmh<4>(VT, SLD, 32 * wv, KeT, SLD, 0, lane, c0); __builtin_amdgcn_sched_barrier(0);
                c1 = mmh<4>(VT, SLD, 32 * wv, KeT, SLD, 32, lane, c1); __builtin_amdgcn_sched_barrier(0);
                c2 = mmh<4>(VT, SLD, 32 * wv, KeT, SLD, 64, lane, c2);
            }
            BAR_LDS();
            if (wv >= 4) {
#pragma unroll
                for (int r = 0; r < 16; ++r) { c0[r] = 0.f; c1[r] = 0.f; }
                c0 = mmh<4>(Am, SLD, 0, VT, SLD, 32 * w4, lane, c0); __builtin_amdgcn_sched_barrier(0); c0 = mmh<6>(Qs, QLD, 0, C16, QLD, 32 * w4, lane, c0); __builtin_amdgcn_sched_barrier(0);
                c1 = mmh<4>(Am, SLD, 32, VT, SLD, 32 * w4, lane, c1); __builtin_amdgcn_sched_barrier(0); c1 = mmh<6>(Qs, QLD, 32, C16, QLD, 32 * w4, lane, c1); __builtin_amdgcn_sched_barrier(0);
                if (wv == 7 && (lane & 31) == 0) {
#pragma unroll
                    for (int r = 0; r < 16; ++r) { const int t = (r & 3) + 8 * (r >> 2) + 4 * (lane >> 5); fb[256 + t] = c0[r]; fb[256 + 32 + t] = c1[r]; }
                }
            }
            BAR_LDS();
            if (wv >= 4 && wv < 7) {
#pragma unroll
                for (int r = 0; r < 16; ++r) {
                    const int t = (r & 3) + 8 * (r >> 2) + 4 * (lane >> 5);
                    const int R0 = scan_row(z, b, s0 + t), R1 = scan_row(z, b, s0 + 32 + t);
                    const float d0 = fmaxf(fabsf(fb[256 + t]), 1.f), d1 = fmaxf(fabsf(fb[256 + 32 + t]), 1.f);
                    P.Y[((size_t)z * NROWS + R0) * 384 + hh * 96 + 32 * w4 + (lane & 31)] = c0[r] * frcp(d0);
                    P.Y[((size_t)z * NROWS + R1) * 384 + hh * 96 + 32 * w4 + (lane & 31)] = c1[r] * frcp(d1);
                    if ((r & 3) == 3) __builtin_amdgcn_sched_barrier(0);
                }
            }
        }
    }
}
DEV void ph_ml_fin2(PRef P, int l, int bid, int nblk) {
    const int tid_ = ltid(); const int lane = tid_ & 63, wv = tid_ >> 6;
    for (int R = (l == 1 ? NCTX : 0) + bid * NW + wv; R < NROWS; R += nblk * NW) {
        float y[6]; float s = 0.f;
#pragma unroll
        for (int i = 0; i < 6; ++i) { const int c = lane * 6 + i; y[i] = P.Y[(size_t)R * 384 + c] + P.Y[((size_t)NROWS + R) * 384 + c]; s += y[i]; }
        s += __shfl_xor(s, 1); s += __shfl_xor(s, 2); s += __shfl_xor(s, 4); s += __shfl_xor(s, 8);
        const float mu = s * (1.f / 96.f); float q = 0.f;
#pragma unroll
        for (int i = 0; i < 6; ++i) { y[i] -= mu; q += y[i] * y[i]; }
        q += __shfl_xor(q, 1); q += __shfl_xor(q, 2); q += __shfl_xor(q, 4); q += __shfl_xor(q, 8);
        const float rs = __builtin_amdgcn_rsqf(q * (1.f / 96.f) + 1e-6f);
#pragma unroll
        for (int i = 0; i < 6; ++i) {
            const int c = lane * 6 + i;
            const float hv = y[i] * rs * P.ml_norm_g[l * 384 + c] + P.ml_skip[l * 384 + c] * ml_xc(P, l, R, c);
            const float zg = (float)P.p[(size_t)R * INW + 2560 + c];
            P.p[(size_t)R * INW + 2560 + c] = (f16)(hv * fsilu(zg));
        }
    }
}


#define XB_TMO      128
#define XB_XCNT(j)  (256  + 64 * (j))
#define XB_XSUB(j)  (1280 + 64 * (j))
#define XB_XGEN(j)  (2304 + 64 * (j))
#define XB_TOP      3328
#define XB_TOPGEN   3392
#define XCD_BAR_WORDS 3456
#define XB_SPIN_CAP (1u << 22)
#define LAS __attribute__((address_space(3)))
DEV unsigned xb_ld(GAS unsigned* p)              { return __hip_atomic_load(p, __ATOMIC_RELAXED, __HIP_MEMORY_SCOPE_AGENT); }
DEV unsigned xb_add(GAS unsigned* p, unsigned v) { return __hip_atomic_fetch_add(p, v, __ATOMIC_RELAXED, __HIP_MEMORY_SCOPE_AGENT); }
DEV unsigned xb_xcc_id() { return (unsigned)__builtin_amdgcn_s_getreg((3 << 11) | 20) & 0xFu; }
#define XB_SPIN(cond, bar) do { unsigned _sp = 0; while (cond) { __builtin_amdgcn_s_sleep(1); \
    if ((++_sp & 255u) == 0u) { if (xb_ld(&(bar)[XB_TMO])) break; if (_sp > XB_SPIN_CAP) { (void)xb_add(&(bar)[XB_TMO], 1u); break; } } } } while (0)
struct XcdBarrier { GAS unsigned* bar; unsigned x; volatile LAS unsigned* st; };
DEV XcdBarrier xcd_barrier_post(GAS unsigned* bar, volatile LAS unsigned* st) {
    XcdBarrier b; b.bar = bar; b.x = xb_xcc_id(); b.st = st;
    if (threadIdx.x == 0) (void)xb_add(&bar[XB_XCNT(b.x)], 1u);
    return b;
}
DEV void xcd_barrier_complete(GAS unsigned* bar, unsigned x, unsigned& nloc, unsigned& nx) {
    const unsigned G = gridDim.x * gridDim.y * gridDim.z;
    unsigned sum, cnt, mine, sp = 0u;
    for (;;) {
        sum = 0u; cnt = 0u; mine = 0u;
#pragma unroll
        for (unsigned j = 0; j < 16; ++j) { const unsigned c = xb_ld(&bar[XB_XCNT(j)]); sum += c; cnt += (c > 0u) ? 1u : 0u; mine = (j == x) ? c : mine; }
        if (sum == G) break;
        __builtin_amdgcn_s_sleep(1);
        if ((++sp & 255u) == 0u) { if (xb_ld(&bar[XB_TMO])) break; if (sp > XB_SPIN_CAP) { (void)xb_add(&bar[XB_TMO], 1u); break; } }
    }
    nloc = mine > 0u ? mine : 1u; nx = cnt > 0u ? cnt : 1u;
}
DEV void xcd_barrier(const XcdBarrier& b, GAS unsigned* bar_) {
    asm volatile("s_waitcnt vmcnt(0)" ::: "memory");
    __syncthreads();
    if (threadIdx.x == 0) {
        GAS unsigned* bar = bar_;
        __builtin_amdgcn_s_waitcnt(0);
        unsigned nloc = b.st[0], nx = b.st[1];
        if (nloc == 0u) { xcd_barrier_complete(bar, b.x, nloc, nx); b.st[0] = nloc; b.st[1] = nx; }
        const unsigned old = xb_add(&bar[XB_XSUB(b.x)], 1u);
        const unsigned gen = old / nloc;
        if (old + 1u == (gen + 1u) * nloc) {
            __builtin_amdgcn_fence(__ATOMIC_RELEASE, "agent");
            asm volatile("s_waitcnt vmcnt(0)" ::: "memory");
            const unsigned og = xb_add(&bar[XB_TOP], 1u);
            const unsigned tg = og / nx;
            if (og + 1u == (tg + 1u) * nx) xb_add(&bar[XB_TOPGEN], 1u);
            else XB_SPIN(xb_ld(&bar[XB_TOPGEN]) == tg, bar);
            __builtin_amdgcn_fence(__ATOMIC_ACQUIRE, "agent");
            xb_add(&bar[XB_XGEN(b.x)], 1u);
            asm volatile("s_waitcnt vmcnt(0)" ::: "memory");
        } else {
            XB_SPIN(xb_ld(&bar[XB_XGEN(b.x)]) == gen, bar);
            __builtin_amdgcn_fence(__ATOMIC_ACQUIRE, "agent");
            asm volatile("s_waitcnt vmcnt(0)" ::: "memory");
        }
    }
    __syncthreads();
}

constexpr size_t al256(size_t x) { return (x + 255) & ~(size_t)255; }
constexpr size_t WS_MODS = 0;
constexpr size_t WS_P = al256(WS_MODS + 2 * 3 * 3072 * 4);
constexpr size_t WS_Y = al256(WS_P + (size_t)NROWS * INW * 2);
constexpr size_t WS_Q = al256(WS_Y + (size_t)2 * NROWS * 384 * 4);
constexpr size_t WS_Q_BYTES = (size_t)NROWS * 1152 * 4;
constexpr size_t WS_GATES = al256(WS_Q + WS_Q_BYTES);
constexpr size_t WS_BON = al256(WS_GATES + (size_t)NROWS * 16 * 4);
constexpr size_t WS_YG = al256(WS_BON + (size_t)2 * NROWS * 6 * 4);
constexpr size_t WS_S5H = al256(WS_YG + (size_t)NROWS * 256 * 2);
constexpr size_t WS_S5PAR = al256(WS_S5H + (size_t)64 * NCHUNK * 128 * 4);
constexpr size_t WS_S5BB = al256(WS_S5PAR + (size_t)64 * S5PW * 64 * 4);
constexpr size_t WS_S5CC = al256(WS_S5BB + (size_t)64 * 128 * 16 * 2);
constexpr size_t WS_GLUT = al256(WS_S5CC + (size_t)64 * 16 * 128 * 2);
constexpr size_t WS_CTX1 = al256(WS_GLUT + (size_t)2 * 256 * 256 * 2);
constexpr size_t WS_WTIN = al256(WS_CTX1 + (size_t)NCTX * D * 4);
constexpr size_t WS_WTOUT = al256(WS_WTIN + (size_t)2 * INW * D * 2);
constexpr size_t WS_RWLT = al256(WS_WTOUT + (size_t)2 * D * D * 2);
constexpr size_t WS_GP = al256(WS_RWLT + (size_t)2 * 2 * 2 * 384 * 32 * 2);
constexpr size_t WS_XBAR = al256(WS_GP + 1024);
constexpr size_t WS_END = al256(WS_XBAR + XCD_BAR_WORDS * 4);
static_assert(3 * RWM_STRIDE * 2 <= WS_Q_BYTES, "rwkv chunk matrices");
static_assert(al256((size_t)NROWS * 1152 * 2) + al256((size_t)16 * NSC * MLE * 4) + 16 * NSC * 4 <= WS_Q_BYTES, "ml region");

static void fill_params(Params& P, void* const* d_in, void* d_out, void* d_ws) {
    const GAS float** pp = (const GAS float**)&P;
    for (int i = 0; i < 41; ++i) pp[i] = (const GAS float*)d_in[i];
    unsigned char* ws = (unsigned char*)d_ws;
    P.out = (GAS float*)d_out;
    P.mods = (GAS float*)(ws + WS_MODS); P.p = (GAS f16*)(ws + WS_P); P.Y = (GAS float*)(ws + WS_Y);
    P.gates = (GAS float*)(ws + WS_GATES); P.bon = (GAS float*)(ws + WS_BON); P.ctx1 = (GAS float*)(ws + WS_CTX1);
    P.hx = (GAS f16*)(ws + WS_Q); P.rwm = (GAS f16*)(ws + WS_Q); P.qkv16 = (GAS f16*)(ws + WS_Q);
    P.mlC = (GAS float*)(ws + WS_Q + al256((size_t)NROWS * 1152 * 2)); P.mlG = (GAS float*)(ws + WS_Q + al256((size_t)NROWS * 1152 * 2) + al256((size_t)16 * NSC * MLE * 4));
    P.wt_in = (GAS f16*)(ws + WS_WTIN); P.wt_out = (GAS f16*)(ws + WS_WTOUT); P.glut = (GAS f16*)(ws + WS_GLUT);
    P.yg = (GAS f16*)(ws + WS_YG); P.s5h = (GAS float*)(ws + WS_S5H); P.s5par = (GAS float*)(ws + WS_S5PAR); P.s5bb = (GAS f16*)(ws + WS_S5BB); P.s5cc = (GAS f16*)(ws + WS_S5CC);
    P.rwlt = (GAS bf16*)(ws + WS_RWLT); P.gp = (GAS Params*)(ws + WS_GP); P.xbar = (GAS unsigned*)(ws + WS_XBAR);
}

constexpr int cmax(int a, int b) { return a > b ? a : b; }
constexpr int MEGA_LDS_BYTES = cmax(cmax(RWP1_LDS_BYTES, S5_LDS_BYTES), cmax(cmax(GEMM_LDS_BYTES, ML_LDS_BYTES), (1152 * 20 + NW * 1152) * 4));

__global__ void __launch_bounds__(NT) mega_fwd(Params Pk) {
    __shared__ __attribute__((aligned(16))) unsigned char smraw[MEGA_LDS_BYTES + 16];
    float* sm = (float*)smraw;
    cg::grid_group grid = cg::this_grid();
    const int bid = blockIdx.x, nblk = gridDim.x;
    if (threadIdx.x == 0) {
        GAS unsigned long long* dstw = (GAS unsigned long long*)Pk.gp; const unsigned long long* srcw = (const unsigned long long*)&Pk;
#pragma unroll
        for (int i = 0; i < (int)(sizeof(Params) / 8); ++i) dstw[i] = srcw[i];
        *(uintx4*)(smraw + MEGA_LDS_BYTES) = (uintx4){0u, 0u, 0u, 0u};
    }
    asm volatile("s_waitcnt vmcnt(0)" ::: "memory");
    __syncthreads();
    const XcdBarrier xb = xcd_barrier_post(Pk.xbar, (volatile LAS unsigned*)(smraw + MEGA_LDS_BYTES));
    const GAS Params* pg = Pk.gp;
    asm volatile("" : "+s"(pg) :: "memory");
    PRef P = *pg;
    ph_mods2(P, lsgpr(bid), nblk, sm);
    ph_wprep(P, lsgpr(bid), nblk, sm);
    ph_tables(P, lsgpr(bid), nblk);
    grid.sync();
    for (int l = 0; l < 2; ++l) {
        for (int rep = 0; rep < REP_HX; ++rep) ph_hx(P, l, lsgpr(bid), nblk);
        xcd_barrier(xb, P.xbar);
        for (int rep = 0; rep < REP_G1; ++rep) ph_gemm_mfma<1>(P, l, lsgpr(bid), nblk, smraw);
        for (int rep = 0; rep < REP_SYNC; ++rep) xcd_barrier(xb, P.xbar);
        for (int rep = 0; rep < REP_P1; ++rep) ph_rw_p1(P, l, lsgpr(bid), nblk, smraw);
        for (int rep = 0; rep < REP_S5A; ++rep) ph_s5_a(P, l, lsgpr(bid), nblk, smraw);
        xcd_barrier(xb, P.xbar);
        ph_rw_stream(P, l, lsgpr(bid), nblk, smraw);
        ph_s5_b(P, l, lsgpr(bid), nblk);
        xcd_barrier(xb, P.xbar);
        ph_rwkv_fin2(P, l, lsgpr(bid), nblk);
        for (int rep = 0; rep < REP_S5C; ++rep) ph_s5_c(P, l, lsgpr(bid), nblk, smraw);
        xcd_barrier(xb, P.xbar);
        ph_gemm_mfma<3>(P, l, lsgpr(bid), nblk, smraw);
        for (int rep = 0; rep < REP_MLA; ++rep) ph_ml_a(P, l, lsgpr(bid), nblk, sm);
        xcd_barrier(xb, P.xbar);
        for (int rep = 0; rep < REP_ML1; ++rep) ph_ml_1(P, l, lsgpr(bid), nblk, smraw);
        xcd_barrier(xb, P.xbar);
        ph_ml_2(P, lsgpr(bid), nblk);
        xcd_barrier(xb, P.xbar);
        for (int rep = 0; rep < REP_ML3; ++rep) ph_ml_3(P, l, lsgpr(bid), nblk, smraw);
        xcd_barrier(xb, P.xbar);
        ph_ml_fin2(P, l, lsgpr(bid), nblk);
        xcd_barrier(xb, P.xbar);
        for (int rep = 0; rep < REP_G2; ++rep) ph_gemm_mfma<2>(P, l, lsgpr(bid), nblk, smraw);
        xcd_barrier(xb, P.xbar);
    }
    ph_final2(P, lsgpr(bid), nblk);
}

extern "C" void kernel_launch(void* const* d_in, const int* in_sizes, int n_in, void* d_out, int out_size, void* d_ws, size_t ws_size, hipStream_t stream) {
    if (ws_size < WS_END) { fprintf(stderr, "workspace too small: %zu < %zu\n", ws_size, (size_t)WS_END); return; }
    static int grid_blocks = 0;
    if (!grid_blocks) {
        int dev = 0, cus = 0, per_cu = 0;
        hipGetDevice(&dev);
        hipDeviceGetAttribute(&cus, hipDeviceAttributeMultiprocessorCount, dev);
        hipOccupancyMaxActiveBlocksPerMultiprocessor(&per_cu, mega_fwd, NT, 0);
        if (per_cu < 1) per_cu = 1;
        grid_blocks = cus * per_cu;
        fprintf(stderr, "mega_fwd: %d CUs x %d blocks/CU\n", cus, per_cu);
    }
    Params P{};
    fill_params(P, d_in, d_out, d_ws);
    hipMemsetAsync((unsigned char*)d_ws + WS_XBAR, 0, XCD_BAR_WORDS * 4, stream);
    void* args[] = {&P};
    hipError_t e = hipLaunchCooperativeKernel((void*)mega_fwd, dim3(grid_blocks), dim3(NT), args, 0, stream);
    if (e != hipSuccess) fprintf(stderr, "cooperative launch failed: %s (grid %d)\n", hipGetErrorString(e), grid_blocks);
}
```

```cpp
#include <hip/hip_runtime.h>
#include <hip/hip_cooperative_groups.h>
#include <cstdint>
#include <cmath>
#include <cstdio>
namespace cg = cooperative_groups;

#ifndef SEQ
#define SEQ 16384
#endif
#ifndef CTX
#define CTX 256
#endif
#ifndef REP_G1
#define REP_G1 1
#endif
#ifndef REP_G2
#define REP_G2 1
#endif
#ifndef REP_P1
#define REP_P1 1
#endif
#ifndef REP_S5A
#define REP_S5A 1
#endif
#ifndef REP_S5C
#define REP_S5C 1
#endif
#ifndef REP_MLA
#define REP_MLA 1
#endif
#ifndef REP_ML1
#define REP_ML1 1
#endif
#ifndef REP_ML3
#define REP_ML3 1
#endif
#ifndef REP_HX
#define REP_HX 1
#endif
#ifndef REP_ST
#define REP_ST 1
#endif
#ifndef REP_RWF
#define REP_RWF 1
#endif
#ifndef REP_MLF
#define REP_MLF 1
#endif
#ifndef REP_G3
#define REP_G3 1
#endif
#ifndef ST_VARIANT
#define ST_VARIANT 0
#endif
#ifndef REP_SYNC
#define REP_SYNC 1
#endif

typedef _Float16 f16;
typedef __bf16 bf16;
typedef _Float16 half8 __attribute__((ext_vector_type(8)));
typedef _Float16 half4 __attribute__((ext_vector_type(4)));
typedef __bf16 bf16x8 __attribute__((ext_vector_type(8)));
typedef __bf16 bf16x4 __attribute__((ext_vector_type(4)));
typedef float floatx16 __attribute__((ext_vector_type(16)));
typedef float floatx4 __attribute__((ext_vector_type(4)));
typedef unsigned uintx4 __attribute__((ext_vector_type(4)));

constexpr int D = 1024, NB = 2, INW = 2944;
constexpr int NCTX = NB * CTX, NLAT = NB * SEQ, NROWS = NCTX + NLAT;
constexpr int TSCAN = CTX + SEQ, NCHUNK = TSCAN / 64;
constexpr int NT = 512, NW = NT / 64;
#define DEV __device__ __forceinline__
#define GAS __attribute__((address_space(1)))
#define BAR_LDS() asm volatile("s_waitcnt lgkmcnt(0)\n\ts_barrier" ::: "memory")

DEV int ltid() { int t = threadIdx.x; asm volatile("" : "+v"(t)); return t; }
DEV int lsgpr(int x) { asm volatile("" : "+s"(x)); return x; }

struct Params;
typedef const GAS Params& PRef;
struct Params {
    const GAS float *x, *c, *ctx, *c_ctx, *ada_w, *ada_b, *norm_g, *w_in, *w_out;
    const GAS float *rw_mu, *rw_w0, *rw_w_up, *rw_a0, *rw_a_up, *rw_k_k, *rw_k_a, *rw_r_k, *rw_ln_g, *rw_ln_b;
    const GAS float *s5_a_re, *s5_a_im, *s5_log_dt, *s5_b_re, *s5_b_im, *s5_c_re, *s5_c_im, *s5_d, *s5_glu_w, *s5_glu_b;
    const GAS float *ml_conv_w, *ml_conv_b, *ml_wq, *ml_wk, *ml_wv, *ml_wi, *ml_bi, *ml_wf, *ml_bf, *ml_norm_g, *ml_skip;
    const GAS float* final_g;
    GAS float* out;
    GAS float* mods;
    GAS f16* p;
    GAS f16* Yh;
    GAS float* gates;
    GAS float* bon;
    GAS float* ctx1;
    GAS f16* hx;
    GAS f16* rwm;
    GAS f16* qkv16;
    GAS float* mlC;
    GAS float* mlG;
    GAS f16* wt_in;
    GAS f16* wt_out;
    GAS f16* glut;
    GAS f16* yg;
    GAS float* s5h;
    GAS float* s5par;
    GAS f16* s5bb;
    GAS f16* s5cc;
    GAS bf16* rwlt;
    GAS unsigned* xbar;
    GAS Params* gp;
};

DEV float sigmoidf_(float x) { return 1.f / (1.f + expf(-x)); }
DEV float siluf_(float x) { return x / (1.f + expf(-x)); }
DEV float frcp(float x) { return __builtin_amdgcn_rcpf(x); }
DEV float fsigmoid(float x) { return frcp(1.f + __expf(-x)); }
DEV float fsilu(float x) { return x * frcp(1.f + __expf(-x)); }
DEV float ftanh(float x) { x = fminf(fmaxf(x, -15.f), 15.f); const float e = __expf(2.f * x); return (e - 1.f) * frcp(e + 1.f); }
DEV float log_sigmoidf_(float x) { return fminf(x, 0.f) - log1pf(expf(-fabsf(x))); }
template <int CTRL> DEV float dpp_f(float v) { return __builtin_bit_cast(float, __builtin_amdgcn_update_dpp(0, __builtin_bit_cast(int, v), CTRL, 0xF, 0xF, false)); }
DEV float row16_sum(float v) {
    v += dpp_f<0xB1>(v); v += dpp_f<0x4E>(v); v += dpp_f<0x141>(v); v += dpp_f<0x140>(v);
    return v;
}
DEV float wave_sum(float v) {
    v = row16_sum(v);
    v += __shfl_xor(v, 16); v += __shfl_xor(v, 32);
    return v;
}
DEV int scan_row(int z, int b, int s) {
    if (s < CTX) { int t = z ? CTX - 1 - s : s; return b * CTX + t; }
    int u = s - CTX; int t = z ? SEQ - 1 - u : u; return NCTX + b * SEQ + t;
}
DEV int mirror_chunk(int tc) { return tc < CTX / 64 ? CTX / 64 - 1 - tc : CTX / 64 + (SEQ / 64 - 1) - (tc - CTX / 64); }
DEV int row_mod(int R) { return R < NCTX ? 2 : (R - NCTX) / SEQ; }
DEV const GAS float* xrow(PRef P, int l, int R) {
    const GAS float* xl = l == 0 ? P.x : P.out; const GAS float* xc = l == 0 ? P.ctx : P.ctx1;
    return R < NCTX ? xc + (size_t)R * D : xl + (size_t)(R - NCTX) * D;
}
DEV int nbr_row(int R, int c) {
    if (R < NCTX) { int t = R % CTX; if ((c & 1) == 0) return t > 0 ? R - 1 : -1; return t < CTX - 1 ? R + 1 : -1; }
    int t = (R - NCTX) % SEQ; int m = c & 3, col = t & 63;
    if (m == 0) return col > 0 ? R - 1 : -1;
    if (m == 1) return col < 63 ? R + 1 : -1;
    if (m == 2) return t >= 64 ? R - 64 : -1;
    return t < SEQ - 64 ? R + 64 : -1;
}
DEV float shl(PRef P, int l, int R, int c) {
    float pv = (float)P.p[(size_t)R * INW + c];
    int nb = nbr_row(R, c);
    float nv = nb >= 0 ? (float)P.p[(size_t)nb * INW + c] : 0.f;
    return pv + (nv - pv) * P.rw_mu[l * 1280 + c];
}
DEV int a2col(int k) { return k < 384 ? 1280 + k : (k < 640 ? 1920 + (k - 384) : 2560 + (k - 640)); }
DEV float ml_xm(PRef P, int R, int c) { return (float)P.p[(size_t)R * INW + 2176 + c]; }
DEV float ml_xc(PRef P, int l, int R, int c) {
    int t, len; if (R < NCTX) { t = R % CTX; len = CTX; } else { t = (R - NCTX) % SEQ; len = SEQ; }
    float a = P.ml_conv_b[l * 384 + c] + P.ml_conv_w[(l * 3 + 1) * 384 + c] * ml_xm(P, R, c);
    if (t > 0) a += P.ml_conv_w[(l * 3 + 0) * 384 + c] * ml_xm(P, R - 1, c);
    if (t < len - 1) a += P.ml_conv_w[(l * 3 + 2) * 384 + c] * ml_xm(P, R + 1, c);
    return fsilu(a);
}

DEV void ph_mods2(PRef P, int bid, int nblk, float* sm) {
    const int tid = ltid(), cl = tid & 15, kq = tid >> 4;
    for (int g = bid; g < 2 * 3 * 3072 / 16; g += nblk) {
        const int idx = g * 16 + cl; const int l = idx / 9216, rem = idx % 9216, j = rem / 3072, col = rem % 3072;
        const GAS float* cin = j < 2 ? P.c + j * D : P.c_ctx;
        float acc = 0.f;
        for (int k = kq * 32; k < kq * 32 + 32; ++k) acc += siluf_(cin[k]) * P.ada_w[((size_t)l * D + k) * 3072 + col];
        sm[kq * 16 + cl] = acc;
        __syncthreads();
        if (tid < 16) { float s = P.ada_b[l * 3072 + col]; for (int q = 0; q < 32; ++q) s += sm[q * 16 + tid]; P.mods[idx] = s; }
        __syncthreads();
    }
}
DEV void ph_wprep(PRef P, int bid, int nblk, float* sm) {
    const int tid = ltid();
    constexpr int T_IN = 16 * 46, T_OUT = 16 * 16, T_GLU = 4 * 4;
    for (int t = bid; t < 2 * (T_IN + T_OUT + T_GLU); t += nblk) {
        int l = t / (T_IN + T_OUT + T_GLU), r = t % (T_IN + T_OUT + T_GLU);
        const GAS float* W; GAS f16* Wt; int N, tk, tn, KW = D;
        if (r < T_IN) { W = P.w_in + (size_t)l * D * INW; Wt = P.wt_in + (size_t)l * INW * D; N = INW; tk = r / 46; tn = r % 46; }
        else if (r < T_IN + T_OUT) { r -= T_IN; W = P.w_out + (size_t)l * D * D; Wt = P.wt_out + (size_t)l * D * D; N = D; tk = r / 16; tn = r % 16; }
        else { r -= T_IN + T_OUT; W = P.s5_glu_w + (size_t)l * 256 * 256; Wt = P.glut + (size_t)l * 256 * 256; N = 256; tk = r / 4; tn = r % 4; KW = 256; }
#pragma unroll
        for (int i = 0; i < 2; ++i) {
            int k = (tid >> 4) + 32 * i, n4 = (tid & 15) * 4;
            floatx4 v = *(const floatx4*)(W + (size_t)(tk * 64 + k) * N + tn * 64 + n4);
            sm[k * 65 + n4] = v[0]; sm[k * 65 + n4 + 1] = v[1]; sm[k * 65 + n4 + 2] = v[2]; sm[k * 65 + n4 + 3] = v[3];
        }
        __syncthreads();
        {
            int n = tid >> 3, k8 = (tid & 7) * 8;
            half8 h;
#pragma unroll
            for (int j = 0; j < 8; ++j) h[j] = (f16)sm[(k8 + j) * 65 + n];
            *(half8*)(Wt + (size_t)(tn * 64 + n) * KW + tk * 64 + k8) = h;
        }
        __syncthreads();
    }
}
constexpr int S5PW = 38;
DEV void ph_tables(PRef P, int bid, int nblk) {
    for (int idx = bid * NT + ltid(); idx < 2 * 2 * 16 * 64; idx += nblk * NT) {
        const int n = idx & 63, lzg = idx >> 6;
        const int pi = lzg * 64 + n;
        const float are_ = P.s5_a_re[pi], aim_ = P.s5_a_im[pi], dt = expf(P.s5_log_dt[pi]);
        const float mag = expf(are_ * dt), abr = mag * cosf(aim_ * dt), abi = mag * sinf(aim_ * dt);
        const float den = are_ * are_ + aim_ * aim_;
        const float qre = ((abr - 1.f) * are_ + abi * aim_) / den, qim = (abi * are_ - (abr - 1.f) * aim_) / den;
        GAS float* tb = P.s5par + (size_t)lzg * S5PW * 64 + n;
        tb[0] = abr; tb[64] = abi;
        for (int pp = 0; pp < 16; ++pp) {
            const float br = P.s5_b_re[(size_t)pi * 16 + pp], bi = P.s5_b_im[(size_t)pi * 16 + pp];
            P.s5bb[((size_t)lzg * 128 + n) * 16 + pp] = (f16)(qre * br - qim * bi);
            P.s5bb[((size_t)lzg * 128 + 64 + n) * 16 + pp] = (f16)(qre * bi + qim * br);
            P.s5cc[((size_t)lzg * 16 + pp) * 128 + n] = (f16)P.s5_c_re[((size_t)lzg * 16 + pp) * 64 + n];
            P.s5cc[((size_t)lzg * 16 + pp) * 128 + 64 + n] = (f16)(-P.s5_c_im[((size_t)lzg * 16 + pp) * 64 + n]);
        }
        const float m64 = expf(64.f * are_ * dt);
        tb[34 * 64] = m64 * cosf(64.f * aim_ * dt); tb[35 * 64] = m64 * sinf(64.f * aim_ * dt);
    }
    for (int idx = bid * NT + ltid(); idx < 2 * 2 * 2 * 384 * 32; idx += nblk * NT) {
        const int r = idx & 31, c = (idx >> 5) % 384, wa = (idx / (32 * 384)) & 1, lz = idx / (2 * 32 * 384);
        const GAS float* src_ = wa ? P.rw_a_up : P.rw_w_up;
        P.rwlt[idx] = (bf16)src_[((size_t)lz * 32 + r) * 384 + c];
    }
}
DEV void ph_hx(PRef P, int l, int bid, int nblk) {
    const int tid_ = ltid(); const int lane = tid_ & 63, wv = tid_ >> 6;
    for (int R = bid * NW + wv; R < NROWS; R += nblk * NW) {
        const GAS float* xr = xrow(P, l, R);
        floatx4 v[4]; float ss = 0.f;
#pragma unroll
        for (int i = 0; i < 4; ++i) { v[i] = *(const floatx4*)(xr + i * 256 + lane * 4); ss += v[i][0] * v[i][0] + v[i][1] * v[i][1] + v[i][2] * v[i][2] + v[i][3] * v[i][3]; }
        ss = wave_sum(ss);
        const float rs = 1.f / sqrtf(ss * (1.f / D) + 1e-6f);
        const GAS float* m = P.mods + (l * 3 + row_mod(R)) * 3072; const GAS float* g = P.norm_g + l * D;
#pragma unroll
        for (int i = 0; i < 4; ++i) {
            int k = i * 256 + lane * 4; half4 h;
#pragma unroll
            for (int j = 0; j < 4; ++j) h[j] = (f16)(v[i][j] * rs * g[k + j] * (1.f + m[D + k + j]) + m[k + j]);
            *(half4*)(P.hx + (size_t)R * D + k) = h;
        }
    }
}
DEV void ph_final2(PRef P, int bid, int nblk) {
    const int tid_ = ltid(); const int lane = tid_ & 63, wv = tid_ >> 6;
    for (int r = bid * NW + wv; r < NLAT; r += nblk * NW) {
        GAS float* xr = P.out + (size_t)r * D; floatx4 v[4]; float ss = 0.f;
#pragma unroll
        for (int i = 0; i < 4; ++i) { v[i] = *(const floatx4*)(xr + i * 256 + lane * 4); ss += v[i][0] * v[i][0] + v[i][1] * v[i][1] + v[i][2] * v[i][2] + v[i][3] * v[i][3]; }
        ss = wave_sum(ss);
        const float rs = 1.f / sqrtf(ss * (1.f / D) + 1e-6f);
#pragma unroll
        for (int i = 0; i < 4; ++i) {
            const floatx4 g = *(const floatx4*)(P.final_g + i * 256 + lane * 4); floatx4 o;
#pragma unroll
            for (int j = 0; j < 4; ++j) o[j] = v[i][j] * rs * g[j];
            *(floatx4*)(xr + i * 256 + lane * 4) = o;
        }
    }
}

constexpr int G_LDA = 72;
constexpr int G_STAGE = (256 + 128) * G_LDA;
constexpr int GEMM_LDS_BYTES = 2 * G_STAGE * 2;
template <int MODE>
DEV void gemm_epi_tile(PRef P, int l, const floatx16 acc, int R0, int n0, int lane) {
#pragma unroll
    for (int r = 0; r < 16; ++r) {
        const int R = R0 + (r & 3) + 8 * (r >> 2) + 4 * (lane >> 5), n = n0 + (lane & 31);
        if (MODE == 1) P.p[(size_t)R * INW + n] = (f16)acc[r];
        else if (MODE == 2) {
            const int j = row_mod(R); const float g = P.mods[(l * 3 + j) * 3072 + 2 * D + n];
            const float xo = xrow(P, l, R)[n];
            GAS float* dst = R < NCTX ? P.ctx1 + (size_t)R * D + n : P.out + (size_t)(R - NCTX) * D + n;
            *dst = xo + g * acc[r];
        } else {
            const float yv = (float)P.yg[(size_t)R * 256 + n]; const float gt = (float)P.p[(size_t)R * INW + 1920 + n];
            P.p[(size_t)R * INW + 1920 + n] = (f16)(yv * fsigmoid(acc[r] + P.s5_glu_b[l * 256 + n]) * fsilu(gt));
        }
    }
}
template <int MODE>
DEV void ph_gemm_mfma(PRef P, int l, int bid, int nblk, unsigned char* smraw) {
    constexpr int N = MODE == 1 ? INW : (MODE == 2 ? D : 256), K = MODE == 3 ? 256 : D;
    const GAS f16* Bt = MODE == 1 ? P.wt_in + (size_t)l * INW * D : (MODE == 2 ? P.wt_out + (size_t)l * D * D : P.glut + (size_t)l * 256 * 256);
    const int tm0 = (MODE != 1 && l == 1) ? NCTX / 256 : 0;
    const int ntm = NROWS / 256 - tm0, ntn = N / 128;
    const int tid = ltid(), lane = tid & 63, wv = tid >> 6, wm = wv & 3, wn = wv >> 2;
    f16* sbase = (f16*)smraw;
    const int ldrow = tid >> 3, ldch = tid & 7;
    constexpr int GM = 8;
    for (int t = bid; t < ntm * ntn; t += nblk) {
        int sg = t / (GM * ntn), rem = t % (GM * ntn);
        int gsz = ntm - sg * GM < GM ? ntm - sg * GM : GM;
        const int tm = tm0 + sg * GM + rem % gsz, tn = rem / gsz;
        floatx16 acc00, acc01, acc10, acc11;
#pragma unroll
        for (int r = 0; r < 16; ++r) { acc00[r] = 0.f; acc01[r] = 0.f; acc10[r] = 0.f; acc11[r] = 0.f; }
        uintx4 pa0, pa1, pa2, pa3, pb0, pb1, qa0, qa1, qa2, qa3, qb0, qb1;
        const GAS f16* arow = MODE == 1 ? P.hx + (size_t)(tm * 256 + ldrow) * D + ldch * 8 : (MODE == 2 ? P.p + (size_t)(tm * 256 + ldrow) * INW + ldch * 8 : P.yg + (size_t)(tm * 256 + ldrow) * 256 + ldch * 8);
        const size_t astr = (size_t)64 * (MODE == 1 ? D : (MODE == 2 ? INW : 256));
        const GAS f16* brow = Bt + (size_t)(tn * 128 + ldrow) * K + ldch * 8;
#define GLOAD(S, kt_) { const int ka = MODE == 2 ? a2col((kt_) * 64) : (kt_) * 64; const int kb = (kt_) * 64; \
            S##a0 = *(const uintx4*)(arow + ka); S##a1 = *(const uintx4*)(arow + astr + ka); S##a2 = *(const uintx4*)(arow + 2 * astr + ka); S##a3 = *(const uintx4*)(arow + 3 * astr + ka); \
            S##b0 = *(const uintx4*)(brow + kb); S##b1 = *(const uintx4*)(brow + (size_t)64 * K + kb); }
#define SWRITE(S, st_) { f16* sA_ = sbase + (st_) * G_STAGE + ldrow * G_LDA + ldch * 8; f16* sB_ = sbase + (st_) * G_STAGE + 256 * G_LDA + ldrow * G_LDA + ldch * 8; \
            *(uintx4*)(sA_) = S##a0; *(uintx4*)(sA_ + 64 * G_LDA) = S##a1; *(uintx4*)(sA_ + 128 * G_LDA) = S##a2; *(uintx4*)(sA_ + 192 * G_LDA) = S##a3; \
            *(uintx4*)(sB_) = S##b0; *(uintx4*)(sB_ + 64 * G_LDA) = S##b1; }
#define GCOMPUTE(st_) { const f16* sA = sbase + (st_) * G_STAGE + (wm * 64 + (lane & 31)) * G_LDA + (lane >> 5) * 8; \
            const f16* sB = sbase + (st_) * G_STAGE + 256 * G_LDA + (wn * 64 + (lane & 31)) * G_LDA + (lane >> 5) * 8; \
            half8 fa0[4], fa1[4], fb0[4], fb1[4]; \
            _Pragma("unroll") for (int ks = 0; ks < 4; ++ks) { \
                fa0[ks] = *(const half8*)(sA + ks * 16); fa1[ks] = *(const half8*)(sA + 32 * G_LDA + ks * 16); \
                fb0[ks] = *(const half8*)(sB + ks * 16); fb1[ks] = *(const half8*)(sB + 32 * G_LDA + ks * 16); } \
            _Pragma("unroll") for (int ks = 0; ks < 4; ++ks) { \
                acc00 = __builtin_amdgcn_mfma_f32_32x32x16_f16(fb0[ks], fa0[ks], acc00, 0, 0, 0); \
                acc01 = __builtin_amdgcn_mfma_f32_32x32x16_f16(fb1[ks], fa0[ks], acc01, 0, 0, 0); \
                acc10 = __builtin_amdgcn_mfma_f32_32x32x16_f16(fb0[ks], fa1[ks], acc10, 0, 0, 0); \
                acc11 = __builtin_amdgcn_mfma_f32_32x32x16_f16(fb1[ks], fa1[ks], acc11, 0, 0, 0); } }
        constexpr int NK = K / 64;
        BAR_LDS();
        GLOAD(p, 0); SWRITE(p, 0); GLOAD(q, 1);
        BAR_LDS();
        for (int kt = 0; kt < NK; kt += 2) {
            if (kt + 2 < NK) GLOAD(p, kt + 2);
            GCOMPUTE(0);
            SWRITE(q, 1);
            BAR_LDS();
            if (kt + 3 < NK) GLOAD(q, kt + 3);
            GCOMPUTE(1);
            if (kt + 2 < NK) SWRITE(p, 0);
            BAR_LDS();
        }
#undef GLOAD
#undef SWRITE
#undef GCOMPUTE
        if (MODE != 2) {
            f16* Cs = (f16*)smraw;
#define CSTORE(acc_, mi_, ni_) { const int m_ = wm * 64 + (mi_) * 32 + (lane & 31); \
                _Pragma("unroll") for (int g = 0; g < 4; ++g) { half4 h_; h_[0] = (f16)acc_[4 * g]; h_[1] = (f16)acc_[4 * g + 1]; h_[2] = (f16)acc_[4 * g + 2]; h_[3] = (f16)acc_[4 * g + 3]; \
                    *(half4*)(Cs + m_ * 136 + wn * 64 + (ni_) * 32 + 8 * g + 4 * (lane >> 5)) = h_; } }
            CSTORE(acc00, 0, 0); CSTORE(acc01, 0, 1); CSTORE(acc10, 1, 0); CSTORE(acc11, 1, 1);
#undef CSTORE
            BAR_LDS();
#pragma unroll 2
            for (int i = 0; i < 8; ++i) {
                const int row = (tid >> 4) + 32 * i, ch = tid & 15; const int R = tm * 256 + row, n = tn * 128 + ch * 8;
                const half8 v = *(const half8*)(Cs + row * 136 + ch * 8);
                if (MODE == 1) *(GAS half8*)(P.p + (size_t)R * INW + n) = v;
                else {
                    const half8 yv = *(const GAS half8*)(P.yg + (size_t)R * 256 + n); const half8 gt = *(const GAS half8*)(P.p + (size_t)R * INW + 1920 + n);
                    const floatx4 b0 = *(const GAS floatx4*)(P.s5_glu_b + l * 256 + n), b1 = *(const GAS floatx4*)(P.s5_glu_b + l * 256 + n + 4);
                    half8 o;
#pragma unroll
                    for (int e = 0; e < 8; ++e) o[e] = (f16)((float)yv[e] * fsigmoid((float)v[e] + (e < 4 ? b0[e] : b1[e - 4])) * fsilu((float)gt[e]));
                    *(GAS half8*)(P.p + (size_t)R * INW + 1920 + n) = o;
                }
            }
        } else {
            float* Cs = (float*)smraw;
#pragma unroll 1
            for (int hm = 0; hm < 2; ++hm) {
                if ((wm >> 1) == hm) {
#define CSTORE(acc_, mi_, ni_) { const int m_ = (wm & 1) * 64 + (mi_) * 32 + (lane & 31); \
                    _Pragma("unroll") for (int g = 0; g < 4; ++g) { floatx4 f_; f_[0] = acc_[4 * g]; f_[1] = acc_[4 * g + 1]; f_[2] = acc_[4 * g + 2]; f_[3] = acc_[4 * g + 3]; \
                        *(floatx4*)(Cs + m_ * 132 + wn * 64 + (ni_) * 32 + 8 * g + 4 * (lane >> 5)) = f_; } }
                    CSTORE(acc00, 0, 0); CSTORE(acc01, 0, 1); CSTORE(acc10, 1, 0); CSTORE(acc11, 1, 1);
#undef CSTORE
                }
                BAR_LDS();
#pragma unroll 2
                for (int i = 0; i < 8; ++i) {
                    const int row = (tid >> 5) + 16 * i, ch = tid & 31; const int R = tm * 256 + hm * 128 + row, n = tn * 128 + ch * 4;
                    const floatx4 a4 = *(const floatx4*)(Cs + row * 132 + ch * 4);
                    const floatx4 g4 = *(const GAS floatx4*)(P.mods + (l * 3 + row_mod(R)) * 3072 + 2 * D + n);
                    const floatx4 x4 = *(const GAS floatx4*)(xrow(P, l, R) + n);
                    GAS float* dst = R < NCTX ? P.ctx1 + (size_t)R * D + n : P.out + (size_t)(R - NCTX) * D + n;
                    floatx4 o;
#pragma unroll
                    for (int e = 0; e < 4; ++e) o[e] = x4[e] + g4[e] * a4[e];
                    *(GAS floatx4*)dst = o;
                }
                BAR_LDS();
            }
        }
    }
}

constexpr int RLD = 72;
constexpr int RSLOT = 64 * RLD;
constexpr int RWP1_LDS_BYTES = 11 * RSLOT * 2 + 2 * 64 * 65 * 4 + 1536 * 4 + 128 * 4;
constexpr size_t RWM_STRIDE = (size_t)24 * NCHUNK * 4096;

DEV bf16x8 ldfrag(const bf16* M, int rowbase, int lane, int ks) {
    return *(const bf16x8*)(M + (rowbase + (lane & 31)) * RLD + ks * 16 + (lane >> 5) * 8);
}
DEV floatx16 mm64(const bf16* A, const bf16* Bt, int wm, int wn, int lane) {
    floatx16 acc;
#pragma unroll
    for (int r = 0; r < 16; ++r) acc[r] = 0.f;
#pragma unroll
    for (int ks = 0; ks < 4; ++ks) acc = __builtin_amdgcn_mfma_f32_32x32x16_bf16(ldfrag(A, wm * 32, lane, ks), ldfrag(Bt, wn * 32, lane, ks), acc, 0, 0, 0);
    return acc;
}
DEV void storeT(bf16* dst, const floatx16 c, int wm, int wn, int lane) {
    const int n = wn * 32 + (lane & 31);
#pragma unroll
    for (int g = 0; g < 4; ++g) {
        const int m0 = wm * 32 + 8 * g + 4 * (lane >> 5);
        bf16x4 v; v[0] = (bf16)c[4 * g]; v[1] = (bf16)c[4 * g + 1]; v[2] = (bf16)c[4 * g + 2]; v[3] = (bf16)c[4 * g + 3];
        *(bf16x4*)(dst + n * RLD + m0) = v;
    }
}

DEV void ph_rw_p1(PRef P, int l, int bid, int nblk, unsigned char* smraw) {
    bf16* sl = (bf16*)smraw;
    bf16 *Am = sl, *AmT = sl + RSLOT, *Bp = sl + 2 * RSLOT, *Kp = sl + 3 * RSLOT, *Rt = sl + 4 * RSLOT, *VT = sl + 5 * RSLOT,
         *BendT = sl + 6 * RSLOT, *KendT = sl + 7 * RSLOT, *Nak = sl + 8 * RSLOT, *Mrb = sl + 9 * RSLOT, *Mrk = sl + 10 * RSLOT;
    bf16 *Tb = Am, *UtT = AmT, *WmT = Bp, *NVT = Kp;
    float* Nf = (float*)(smraw + 11 * RSLOT * 2); float* Tf = Nf + 64 * 65; float* Wb = Tf + 64 * 65; float* gl = Wb + 1536;
    float* av = Nf; float* lwb = Tf;
    f16* Sr = (f16*)Nak; f16* Sk = (f16*)Mrb; f16* Sv = (f16*)Mrk; bf16* lt = KendT;
    float* part = Wb;
    const int tid = ltid(), lane = tid & 63, wv = tid >> 6, q4 = wv & 3, wm = q4 & 1, wn = q4 >> 1, hs = wv >> 2;
    GAS f16* PTg = P.rwm; GAS f16* RPg = PTg + RWM_STRIDE; GAS f16* Qg = RPg + RWM_STRIDE;
    for (int item = bid; item < 24 * NCHUNK; item += nblk) {
        const int chain = item / NCHUNK, ck = item % NCHUNK;
        const int z = chain / 12, b = (chain / 6) % 2, h = chain % 6, s0 = ck * 64;
        const int j = lane, tq = wv, c = h * 64 + j;
#pragma unroll 1
        for (int i = 0; i < 4; ++i) {
            const int task = tid + NT * i, c8 = task & 7, t = (task >> 3) & 63, q = task >> 9;
            const int col0 = q < 3 ? q * 384 + h * 64 + c8 * 8 : (c8 < 4 ? 1152 + z * 32 + c8 * 8 : 1216 + z * 32 + (c8 - 4) * 8);
            const int R = scan_row(z, b, s0 + t);
            const GAS f16* pr = P.p + (size_t)R * INW + col0;
            const half8 own = *(const half8*)pr;
            half8 n0, n1, n2, n3;
#pragma unroll
            for (int e = 0; e < 8; ++e) { n0[e] = (f16)0.f; n1[e] = (f16)0.f; n2[e] = (f16)0.f; n3[e] = (f16)0.f; }
            if (R < NCTX) {
                const int tt = R % CTX;
                if (tt > 0) n0 = *(const half8*)(pr - INW);
                if (tt < CTX - 1) n1 = *(const half8*)(pr + INW);
                n2 = n0; n3 = n1;
            } else {
                const int tt = (R - NCTX) % SEQ, col = tt & 63;
                if (col > 0) n0 = *(const half8*)(pr - INW);
                if (col < 63) n1 = *(const half8*)(pr + INW);
                if (tt >= 64) n2 = *(const half8*)(pr - 64 * INW);
                if (tt < SEQ - 64) n3 = *(const half8*)(pr + 64 * INW);
            }
            const floatx4 mu0 = *(const floatx4*)(P.rw_mu + l * 1280 + col0), mu1 = *(const floatx4*)(P.rw_mu + l * 1280 + col0 + 4);
            float s[8];
#pragma unroll
            for (int e = 0; e < 8; ++e) {
                const float pv = (float)own[e];
                const float nv = (float)((e & 3) == 0 ? n0[e] : (e & 3) == 1 ? n1[e] : (e & 3) == 2 ? n2[e] : n3[e]);
                s[e] = pv + (nv - pv) * (e < 4 ? mu0[e] : mu1[e - 4]);
            }
            if (q < 3) {
                half8 o;
#pragma unroll
                for (int e = 0; e < 8; ++e) o[e] = (f16)s[e];
                *(half8*)((q == 0 ? Sr : q == 1 ? Sk : Sv) + t * RLD + c8 * 8) = o;
            } else {
                bf16x8 o;
#pragma unroll
                for (int e = 0; e < 8; ++e) o[e] = (bf16)(c8 < 4 ? ftanh(s[e]) : s[e]);
                *(bf16x8*)(lt + t * RLD + c8 * 8) = o;
            }
        }
        BAR_LDS();
        {
            const GAS bf16* tab = P.rwlt + ((size_t)((l * 2 + z) * 2 + hs) * 384 + h * 64 + wn * 32 + (lane & 31)) * 32 + (lane >> 5) * 8;
            floatx16 aw;
#pragma unroll
            for (int r = 0; r < 16; ++r) aw[r] = 0.f;
#pragma unroll
            for (int ks = 0; ks < 2; ++ks) aw = __builtin_amdgcn_mfma_f32_32x32x16_bf16(ldfrag(lt + hs * 32, wm * 32, lane, ks), *(const bf16x8*)(tab + ks * 16), aw, 0, 0, 0);
            const int cc = h * 64 + wn * 32 + (lane & 31);
            const float bias = hs ? P.rw_a0[(l * 2 + z) * 384 + cc] : P.rw_w0[(l * 2 + z) * 384 + cc];
#pragma unroll
            for (int r = 0; r < 16; ++r) {
                const int m = wm * 32 + (r & 3) + 8 * (r >> 2) + 4 * (lane >> 5), n = wn * 32 + (lane & 31);
                const float sg = fsigmoid(aw[r] + bias);
                if (hs) av[m * 65 + n] = sg; else lwb[m * 65 + n] = -0.6065306597126334f * sg;
            }
        }
        BAR_LDS();
        float gpre, gtot;
        {
            float run = 0.f, gv[8];
#pragma unroll
            for (int tt = 0; tt < 8; ++tt) { run += lwb[(tq * 8 + tt) * 65 + j]; gv[tt] = run; }
            part[tq * 64 + j] = run;
            const int t = lane, q8 = wv;
            float ss = 0.f, bn = 0.f;
#pragma unroll
            for (int e = 0; e < 8; ++e) {
                const int jj = q8 * 8 + e, c2 = h * 64 + jj;
                const float k_ = (float)Sk[t * RLD + jj], r_ = (float)Sr[t * RLD + jj], a = av[t * 65 + jj];
                const float kku = k_ * P.rw_k_k[l * 384 + c2];
                ss += kku * kku; bn += r_ * k_ * (1.f + (a - 1.f) * P.rw_k_a[l * 384 + c2]) * P.rw_r_k[l * 384 + c2];
            }
            part[512 + q8 * 64 + t] = ss; part[1024 + q8 * 64 + t] = bn;
            BAR_LDS();
            gpre = 0.f; gtot = 0.f;
#pragma unroll
            for (int q = 0; q < 8; ++q) { const float x = part[q * 64 + j]; gtot += x; if (q < tq) gpre += x; }
#pragma unroll
            for (int tt = 0; tt < 8; ++tt) lwb[(tq * 8 + tt) * 65 + j] = gv[tt] + gpre;
            if (tq == 0) {
                gl[j] = __expf(gtot);
                float sst = 0.f, bnt = 0.f;
#pragma unroll
                for (int q = 0; q < 8; ++q) { sst += part[512 + q * 64 + lane]; bnt += part[1024 + q * 64 + lane]; }
                gl[64 + lane] = __builtin_amdgcn_rsqf(sst + 1e-6f);
                P.bon[((size_t)z * NROWS + scan_row(z, b, s0 + lane)) * 6 + h] = bnt;
            }
        }
        BAR_LDS();
        {
            const float kkc = P.rw_k_k[l * 384 + c], kac = P.rw_k_a[l * 384 + c];
            const float Gt = __expf(gtot);
            float e_prev = __expf(gpre);
            bf16x8 amT, vT, beT, keT;
#pragma unroll
            for (int tt = 0; tt < 8; ++tt) {
                const int t = tq * 8 + tt;
                const float r_ = (float)Sr[t * RLD + j], k_ = (float)Sk[t * RLD + j], v_ = (float)Sv[t * RLD + j];
                const float a = av[t * 65 + j], g = lwb[t * 65 + j], sinv = gl[64 + t];
                const float e_t = __expf(g), e_p = frcp(e_t), e_m = e_prev, e_e = Gt * e_p;
                e_prev = e_t;
                const float kkn = k_ * kkc * sinv, kd = k_ * (1.f + (a - 1.f) * kac), bb = a * kkn;
                const bf16 am = (bf16)(kkn * e_m);
                Am[t * RLD + j] = am; Bp[t * RLD + j] = (bf16)(bb * e_p); Kp[t * RLD + j] = (bf16)(kd * e_p); Rt[t * RLD + j] = (bf16)(r_ * e_t);
                amT[tt] = am; vT[tt] = (bf16)v_; beT[tt] = (bf16)(bb * e_e); keT[tt] = (bf16)(kd * e_e);
            }
            BAR_LDS();
            const int to = j * RLD + tq * 8;
            *(bf16x8*)(AmT + to) = amT; *(bf16x8*)(VT + to) = vT; *(bf16x8*)(BendT + to) = beT; *(bf16x8*)(KendT + to) = keT;
        }
        BAR_LDS();
        {
            floatx16 c1, c2;
#pragma unroll
            for (int r = 0; r < 16; ++r) { c1[r] = 0.f; c2[r] = 0.f; }
            if (!(wm == 0 && wn == 1)) {
                const bf16* Aop = hs ? Rt : Am;
#pragma unroll
                for (int ks = 0; ks < 4; ++ks) {
                    const bf16x8 a1 = ldfrag(Aop, wm * 32, lane, ks), b1 = ldfrag(Bp, wn * 32, lane, ks), b2 = ldfrag(Kp, wn * 32, lane, ks);
                    c1 = __builtin_amdgcn_mfma_f32_32x32x16_bf16(a1, b1, c1, 0, 0, 0);
                    c2 = __builtin_amdgcn_mfma_f32_32x32x16_bf16(a1, b2, c2, 0, 0, 0);
                }
            }
#pragma unroll
            for (int r = 0; r < 16; ++r) {
                const int m = wm * 32 + (r & 3) + 8 * (r >> 2) + 4 * (lane >> 5), n = wn * 32 + (lane & 31);
                if (hs == 0) { Nf[m * 65 + n] = n < m ? c1[r] : 0.f; Nak[m * RLD + n] = (bf16)(n < m ? c2[r] : 0.f); }
                else { Mrb[m * RLD + n] = (bf16)(n <= m ? c1[r] : 0.f); Mrk[m * RLD + n] = (bf16)(n <= m ? c2[r] : 0.f); }
            }
        }
        BAR_LDS();
        if (tid < 64) {
            const int i = tid >> 4, jc = tid & 15; float x[16];
#pragma unroll
            for (int row = 0; row < 16; ++row) {
                float s = row == jc ? 1.f : 0.f;
#pragma unroll
                for (int m = 0; m < row; ++m) s -= Nf[(16 * i + row) * 65 + 16 * i + m] * x[m];
                x[row] = s;
            }
#pragma unroll
            for (int row = 0; row < 16; ++row) Tf[(16 * i + row) * 65 + 16 * i + jc] = x[row];
        }
        BAR_LDS();
        {
            const int a = (tid >> 4) & 15, cc = tid & 15;
#pragma unroll
            for (int i = 1; i < 4; ++i) {
                if (tid < 256) {
#pragma unroll
                    for (int jb = 0; jb < i; ++jb) {
                        float s = 0.f;
#pragma unroll
                        for (int mb = jb; mb < i; ++mb)
#pragma unroll
                            for (int m = 0; m < 16; ++m) s += Nf[(16 * i + a) * 65 + 16 * mb + m] * Tf[(16 * mb + m) * 65 + 16 * jb + cc];
                        Wb[jb * 256 + a * 16 + cc] = s;
                        __builtin_amdgcn_sched_barrier(0);
                    }
                }
                BAR_LDS();
                if (tid < 256) {
#pragma unroll
                    for (int jb = 0; jb < i; ++jb) {
                        float s = 0.f;
#pragma unroll
                        for (int m = 0; m < 16; ++m) s += Tf[(16 * i + a) * 65 + 16 * i + m] * Wb[jb * 256 + m * 16 + cc];
                        Tf[(16 * i + a) * 65 + 16 * jb + cc] = -s;
                    }
                }
                BAR_LDS();
            }
        }
        for (int idx = tid; idx < 4096; idx += NT) { const int t = idx >> 6, s = idx & 63; Tb[t * RLD + s] = (bf16)(((s >> 4) <= (t >> 4)) ? Tf[t * 65 + s] : 0.f); }
        BAR_LDS();
        if (hs == 0) { const floatx16 c1 = mm64(Tb, AmT, wm, wn, lane); storeT(WmT, c1, wm, wn, lane); }
        else { const floatx16 c2 = mm64(Nak, VT, wm, wn, lane); storeT(NVT, c2, wm, wn, lane); }
        BAR_LDS();
        if (hs == 0) { const floatx16 c1 = mm64(Tb, NVT, wm, wn, lane); storeT(UtT, c1, wm, wn, lane); }
        BAR_LDS();
        {
            f16* T0 = (f16*)Am; f16* T1 = (f16*)Kp; f16* T2 = (f16*)Nak; f16* T3 = (f16*)Nf;
            const int n = wn * 32 + (lane & 31);
            if (hs == 0) {
                {
                    const floatx16 c1 = mm64(WmT, Mrb, wm, wn, lane);
#pragma unroll
                    for (int g = 0; g < 4; ++g) {
                        const int m0 = wm * 32 + 8 * g + 4 * (lane >> 5);
                        const bf16x4 rt = *(const bf16x4*)(Rt + n * RLD + m0);
                        half4 v; v[0] = (f16)((float)rt[0] - c1[4 * g]); v[1] = (f16)((float)rt[1] - c1[4 * g + 1]); v[2] = (f16)((float)rt[2] - c1[4 * g + 2]); v[3] = (f16)((float)rt[3] - c1[4 * g + 3]);
                        *(half4*)(T0 + n * RLD + m0) = v;
                    }
                }
                __builtin_amdgcn_sched_barrier(0);
                {
                    const floatx16 c2 = mm64(VT, Mrk, wm, wn, lane); __builtin_amdgcn_sched_barrier(0); const floatx16 c3 = mm64(UtT, Mrb, wm, wn, lane);
#pragma unroll
                    for (int g = 0; g < 4; ++g) {
                        const int m0 = wm * 32 + 8 * g + 4 * (lane >> 5);
                        half4 v; v[0] = (f16)(c2[4 * g] - c3[4 * g]); v[1] = (f16)(c2[4 * g + 1] - c3[4 * g + 1]); v[2] = (f16)(c2[4 * g + 2] - c3[4 * g + 2]); v[3] = (f16)(c2[4 * g + 3] - c3[4 * g + 3]);
                        *(half4*)(T1 + n * RLD + m0) = v;
                    }
                }
            } else {
                {
                    const floatx16 c4 = mm64(WmT, BendT, wm, wn, lane);
                    const float gd = gl[n];
#pragma unroll
                    for (int g = 0; g < 4; ++g) {
                        const int m0 = wm * 32 + 8 * g + 4 * (lane >> 5);
                        half4 v;
#pragma unroll
                        for (int e = 0; e < 4; ++e) v[e] = (f16)((m0 + e == n ? gd : 0.f) - c4[4 * g + e]);
                        *(half4*)(T2 + n * RLD + m0) = v;
                    }
                }
                __builtin_amdgcn_sched_barrier(0);
                {
                    const floatx16 c5 = mm64(KendT, VT, wm, wn, lane); __builtin_amdgcn_sched_barrier(0); const floatx16 c6 = mm64(BendT, UtT, wm, wn, lane);
#pragma unroll
                    for (int g = 0; g < 4; ++g) {
                        const int m0 = wm * 32 + 8 * g + 4 * (lane >> 5);
                        half4 v; v[0] = (f16)(c5[4 * g] - c6[4 * g]); v[1] = (f16)(c5[4 * g + 1] - c6[4 * g + 1]); v[2] = (f16)(c5[4 * g + 2] - c6[4 * g + 2]); v[3] = (f16)(c5[4 * g + 3] - c6[4 * g + 3]);
                        *(half4*)(T3 + n * RLD + m0) = v;
                    }
                }
            }
            BAR_LDS();
            {
                const size_t gb = (size_t)item * 4096;
                const int row = tid >> 3, ch = tid & 7;
                const half8 v0 = *(const half8*)(T0 + row * RLD + ch * 8), v1 = *(const half8*)(T1 + row * RLD + ch * 8);
                const half8 v2 = *(const half8*)(T2 + row * RLD + ch * 8), v3 = *(const half8*)(T3 + row * RLD + ch * 8);
                *(GAS half8*)(RPg + gb + row * 64 + ch * 8) = v0;
                *(GAS half8*)(P.Yh + ((size_t)z * NROWS + scan_row(z, b, s0 + row)) * 384 + h * 64 + ch * 8) = v1;
                *(GAS half8*)(PTg + gb + row * 64 + ch * 8) = v2;
                *(GAS half8*)(Qg + gb + row * 64 + ch * 8) = v3;
            }
        }
        BAR_LDS();
    }
}

DEV void ph_rw_stream(PRef P, int l, int bid, int nblk, unsigned char* smraw, bool dry = false) {
    const int tid = ltid(), lane = tid & 63, wv = tid >> 6, w4 = wv & 3, role = wv >> 2;
    f16* S16 = (f16*)smraw;
    const GAS f16* PTg = P.rwm; const GAS f16* RPg = PTg + RWM_STRIDE; const GAS f16* Qg = RPg + RWM_STRIDE;
    for (int item = bid; item < 96; item += nblk) {
        const int chain = item >> 2, vs = item & 3;
        const int z = chain / 12, b = (chain / 6) % 2, h = chain % 6;
        __syncthreads();
        for (int idx = tid; idx < 2 * 16 * 72; idx += NT) S16[idx] = (f16)0.f;
        __syncthreads();
        const size_t cb = (size_t)chain * NCHUNK * 4096;
        const int rowA = 16 * w4 + (lane & 15), kof = 8 * (lane >> 4);
        const int qoff = (vs * 16 + (lane & 15)) * 64 + 16 * w4 + (lane >> 4) * 4;
        const GAS f16* Ag = role ? RPg : PTg;
        GAS f16* ycol = P.Yh + ((size_t)(2 + z) * NROWS) * 384 + h * 64 + vs * 16 + (lane & 15);
        const int trow = 16 * w4 + (lane >> 4) * 4;
        const int rstep = z ? -384 : 384;
        half8 a0[8], a1[8]; half4 qv[8];
#define RW_LOAD(slot_, ck_) { const size_t gb_ = cb + (size_t)(ck_) * 4096; \
            a0[slot_] = *(const GAS half8*)(Ag + gb_ + rowA * 64 + kof); a1[slot_] = *(const GAS half8*)(Ag + gb_ + rowA * 64 + 32 + kof); \
            if (role == 0) qv[slot_] = *(const GAS half4*)(Qg + gb_ + qoff); }
#define RW_STEP(slot_, ck_) { const f16* Sc_ = S16 + ((ck_) & 1) * 16 * 72; f16* Sn_ = S16 + (((ck_) + 1) & 1) * 16 * 72; \
            const half8 b0_ = *(const half8*)(Sc_ + (lane & 15) * 72 + kof); const half8 b1_ = *(const half8*)(Sc_ + (lane & 15) * 72 + 32 + kof); \
            floatx4 acc_ = {0.f, 0.f, 0.f, 0.f}; \
            if (role == 0) { acc_[0] = (float)qv[slot_][0]; acc_[1] = (float)qv[slot_][1]; acc_[2] = (float)qv[slot_][2]; acc_[3] = (float)qv[slot_][3]; } \
            acc_ = __builtin_amdgcn_mfma_f32_16x16x32_f16(a0[slot_], b0_, acc_, 0, 0, 0); acc_ = __builtin_amdgcn_mfma_f32_16x16x32_f16(a1[slot_], b1_, acc_, 0, 0, 0); \
            half4 sn_; sn_[0] = (f16)acc_[0]; sn_[1] = (f16)acc_[1]; sn_[2] = (f16)acc_[2]; sn_[3] = (f16)acc_[3]; \
            if (role == 0) *(half4*)(Sn_ + (lane & 15) * 72 + trow) = sn_; \
            else if (!dry) { GAS f16* yp_ = ycol + (size_t)scan_row(z, b, (ck_) * 64 + trow) * 384; \
                _Pragma("unroll") for (int r_ = 0; r_ < 4; ++r_) yp_[r_ * rstep] = sn_[r_]; } \
            BAR_LDS(); }
        RW_LOAD(0, 0); RW_LOAD(1, 1); RW_LOAD(2, 2); RW_LOAD(3, 3); RW_LOAD(4, 4); RW_LOAD(5, 5); RW_LOAD(6, 6);
        for (int ck = 0; ck < NCHUNK; ck += 8) {
            RW_LOAD(7, ck + 7 < NCHUNK ? ck + 7 : NCHUNK - 1); RW_STEP(0, ck);
            RW_LOAD(0, ck + 8 < NCHUNK ? ck + 8 : NCHUNK - 1); RW_STEP(1, ck + 1);
            RW_LOAD(1, ck + 9 < NCHUNK ? ck + 9 : NCHUNK - 1); RW_STEP(2, ck + 2);
            RW_LOAD(2, ck + 10 < NCHUNK ? ck + 10 : NCHUNK - 1); RW_STEP(3, ck + 3);
            if (ck + 4 < NCHUNK) {
                RW_LOAD(3, ck + 11 < NCHUNK ? ck + 11 : NCHUNK - 1); RW_STEP(4, ck + 4);
                RW_LOAD(4, ck + 12 < NCHUNK ? ck + 12 : NCHUNK - 1); RW_STEP(5, ck + 5);
                RW_LOAD(5, ck + 13 < NCHUNK ? ck + 13 : NCHUNK - 1); RW_STEP(6, ck + 6);
                RW_LOAD(6, ck + 14 < NCHUNK ? ck + 14 : NCHUNK - 1); RW_STEP(7, ck + 7);
            }
        }
#undef RW_LOAD
#undef RW_STEP
    }
}
DEV void ph_rwkv_fin2(PRef P, int l, int bid, int nblk, bool dry = false) {
    const int tid_ = ltid(); const int lane = tid_ & 63, wv = tid_ >> 6;
    for (int R = (l == 1 ? NCTX : 0) + bid * NW + wv; R < NROWS; R += nblk * NW) {
#pragma unroll
        for (int h = 0; h < 6; ++h) {
            const int c = h * 64 + lane;
            const float y = ((float)P.Yh[(size_t)R * 384 + c] + (float)P.Yh[((size_t)NROWS + R) * 384 + c]) + ((float)P.Yh[((size_t)2 * NROWS + R) * 384 + c] + (float)P.Yh[((size_t)3 * NROWS + R) * 384 + c]);
            const float mu = wave_sum(y) * (1.f / 64.f); const float d = y - mu;
            const float var = wave_sum(d * d) * (1.f / 64.f);
            const float rs = __builtin_amdgcn_rsqf(var + 64e-5f);
            const float bonus = P.bon[(size_t)R * 6 + h] + P.bon[((size_t)NROWS + R) * 6 + h];
            const float o = d * rs * P.rw_ln_g[l * 384 + c] + P.rw_ln_b[l * 384 + c] + bonus * shl(P, l, R, 768 + c);
            const float g = (float)P.p[(size_t)R * INW + 1280 + c];
            if (!dry) P.p[(size_t)R * INW + 1280 + c] = (f16)(o * fsilu(g)); else P.rwm[(size_t)R * 384 + c] = (f16)(o * fsilu(g));
        }
    }
}

constexpr int HLD = 136;
constexpr int S5_LDS_BYTES = NW * 64 * HLD * 2;
DEV void s5_wave_scan(PRef P, int l, int z, int b, int g, int tc, float& hre, float& him, f16* hb, int lane, bool store) {
    const int lzg = (l * 2 + z) * 16 + g;
    half8 au[2];
#pragma unroll
    for (int mt = 0; mt < 2; ++mt) {
        const int R = scan_row(0, b, tc * 64 + 32 * mt + (lane & 31));
        au[mt] = *(const half8*)(P.p + (size_t)R * INW + 1664 + g * 16 + (lane >> 5) * 8);
    }
#pragma unroll
    for (int nt = 0; nt < 4; ++nt) {
        const half8 bb = *(const half8*)(P.s5bb + ((size_t)lzg * 128 + 32 * nt + (lane & 31)) * 16 + (lane >> 5) * 8);
#pragma unroll
        for (int mt = 0; mt < 2; ++mt) {
            floatx16 acc;
#pragma unroll
            for (int r = 0; r < 16; ++r) acc[r] = 0.f;
            acc = __builtin_amdgcn_mfma_f32_32x32x16_f16(au[mt], bb, acc, 0, 0, 0);
#pragma unroll
            for (int r = 0; r < 16; ++r) hb[(32 * mt + (r & 3) + 8 * (r >> 2) + 4 * (lane >> 5)) * HLD + 32 * nt + (lane & 31)] = (f16)acc[r];
        }
    }
    const GAS float* tb = P.s5par + (size_t)lzg * S5PW * 64 + lane;
    const float abr = tb[0], abi = tb[64];
#pragma unroll 4
    for (int s = 0; s < 64; ++s) {
        const int tt = z ? 63 - s : s;
        const float bur = (float)hb[tt * HLD + lane], bui = (float)hb[tt * HLD + 64 + lane];
        const float nr = abr * hre - abi * him + bur, ni = abr * him + abi * hre + bui;
        hre = nr; him = ni;
        if (store) { hb[tt * HLD + lane] = (f16)hre; hb[tt * HLD + 64 + lane] = (f16)him; }
    }
}
DEV void ph_s5_a(PRef P, int l, int bid, int nblk, unsigned char* smraw) {
    const int tid_ = ltid(); const int lane = tid_ & 63, wv = tid_ >> 6;
    f16* hb = (f16*)smraw + wv * 64 * HLD;
    for (int item = bid * NW + wv; item < 2 * 2 * 16 * NCHUNK; item += nblk * NW) {
        const int tc = item % NCHUNK, zbg = item / NCHUNK, g = zbg & 15, b = (zbg >> 4) & 1, z = zbg >> 5;
        float hre = 0.f, him = 0.f;
        s5_wave_scan(P, l, z, b, g, tc, hre, him, hb, lane, false);
        const int ck = z ? mirror_chunk(tc) : tc;
        GAS float* ho = P.s5h + ((size_t)zbg * NCHUNK + ck) * 128;
        ho[lane] = hre; ho[64 + lane] = him;
    }
}
DEV void ph_s5_b(PRef P, int l, int bid, int nblk) {
    for (int idx = bid * NT + ltid(); idx < 2 * 2 * 16 * 64; idx += nblk * NT) {
        const int n = idx & 63, zbg = idx >> 6, g = zbg & 15, z = zbg >> 5;
        const GAS float* tb = P.s5par + (size_t)((l * 2 + z) * 16 + g) * S5PW * 64 + n;
        const float a64r = tb[34 * 64], a64i = tb[35 * 64];
        float hr = 0.f, hi = 0.f;
        GAS float* hp = P.s5h + (size_t)zbg * NCHUNK * 128 + n;
        for (int c0 = 0; c0 < NCHUNK; c0 += 20) {
            float lr[20], li[20];
#pragma unroll
            for (int i = 0; i < 20; ++i) { lr[i] = hp[(c0 + i) * 128]; li[i] = hp[(c0 + i) * 128 + 64]; }
#pragma unroll
            for (int i = 0; i < 20; ++i) {
                hp[(c0 + i) * 128] = hr; hp[(c0 + i) * 128 + 64] = hi;
                const float nr = a64r * hr - a64i * hi + lr[i], ni = a64r * hi + a64i * hr + li[i];
                hr = nr; hi = ni;
            }
        }
    }
}
DEV void ph_s5_c(PRef P, int l, int bid, int nblk, unsigned char* smraw) {
    const int tid = ltid(), lane = tid & 63, wv = tid >> 6, ci = wv >> 1, z = wv & 1;
    f16* base = (f16*)smraw;
    for (int it = bid; it < 2 * 16 * (NCHUNK / 4); it += nblk) {
        const int grp = it % (NCHUNK / 4), bg = it / (NCHUNK / 4), g = bg & 15, b = bg >> 4;
        if (l == 1 && grp == 0) continue;
        BAR_LDS();
        const int tc = grp * 4 + ci;
        {
            const int ck = z ? mirror_chunk(tc) : tc;
            const GAS float* hi_ = P.s5h + ((size_t)((z * 2 + b) * 16 + g) * NCHUNK + ck) * 128;
            float hre = hi_[lane], him = hi_[64 + lane];
            s5_wave_scan(P, l, z, b, g, tc, hre, him, base + wv * 64 * HLD, lane, true);
        }
        BAR_LDS();
        {
            half8 bf[2][4];
#pragma unroll
            for (int z2 = 0; z2 < 2; ++z2)
#pragma unroll
                for (int ks = 0; ks < 4; ++ks) bf[z2][ks] = *(const half8*)(P.s5cc + ((size_t)((l * 2 + z2) * 16 + g) * 16 + (lane & 15)) * 128 + 32 * ks + 8 * (lane >> 4));
            const int pch = g * 16 + (lane & 15);
            const float dsk = P.s5_d[l * 256 + pch];
#pragma unroll
            for (int mi = 0; mi < 2; ++mi) {
                const int mt = 2 * z + mi;
                floatx4 acc = {0.f, 0.f, 0.f, 0.f};
#pragma unroll
                for (int z2 = 0; z2 < 2; ++z2) {
                    const f16* hbz = base + (2 * ci + z2) * 64 * HLD;
#pragma unroll
                    for (int ks = 0; ks < 4; ++ks) {
                        const half8 a = *(const half8*)(hbz + (16 * mt + (lane & 15)) * HLD + 32 * ks + 8 * (lane >> 4));
                        acc = __builtin_amdgcn_mfma_f32_16x16x32_f16(a, bf[z2][ks], acc, 0, 0, 0);
                    }
                }
#pragma unroll
                for (int r = 0; r < 4; ++r) {
                    const int tt = 16 * mt + (lane >> 4) * 4 + r; const int R = scan_row(0, b, tc * 64 + tt);
                    const float u = (float)P.p[(size_t)R * INW + 1664 + pch];
                    const float y = acc[r] + dsk * u;
                    P.yg[(size_t)R * 256 + pch] = (f16)(0.5f * y * (1.f + ftanh(0.7978845608028654f * (y + 0.044715f * y * y * y))));
                }
            }
        }
    }
}

constexpr int NSC = TSCAN / 256;
constexpr int QLD = 104, SLD = 72;
constexpr int MLE = 97 * 96;
template <int KSTEPS>
DEV floatx16 mmh(const f16* A, int lda, int arow0, const f16* Bt, int ldb, int brow0, int lane, floatx16 acc) {
#pragma unroll
    for (int ks = 0; ks < KSTEPS; ++ks) {
        const half8 a = *(const half8*)(A + (arow0 + (lane & 31)) * lda + ks * 16 + (lane >> 5) * 8);
        const half8 b = *(const half8*)(Bt + (brow0 + (lane & 31)) * ldb + ks * 16 + (lane >> 5) * 8);
        acc = __builtin_amdgcn_mfma_f32_32x32x16_f16(a, b, acc, 0, 0, 0);
    }
    return acc;
}
DEV void ph_ml_a(PRef P, int l, int bid, int nblk, float* sm) {
    const int tid_ = ltid(); const int lane = tid_ & 63, wv = tid_ >> 6;
    float* gin = sm + 1152 * 20 + wv * 1152;
    __syncthreads();
    for (int idx = tid_; idx < 1152 * 16; idx += NT) {
        const int c = idx >> 4, o = idx & 15, z = o >> 3, hh = (o >> 1) & 3, which = o & 1;
        sm[c * 20 + o] = (which ? P.ml_wf : P.ml_wi)[((size_t)(l * 2 + z) * 1152 + c) * 4 + hh];
    }
    __syncthreads();
    const int lc = lane < 48 ? lane : 0;
    float cvb[8], cv0[8], cv1[8], cv2[8], bq[2][16], bk[2][16], bv[2][16];
#pragma unroll
    for (int i = 0; i < 8; ++i) { const int c = lc * 8 + i; cvb[i] = P.ml_conv_b[l * 384 + c]; cv0[i] = P.ml_conv_w[(l * 3 + 0) * 384 + c]; cv1[i] = P.ml_conv_w[(l * 3 + 1) * 384 + c]; cv2[i] = P.ml_conv_w[(l * 3 + 2) * 384 + c]; }
#pragma unroll
    for (int blk = 0; blk < 2; ++blk)
#pragma unroll
        for (int e = 0; e < 16; ++e) { const int wi = (l * 96 + lc * 2 + blk) * 16 + e; bq[blk][e] = P.ml_wq[wi]; bk[blk][e] = P.ml_wk[wi]; bv[blk][e] = P.ml_wv[wi]; }
    for (int R = bid * NW + wv; R < NROWS; R += nblk * NW) {
        if (lane < 48) {
            const int c0 = lane * 8;
            int t, len; if (R < NCTX) { t = R % CTX; len = CTX; } else { t = (R - NCTX) % SEQ; len = SEQ; }
            const half8 x0 = *(const half8*)(P.p + (size_t)R * INW + 2176 + c0);
            half8 xm_, xp_;
#pragma unroll
            for (int i = 0; i < 8; ++i) { xm_[i] = (f16)0.f; xp_[i] = (f16)0.f; }
            if (t > 0) xm_ = *(const half8*)(P.p + (size_t)(R - 1) * INW + 2176 + c0);
            if (t < len - 1) xp_ = *(const half8*)(P.p + (size_t)(R + 1) * INW + 2176 + c0);
            half8 hq, hk, hv;
#pragma unroll
            for (int blk = 0; blk < 2; ++blk) {
                float xc[4], xm[4];
#pragma unroll
                for (int i = 0; i < 4; ++i) {
                    xm[i] = (float)x0[4 * blk + i];
                    const float a = cvb[4 * blk + i] + cv1[4 * blk + i] * xm[i] + cv0[4 * blk + i] * (float)xm_[4 * blk + i] + cv2[4 * blk + i] * (float)xp_[4 * blk + i];
                    xc[i] = fsilu(a);
                }
#pragma unroll
                for (int i = 0; i < 4; ++i) {
                    float qq = 0.f, kk = 0.f, vv = 0.f;
#pragma unroll
                    for (int jj = 0; jj < 4; ++jj) {
                        qq += xc[jj] * bq[blk][jj * 4 + i]; kk += xc[jj] * bk[blk][jj * 4 + i]; vv += xm[jj] * bv[blk][jj * 4 + i];
                    }
                    const int c = c0 + 4 * blk + i;
                    gin[c] = qq; gin[384 + c] = kk; gin[768 + c] = vv;
                    hq[4 * blk + i] = (f16)qq; hk[4 * blk + i] = (f16)(kk * 0.10206207261596577f); hv[4 * blk + i] = (f16)vv;
                }
            }
            GAS f16* o = P.qkv16 + (size_t)R * 1152 + c0;
            *(half8*)o = hq; *(half8*)(o + 384) = hk; *(half8*)(o + 768) = hv;
        }
        float acc[16];
#pragma unroll
        for (int o = 0; o < 16; ++o) acc[o] = 0.f;
#pragma unroll 3
        for (int i = 0; i < 18; ++i) {
            const int c = lane + 64 * i;
            const float gval = gin[c];
            const float* wr = sm + c * 20;
            const floatx4 w0 = *(const floatx4*)wr, w1 = *(const floatx4*)(wr + 4), w2 = *(const floatx4*)(wr + 8), w3 = *(const floatx4*)(wr + 12);
#pragma unroll
            for (int o2 = 0; o2 < 4; ++o2) { acc[o2] += gval * w0[o2]; acc[4 + o2] += gval * w1[o2]; acc[8 + o2] += gval * w2[o2]; acc[12 + o2] += gval * w3[o2]; }
        }
        float mine = 0.f;
#pragma unroll
        for (int o = 0; o < 16; ++o) { const float s = wave_sum(acc[o]); if (lane == o) mine = s; }
        if (lane < 16) {
            const int z = lane >> 3, hh = (lane >> 1) & 3, which = lane & 1;
            const float val = mine + (which ? P.ml_bf : P.ml_bi)[(l * 2 + z) * 4 + hh];
            P.gates[(size_t)R * 16 + lane] = which ? log_sigmoidf_(val) : val;
        }
    }
}
DEV void ml_load_T(PRef P, int z, int b, int hh, int s0, const float* wgt, f16* VT, f16* KeT, int tid) {
#pragma unroll
    for (int i = 0; i < 3; ++i) {
        const int e = tid + NT * i, which = e / 768, rem = e % 768, c8 = rem >> 6, t = rem & 63;
        const int R = scan_row(z, b, s0 + t);
        const half8 x = *(const half8*)(P.qkv16 + (size_t)R * 1152 + (which ? 384 : 768) + hh * 96 + c8 * 8);
        if (which == 0) {
#pragma unroll
            for (int j = 0; j < 8; ++j) VT[(c8 * 8 + j) * SLD + t] = x[j];
        } else {
            const float w = wgt[t];
#pragma unroll
            for (int j = 0; j < 8; ++j) KeT[(c8 * 8 + j) * SLD + t] = (f16)((float)x[j] * w);
        }
    }
}
constexpr int ML_VT_OFF = 0, ML_KE_OFF = 128 * SLD, ML_QS_OFF = ML_KE_OFF + 96 * SLD, ML_KS_OFF = ML_QS_OFF + 64 * QLD, ML_C16_OFF = ML_KS_OFF + 64 * QLD,
              ML_AM_OFF = ML_C16_OFF + 128 * QLD, ML_F_OFF_BYTES = (ML_AM_OFF + 64 * SLD) * 2;
constexpr int ML_LDS_BYTES = ML_F_OFF_BYTES + 320 * 4;
DEV void ph_ml_1(PRef P, int l, int bid, int nblk, unsigned char* smraw) {
    f16* VT = (f16*)smraw + ML_VT_OFF; f16* KeT = (f16*)smraw + ML_KE_OFF; float* fb = (float*)(smraw + ML_F_OFF_BYTES);
    const int tid = ltid(), lane = tid & 63, wv = tid >> 6;
    for (int item = bid; item < 16 * NSC; item += nblk) {
        const int chain = item / NSC, sc = item % NSC, z = chain / 8, b = (chain / 4) % 2, hh = chain % 4;
        BAR_LDS();
        for (int idx = tid; idx < 32 * SLD; idx += NT) VT[96 * SLD + idx] = (f16)((idx < SLD) ? 1.f : 0.f);
        float x = 0.f, li = 0.f;
        if (tid < 256) {
            const int R = scan_row(z, b, sc * 256 + tid);
            li = P.gates[(size_t)R * 16 + z * 8 + hh * 2]; x = P.gates[(size_t)R * 16 + z * 8 + hh * 2 + 1];
#pragma unroll
            for (int o = 1; o < 64; o <<= 1) { const float y = __shfl_up(x, o); if (lane >= o) x += y; }
            if (lane == 63) fb[256 + wv] = x;
        }
        BAR_LDS();
        if (tid < 256) {
            float off = 0.f, tot = 0.f;
#pragma unroll
            for (int w = 0; w < 4; ++w) { const float q = fb[256 + w]; tot += q; if (w < wv) off += q; }
            fb[tid] = __expf(li + tot - (x + off));
            if (tid == 0) P.mlG[item] = __expf(tot);
        }
        floatx16 c0, c1, c2;
#pragma unroll
        for (int r = 0; r < 16; ++r) { c0[r] = 0.f; c1[r] = 0.f; c2[r] = 0.f; }
#pragma unroll 1
        for (int cc = 0; cc < 4; ++cc) {
            BAR_LDS();
            ml_load_T(P, z, b, hh, sc * 256 + cc * 64, fb + cc * 64, VT, KeT, tid);
            BAR_LDS();
            if (wv < 4) {
                c0 = mmh<4>(VT, SLD, 32 * wv, KeT, SLD, 0, lane, c0);
                c1 = mmh<4>(VT, SLD, 32 * wv, KeT, SLD, 32, lane, c1);
                c2 = mmh<4>(VT, SLD, 32 * wv, KeT, SLD, 64, lane, c2);
            }
        }
        if (wv < 4) {
            GAS float* dst = P.mlC + (size_t)item * MLE;
#pragma unroll
            for (int r = 0; r < 16; ++r) {
                const int v = 32 * wv + (r & 3) + 8 * (r >> 2) + 4 * (lane >> 5), k = lane & 31;
                if (v <= 96) { dst[v * 96 + k] = c0[r]; dst[v * 96 + 32 + k] = c1[r]; dst[v * 96 + 64 + k] = c2[r]; }
            }
        }
    }
}
DEV void ph_ml_2(PRef P, int bid, int nblk) {
    for (int idx = bid * NT + ltid(); idx < 16 * MLE; idx += nblk * NT) {
        const int chain = idx / MLE, e = idx % MLE; float run = 0.f;
        for (int s0 = 0; s0 < NSC; s0 += 13) {
            float loc[13], gg[13];
#pragma unroll
            for (int i = 0; i < 13; ++i) { loc[i] = P.mlC[((size_t)chain * NSC + s0 + i) * MLE + e]; gg[i] = P.mlG[chain * NSC + s0 + i]; }
#pragma unroll
            for (int i = 0; i < 13; ++i) { P.mlC[((size_t)chain * NSC + s0 + i) * MLE + e] = run; run = gg[i] * run + loc[i]; }
        }
    }
}
DEV void ph_ml_3(PRef P, int l, int bid, int nblk, unsigned char* smraw) {
    f16* sh = (f16*)smraw;
    f16 *VT = sh + ML_VT_OFF, *KeT = sh + ML_KE_OFF, *Qs = sh + ML_QS_OFF, *Ks = sh + ML_KS_OFF, *C16 = sh + ML_C16_OFF, *Am = sh + ML_AM_OFF;
    float* fb = (float*)(smraw + ML_F_OFF_BYTES);
    const int tid = ltid(), lane = tid & 63, wv = tid >> 6, w4 = wv & 3, wm = w4 & 1, wn = w4 >> 1;
    for (int item = bid; item < 16 * NSC; item += nblk) {
        const int chain = item / NSC, sc = item % NSC, z = chain / 8, b = (chain / 4) % 2, hh = chain % 4;
        if (l == 1 && sc == 0) continue;
        BAR_LDS();
        for (int idx = tid; idx < 32 * SLD; idx += NT) VT[96 * SLD + idx] = (f16)((idx < SLD) ? 1.f : 0.f);
        floatx16 c0, c1, c2;
#pragma unroll
        for (int r = 0; r < 16; ++r) { c0[r] = 0.f; c1[r] = 0.f; c2[r] = 0.f; }
        if (wv < 4) {
            const GAS float* srcC = P.mlC + (size_t)item * MLE;
#pragma unroll
            for (int r = 0; r < 16; ++r) {
                const int v = 32 * wv + (r & 3) + 8 * (r >> 2) + 4 * (lane >> 5), k = lane & 31;
                const bool ok = v <= 96;
                c0[r] = ok ? srcC[v * 96 + k] : 0.f; c1[r] = ok ? srcC[v * 96 + 32 + k] : 0.f; c2[r] = ok ? srcC[v * 96 + 64 + k] : 0.f;
            }
        }
#pragma unroll 1
        for (int cc = 0; cc < 4; ++cc) {
            const int s0 = sc * 256 + cc * 64;
            BAR_LDS();
            if (wv == 7) {
                const int R = scan_row(z, b, s0 + lane);
                const float li = P.gates[(size_t)R * 16 + z * 8 + hh * 2], lf = P.gates[(size_t)R * 16 + z * 8 + hh * 2 + 1];
                float F = lf;
#pragma unroll
                for (int o = 1; o < 64; o <<= 1) { const float y = __shfl_up(F, o); if (lane >= o) F += y; }
                const float FL = __shfl(F, 63);
                fb[lane] = __expf(F); fb[64 + lane] = __expf(fminf(li - F, 10.f)); fb[128 + lane] = __expf(li + FL - F);
                if (lane == 63) fb[192] = __expf(FL);
            }
            if (wv < 4) {
#pragma unroll
                for (int r = 0; r < 16; ++r) {
                    const int v = 32 * wv + (r & 3) + 8 * (r >> 2) + 4 * (lane >> 5), k = lane & 31;
                    C16[v * QLD + k] = (f16)c0[r]; C16[v * QLD + 32 + k] = (f16)c1[r]; C16[v * QLD + 64 + k] = (f16)c2[r];
                }
            }
            BAR_LDS();
#pragma unroll
            for (int i = 0; i < 3; ++i) {
                const int e = tid + NT * i, which = e / 768, rem = e % 768, t = rem / 12, c8 = rem % 12;
                const int R = scan_row(z, b, s0 + t);
                const half8 x = *(const half8*)(P.qkv16 + (size_t)R * 1152 + (which ? 384 : 0) + hh * 96 + c8 * 8);
                const float w = which ? fb[64 + t] : fb[t];
                half8 y;
#pragma unroll
                for (int jj = 0; jj < 8; ++jj) y[jj] = (f16)((float)x[jj] * w);
                *(half8*)((which ? Ks : Qs) + t * QLD + c8 * 8) = y;
            }
            ml_load_T(P, z, b, hh, s0, fb + 128, VT, KeT, tid);
            BAR_LDS();
            if (wv >= 4) {
#pragma unroll
                for (int r = 0; r < 16; ++r) c2[r] = 0.f;
                if (!(wm == 0 && wn == 1)) c2 = mmh<6>(Qs, QLD, wm * 32, Ks, QLD, wn * 32, lane, c2);
#pragma unroll
                for (int r = 0; r < 16; ++r) {
                    const int m = wm * 32 + (r & 3) + 8 * (r >> 2) + 4 * (lane >> 5), n = wn * 32 + (lane & 31);
                    Am[m * SLD + n] = (f16)(n <= m ? c2[r] : 0.f);
                }
            } else {
                const float gL = fb[192];
#pragma unroll
                for (int r = 0; r < 16; ++r) { c0[r] *= gL; c1[r] *= gL; c2[r] *= gL; }
                c0 = mmh<4>(VT, SLD, 32 * wv, KeT, SLD, 0, lane, c0); __builtin_amdgcn_sched_barrier(0);
                c1 = mmh<4>(VT, SLD, 32 * wv, KeT, SLD, 32, lane, c1); __builtin_amdgcn_sched_barrier(0);
                c2 = mmh<4>(VT, SLD, 32 * wv, KeT, SLD, 64, lane, c2);
            }
            BAR_LDS();
            if (wv >= 4) {
#pragma unroll
                for (int r = 0; r < 16; ++r) { c0[r] = 0.f; c1[r] = 0.f; }
                c0 = mmh<4>(Am, SLD, 0, VT, SLD, 32 * w4, lane, c0); __builtin_amdgcn_sched_barrier(0); c0 = mmh<6>(Qs, QLD, 0, C16, QLD, 32 * w4, lane, c0); __builtin_amdgcn_sched_barrier(0);
                c1 = mmh<4>(Am, SLD, 32, VT, SLD, 32 * w4, lane, c1); __builtin_amdgcn_sched_barrier(0); c1 = mmh<6>(Qs, QLD, 32, C16, QLD, 32 * w4, lane, c1); __builtin_amdgcn_sched_barrier(0);
                if (wv == 7 && (lane & 31) == 0) {
#pragma unroll
                    for (int r = 0; r < 16; ++r) { const int t = (r & 3) + 8 * (r >> 2) + 4 * (lane >> 5); fb[256 + t] = c0[r]; fb[256 + 32 + t] = c1[r]; }
                }
            }
            BAR_LDS();
            if (wv >= 4 && wv < 7) {
#pragma unroll
                for (int r = 0; r < 16; ++r) {
                    const int t = (r & 3) + 8 * (r >> 2) + 4 * (lane >> 5);
                    const int R0 = scan_row(z, b, s0 + t), R1 = scan_row(z, b, s0 + 32 + t);
                    const float d0 = fmaxf(fabsf(fb[256 + t]), 1.f), d1 = fmaxf(fabsf(fb[256 + 32 + t]), 1.f);
                    P.Yh[((size_t)z * NROWS + R0) * 384 + hh * 96 + 32 * w4 + (lane & 31)] = (f16)(c0[r] * frcp(d0));
                    P.Yh[((size_t)z * NROWS + R1) * 384 + hh * 96 + 32 * w4 + (lane & 31)] = (f16)(c1[r] * frcp(d1));
                    if ((r & 3) == 3) __builtin_amdgcn_sched_barrier(0);
                }
            }
        }
    }
}
DEV void ph_ml_fin2(PRef P, int l, int bid, int nblk, bool dry = false) {
    const int tid_ = ltid(); const int lane = tid_ & 63, wv = tid_ >> 6;
    for (int R = (l == 1 ? NCTX : 0) + bid * NW + wv; R < NROWS; R += nblk * NW) {
        float y[6]; float s = 0.f;
#pragma unroll
        for (int i = 0; i < 6; ++i) { const int c = lane * 6 + i; y[i] = (float)P.Yh[(size_t)R * 384 + c] + (float)P.Yh[((size_t)NROWS + R) * 384 + c]; s += y[i]; }
        s = row16_sum(s);
        const float mu = s * (1.f / 96.f); float q = 0.f;
#pragma unroll
        for (int i = 0; i < 6; ++i) { y[i] -= mu; q += y[i] * y[i]; }
        q = row16_sum(q);
        const float rs = __builtin_amdgcn_rsqf(q * (1.f / 96.f) + 1e-6f);
#pragma unroll
        for (int i = 0; i < 6; ++i) {
            const int c = lane * 6 + i;
            const float hv = y[i] * rs * P.ml_norm_g[l * 384 + c] + P.ml_skip[l * 384 + c] * ml_xc(P, l, R, c);
            const float zg = (float)P.p[(size_t)R * INW + 2560 + c];
            if (!dry) P.p[(size_t)R * INW + 2560 + c] = (f16)(hv * fsilu(zg)); else P.rwm[(size_t)R * 384 + c] = (f16)(hv * fsilu(zg));
        }
    }
}


#define XB_TMO      128
#define XB_XCNT(j)  (256  + 64 * (j))
#define XB_XSUB(j)  (1280 + 64 * (j))
#define XB_XGEN(j)  (2304 + 64 * (j))
#define XB_TOP      3328
#define XB_TOPGEN   3392
#define XCD_BAR_WORDS 3456
#define XB_SPIN_CAP (1u << 22)
#define LAS __attribute__((address_space(3)))
DEV unsigned xb_ld(GAS unsigned* p)              { return __hip_atomic_load(p, __ATOMIC_RELAXED, __HIP_MEMORY_SCOPE_AGENT); }
DEV unsigned xb_add(GAS unsigned* p, unsigned v) { return __hip_atomic_fetch_add(p, v, __ATOMIC_RELAXED, __HIP_MEMORY_SCOPE_AGENT); }
DEV unsigned xb_xcc_id() { return (unsigned)__builtin_amdgcn_s_getreg((3 << 11) | 20) & 0xFu; }
#define XB_SPIN(cond, bar) do { unsigned _sp = 0; while (cond) { __builtin_amdgcn_s_sleep(1); \
    if ((++_sp & 255u) == 0u) { if (xb_ld(&(bar)[XB_TMO])) break; if (_sp > XB_SPIN_CAP) { (void)xb_add(&(bar)[XB_TMO], 1u); break; } } } } while (0)
struct XcdBarrier { GAS unsigned* bar; unsigned x; volatile LAS unsigned* st; };
DEV XcdBarrier xcd_barrier_post(GAS unsigned* bar, volatile LAS unsigned* st) {
    XcdBarrier b; b.bar = bar; b.x = xb_xcc_id(); b.st = st;
    if (threadIdx.x == 0) (void)xb_add(&bar[XB_XCNT(b.x)], 1u);
    return b;
}
DEV void xcd_barrier_complete(GAS unsigned* bar, unsigned x, unsigned& nloc, unsigned& nx) {
    const unsigned G = gridDim.x * gridDim.y * gridDim.z;
    unsigned sum, cnt, mine, sp = 0u;
    for (;;) {
        sum = 0u; cnt = 0u; mine = 0u;
#pragma unroll
        for (unsigned j = 0; j < 16; ++j) { const unsigned c = xb_ld(&bar[XB_XCNT(j)]); sum += c; cnt += (c > 0u) ? 1u : 0u; mine = (j == x) ? c : mine; }
        if (sum == G) break;
        __builtin_amdgcn_s_sleep(1);
        if ((++sp & 255u) == 0u) { if (xb_ld(&bar[XB_TMO])) break; if (sp > XB_SPIN_CAP) { (void)xb_add(&bar[XB_TMO], 1u); break; } }
    }
    nloc = mine > 0u ? mine : 1u; nx = cnt > 0u ? cnt : 1u;
}
DEV void xcd_barrier(const XcdBarrier& b, GAS unsigned* bar_) {
    asm volatile("s_waitcnt vmcnt(0)" ::: "memory");
    __syncthreads();
    if (threadIdx.x == 0) {
        GAS unsigned* bar = bar_;
        __builtin_amdgcn_s_waitcnt(0);
        unsigned nloc = b.st[0], nx = b.st[1];
        if (nloc == 0u) { xcd_barrier_complete(bar, b.x, nloc, nx); b.st[0] = nloc; b.st[1] = nx; }
        const unsigned old = xb_add(&bar[XB_XSUB(b.x)], 1u);
        const unsigned gen = old / nloc;
        if (old + 1u == (gen + 1u) * nloc) {
            __builtin_amdgcn_fence(__ATOMIC_RELEASE, "agent");
            asm volatile("s_waitcnt vmcnt(0)" ::: "memory");
            const unsigned og = xb_add(&bar[XB_TOP], 1u);
            const unsigned tg = og / nx;
            if (og + 1u == (tg + 1u) * nx) xb_add(&bar[XB_TOPGEN], 1u);
            else XB_SPIN(xb_ld(&bar[XB_TOPGEN]) == tg, bar);
            __builtin_amdgcn_fence(__ATOMIC_ACQUIRE, "agent");
            xb_add(&bar[XB_XGEN(b.x)], 1u);
            asm volatile("s_waitcnt vmcnt(0)" ::: "memory");
        } else {
            XB_SPIN(xb_ld(&bar[XB_XGEN(b.x)]) == gen, bar);
            __builtin_amdgcn_fence(__ATOMIC_ACQUIRE, "agent");
            asm volatile("s_waitcnt vmcnt(0)" ::: "memory");
        }
    }
    __syncthreads();
}

constexpr size_t al256(size_t x) { return (x + 255) & ~(size_t)255; }
constexpr size_t WS_MODS = 0;
constexpr size_t WS_P = al256(WS_MODS + 2 * 3 * 3072 * 4);
constexpr size_t WS_Y = al256(WS_P + (size_t)NROWS * INW * 2);
constexpr size_t WS_Q = al256(WS_Y + (size_t)2 * NROWS * 384 * 4);
constexpr size_t WS_Q_BYTES = (size_t)NROWS * 1152 * 4;
constexpr size_t WS_GATES = al256(WS_Q + WS_Q_BYTES);
constexpr size_t WS_BON = al256(WS_GATES + (size_t)NROWS * 16 * 4);
constexpr size_t WS_YG = al256(WS_BON + (size_t)2 * NROWS * 6 * 4);
constexpr size_t WS_S5H = al256(WS_YG + (size_t)NROWS * 256 * 2);
constexpr size_t WS_S5PAR = al256(WS_S5H + (size_t)64 * NCHUNK * 128 * 4);
constexpr size_t WS_S5BB = al256(WS_S5PAR + (size_t)64 * S5PW * 64 * 4);
constexpr size_t WS_S5CC = al256(WS_S5BB + (size_t)64 * 128 * 16 * 2);
constexpr size_t WS_GLUT = al256(WS_S5CC + (size_t)64 * 16 * 128 * 2);
constexpr size_t WS_CTX1 = al256(WS_GLUT + (size_t)2 * 256 * 256 * 2);
constexpr size_t WS_WTIN = al256(WS_CTX1 + (size_t)NCTX * D * 4);
constexpr size_t WS_WTOUT = al256(WS_WTIN + (size_t)2 * INW * D * 2);
constexpr size_t WS_RWLT = al256(WS_WTOUT + (size_t)2 * D * D * 2);
constexpr size_t WS_GP = al256(WS_RWLT + (size_t)2 * 2 * 2 * 384 * 32 * 2);
constexpr size_t WS_XBAR = al256(WS_GP + 1024);
constexpr size_t WS_END = al256(WS_XBAR + XCD_BAR_WORDS * 4);
static_assert(3 * RWM_STRIDE * 2 <= WS_Q_BYTES, "rwkv chunk matrices");
static_assert(al256((size_t)NROWS * 1152 * 2) + al256((size_t)16 * NSC * MLE * 4) + 16 * NSC * 4 <= WS_Q_BYTES, "ml region");

static void fill_params(Params& P, void* const* d_in, void* d_out, void* d_ws) {
    const GAS float** pp = (const GAS float**)&P;
    for (int i = 0; i < 41; ++i) pp[i] = (const GAS float*)d_in[i];
    unsigned char* ws = (unsigned char*)d_ws;
    P.out = (GAS float*)d_out;
    P.mods = (GAS float*)(ws + WS_MODS); P.p = (GAS f16*)(ws + WS_P); P.Yh = (GAS f16*)(ws + WS_Y);
    P.gates = (GAS float*)(ws + WS_GATES); P.bon = (GAS float*)(ws + WS_BON); P.ctx1 = (GAS float*)(ws + WS_CTX1);
    P.hx = (GAS f16*)(ws + WS_Q); P.rwm = (GAS f16*)(ws + WS_Q); P.qkv16 = (GAS f16*)(ws + WS_Q);
    P.mlC = (GAS float*)(ws + WS_Q + al256((size_t)NROWS * 1152 * 2)); P.mlG = (GAS float*)(ws + WS_Q + al256((size_t)NROWS * 1152 * 2) + al256((size_t)16 * NSC * MLE * 4));
    P.wt_in = (GAS f16*)(ws + WS_WTIN); P.wt_out = (GAS f16*)(ws + WS_WTOUT); P.glut = (GAS f16*)(ws + WS_GLUT);
    P.yg = (GAS f16*)(ws + WS_YG); P.s5h = (GAS float*)(ws + WS_S5H); P.s5par = (GAS float*)(ws + WS_S5PAR); P.s5bb = (GAS f16*)(ws + WS_S5BB); P.s5cc = (GAS f16*)(ws + WS_S5CC);
    P.rwlt = (GAS bf16*)(ws + WS_RWLT); P.gp = (GAS Params*)(ws + WS_GP); P.xbar = (GAS unsigned*)(ws + WS_XBAR);
}

constexpr int cmax(int a, int b) { return a > b ? a : b; }
constexpr int MEGA_LDS_BYTES = cmax(cmax(RWP1_LDS_BYTES, S5_LDS_BYTES), cmax(cmax(GEMM_LDS_BYTES, ML_LDS_BYTES), (1152 * 20 + NW * 1152) * 4));

__global__ void __launch_bounds__(NT) mega_fwd(Params Pk) {
    __shared__ __attribute__((aligned(16))) unsigned char smraw[MEGA_LDS_BYTES + 16];
    float* sm = (float*)smraw;
    cg::grid_group grid = cg::this_grid();
    const int bid = blockIdx.x, nblk = gridDim.x;
    if (threadIdx.x == 0) {
        GAS unsigned long long* dstw = (GAS unsigned long long*)Pk.gp; const unsigned long long* srcw = (const unsigned long long*)&Pk;
#pragma unroll
        for (int i = 0; i < (int)(sizeof(Params) / 8); ++i) dstw[i] = srcw[i];
        *(uintx4*)(smraw + MEGA_LDS_BYTES) = (uintx4){0u, 0u, 0u, 0u};
    }
    asm volatile("s_waitcnt vmcnt(0)" ::: "memory");
    __syncthreads();
    const XcdBarrier xb = xcd_barrier_post(Pk.xbar, (volatile LAS unsigned*)(smraw + MEGA_LDS_BYTES));
    const GAS Params* pg = Pk.gp;
    asm volatile("" : "+s"(pg) :: "memory");
    PRef P = *pg;
    ph_mods2(P, lsgpr(bid), nblk, sm);
    ph_wprep(P, lsgpr(bid), nblk, sm);
    ph_tables(P, lsgpr(bid), nblk);
    grid.sync();
    for (int l = 0; l < 2; ++l) {
        for (int rep = 0; rep < REP_HX; ++rep) ph_hx(P, l, lsgpr(bid), nblk);
        xcd_barrier(xb, P.xbar);
        for (int rep = 0; rep < REP_G1; ++rep) ph_gemm_mfma<1>(P, l, lsgpr(bid), nblk, smraw);
        for (int rep = 0; rep < REP_SYNC; ++rep) xcd_barrier(xb, P.xbar);
        for (int rep = 0; rep < REP_P1; ++rep) ph_rw_p1(P, l, lsgpr(bid), nblk, smraw);
        for (int rep = 0; rep < REP_S5A; ++rep) ph_s5_a(P, l, lsgpr(bid), nblk, smraw);
        xcd_barrier(xb, P.xbar);
        for (int rep = 0; rep < REP_ST; ++rep) ph_rw_stream(P, l, lsgpr(bid), nblk, smraw, rep + 1 < REP_ST);
        ph_s5_b(P, l, lsgpr(bid), nblk);
        xcd_barrier(xb, P.xbar);
        for (int rep = 0; rep < REP_RWF; ++rep) ph_rwkv_fin2(P, l, lsgpr(bid), nblk, rep + 1 < REP_RWF);
        for (int rep = 0; rep < REP_S5C; ++rep) ph_s5_c(P, l, lsgpr(bid), nblk, smraw);
        xcd_barrier(xb, P.xbar);
        ph_gemm_mfma<3>(P, l, lsgpr(bid), nblk, smraw);
        for (int rep = 0; rep < REP_MLA; ++rep) ph_ml_a(P, l, lsgpr(bid), nblk, sm);
        xcd_barrier(xb, P.xbar);
        for (int rep = 0; rep < REP_ML1; ++rep) ph_ml_1(P, l, lsgpr(bid), nblk, smraw);
        xcd_barrier(xb, P.xbar);
        ph_ml_2(P, lsgpr(bid), nblk);
        xcd_barrier(xb, P.xbar);
        for (int rep = 0; rep < REP_ML3; ++rep) ph_ml_3(P, l, lsgpr(bid), nblk, smraw);
        xcd_barrier(xb, P.xbar);
        for (int rep = 0; rep < REP_MLF; ++rep) ph_ml_fin2(P, l, lsgpr(bid), nblk, rep + 1 < REP_MLF);
        xcd_barrier(xb, P.xbar);
        for (int rep = 0; rep < (l == 0 ? REP_G2 : 1); ++rep) ph_gemm_mfma<2>(P, l, lsgpr(bid), nblk, smraw);
        xcd_barrier(xb, P.xbar);
    }
    ph_final2(P, lsgpr(bid), nblk);
}

extern "C" void kernel_launch(void* const* d_in, const int* in_sizes, int n_in, void* d_out, int out_size, void* d_ws, size_t ws_size, hipStream_t stream) {
    if (ws_size < WS_END) { fprintf(stderr, "workspace too small: %zu < %zu\n", ws_size, (size_t)WS_END); return; }
    static int grid_blocks = 0;
    if (!grid_blocks) {
        int dev = 0, cus = 0, per_cu = 0;
        hipGetDevice(&dev);
        hipDeviceGetAttribute(&cus, hipDeviceAttributeMultiprocessorCount, dev);
        hipOccupancyMaxActiveBlocksPerMultiprocessor(&per_cu, mega_fwd, NT, 0);
        if (per_cu < 1) per_cu = 1;
        grid_blocks = cus * per_cu;
        fprintf(stderr, "mega_fwd: %d CUs x %d blocks/CU\n", cus, per_cu);
    }
    Params P{};
    fill_params(P, d_in, d_out, d_ws);
    hipMemsetAsync((unsigned char*)d_ws + WS_XBAR, 0, XCD_BAR_WORDS * 4, stream);
    void* args[] = {&P};
    hipError_t e = hipLaunchCooperativeKernel((void*)mega_fwd, dim3(grid_blocks), dim3(NT), args, 0, stream);
    if (e != hipSuccess) fprintf(stderr, "cooperative launch failed: %s (grid %d)\n", hipGetErrorString(e), grid_blocks);
}
```

```cpp
#include <hip/hip_runtime.h>
#include <hip/hip_cooperative_groups.h>
#include <cstdint>
#include <cmath>
#include <cstdio>
namespace cg = cooperative_groups;

#ifndef SEQ
#define SEQ 16384
#endif
#ifndef CTX
#define CTX 256
#endif
#ifndef REP_G1
#define REP_G1 1
#endif
#ifndef REP_G2
#define REP_G2 1
#endif
#ifndef REP_P1
#define REP_P1 1
#endif
#ifndef REP_S5A
#define REP_S5A 1
#endif
#ifndef REP_S5C
#define REP_S5C 1
#endif
#ifndef REP_MLA
#define REP_MLA 1
#endif
#ifndef REP_ML1
#define REP_ML1 1
#endif
#ifndef REP_ML3
#define REP_ML3 1
#endif
#ifndef REP_HX
#define REP_HX 1
#endif
#ifndef REP_ST
#define REP_ST 1
#endif
#ifndef REP_RWF
#define REP_RWF 1
#endif
#ifndef REP_MLF
#define REP_MLF 1
#endif
#ifndef REP_G3
#define REP_G3 1
#endif
#ifndef ST_VARIANT
#define ST_VARIANT 0
#endif
#ifndef G_VARIANT
#define G_VARIANT 0
#endif
#ifndef REP_SYNC
#define REP_SYNC 1
#endif

typedef _Float16 f16;
typedef __bf16 bf16;
typedef _Float16 half8 __attribute__((ext_vector_type(8)));
typedef _Float16 half4 __attribute__((ext_vector_type(4)));
typedef __bf16 bf16x8 __attribute__((ext_vector_type(8)));
typedef __bf16 bf16x4 __attribute__((ext_vector_type(4)));
typedef float floatx16 __attribute__((ext_vector_type(16)));
typedef float floatx4 __attribute__((ext_vector_type(4)));
typedef unsigned uintx4 __attribute__((ext_vector_type(4)));

constexpr int D = 1024, NB = 2, INW = 2944;
constexpr int NCTX = NB * CTX, NLAT = NB * SEQ, NROWS = NCTX + NLAT;
constexpr int TSCAN = CTX + SEQ, NCHUNK = TSCAN / 64;
constexpr int NT = 512, NW = NT / 64;
#define DEV __device__ __forceinline__
#define GAS __attribute__((address_space(1)))
#define BAR_LDS() asm volatile("s_waitcnt lgkmcnt(0)\n\ts_barrier" ::: "memory")

DEV int ltid() { int t = threadIdx.x; asm volatile("" : "+v"(t)); return t; }
DEV int lsgpr(int x) { asm volatile("" : "+s"(x)); return x; }

struct Params;
typedef const GAS Params& PRef;
struct Params {
    const GAS float *x, *c, *ctx, *c_ctx, *ada_w, *ada_b, *norm_g, *w_in, *w_out;
    const GAS float *rw_mu, *rw_w0, *rw_w_up, *rw_a0, *rw_a_up, *rw_k_k, *rw_k_a, *rw_r_k, *rw_ln_g, *rw_ln_b;
    const GAS float *s5_a_re, *s5_a_im, *s5_log_dt, *s5_b_re, *s5_b_im, *s5_c_re, *s5_c_im, *s5_d, *s5_glu_w, *s5_glu_b;
    const GAS float *ml_conv_w, *ml_conv_b, *ml_wq, *ml_wk, *ml_wv, *ml_wi, *ml_bi, *ml_wf, *ml_bf, *ml_norm_g, *ml_skip;
    const GAS float* final_g;
    GAS float* out;
    GAS float* mods;
    GAS f16* p;
    GAS f16* Yh;
    GAS float* gates;
    GAS float* bon;
    GAS float* ctx1;
    GAS f16* hx;
    GAS f16* rwm;
    GAS f16* qkv16;
    GAS float* mlC;
    GAS float* mlG;
    GAS f16* wt_in;
    GAS f16* wt_out;
    GAS f16* glut;
    GAS f16* yg;
    GAS float* s5h;
    GAS float* s5par;
    GAS f16* s5bb;
    GAS f16* s5cc;
    GAS bf16* rwlt;
    GAS unsigned* xbar;
    GAS Params* gp;
};

DEV float sigmoidf_(float x) { return 1.f / (1.f + expf(-x)); }
DEV float siluf_(float x) { return x / (1.f + expf(-x)); }
DEV float frcp(float x) { return __builtin_amdgcn_rcpf(x); }
DEV float fsigmoid(float x) { return frcp(1.f + __expf(-x)); }
DEV float fsilu(float x) { return x * frcp(1.f + __expf(-x)); }
DEV float ftanh(float x) { x = fminf(fmaxf(x, -15.f), 15.f); const float e = __expf(2.f * x); return (e - 1.f) * frcp(e + 1.f); }
DEV float log_sigmoidf_(float x) { return fminf(x, 0.f) - log1pf(expf(-fabsf(x))); }
template <int CTRL> DEV float dpp_f(float v) { return __builtin_bit_cast(float, __builtin_amdgcn_update_dpp(0, __builtin_bit_cast(int, v), CTRL, 0xF, 0xF, false)); }
DEV float row16_sum(float v) {
    v += dpp_f<0xB1>(v); v += dpp_f<0x4E>(v); v += dpp_f<0x141>(v); v += dpp_f<0x140>(v);
    return v;
}
DEV float wave_sum(float v) {
    v = row16_sum(v);
    v += __shfl_xor(v, 16); v += __shfl_xor(v, 32);
    return v;
}
DEV int scan_row(int z, int b, int s) {
    if (s < CTX) { int t = z ? CTX - 1 - s : s; return b * CTX + t; }
    int u = s - CTX; int t = z ? SEQ - 1 - u : u; return NCTX + b * SEQ + t;
}
DEV int mirror_chunk(int tc) { return tc < CTX / 64 ? CTX / 64 - 1 - tc : CTX / 64 + (SEQ / 64 - 1) - (tc - CTX / 64); }
DEV int row_mod(int R) { return R < NCTX ? 2 : (R - NCTX) / SEQ; }
DEV const GAS float* xrow(PRef P, int l, int R) {
    const GAS float* xl = l == 0 ? P.x : P.out; const GAS float* xc = l == 0 ? P.ctx : P.ctx1;
    return R < NCTX ? xc + (size_t)R * D : xl + (size_t)(R - NCTX) * D;
}
DEV int nbr_row(int R, int c) {
    if (R < NCTX) { int t = R % CTX; if ((c & 1) == 0) return t > 0 ? R - 1 : -1; return t < CTX - 1 ? R + 1 : -1; }
    int t = (R - NCTX) % SEQ; int m = c & 3, col = t & 63;
    if (m == 0) return col > 0 ? R - 1 : -1;
    if (m == 1) return col < 63 ? R + 1 : -1;
    if (m == 2) return t >= 64 ? R - 64 : -1;
    return t < SEQ - 64 ? R + 64 : -1;
}
DEV float shl(PRef P, int l, int R, int c) {
    float pv = (float)P.p[(size_t)R * INW + c];
    int nb = nbr_row(R, c);
    float nv = nb >= 0 ? (float)P.p[(size_t)nb * INW + c] : 0.f;
    return pv + (nv - pv) * P.rw_mu[l * 1280 + c];
}
DEV int a2col(int k) { return k < 384 ? 1280 + k : (k < 640 ? 1920 + (k - 384) : 2560 + (k - 640)); }
DEV float ml_xm(PRef P, int R, int c) { return (float)P.p[(size_t)R * INW + 2176 + c]; }
DEV float ml_xc(PRef P, int l, int R, int c) {
    int t, len; if (R < NCTX) { t = R % CTX; len = CTX; } else { t = (R - NCTX) % SEQ; len = SEQ; }
    float a = P.ml_conv_b[l * 384 + c] + P.ml_conv_w[(l * 3 + 1) * 384 + c] * ml_xm(P, R, c);
    if (t > 0) a += P.ml_conv_w[(l * 3 + 0) * 384 + c] * ml_xm(P, R - 1, c);
    if (t < len - 1) a += P.ml_conv_w[(l * 3 + 2) * 384 + c] * ml_xm(P, R + 1, c);
    return fsilu(a);
}

DEV void ph_mods2(PRef P, int bid, int nblk, float* sm) {
    const int tid = ltid(), cl = tid & 15, kq = tid >> 4;
    for (int g = bid; g < 2 * 3 * 3072 / 16; g += nblk) {
        const int idx = g * 16 + cl; const int l = idx / 9216, rem = idx % 9216, j = rem / 3072, col = rem % 3072;
        const GAS float* cin = j < 2 ? P.c + j * D : P.c_ctx;
        float acc = 0.f;
        for (int k = kq * 32; k < kq * 32 + 32; ++k) acc += siluf_(cin[k]) * P.ada_w[((size_t)l * D + k) * 3072 + col];
        sm[kq * 16 + cl] = acc;
        __syncthreads();
        if (tid < 16) { float s = P.ada_b[l * 3072 + col]; for (int q = 0; q < 32; ++q) s += sm[q * 16 + tid]; P.mods[idx] = s; }
        __syncthreads();
    }
}
DEV void ph_wprep(PRef P, int bid, int nblk, float* sm) {
    const int tid = ltid();
    constexpr int T_IN = 16 * 46, T_OUT = 16 * 16, T_GLU = 4 * 4;
    for (int t = bid; t < 2 * (T_IN + T_OUT + T_GLU); t += nblk) {
        int l = t / (T_IN + T_OUT + T_GLU), r = t % (T_IN + T_OUT + T_GLU);
        const GAS float* W; GAS f16* Wt; int N, tk, tn, KW = D;
        if (r < T_IN) { W = P.w_in + (size_t)l * D * INW; Wt = P.wt_in + (size_t)l * INW * D; N = INW; tk = r / 46; tn = r % 46; }
        else if (r < T_IN + T_OUT) { r -= T_IN; W = P.w_out + (size_t)l * D * D; Wt = P.wt_out + (size_t)l * D * D; N = D; tk = r / 16; tn = r % 16; }
        else { r -= T_IN + T_OUT; W = P.s5_glu_w + (size_t)l * 256 * 256; Wt = P.glut + (size_t)l * 256 * 256; N = 256; tk = r / 4; tn = r % 4; KW = 256; }
#pragma unroll
        for (int i = 0; i < 2; ++i) {
            int k = (tid >> 4) + 32 * i, n4 = (tid & 15) * 4;
            floatx4 v = *(const floatx4*)(W + (size_t)(tk * 64 + k) * N + tn * 64 + n4);
            sm[k * 65 + n4] = v[0]; sm[k * 65 + n4 + 1] = v[1]; sm[k * 65 + n4 + 2] = v[2]; sm[k * 65 + n4 + 3] = v[3];
        }
        __syncthreads();
        {
            int n = tid >> 3, k8 = (tid & 7) * 8;
            half8 h;
#pragma unroll
            for (int j = 0; j < 8; ++j) h[j] = (f16)sm[(k8 + j) * 65 + n];
            *(half8*)(Wt + (size_t)(tn * 64 + n) * KW + tk * 64 + k8) = h;
        }
        __syncthreads();
    }
}
constexpr int S5PW = 38;
DEV void ph_tables(PRef P, int bid, int nblk) {
    for (int idx = bid * NT + ltid(); idx < 2 * 2 * 16 * 64; idx += nblk * NT) {
        const int n = idx & 63, lzg = idx >> 6;
        const int pi = lzg * 64 + n;
        const float are_ = P.s5_a_re[pi], aim_ = P.s5_a_im[pi], dt = expf(P.s5_log_dt[pi]);
        const float mag = expf(are_ * dt), abr = mag * cosf(aim_ * dt), abi = mag * sinf(aim_ * dt);
        const float den = are_ * are_ + aim_ * aim_;
        const float qre = ((abr - 1.f) * are_ + abi * aim_) / den, qim = (abi * are_ - (abr - 1.f) * aim_) / den;
        GAS float* tb = P.s5par + (size_t)lzg * S5PW * 64 + n;
        tb[0] = abr; tb[64] = abi;
        for (int pp = 0; pp < 16; ++pp) {
            const float br = P.s5_b_re[(size_t)pi * 16 + pp], bi = P.s5_b_im[(size_t)pi * 16 + pp];
            P.s5bb[((size_t)lzg * 128 + n) * 16 + pp] = (f16)(qre * br - qim * bi);
            P.s5bb[((size_t)lzg * 128 + 64 + n) * 16 + pp] = (f16)(qre * bi + qim * br);
            P.s5cc[((size_t)lzg * 16 + pp) * 128 + n] = (f16)P.s5_c_re[((size_t)lzg * 16 + pp) * 64 + n];
            P.s5cc[((size_t)lzg * 16 + pp) * 128 + 64 + n] = (f16)(-P.s5_c_im[((size_t)lzg * 16 + pp) * 64 + n]);
        }
        const float m64 = expf(64.f * are_ * dt);
        tb[34 * 64] = m64 * cosf(64.f * aim_ * dt); tb[35 * 64] = m64 * sinf(64.f * aim_ * dt);
    }
    for (int idx = bid * NT + ltid(); idx < 2 * 2 * 2 * 384 * 32; idx += nblk * NT) {
        const int r = idx & 31, c = (idx >> 5) % 384, wa = (idx / (32 * 384)) & 1, lz = idx / (2 * 32 * 384);
        const GAS float* src_ = wa ? P.rw_a_up : P.rw_w_up;
        P.rwlt[idx] = (bf16)src_[((size_t)lz * 32 + r) * 384 + c];
    }
}
DEV void ph_hx(PRef P, int l, int bid, int nblk) {
    const int tid_ = ltid(); const int lane = tid_ & 63, wv = tid_ >> 6;
    for (int R = bid * NW + wv; R < NROWS; R += nblk * NW) {
        const GAS float* xr = xrow(P, l, R);
        floatx4 v[4]; float ss = 0.f;
#pragma unroll
        for (int i = 0; i < 4; ++i) { v[i] = *(const floatx4*)(xr + i * 256 + lane * 4); ss += v[i][0] * v[i][0] + v[i][1] * v[i][1] + v[i][2] * v[i][2] + v[i][3] * v[i][3]; }
        ss = wave_sum(ss);
        const float rs = 1.f / sqrtf(ss * (1.f / D) + 1e-6f);
        const GAS float* m = P.mods + (l * 3 + row_mod(R)) * 3072; const GAS float* g = P.norm_g + l * D;
#pragma unroll
        for (int i = 0; i < 4; ++i) {
            int k = i * 256 + lane * 4; half4 h;
#pragma unroll
            for (int j = 0; j < 4; ++j) h[j] = (f16)(v[i][j] * rs * g[k + j] * (1.f + m[D + k + j]) + m[k + j]);
            *(half4*)(P.hx + (size_t)R * D + k) = h;
        }
    }
}
DEV void ph_final2(PRef P, int bid, int nblk) {
    const int tid_ = ltid(); const int lane = tid_ & 63, wv = tid_ >> 6;
    for (int r = bid * NW + wv; r < NLAT; r += nblk * NW) {
        GAS float* xr = P.out + (size_t)r * D; floatx4 v[4]; float ss = 0.f;
#pragma unroll
        for (int i = 0; i < 4; ++i) { v[i] = *(const floatx4*)(xr + i * 256 + lane * 4); ss += v[i][0] * v[i][0] + v[i][1] * v[i][1] + v[i][2] * v[i][2] + v[i][3] * v[i][3]; }
        ss = wave_sum(ss);
        const float rs = 1.f / sqrtf(ss * (1.f / D) + 1e-6f);
#pragma unroll
        for (int i = 0; i < 4; ++i) {
            const floatx4 g = *(const floatx4*)(P.final_g + i * 256 + lane * 4); floatx4 o;
#pragma unroll
            for (int j = 0; j < 4; ++j) o[j] = v[i][j] * rs * g[j];
            *(floatx4*)(xr + i * 256 + lane * 4) = o;
        }
    }
}

constexpr int G_LDA = 72;
constexpr int G_STAGE = (256 + 128) * G_LDA;
constexpr int GEMM_LDS_BYTES = 2 * G_STAGE * 2;
template <int MODE>
DEV void gemm_epi_tile(PRef P, int l, const floatx16 acc, int R0, int n0, int lane) {
#pragma unroll
    for (int r = 0; r < 16; ++r) {
        const int R = R0 + (r & 3) + 8 * (r >> 2) + 4 * (lane >> 5), n = n0 + (lane & 31);
        if (MODE == 1) P.p[(size_t)R * INW + n] = (f16)acc[r];
        else if (MODE == 2) {
            const int j = row_mod(R); const float g = P.mods[(l * 3 + j) * 3072 + 2 * D + n];
            const float xo = xrow(P, l, R)[n];
            GAS float* dst = R < NCTX ? P.ctx1 + (size_t)R * D + n : P.out + (size_t)(R - NCTX) * D + n;
            *dst = xo + g * acc[r];
        } else {
            const float yv = (float)P.yg[(size_t)R * 256 + n]; const float gt = (float)P.p[(size_t)R * INW + 1920 + n];
            P.p[(size_t)R * INW + 1920 + n] = (f16)(yv * fsigmoid(acc[r] + P.s5_glu_b[l * 256 + n]) * fsilu(gt));
        }
    }
}
template <int MODE>
DEV void ph_gemm_mfma(PRef P, int l, int bid, int nblk, unsigned char* smraw, bool dry = false) {
    constexpr int N = MODE == 1 ? INW : (MODE == 2 ? D : 256), K = MODE == 3 ? 256 : D;
    const GAS f16* Bt = MODE == 1 ? P.wt_in + (size_t)l * INW * D : (MODE == 2 ? P.wt_out + (size_t)l * D * D : P.glut + (size_t)l * 256 * 256);
    const int tm0 = (MODE != 1 && l == 1) ? NCTX / 256 : 0;
    const int ntm = NROWS / 256 - tm0, ntn = N / 128;
    const int tid = ltid(), lane = tid & 63, wv = tid >> 6, wm = wv & 3, wn = wv >> 2;
    f16* sbase = (f16*)smraw;
    const int ldrow = tid >> 3, ldch = tid & 7;
    constexpr int GM = 8;
    for (int t = bid; t < ntm * ntn; t += nblk) {
        int sg = t / (GM * ntn), rem = t % (GM * ntn);
        int gsz = ntm - sg * GM < GM ? ntm - sg * GM : GM;
        const int tm = tm0 + sg * GM + rem % gsz, tn = rem / gsz;
        floatx16 acc00, acc01, acc10, acc11;
#pragma unroll
        for (int r = 0; r < 16; ++r) { acc00[r] = 0.f; acc01[r] = 0.f; acc10[r] = 0.f; acc11[r] = 0.f; }
        uintx4 pa0, pa1, pa2, pa3, pb0, pb1, qa0, qa1, qa2, qa3, qb0, qb1;
        const GAS f16* arow = MODE == 1 ? P.hx + (size_t)(tm * 256 + ldrow) * D + ldch * 8 : (MODE == 2 ? P.p + (size_t)(tm * 256 + ldrow) * INW + ldch * 8 : P.yg + (size_t)(tm * 256 + ldrow) * 256 + ldch * 8);
        const size_t astr = (size_t)64 * (MODE == 1 ? D : (MODE == 2 ? INW : 256));
        const GAS f16* brow = Bt + (size_t)(tn * 128 + ldrow) * K + ldch * 8;
#define GLOAD(S, kt_) if (!(dry && G_VARIANT == 3 && (kt_) > 1)) { const int ka = MODE == 2 ? a2col((kt_) * 64) : (kt_) * 64; const int kb = (kt_) * 64; \
            S##a0 = *(const uintx4*)(arow + ka); S##a1 = *(const uintx4*)(arow + astr + ka); S##a2 = *(const uintx4*)(arow + 2 * astr + ka); S##a3 = *(const uintx4*)(arow + 3 * astr + ka); \
            S##b0 = *(const uintx4*)(brow + kb); S##b1 = *(const uintx4*)(brow + (size_t)64 * K + kb); }
#define SWRITE(S, st_) if (!(dry && G_VARIANT == 4)) { f16* sA_ = sbase + (st_) * G_STAGE + ldrow * G_LDA + ldch * 8; f16* sB_ = sbase + (st_) * G_STAGE + 256 * G_LDA + ldrow * G_LDA + ldch * 8; \
            *(uintx4*)(sA_) = S##a0; *(uintx4*)(sA_ + 64 * G_LDA) = S##a1; *(uintx4*)(sA_ + 128 * G_LDA) = S##a2; *(uintx4*)(sA_ + 192 * G_LDA) = S##a3; \
            *(uintx4*)(sB_) = S##b0; *(uintx4*)(sB_ + 64 * G_LDA) = S##b1; }
#define GFRAG(ks_, b_) { fa0[b_] = *(const half8*)(sA_ + (ks_) * 16); fa1[b_] = *(const half8*)(sA_ + 32 * G_LDA + (ks_) * 16); \
            fb0[b_] = *(const half8*)(sB_ + (ks_) * 16); fb1[b_] = *(const half8*)(sB_ + 32 * G_LDA + (ks_) * 16); }
#define GMMA(b_) { acc00 = __builtin_amdgcn_mfma_f32_32x32x16_f16(fb0[b_], fa0[b_], acc00, 0, 0, 0); acc01 = __builtin_amdgcn_mfma_f32_32x32x16_f16(fb1[b_], fa0[b_], acc01, 0, 0, 0); \
            acc10 = __builtin_amdgcn_mfma_f32_32x32x16_f16(fb0[b_], fa1[b_], acc10, 0, 0, 0); acc11 = __builtin_amdgcn_mfma_f32_32x32x16_f16(fb1[b_], fa1[b_], acc11, 0, 0, 0); }
#define GCOMPUTE(st_) { const f16* sA_ = sbase + (st_) * G_STAGE + (wm * 64 + (lane & 31)) * G_LDA + (lane >> 5) * 8; \
            const f16* sB_ = sbase + (st_) * G_STAGE + 256 * G_LDA + (wn * 64 + (lane & 31)) * G_LDA + (lane >> 5) * 8; \
            half8 fa0[2], fa1[2], fb0[2], fb1[2]; \
            GFRAG(0, 0); GFRAG(1, 1); __builtin_amdgcn_sched_barrier(0); \
            GMMA(0); GFRAG(2, 0); __builtin_amdgcn_sched_barrier(0); \
            GMMA(1); GFRAG(3, 1); __builtin_amdgcn_sched_barrier(0); \
            GMMA(0); __builtin_amdgcn_sched_barrier(0); GMMA(1); }
        constexpr int NK = K / 64;
        BAR_LDS();
        GLOAD(p, 0); SWRITE(p, 0); GLOAD(q, 1); if (2 < NK) GLOAD(p, 2);
        BAR_LDS();
        for (int kt = 0; kt < NK; kt += 2) {
            SWRITE(q, 1);
            if (kt + 3 < NK) GLOAD(q, kt + 3);
            GCOMPUTE(0);
            BAR_LDS();
            if (kt + 2 < NK) { SWRITE(p, 0); if (kt + 4 < NK) GLOAD(p, kt + 4); }
            GCOMPUTE(1);
            BAR_LDS();
        }
#undef GLOAD
#undef SWRITE
#undef GCOMPUTE
#undef GFRAG
#undef GMMA
        if (dry) continue;
        if (MODE != 2) {
            f16* Cs = (f16*)smraw;
#define CSTORE(acc_, mi_, ni_) { const int m_ = wm * 64 + (mi_) * 32 + (lane & 31); \
                _Pragma("unroll") for (int g = 0; g < 4; ++g) { half4 h_; h_[0] = (f16)acc_[4 * g]; h_[1] = (f16)acc_[4 * g + 1]; h_[2] = (f16)acc_[4 * g + 2]; h_[3] = (f16)acc_[4 * g + 3]; \
                    *(half4*)(Cs + m_ * 136 + wn * 64 + (ni_) * 32 + 8 * g + 4 * (lane >> 5)) = h_; } }
            CSTORE(acc00, 0, 0); CSTORE(acc01, 0, 1); CSTORE(acc10, 1, 0); CSTORE(acc11, 1, 1);
#undef CSTORE
            BAR_LDS();
#pragma unroll 2
            for (int i = 0; i < 8; ++i) {
                const int row = (tid >> 4) + 32 * i, ch = tid & 15; const int R = tm * 256 + row, n = tn * 128 + ch * 8;
                const half8 v = *(const half8*)(Cs + row * 136 + ch * 8);
                if (MODE == 1) *(GAS half8*)(P.p + (size_t)R * INW + n) = v;
                else {
                    const half8 yv = *(const GAS half8*)(P.yg + (size_t)R * 256 + n); const half8 gt = *(const GAS half8*)(P.p + (size_t)R * INW + 1920 + n);
                    const floatx4 b0 = *(const GAS floatx4*)(P.s5_glu_b + l * 256 + n), b1 = *(const GAS floatx4*)(P.s5_glu_b + l * 256 + n + 4);
                    half8 o;
#pragma unroll
                    for (int e = 0; e < 8; ++e) o[e] = (f16)((float)yv[e] * fsigmoid((float)v[e] + (e < 4 ? b0[e] : b1[e - 4])) * fsilu((float)gt[e]));
                    *(GAS half8*)(P.p + (size_t)R * INW + 1920 + n) = o;
                }
            }
        } else {
            float* Cs = (float*)smraw;
#pragma unroll 1
            for (int hm = 0; hm < 2; ++hm) {
                if ((wm >> 1) == hm) {
#define CSTORE(acc_, mi_, ni_) { const int m_ = (wm & 1) * 64 + (mi_) * 32 + (lane & 31); \
                    _Pragma("unroll") for (int g = 0; g < 4; ++g) { floatx4 f_; f_[0] = acc_[4 * g]; f_[1] = acc_[4 * g + 1]; f_[2] = acc_[4 * g + 2]; f_[3] = acc_[4 * g + 3]; \
                        *(floatx4*)(Cs + m_ * 132 + wn * 64 + (ni_) * 32 + 8 * g + 4 * (lane >> 5)) = f_; } }
                    CSTORE(acc00, 0, 0); CSTORE(acc01, 0, 1); CSTORE(acc10, 1, 0); CSTORE(acc11, 1, 1);
#undef CSTORE
                }
                BAR_LDS();
#pragma unroll 2
                for (int i = 0; i < 8; ++i) {
                    const int row = (tid >> 5) + 16 * i, ch = tid & 31; const int R = tm * 256 + hm * 128 + row, n = tn * 128 + ch * 4;
                    const floatx4 a4 = *(const floatx4*)(Cs + row * 132 + ch * 4);
                    const floatx4 g4 = *(const GAS floatx4*)(P.mods + (l * 3 + row_mod(R)) * 3072 + 2 * D + n);
                    const floatx4 x4 = *(const GAS floatx4*)(xrow(P, l, R) + n);
                    GAS float* dst = R < NCTX ? P.ctx1 + (size_t)R * D + n : P.out + (size_t)(R - NCTX) * D + n;
                    floatx4 o;
#pragma unroll
                    for (int e = 0; e < 4; ++e) o[e] = x4[e] + g4[e] * a4[e];
                    *(GAS floatx4*)dst = o;
                }
                BAR_LDS();
            }
        }
    }
}

constexpr int RLD = 72;
constexpr int RSLOT = 64 * RLD;
constexpr int RWP1_LDS_BYTES = 11 * RSLOT * 2 + 2 * 64 * 65 * 4 + 1536 * 4 + 128 * 4;
constexpr size_t RWM_STRIDE = (size_t)24 * NCHUNK * 4096;

DEV bf16x8 ldfrag(const bf16* M, int rowbase, int lane, int ks) {
    return *(const bf16x8*)(M + (rowbase + (lane & 31)) * RLD + ks * 16 + (lane >> 5) * 8);
}
DEV floatx16 mm64(const bf16* A, const bf16* Bt, int wm, int wn, int lane) {
    floatx16 acc;
#pragma unroll
    for (int r = 0; r < 16; ++r) acc[r] = 0.f;
#pragma unroll
    for (int ks = 0; ks < 4; ++ks) acc = __builtin_amdgcn_mfma_f32_32x32x16_bf16(ldfrag(A, wm * 32, lane, ks), ldfrag(Bt, wn * 32, lane, ks), acc, 0, 0, 0);
    return acc;
}
DEV void storeT(bf16* dst, const floatx16 c, int wm, int wn, int lane) {
    const int n = wn * 32 + (lane & 31);
#pragma unroll
    for (int g = 0; g < 4; ++g) {
        const int m0 = wm * 32 + 8 * g + 4 * (lane >> 5);
        bf16x4 v; v[0] = (bf16)c[4 * g]; v[1] = (bf16)c[4 * g + 1]; v[2] = (bf16)c[4 * g + 2]; v[3] = (bf16)c[4 * g + 3];
        *(bf16x4*)(dst + n * RLD + m0) = v;
    }
}

DEV void ph_rw_p1(PRef P, int l, int bid, int nblk, unsigned char* smraw) {
    bf16* sl = (bf16*)smraw;
    bf16 *Am = sl, *AmT = sl + RSLOT, *Bp = sl + 2 * RSLOT, *Kp = sl + 3 * RSLOT, *Rt = sl + 4 * RSLOT, *VT = sl + 5 * RSLOT,
         *BendT = sl + 6 * RSLOT, *KendT = sl + 7 * RSLOT, *Nak = sl + 8 * RSLOT, *Mrb = sl + 9 * RSLOT, *Mrk = sl + 10 * RSLOT;
    bf16 *UtT = Am, *WmT = Bp, *NVT = Kp;
    float* Nf = (float*)(smraw + 11 * RSLOT * 2); float* Tf = Nf + 64 * 65; float* Wb = Tf + 64 * 65; float* gl = Wb + 1536;
    bf16* Noff = (bf16*)Nf; float* Nfull = Nf + 2304;
    bf16* Td = (bf16*)(Nf + 2304 + 4096); bf16* Zs = (bf16*)Wb;
    float* av = Nf; float* lwb = Tf;
    f16* Sr = (f16*)Nak; f16* Sk = (f16*)Mrb; f16* Sv = (f16*)Mrk; bf16* lt = KendT;
    float* part = Wb;
    GAS f16* PTg = P.rwm; GAS f16* RPg = PTg + RWM_STRIDE; GAS f16* Qg = RPg + RWM_STRIDE;
    for (int item = bid; item < 24 * NCHUNK; item += nblk) {
        const int tid = ltid(), lane = tid & 63, wv = tid >> 6, q4 = wv & 3, wm = q4 & 1, wn = q4 >> 1, hs = wv >> 2;
        const int chain = item / NCHUNK, ck = item % NCHUNK;
        const int z = chain / 12, b = (chain / 6) % 2, h = chain % 6, s0 = ck * 64;
        const int j = lane, tq = wv, c = h * 64 + j;
#pragma unroll 4
        for (int i = 0; i < 4; ++i) {
            const int task = tid + NT * i, c8 = task & 7, t = (task >> 3) & 63, q = task >> 9;
            const int col0 = q < 3 ? q * 384 + h * 64 + c8 * 8 : (c8 < 4 ? 1152 + z * 32 + c8 * 8 : 1216 + z * 32 + (c8 - 4) * 8);
            const int R = scan_row(z, b, s0 + t);
            const GAS f16* pr = P.p + (size_t)R * INW + col0;
            const half8 own = *(const half8*)pr;
            half8 n0, n1, n2, n3;
#pragma unroll
            for (int e = 0; e < 8; ++e) { n0[e] = (f16)0.f; n1[e] = (f16)0.f; n2[e] = (f16)0.f; n3[e] = (f16)0.f; }
            if (R < NCTX) {
                const int tt = R % CTX;
                if (tt > 0) n0 = *(const half8*)(pr - INW);
                if (tt < CTX - 1) n1 = *(const half8*)(pr + INW);
                n2 = n0; n3 = n1;
            } else {
                const int tt = (R - NCTX) % SEQ, col = tt & 63;
                if (col > 0) n0 = *(const half8*)(pr - INW);
                if (col < 63) n1 = *(const half8*)(pr + INW);
                if (tt >= 64) n2 = *(const half8*)(pr - 64 * INW);
                if (tt < SEQ - 64) n3 = *(const half8*)(pr + 64 * INW);
            }
            const floatx4 mu0 = *(const floatx4*)(P.rw_mu + l * 1280 + col0), mu1 = *(const floatx4*)(P.rw_mu + l * 1280 + col0 + 4);
            float s[8];
#pragma unroll
            for (int e = 0; e < 8; ++e) {
                const float pv = (float)own[e];
                const float nv = (float)((e & 3) == 0 ? n0[e] : (e & 3) == 1 ? n1[e] : (e & 3) == 2 ? n2[e] : n3[e]);
                s[e] = pv + (nv - pv) * (e < 4 ? mu0[e] : mu1[e - 4]);
            }
            if (q < 3) {
                half8 o;
#pragma unroll
                for (int e = 0; e < 8; ++e) o[e] = (f16)s[e];
                *(half8*)((q == 0 ? Sr : q == 1 ? Sk : Sv) + t * RLD + c8 * 8) = o;
            } else {
                bf16x8 o;
#pragma unroll
                for (int e = 0; e < 8; ++e) o[e] = (bf16)(c8 < 4 ? ftanh(s[e]) : s[e]);
                *(bf16x8*)(lt + t * RLD + c8 * 8) = o;
            }
        }
        BAR_LDS();
        {
            const GAS bf16* tab = P.rwlt + ((size_t)((l * 2 + z) * 2 + hs) * 384 + h * 64 + wn * 32 + (lane & 31)) * 32 + (lane >> 5) * 8;
            floatx16 aw;
#pragma unroll
            for (int r = 0; r < 16; ++r) aw[r] = 0.f;
#pragma unroll
            for (int ks = 0; ks < 2; ++ks) aw = __builtin_amdgcn_mfma_f32_32x32x16_bf16(ldfrag(lt + hs * 32, wm * 32, lane, ks), *(const bf16x8*)(tab + ks * 16), aw, 0, 0, 0);
            const int cc = h * 64 + wn * 32 + (lane & 31);
            const float bias = hs ? P.rw_a0[(l * 2 + z) * 384 + cc] : P.rw_w0[(l * 2 + z) * 384 + cc];
#pragma unroll
            for (int r = 0; r < 16; ++r) {
                const int m = wm * 32 + (r & 3) + 8 * (r >> 2) + 4 * (lane >> 5), n = wn * 32 + (lane & 31);
                const float sg = fsigmoid(aw[r] + bias);
                if (hs) av[m * 65 + n] = sg; else lwb[m * 65 + n] = -0.6065306597126334f * sg;
            }
        }
        BAR_LDS();
        float gpre, gtot;
        {
            float run = 0.f, gv[8];
#pragma unroll
            for (int tt = 0; tt < 8; ++tt) { run += lwb[(tq * 8 + tt) * 65 + j]; gv[tt] = run; }
            part[tq * 64 + j] = run;
            const int t = lane, q8 = wv;
            float ss = 0.f, bn = 0.f;
#pragma unroll
            for (int e = 0; e < 8; ++e) {
                const int jj = q8 * 8 + e, c2 = h * 64 + jj;
                const float k_ = (float)Sk[t * RLD + jj], r_ = (float)Sr[t * RLD + jj], a = av[t * 65 + jj];
                const float kku = k_ * P.rw_k_k[l * 384 + c2];
                ss += kku * kku; bn += r_ * k_ * (1.f + (a - 1.f) * P.rw_k_a[l * 384 + c2]) * P.rw_r_k[l * 384 + c2];
            }
            part[512 + q8 * 64 + t] = ss; part[1024 + q8 * 64 + t] = bn;
            BAR_LDS();
            gpre = 0.f; gtot = 0.f;
#pragma unroll
            for (int q = 0; q < 8; ++q) { const float x = part[q * 64 + j]; gtot += x; if (q < tq) gpre += x; }
#pragma unroll
            for (int tt = 0; tt < 8; ++tt) lwb[(tq * 8 + tt) * 65 + j] = gv[tt] + gpre;
            if (tq == 0) {
                gl[j] = __expf(gtot);
                float sst = 0.f, bnt = 0.f;
#pragma unroll
                for (int q = 0; q < 8; ++q) { sst += part[512 + q * 64 + lane]; bnt += part[1024 + q * 64 + lane]; }
                gl[64 + lane] = __builtin_amdgcn_rsqf(sst + 1e-6f);
                P.bon[((size_t)z * NROWS + scan_row(z, b, s0 + lane)) * 6 + h] = bnt;
            }
        }
        BAR_LDS();
        {
            const float kkc = P.rw_k_k[l * 384 + c], kac = P.rw_k_a[l * 384 + c];
            const float Gt = __expf(gtot);
            float e_prev = __expf(gpre);
            bf16x8 amT, vT, beT, keT;
#pragma unroll
            for (int tt = 0; tt < 8; ++tt) {
                const int t = tq * 8 + tt;
                const float r_ = (float)Sr[t * RLD + j], k_ = (float)Sk[t * RLD + j], v_ = (float)Sv[t * RLD + j];
                const float a = av[t * 65 + j], g = lwb[t * 65 + j], sinv = gl[64 + t];
                const float e_t = __expf(g), e_p = frcp(e_t), e_m = e_prev, e_e = Gt * e_p;
                e_prev = e_t;
                const float kkn = k_ * kkc * sinv, kd = k_ * (1.f + (a - 1.f) * kac), bb = a * kkn;
                const bf16 am = (bf16)(kkn * e_m);
                Am[t * RLD + j] = am; Bp[t * RLD + j] = (bf16)(bb * e_p); Kp[t * RLD + j] = (bf16)(kd * e_p); Rt[t * RLD + j] = (bf16)(r_ * e_t);
                amT[tt] = am; vT[tt] = (bf16)v_; beT[tt] = (bf16)(bb * e_e); keT[tt] = (bf16)(kd * e_e);
            }
            BAR_LDS();
            const int to = j * RLD + tq * 8;
            *(bf16x8*)(AmT + to) = amT; *(bf16x8*)(VT + to) = vT; *(bf16x8*)(BendT + to) = beT; *(bf16x8*)(KendT + to) = keT;
        }
        BAR_LDS();
        {
            floatx16 c1, c2;
#pragma unroll
            for (int r = 0; r < 16; ++r) { c1[r] = 0.f; c2[r] = 0.f; }
            if (!(wm == 0 && wn == 1)) {
                const bf16* Aop = hs ? Rt : Am;
#pragma unroll
                for (int ks = 0; ks < 4; ++ks) {
                    const bf16x8 a1 = ldfrag(Aop, wm * 32, lane, ks), b1 = ldfrag(Bp, wn * 32, lane, ks), b2 = ldfrag(Kp, wn * 32, lane, ks);
                    c1 = __builtin_amdgcn_mfma_f32_32x32x16_bf16(a1, b1, c1, 0, 0, 0);
                    c2 = __builtin_amdgcn_mfma_f32_32x32x16_bf16(a1, b2, c2, 0, 0, 0);
                }
            }
#pragma unroll
            for (int r = 0; r < 16; ++r) {
                const int m = wm * 32 + (r & 3) + 8 * (r >> 2) + 4 * (lane >> 5), n = wn * 32 + (lane & 31);
                if (hs == 0) {
                    const float nv_ = n < m ? c1[r] : 0.f;
                    Noff[m * RLD + n] = (bf16)(((n >> 4) != (m >> 4)) ? nv_ : 0.f);
                    Nfull[m * 64 + n] = nv_;
                    Nak[m * RLD + n] = (bf16)(n < m ? c2[r] : 0.f);
                }
                else { Mrb[m * RLD + n] = (bf16)(n <= m ? c1[r] : 0.f); Mrk[m * RLD + n] = (bf16)(n <= m ? c2[r] : 0.f); }
            }
        }
        BAR_LDS();
        if (tid < 64) {
            const int i = tid >> 4, jc = tid & 15; float x[16];
#pragma unroll
            for (int row = 0; row < 16; ++row) {
                float s = row == jc ? 1.f : 0.f;
#pragma unroll
                for (int m = 0; m < row; ++m) s -= Nfull[(16 * i + row) * 64 + 16 * i + m] * x[m];
                x[row] = s;
                if ((row & 3) == 3) __builtin_amdgcn_sched_barrier(0);
            }
#pragma unroll
            for (int row = 0; row < 16; ++row) { Td[(i * 16 + row) * 32 + jc] = (bf16)x[row]; Td[(i * 16 + row) * 32 + 16 + jc] = (bf16)0.f; }
        }
        if (hs == 1) { const floatx16 c2 = mm64(Nak, VT, wm, wn, lane); storeT(NVT, c2, wm, wn, lane); }
        BAR_LDS();
        {
            bf16* XT = hs ? UtT : WmT;
            const bf16* RT = hs ? NVT : AmT;
            bf16* ZT = Zs + wv * 256;
            const int cn = 16 * q4 + (lane & 15);
            {
                bf16x8 zz;
#pragma unroll
                for (int e = 0; e < 8; ++e) zz[e] = (bf16)0.f;
                *(bf16x8*)(XT + (16 * q4 + (lane >> 2)) * RLD + (lane & 3) * 16) = zz; *(bf16x8*)(XT + (16 * q4 + (lane >> 2)) * RLD + (lane & 3) * 16 + 8) = zz;
            }
#pragma unroll 1
            for (int i = 0; i < 4; ++i) {
                floatx4 acc = {0.f, 0.f, 0.f, 0.f};
                if (i > 0) {
#pragma unroll
                    for (int ks = 0; ks < 2; ++ks) {
                        if (ks * 32 < 16 * i) {
                            const bf16x8 a = *(const bf16x8*)(Noff + (16 * i + (lane & 15)) * RLD + 32 * ks + 8 * (lane >> 4));
                            const bf16x8 bq = *(const bf16x8*)(XT + cn * RLD + 32 * ks + 8 * (lane >> 4));
                            acc = __builtin_amdgcn_mfma_f32_16x16x32_bf16(a, bq, acc, 0, 0, 0);
                        }
                    }
                }
                {
                    const bf16x4 rh = *(const bf16x4*)(RT + cn * RLD + 16 * i + 4 * (lane >> 4));
                    bf16x4 zv; zv[0] = (bf16)((float)rh[0] - acc[0]); zv[1] = (bf16)((float)rh[1] - acc[1]); zv[2] = (bf16)((float)rh[2] - acc[2]); zv[3] = (bf16)((float)rh[3] - acc[3]);
                    *(bf16x4*)(ZT + (lane & 15) * 16 + 4 * (lane >> 4)) = zv;
                }
                {
                    const bf16x8 a = *(const bf16x8*)(Td + (i * 16 + (lane & 15)) * 32 + 8 * (lane >> 4));
                    bf16x8 bz;
#pragma unroll
                    for (int e = 0; e < 8; ++e) bz[e] = (bf16)0.f;
                    if ((lane >> 4) < 2) bz = *(const bf16x8*)(ZT + (lane & 15) * 16 + 8 * (lane >> 4));
                    floatx4 xo = {0.f, 0.f, 0.f, 0.f};
                    xo = __builtin_amdgcn_mfma_f32_16x16x32_bf16(a, bz, xo, 0, 0, 0);
                    bf16x4 xv; xv[0] = (bf16)xo[0]; xv[1] = (bf16)xo[1]; xv[2] = (bf16)xo[2]; xv[3] = (bf16)xo[3];
                    *(bf16x4*)(XT + cn * RLD + 16 * i + 4 * (lane >> 4)) = xv;
                }
            }
        }
        BAR_LDS();
        {
            f16* T0 = (f16*)AmT; f16* T1 = (f16*)Kp; f16* T2 = (f16*)Nak; f16* T3 = (f16*)Nf;
            const int n = wn * 32 + (lane & 31);
            if (hs == 0) {
                {
                    const floatx16 c1 = mm64(WmT, Mrb, wm, wn, lane);
#pragma unroll
                    for (int g = 0; g < 4; ++g) {
                        const int m0 = wm * 32 + 8 * g + 4 * (lane >> 5);
                        const bf16x4 rt = *(const bf16x4*)(Rt + n * RLD + m0);
                        half4 v; v[0] = (f16)((float)rt[0] - c1[4 * g]); v[1] = (f16)((float)rt[1] - c1[4 * g + 1]); v[2] = (f16)((float)rt[2] - c1[4 * g + 2]); v[3] = (f16)((float)rt[3] - c1[4 * g + 3]);
                        *(half4*)(T0 + n * RLD + m0) = v;
                    }
                }
                __builtin_amdgcn_sched_barrier(0);
                {
                    const floatx16 c2 = mm64(VT, Mrk, wm, wn, lane); __builtin_amdgcn_sched_barrier(0); const floatx16 c3 = mm64(UtT, Mrb, wm, wn, lane);
#pragma unroll
                    for (int g = 0; g < 4; ++g) {
                        const int m0 = wm * 32 + 8 * g + 4 * (lane >> 5);
                        half4 v; v[0] = (f16)(c2[4 * g] - c3[4 * g]); v[1] = (f16)(c2[4 * g + 1] - c3[4 * g + 1]); v[2] = (f16)(c2[4 * g + 2] - c3[4 * g + 2]); v[3] = (f16)(c2[4 * g + 3] - c3[4 * g + 3]);
                        *(half4*)(T1 + n * RLD + m0) = v;
                    }
                }
            } else {
                {
                    const floatx16 c4 = mm64(WmT, BendT, wm, wn, lane);
                    const float gd = gl[n];
#pragma unroll
                    for (int g = 0; g < 4; ++g) {
                        const int m0 = wm * 32 + 8 * g + 4 * (lane >> 5);
                        half4 v;
#pragma unroll
                        for (int e = 0; e < 4; ++e) v[e] = (f16)((m0 + e == n ? gd : 0.f) - c4[4 * g + e]);
                        *(half4*)(T2 + n * RLD + m0) = v;
                    }
                }
                __builtin_amdgcn_sched_barrier(0);
                {
                    const floatx16 c5 = mm64(KendT, VT, wm, wn, lane); __builtin_amdgcn_sched_barrier(0); const floatx16 c6 = mm64(BendT, UtT, wm, wn, lane);
#pragma unroll
                    for (int g = 0; g < 4; ++g) {
                        const int m0 = wm * 32 + 8 * g + 4 * (lane >> 5);
                        half4 v; v[0] = (f16)(c5[4 * g] - c6[4 * g]); v[1] = (f16)(c5[4 * g + 1] - c6[4 * g + 1]); v[2] = (f16)(c5[4 * g + 2] - c6[4 * g + 2]); v[3] = (f16)(c5[4 * g + 3] - c6[4 * g + 3]);
                        *(half4*)(T3 + n * RLD + m0) = v;
                    }
                }
            }
            BAR_LDS();
            {
                const size_t gb = (size_t)item * 4096;
                const int row = tid >> 3, ch = tid & 7;
                const half8 v0 = *(const half8*)(T0 + row * RLD + ch * 8), v1 = *(const half8*)(T1 + row * RLD + ch * 8);
                const half8 v2 = *(const half8*)(T2 + row * RLD + ch * 8), v3 = *(const half8*)(T3 + row * RLD + ch * 8);
                *(GAS half8*)(RPg + gb + row * 64 + ch * 8) = v0;
                *(GAS half8*)(P.Yh + ((size_t)z * NROWS + scan_row(z, b, s0 + row)) * 384 + h * 64 + ch * 8) = v1;
                *(GAS half8*)(PTg + gb + row * 64 + ch * 8) = v2;
                *(GAS half8*)(Qg + gb + row * 64 + ch * 8) = v3;
            }
        }
        BAR_LDS();
    }
}

DEV void ph_rw_stream(PRef P, int l, int bid, int nblk, unsigned char* smraw, bool dry = false) {
    const int tid = ltid(), lane = tid & 63, wv = tid >> 6, w4 = wv & 3, role = wv >> 2;
    f16* S16 = (f16*)smraw;
    const GAS f16* PTg = P.rwm; const GAS f16* RPg = PTg + RWM_STRIDE; const GAS f16* Qg = RPg + RWM_STRIDE;
    for (int item = bid; item < 96; item += nblk) {
        const int chain = item >> 2, vs = item & 3;
        const int z = chain / 12, b = (chain / 6) % 2, h = chain % 6;
        __syncthreads();
        for (int idx = tid; idx < 2 * 16 * 72; idx += NT) S16[idx] = (f16)0.f;
        __syncthreads();
        const size_t cb = (size_t)chain * NCHUNK * 4096;
        const int rowA = 16 * w4 + (lane & 15), kof = 8 * (lane >> 4);
        const int qoff = (vs * 16 + (lane & 15)) * 64 + 16 * w4 + (lane >> 4) * 4;
        const GAS f16* Ag = role ? RPg : PTg;
        GAS f16* ycol = P.Yh + ((size_t)(2 + z) * NROWS) * 384 + h * 64 + vs * 16 + (lane & 15);
        const int trow = 16 * w4 + (lane >> 4) * 4;
        const int rstep = z ? -384 : 384;
        half8 a0[8], a1[8]; half4 qv[8];
#define RW_LOAD(slot_, ck_) { const size_t gb_ = cb + (size_t)(ck_) * 4096; \
            a0[slot_] = *(const GAS half8*)(Ag + gb_ + rowA * 64 + kof); a1[slot_] = *(const GAS half8*)(Ag + gb_ + rowA * 64 + 32 + kof); \
            if (role == 0) qv[slot_] = *(const GAS half4*)(Qg + gb_ + qoff); }
#define RW_STEP(slot_, ck_) { const f16* Sc_ = S16 + ((ck_) & 1) * 16 * 72; f16* Sn_ = S16 + (((ck_) + 1) & 1) * 16 * 72; \
            const half8 b0_ = *(const half8*)(Sc_ + (lane & 15) * 72 + kof); const half8 b1_ = *(const half8*)(Sc_ + (lane & 15) * 72 + 32 + kof); \
            floatx4 acc_ = {0.f, 0.f, 0.f, 0.f}; \
            if (role == 0) { acc_[0] = (float)qv[slot_][0]; acc_[1] = (float)qv[slot_][1]; acc_[2] = (float)qv[slot_][2]; acc_[3] = (float)qv[slot_][3]; } \
            acc_ = __builtin_amdgcn_mfma_f32_16x16x32_f16(a0[slot_], b0_, acc_, 0, 0, 0); acc_ = __builtin_amdgcn_mfma_f32_16x16x32_f16(a1[slot_], b1_, acc_, 0, 0, 0); \
            half4 sn_; sn_[0] = (f16)acc_[0]; sn_[1] = (f16)acc_[1]; sn_[2] = (f16)acc_[2]; sn_[3] = (f16)acc_[3]; \
            if (role == 0) *(half4*)(Sn_ + (lane & 15) * 72 + trow) = sn_; \
            else if (!dry) { GAS f16* yp_ = ycol + (size_t)scan_row(z, b, (ck_) * 64 + trow) * 384; \
                _Pragma("unroll") for (int r_ = 0; r_ < 4; ++r_) yp_[r_ * rstep] = sn_[r_]; } \
            BAR_LDS(); }
        RW_LOAD(0, 0); RW_LOAD(1, 1); RW_LOAD(2, 2); RW_LOAD(3, 3); RW_LOAD(4, 4); RW_LOAD(5, 5); RW_LOAD(6, 6);
        for (int ck = 0; ck < NCHUNK; ck += 8) {
            RW_LOAD(7, ck + 7 < NCHUNK ? ck + 7 : NCHUNK - 1); RW_STEP(0, ck);
            RW_LOAD(0, ck + 8 < NCHUNK ? ck + 8 : NCHUNK - 1); RW_STEP(1, ck + 1);
            RW_LOAD(1, ck + 9 < NCHUNK ? ck + 9 : NCHUNK - 1); RW_STEP(2, ck + 2);
            RW_LOAD(2, ck + 10 < NCHUNK ? ck + 10 : NCHUNK - 1); RW_STEP(3, ck + 3);
            if (ck + 4 < NCHUNK) {
                RW_LOAD(3, ck + 11 < NCHUNK ? ck + 11 : NCHUNK - 1); RW_STEP(4, ck + 4);
                RW_LOAD(4, ck + 12 < NCHUNK ? ck + 12 : NCHUNK - 1); RW_STEP(5, ck + 5);
                RW_LOAD(5, ck + 13 < NCHUNK ? ck + 13 : NCHUNK - 1); RW_STEP(6, ck + 6);
                RW_LOAD(6, ck + 14 < NCHUNK ? ck + 14 : NCHUNK - 1); RW_STEP(7, ck + 7);
            }
        }
#undef RW_LOAD
#undef RW_STEP
    }
}
DEV void ph_rwkv_fin2(PRef P, int l, int bid, int nblk, bool dry = false) {
    const int tid_ = ltid(); const int lane = tid_ & 63, wv = tid_ >> 6;
    floatx4 mu_[2], lg_[2], lb_[2];
#pragma unroll
    for (int pass = 0; pass < 2; ++pass) {
        const int hc = pass * 4 + (lane >> 4), cc = (hc < 6 ? hc : 0) * 64 + (lane & 15) * 4;
        mu_[pass] = *(const GAS floatx4*)(P.rw_mu + l * 1280 + 768 + cc); lg_[pass] = *(const GAS floatx4*)(P.rw_ln_g + l * 384 + cc); lb_[pass] = *(const GAS floatx4*)(P.rw_ln_b + l * 384 + cc);
    }
    for (int R = (l == 1 ? NCTX : 0) + bid * NW + wv; R < NROWS; R += nblk * NW) {
#pragma unroll
        for (int pass = 0; pass < 2; ++pass) {
            const int h = pass * 4 + (lane >> 4);
            if (h < 6) {
                const int c = h * 64 + (lane & 15) * 4;
                const half4 y0 = *(const GAS half4*)(P.Yh + (size_t)R * 384 + c), y1 = *(const GAS half4*)(P.Yh + ((size_t)NROWS + R) * 384 + c);
                const half4 y2 = *(const GAS half4*)(P.Yh + ((size_t)2 * NROWS + R) * 384 + c), y3 = *(const GAS half4*)(P.Yh + ((size_t)3 * NROWS + R) * 384 + c);
                const half4 gt = *(const GAS half4*)(P.p + (size_t)R * INW + 1280 + c);
                const half4 vo = *(const GAS half4*)(P.p + (size_t)R * INW + 768 + c);
                const floatx4 mu4 = mu_[pass], lg = lg_[pass], lb = lb_[pass];
                float nv[4];
#pragma unroll
                for (int e = 0; e < 4; ++e) { const int nb = nbr_row(R, 768 + c + e); nv[e] = nb >= 0 ? (float)P.p[(size_t)nb * INW + 768 + c + e] : 0.f; }
                float y[4], s = 0.f;
#pragma unroll
                for (int e = 0; e < 4; ++e) { y[e] = ((float)y0[e] + (float)y1[e]) + ((float)y2[e] + (float)y3[e]); s += y[e]; }
                const float mu = row16_sum(s) * (1.f / 64.f); float q = 0.f;
#pragma unroll
                for (int e = 0; e < 4; ++e) { y[e] -= mu; q += y[e] * y[e]; }
                const float rs = __builtin_amdgcn_rsqf(row16_sum(q) * (1.f / 64.f) + 64e-5f);
                const float bonus = P.bon[(size_t)R * 6 + h] + P.bon[((size_t)NROWS + R) * 6 + h];
                half4 o;
#pragma unroll
                for (int e = 0; e < 4; ++e) {
                    const float pv = (float)vo[e], vs = pv + (nv[e] - pv) * mu4[e];
                    o[e] = (f16)((y[e] * rs * lg[e] + lb[e] + bonus * vs) * fsilu((float)gt[e]));
                }
                if (!dry) *(GAS half4*)(P.p + (size_t)R * INW + 1280 + c) = o; else *(GAS half4*)(P.rwm + (size_t)R * 384 + c) = o;
            }
        }
    }
}
constexpr int HLD = 136;
constexpr int S5_LDS_BYTES = NW * 64 * HLD * 2;
struct S5Ops { half8 au0, au1, bb0, bb1, bb2, bb3; float hre, him; };
DEV void s5_load(PRef P, int l, int z, int b, int g, int tc, int lane, S5Ops& o) {
    const int lzg = (l * 2 + z) * 16 + g;
    o.au0 = *(const GAS half8*)(P.p + (size_t)scan_row(0, b, tc * 64 + (lane & 31)) * INW + 1664 + g * 16 + (lane >> 5) * 8);
    o.au1 = *(const GAS half8*)(P.p + (size_t)scan_row(0, b, tc * 64 + 32 + (lane & 31)) * INW + 1664 + g * 16 + (lane >> 5) * 8);
    const GAS f16* bbp = P.s5bb + ((size_t)lzg * 128 + (lane & 31)) * 16 + (lane >> 5) * 8;
    o.bb0 = *(const GAS half8*)bbp; o.bb1 = *(const GAS half8*)(bbp + 32 * 16); o.bb2 = *(const GAS half8*)(bbp + 64 * 16); o.bb3 = *(const GAS half8*)(bbp + 96 * 16);
}
DEV void s5_wave_scan(PRef P, int l, int z, int g, const S5Ops& o, float& hre, float& him, f16* hb, int lane, bool store) {
    const int lzg = (l * 2 + z) * 16 + g;
#pragma unroll
    for (int nt = 0; nt < 4; ++nt) {
        const half8 bb = nt == 0 ? o.bb0 : nt == 1 ? o.bb1 : nt == 2 ? o.bb2 : o.bb3;
#pragma unroll
        for (int mt = 0; mt < 2; ++mt) {
            floatx16 acc;
#pragma unroll
            for (int r = 0; r < 16; ++r) acc[r] = 0.f;
            acc = __builtin_amdgcn_mfma_f32_32x32x16_f16(mt == 0 ? o.au0 : o.au1, bb, acc, 0, 0, 0);
#pragma unroll
            for (int r = 0; r < 16; ++r) hb[(32 * mt + (r & 3) + 8 * (r >> 2) + 4 * (lane >> 5)) * HLD + 32 * nt + (lane & 31)] = (f16)acc[r];
        }
    }
    const GAS float* tb = P.s5par + (size_t)lzg * S5PW * 64 + lane;
    const float abr = tb[0], abi = tb[64];
#pragma unroll 1
    for (int s0 = 0; s0 < 64; s0 += 16) {
        float br[16], bi[16];
#pragma unroll
        for (int i = 0; i < 16; ++i) { const int tt = z ? 63 - (s0 + i) : s0 + i; br[i] = (float)hb[tt * HLD + lane]; bi[i] = (float)hb[tt * HLD + 64 + lane]; }
#pragma unroll
        for (int i = 0; i < 16; ++i) {
            const float nr = abr * hre - abi * him + br[i], ni = abr * him + abi * hre + bi[i];
            hre = nr; him = ni; br[i] = hre; bi[i] = him;
        }
        if (store) {
#pragma unroll
            for (int i = 0; i < 16; ++i) { const int tt = z ? 63 - (s0 + i) : s0 + i; hb[tt * HLD + lane] = (f16)br[i]; hb[tt * HLD + 64 + lane] = (f16)bi[i]; }
        }
    }
}
DEV void ph_s5_a(PRef P, int l, int bid, int nblk, unsigned char* smraw) {
    const int tid_ = ltid(); const int lane = tid_ & 63, wv = tid_ >> 6;
    f16* hb = (f16*)smraw + wv * 64 * HLD;
    constexpr int NI = 2 * 2 * 16 * NCHUNK;
    int item = bid * NW + wv;
    S5Ops nx;
    if (item < NI) { const int tc = item % NCHUNK, zbg = item / NCHUNK; s5_load(P, l, zbg >> 5, (zbg >> 4) & 1, zbg & 15, tc, lane, nx); }
    for (; item < NI; item += nblk * NW) {
        const int tc = item % NCHUNK, zbg = item / NCHUNK, g = zbg & 15, z = zbg >> 5;
        const S5Ops cur = nx;
        const int nitem = item + nblk * NW;
        if (nitem < NI) { const int tc2 = nitem % NCHUNK, zbg2 = nitem / NCHUNK; s5_load(P, l, zbg2 >> 5, (zbg2 >> 4) & 1, zbg2 & 15, tc2, lane, nx); }
        float hre = 0.f, him = 0.f;
        s5_wave_scan(P, l, z, g, cur, hre, him, hb, lane, false);
        const int ck = z ? mirror_chunk(tc) : tc;
        GAS float* ho = P.s5h + ((size_t)zbg * NCHUNK + ck) * 128;
        ho[lane] = hre; ho[64 + lane] = him;
    }
}
DEV void ph_s5_b(PRef P, int l, int bid, int nblk) {
    for (int idx = bid * NT + ltid(); idx < 2 * 2 * 16 * 64; idx += nblk * NT) {
        const int n = idx & 63, zbg = idx >> 6, g = zbg & 15, z = zbg >> 5;
        const GAS float* tb = P.s5par + (size_t)((l * 2 + z) * 16 + g) * S5PW * 64 + n;
        const float a64r = tb[34 * 64], a64i = tb[35 * 64];
        float hr = 0.f, hi = 0.f;
        GAS float* hp = P.s5h + (size_t)zbg * NCHUNK * 128 + n;
        for (int c0 = 0; c0 < NCHUNK; c0 += 20) {
            float lr[20], li[20];
#pragma unroll
            for (int i = 0; i < 20; ++i) { lr[i] = hp[(c0 + i) * 128]; li[i] = hp[(c0 + i) * 128 + 64]; }
#pragma unroll
            for (int i = 0; i < 20; ++i) {
                hp[(c0 + i) * 128] = hr; hp[(c0 + i) * 128 + 64] = hi;
                const float nr = a64r * hr - a64i * hi + lr[i], ni = a64r * hi + a64i * hr + li[i];
                hr = nr; hi = ni;
            }
        }
    }
}
DEV void ph_s5_c(PRef P, int l, int bid, int nblk, unsigned char* smraw) {
    const int tid = ltid(), lane = tid & 63, wv = tid >> 6, ci = wv >> 1, z = wv & 1;
    f16* base = (f16*)smraw;
    constexpr int NG = NCHUNK / 4, NI = 2 * 16 * NG;
    int it = bid; if (l == 1 && it < NI && it % NG == 0) it += nblk;
    S5Ops nx;
#define S5C_LOAD(it_, o_) { const int grp_ = (it_) % NG, bg_ = (it_) / NG, tc_ = grp_ * 4 + ci; \
        s5_load(P, l, z, bg_ >> 4, bg_ & 15, tc_, lane, o_); \
        const GAS float* hi_ = P.s5h + ((size_t)((z * 2 + (bg_ >> 4)) * 16 + (bg_ & 15)) * NCHUNK + (z ? mirror_chunk(tc_) : tc_)) * 128; \
        o_.hre = hi_[lane]; o_.him = hi_[64 + lane]; }
    if (it < NI) S5C_LOAD(it, nx);
    while (it < NI) {
        const int grp = it % NG, bg = it / NG, g = bg & 15, b = bg >> 4;
        const S5Ops cur = nx;
        int nit = it + nblk; if (l == 1 && nit < NI && nit % NG == 0) nit += nblk;
        if (nit < NI) S5C_LOAD(nit, nx);
        BAR_LDS();
        const int tc = grp * 4 + ci;
        {
            float hre = cur.hre, him = cur.him;
            s5_wave_scan(P, l, z, g, cur, hre, him, base + wv * 64 * HLD, lane, true);
        }
        BAR_LDS();
        {
            half8 bf[2][4];
#pragma unroll
            for (int z2 = 0; z2 < 2; ++z2)
#pragma unroll
                for (int ks = 0; ks < 4; ++ks) bf[z2][ks] = *(const half8*)(P.s5cc + ((size_t)((l * 2 + z2) * 16 + g) * 16 + (lane & 15)) * 128 + 32 * ks + 8 * (lane >> 4));
            const int pch = g * 16 + (lane & 15);
            const float dsk = P.s5_d[l * 256 + pch];
#pragma unroll
            for (int mi = 0; mi < 2; ++mi) {
                const int mt = 2 * z + mi;
                floatx4 acc = {0.f, 0.f, 0.f, 0.f};
#pragma unroll
                for (int z2 = 0; z2 < 2; ++z2) {
                    const f16* hbz = base + (2 * ci + z2) * 64 * HLD;
#pragma unroll
                    for (int ks = 0; ks < 4; ++ks) {
                        const half8 a = *(const half8*)(hbz + (16 * mt + (lane & 15)) * HLD + 32 * ks + 8 * (lane >> 4));
                        acc = __builtin_amdgcn_mfma_f32_16x16x32_f16(a, bf[z2][ks], acc, 0, 0, 0);
                    }
                }
#pragma unroll
                for (int r = 0; r < 4; ++r) {
                    const int tt = 16 * mt + (lane >> 4) * 4 + r; const int R = scan_row(0, b, tc * 64 + tt);
                    const float u = (float)P.p[(size_t)R * INW + 1664 + pch];
                    const float y = acc[r] + dsk * u;
                    P.yg[(size_t)R * 256 + pch] = (f16)(0.5f * y * (1.f + ftanh(0.7978845608028654f * (y + 0.044715f * y * y * y))));
                }
            }
        }
        it = nit;
    }
#undef S5C_LOAD
}

constexpr int NSC = TSCAN / 256;
constexpr int QLD = 104, SLD = 72;
constexpr int MLE = 97 * 96;
template <int KSTEPS>
DEV floatx16 mmh(const f16* A, int lda, int arow0, const f16* Bt, int ldb, int brow0, int lane, floatx16 acc) {
#pragma unroll
    for (int ks = 0; ks < KSTEPS; ++ks) {
        const half8 a = *(const half8*)(A + (arow0 + (lane & 31)) * lda + ks * 16 + (lane >> 5) * 8);
        const half8 b = *(const half8*)(Bt + (brow0 + (lane & 31)) * ldb + ks * 16 + (lane >> 5) * 8);
        acc = __builtin_amdgcn_mfma_f32_32x32x16_f16(a, b, acc, 0, 0, 0);
    }
    return acc;
}
DEV void ph_ml_a(PRef P, int l, int bid, int nblk, float* sm) {
    const int tid_ = ltid(); const int lane = tid_ & 63, wv = tid_ >> 6;
    float* gin = sm + 1152 * 20 + wv * 1152;
    __syncthreads();
    for (int idx = tid_; idx < 1152 * 16; idx += NT) {
        const int c = idx >> 4, o = idx & 15, z = o >> 3, hh = (o >> 1) & 3, which = o & 1;
        sm[c * 20 + o] = (which ? P.ml_wf : P.ml_wi)[((size_t)(l * 2 + z) * 1152 + c) * 4 + hh];
    }
    __syncthreads();
    const int lc = lane < 48 ? lane : 0;
    float cvb[8], cv0[8], cv1[8], cv2[8], bq[2][16], bk[2][16], bv[2][16];
#pragma unroll
    for (int i = 0; i < 8; ++i) { const int c = lc * 8 + i; cvb[i] = P.ml_conv_b[l * 384 + c]; cv0[i] = P.ml_conv_w[(l * 3 + 0) * 384 + c]; cv1[i] = P.ml_conv_w[(l * 3 + 1) * 384 + c]; cv2[i] = P.ml_conv_w[(l * 3 + 2) * 384 + c]; }
#pragma unroll
    for (int blk = 0; blk < 2; ++blk)
#pragma unroll
        for (int e = 0; e < 16; ++e) { const int wi = (l * 96 + lc * 2 + blk) * 16 + e; bq[blk][e] = P.ml_wq[wi]; bk[blk][e] = P.ml_wk[wi]; bv[blk][e] = P.ml_wv[wi]; }
    for (int R = bid * NW + wv; R < NROWS; R += nblk * NW) {
        if (lane < 48) {
            const int c0 = lane * 8;
            int t, len; if (R < NCTX) { t = R % CTX; len = CTX; } else { t = (R - NCTX) % SEQ; len = SEQ; }
            const half8 x0 = *(const half8*)(P.p + (size_t)R * INW + 2176 + c0);
            half8 xm_, xp_;
#pragma unroll
            for (int i = 0; i < 8; ++i) { xm_[i] = (f16)0.f; xp_[i] = (f16)0.f; }
            if (t > 0) xm_ = *(const half8*)(P.p + (size_t)(R - 1) * INW + 2176 + c0);
            if (t < len - 1) xp_ = *(const half8*)(P.p + (size_t)(R + 1) * INW + 2176 + c0);
            half8 hq, hk, hv;
#pragma unroll
            for (int blk = 0; blk < 2; ++blk) {
                float xc[4], xm[4];
#pragma unroll
                for (int i = 0; i < 4; ++i) {
                    xm[i] = (float)x0[4 * blk + i];
                    const float a = cvb[4 * blk + i] + cv1[4 * blk + i] * xm[i] + cv0[4 * blk + i] * (float)xm_[4 * blk + i] + cv2[4 * blk + i] * (float)xp_[4 * blk + i];
                    xc[i] = fsilu(a);
                }
#pragma unroll
                for (int i = 0; i < 4; ++i) {
                    float qq = 0.f, kk = 0.f, vv = 0.f;
#pragma unroll
                    for (int jj = 0; jj < 4; ++jj) {
                        qq += xc[jj] * bq[blk][jj * 4 + i]; kk += xc[jj] * bk[blk][jj * 4 + i]; vv += xm[jj] * bv[blk][jj * 4 + i];
                    }
                    const int c = c0 + 4 * blk + i;
                    gin[c] = qq; gin[384 + c] = kk; gin[768 + c] = vv;
                    hq[4 * blk + i] = (f16)qq; hk[4 * blk + i] = (f16)(kk * 0.10206207261596577f); hv[4 * blk + i] = (f16)vv;
                }
            }
            GAS f16* o = P.qkv16 + (size_t)R * 1152 + c0;
            *(half8*)o = hq; *(half8*)(o + 384) = hk; *(half8*)(o + 768) = hv;
        }
        float acc[16];
#pragma unroll
        for (int o = 0; o < 16; ++o) acc[o] = 0.f;
#pragma unroll 3
        for (int i = 0; i < 18; ++i) {
            const int c = lane + 64 * i;
            const float gval = gin[c];
            const float* wr = sm + c * 20;
            const floatx4 w0 = *(const floatx4*)wr, w1 = *(const floatx4*)(wr + 4), w2 = *(const floatx4*)(wr + 8), w3 = *(const floatx4*)(wr + 12);
#pragma unroll
            for (int o2 = 0; o2 < 4; ++o2) { acc[o2] += gval * w0[o2]; acc[4 + o2] += gval * w1[o2]; acc[8 + o2] += gval * w2[o2]; acc[12 + o2] += gval * w3[o2]; }
        }
        float mine = 0.f;
#pragma unroll
        for (int o = 0; o < 16; ++o) { const float s = wave_sum(acc[o]); if (lane == o) mine = s; }
        if (lane < 16) {
            const int z = lane >> 3, hh = (lane >> 1) & 3, which = lane & 1;
            const float val = mine + (which ? P.ml_bf : P.ml_bi)[(l * 2 + z) * 4 + hh];
            P.gates[(size_t)R * 16 + lane] = which ? log_sigmoidf_(val) : val;
        }
    }
}
DEV void ml_load_T(PRef P, int z, int b, int hh, int s0, const float* wgt, f16* VT, f16* KeT, int tid) {
#pragma unroll
    for (int i = 0; i < 3; ++i) {
        const int e = tid + NT * i, which = e / 768, rem = e % 768, c8 = rem >> 6, t = rem & 63;
        const int R = scan_row(z, b, s0 + t);
        const half8 x = *(const half8*)(P.qkv16 + (size_t)R * 1152 + (which ? 384 : 768) + hh * 96 + c8 * 8);
        if (which == 0) {
#pragma unroll
            for (int j = 0; j < 8; ++j) VT[(c8 * 8 + j) * SLD + t] = x[j];
        } else {
            const float w = wgt[t];
#pragma unroll
            for (int j = 0; j < 8; ++j) KeT[(c8 * 8 + j) * SLD + t] = (f16)((float)x[j] * w);
        }
    }
}
constexpr int ML_VT_OFF = 0, ML_KE_OFF = 128 * SLD, ML_QS_OFF = ML_KE_OFF + 96 * SLD, ML_KS_OFF = ML_QS_OFF + 64 * QLD, ML_C16_OFF = ML_KS_OFF + 64 * QLD,
              ML_AM_OFF = ML_C16_OFF + 128 * QLD, ML_F_OFF_BYTES = (ML_AM_OFF + 64 * SLD) * 2;
constexpr int ML_LDS_BYTES = ML_F_OFF_BYTES + 320 * 4;
DEV void ph_ml_1(PRef P, int l, int bid, int nblk, unsigned char* smraw) {
    f16* VT = (f16*)smraw + ML_VT_OFF; f16* KeT = (f16*)smraw + ML_KE_OFF; float* fb = (float*)(smraw + ML_F_OFF_BYTES);
    for (int item = bid; item < 16 * NSC; item += nblk) {
        const int tid = ltid(), lane = tid & 63, wv = tid >> 6;
        const int chain = item / NSC, sc = item % NSC, z = chain / 8, b = (chain / 4) % 2, hh = chain % 4;
        BAR_LDS();
        for (int idx = tid; idx < 32 * SLD; idx += NT) VT[96 * SLD + idx] = (f16)((idx < SLD) ? 1.f : 0.f);
        float x = 0.f, li = 0.f;
        if (tid < 256) {
            const int R = scan_row(z, b, sc * 256 + tid);
            li = P.gates[(size_t)R * 16 + z * 8 + hh * 2]; x = P.gates[(size_t)R * 16 + z * 8 + hh * 2 + 1];
#pragma unroll
            for (int o = 1; o < 64; o <<= 1) { const float y = __shfl_up(x, o); if (lane >= o) x += y; }
            if (lane == 63) fb[256 + wv] = x;
        }
        BAR_LDS();
        if (tid < 256) {
            float off = 0.f, tot = 0.f;
#pragma unroll
            for (int w = 0; w < 4; ++w) { const float q = fb[256 + w]; tot += q; if (w < wv) off += q; }
            fb[tid] = __expf(li + tot - (x + off));
            if (tid == 0) P.mlG[item] = __expf(tot);
        }
        floatx16 c0, c1, c2;
#pragma unroll
        for (int r = 0; r < 16; ++r) { c0[r] = 0.f; c1[r] = 0.f; c2[r] = 0.f; }
#pragma unroll 1
        for (int cc = 0; cc < 4; ++cc) {
            BAR_LDS();
            ml_load_T(P, z, b, hh, sc * 256 + cc * 64, fb + cc * 64, VT, KeT, tid);
            BAR_LDS();
            if (wv < 4) {
                c0 = mmh<4>(VT, SLD, 32 * wv, KeT, SLD, 0, lane, c0);
                c1 = mmh<4>(VT, SLD, 32 * wv, KeT, SLD, 32, lane, c1);
                c2 = mmh<4>(VT, SLD, 32 * wv, KeT, SLD, 64, lane, c2);
            }
        }
        if (wv < 4) {
            GAS float* dst = P.mlC + (size_t)item * MLE;
#pragma unroll
            for (int r = 0; r < 16; ++r) {
                const int v = 32 * wv + (r & 3) + 8 * (r >> 2) + 4 * (lane >> 5), k = lane & 31;
                if (v <= 96) { dst[v * 96 + k] = c0[r]; dst[v * 96 + 32 + k] = c1[r]; dst[v * 96 + 64 + k] = c2[r]; }
            }
        }
    }
}
DEV void ph_ml_2(PRef P, int bid, int nblk) {
    for (int idx = bid * NT + ltid(); idx < 16 * MLE; idx += nblk * NT) {
        const int chain = idx / MLE, e = idx % MLE; float run = 0.f;
        for (int s0 = 0; s0 < NSC; s0 += 13) {
            float loc[13], gg[13];
#pragma unroll
            for (int i = 0; i < 13; ++i) { loc[i] = P.mlC[((size_t)chain * NSC + s0 + i) * MLE + e]; gg[i] = P.mlG[chain * NSC + s0 + i]; }
#pragma unroll
            for (int i = 0; i < 13; ++i) { P.mlC[((size_t)chain * NSC + s0 + i) * MLE + e] = run; run = gg[i] * run + loc[i]; }
        }
    }
}
DEV void ph_ml_3(PRef P, int l, int bid, int nblk, unsigned char* smraw) {
    f16* sh = (f16*)smraw;
    f16 *VT = sh + ML_VT_OFF, *KeT = sh + ML_KE_OFF, *Qs = sh + ML_QS_OFF, *Ks = sh + ML_KS_OFF, *C16 = sh + ML_C16_OFF, *Am = sh + ML_AM_OFF;
    float* fb = (float*)(smraw + ML_F_OFF_BYTES);
    for (int item = bid; item < 16 * NSC; item += nblk) {
        const int tid = ltid(), lane = tid & 63, wv = tid >> 6, w4 = wv & 3, wm = w4 & 1, wn = w4 >> 1;
        const int chain = item / NSC, sc = item % NSC, z = chain / 8, b = (chain / 4) % 2, hh = chain % 4;
        if (l == 1 && sc == 0) continue;
        BAR_LDS();
        for (int idx = tid; idx < 32 * SLD; idx += NT) VT[96 * SLD + idx] = (f16)((idx < SLD) ? 1.f : 0.f);
        floatx16 c0, c1, c2;
#pragma unroll
        for (int r = 0; r < 16; ++r) { c0[r] = 0.f; c1[r] = 0.f; c2[r] = 0.f; }
        if (wv < 4) {
            const GAS float* srcC = P.mlC + (size_t)item * MLE;
#pragma unroll
            for (int r = 0; r < 16; ++r) {
                const int v = 32 * wv + (r & 3) + 8 * (r >> 2) + 4 * (lane >> 5), k = lane & 31;
                const bool ok = v <= 96;
                c0[r] = ok ? srcC[v * 96 + k] : 0.f; c1[r] = ok ? srcC[v * 96 + 32 + k] : 0.f; c2[r] = ok ? srcC[v * 96 + 64 + k] : 0.f;
            }
        }
#pragma unroll 1
        for (int cc = 0; cc < 4; ++cc) {
            const int s0 = sc * 256 + cc * 64;
            BAR_LDS();
            if (wv == 7) {
                const int R = scan_row(z, b, s0 + lane);
                const float li = P.gates[(size_t)R * 16 + z * 8 + hh * 2], lf = P.gates[(size_t)R * 16 + z * 8 + hh * 2 + 1];
                float F = lf;
#pragma unroll
                for (int o = 1; o < 64; o <<= 1) { const float y = __shfl_up(F, o); if (lane >= o) F += y; }
                const float FL = __shfl(F, 63);
                fb[lane] = __expf(F); fb[64 + lane] = __expf(fminf(li - F, 10.f)); fb[128 + lane] = __expf(li + FL - F);
                if (lane == 63) fb[192] = __expf(FL);
            }
            if (wv < 4) {
#pragma unroll
                for (int r = 0; r < 16; ++r) {
                    const int v = 32 * wv + (r & 3) + 8 * (r >> 2) + 4 * (lane >> 5), k = lane & 31;
                    C16[v * QLD + k] = (f16)c0[r]; C16[v * QLD + 32 + k] = (f16)c1[r]; C16[v * QLD + 64 + k] = (f16)c2[r];
                }
            }
            BAR_LDS();
#pragma unroll
            for (int i = 0; i < 3; ++i) {
                const int e = tid + NT * i, which = e / 768, rem = e % 768, t = rem / 12, c8 = rem % 12;
                const int R = scan_row(z, b, s0 + t);
                const half8 x = *(const half8*)(P.qkv16 + (size_t)R * 1152 + (which ? 384 : 0) + hh * 96 + c8 * 8);
                const float w = which ? fb[64 + t] : fb[t];
                half8 y;
#pragma unroll
                for (int jj = 0; jj < 8; ++jj) y[jj] = (f16)((float)x[jj] * w);
                *(half8*)((which ? Ks : Qs) + t * QLD + c8 * 8) = y;
            }
            ml_load_T(P, z, b, hh, s0, fb + 128, VT, KeT, tid);
            BAR_LDS();
            if (wv >= 4) {
#pragma unroll
                for (int r = 0; r < 16; ++r) c2[r] = 0.f;
                if (!(wm == 0 && wn == 1)) c2 = mmh<6>(Qs, QLD, wm * 32, Ks, QLD, wn * 32, lane, c2);
#pragma unroll
                for (int r = 0; r < 16; ++r) {
                    const int m = wm * 32 + (r & 3) + 8 * (r >> 2) + 4 * (lane >> 5), n = wn * 32 + (lane & 31);
                    Am[m * SLD + n] = (f16)(n <= m ? c2[r] : 0.f);
                }
            } else {
                const float gL = fb[192];
#pragma unroll
                for (int r = 0; r < 16; ++r) { c0[r] *= gL; c1[r] *= gL; c2[r] *= gL; }
                c0 = mmh<4>(VT, SLD, 32 * wv, KeT, SLD, 0, lane, c0); __builtin_amdgcn_sched_barrier(0);
                c1 = mmh<4>(VT, SLD, 32 * wv, KeT, SLD, 32, lane, c1); __builtin_amdgcn_sched_barrier(0);
                c2 = mmh<4>(VT, SLD, 32 * wv, KeT, SLD, 64, lane, c2);
            }
            BAR_LDS();
            if (wv >= 4) {
#pragma unroll
                for (int r = 0; r < 16; ++r) { c0[r] = 0.f; c1[r] = 0.f; }
                c0 = mmh<4>(Am, SLD, 0, VT, SLD, 32 * w4, lane, c0); __builtin_amdgcn_sched_barrier(0); c0 = mmh<6>(Qs, QLD, 0, C16, QLD, 32 * w4, lane, c0); __builtin_amdgcn_sched_barrier(0);
                c1 = mmh<4>(Am, SLD, 32, VT, SLD, 32 * w4, lane, c1); __builtin_amdgcn_sched_barrier(0); c1 = mmh<6>(Qs, QLD, 32, C16, QLD, 32 * w4, lane, c1); __builtin_amdgcn_sched_barrier(0);
                if (wv == 7 && (lane & 31) == 0) {
#pragma unroll
                    for (int r = 0; r < 16; ++r) { const int t = (r & 3) + 8 * (r >> 2) + 4 * (lane >> 5); fb[256 + t] = c0[r]; fb[256 + 32 + t] = c1[r]; }
                }
            }
            BAR_LDS();
            if (wv >= 4 && wv < 7) {
#pragma unroll
                for (int r = 0; r < 16; ++r) {
                    const int t = (r & 3) + 8 * (r >> 2) + 4 * (lane >> 5);
                    const int R0 = scan_row(z, b, s0 + t), R1 = scan_row(z, b, s0 + 32 + t);
                    const float d0 = fmaxf(fabsf(fb[256 + t]), 1.f), d1 = fmaxf(fabsf(fb[256 + 32 + t]), 1.f);
                    P.Yh[((size_t)z * NROWS + R0) * 384 + hh * 96 + 32 * w4 + (lane & 31)] = (f16)(c0[r] * frcp(d0));
                    P.Yh[((size_t)z * NROWS + R1) * 384 + hh * 96 + 32 * w4 + (lane & 31)] = (f16)(c1[r] * frcp(d1));
                    if ((r & 3) == 3) __builtin_amdgcn_sched_barrier(0);
                }
            }
        }
    }
}
DEV void ph_ml_fin2(PRef P, int l, int bid, int nblk, bool dry = false) {
    typedef _Float16 half2_ __attribute__((ext_vector_type(2)));
    const int tid_ = ltid(); const int lane = tid_ & 63, wv = tid_ >> 6;
    const int c0 = lane * 6;
    float ng[6], sk[6], cb[6], w0[6], w1[6], w2[6];
#pragma unroll
    for (int i = 0; i < 6; ++i) {
        ng[i] = P.ml_norm_g[l * 384 + c0 + i]; sk[i] = P.ml_skip[l * 384 + c0 + i]; cb[i] = P.ml_conv_b[l * 384 + c0 + i];
        w0[i] = P.ml_conv_w[(l * 3 + 0) * 384 + c0 + i]; w1[i] = P.ml_conv_w[(l * 3 + 1) * 384 + c0 + i]; w2[i] = P.ml_conv_w[(l * 3 + 2) * 384 + c0 + i];
    }
    for (int R = (l == 1 ? NCTX : 0) + bid * NW + wv; R < NROWS; R += nblk * NW) {
        int t, len; if (R < NCTX) { t = R % CTX; len = CTX; } else { t = (R - NCTX) % SEQ; len = SEQ; }
        float y[6], xm[6], xa[6], xb[6], zg[6]; float s = 0.f;
#pragma unroll
        for (int i = 0; i < 3; ++i) {
            const half2_ a = *(const GAS half2_*)(P.Yh + (size_t)R * 384 + c0 + 2 * i), b2 = *(const GAS half2_*)(P.Yh + ((size_t)NROWS + R) * 384 + c0 + 2 * i);
            const half2_ m = *(const GAS half2_*)(P.p + (size_t)R * INW + 2176 + c0 + 2 * i), zz = *(const GAS half2_*)(P.p + (size_t)R * INW + 2560 + c0 + 2 * i);
            half2_ pa, pb; pa[0] = (f16)0.f; pa[1] = (f16)0.f; pb = pa;
            if (t > 0) pa = *(const GAS half2_*)(P.p + (size_t)(R - 1) * INW + 2176 + c0 + 2 * i);
            if (t < len - 1) pb = *(const GAS half2_*)(P.p + (size_t)(R + 1) * INW + 2176 + c0 + 2 * i);
#pragma unroll
            for (int e = 0; e < 2; ++e) {
                y[2 * i + e] = (float)a[e] + (float)b2[e]; s += y[2 * i + e];
                xm[2 * i + e] = (float)m[e]; xa[2 * i + e] = (float)pa[e]; xb[2 * i + e] = (float)pb[e]; zg[2 * i + e] = (float)zz[e];
            }
        }
        s = row16_sum(s);
        const float mu = s * (1.f / 96.f); float q = 0.f;
#pragma unroll
        for (int i = 0; i < 6; ++i) { y[i] -= mu; q += y[i] * y[i]; }
        q = row16_sum(q);
        const float rs = __builtin_amdgcn_rsqf(q * (1.f / 96.f) + 1e-6f);
#pragma unroll
        for (int i = 0; i < 3; ++i) {
            half2_ o;
#pragma unroll
            for (int e = 0; e < 2; ++e) {
                const int k = 2 * i + e;
                const float xc = fsilu(cb[k] + w1[k] * xm[k] + w0[k] * xa[k] + w2[k] * xb[k]);
                o[e] = (f16)((y[k] * rs * ng[k] + sk[k] * xc) * fsilu(zg[k]));
            }
            if (!dry) *(GAS half2_*)(P.p + (size_t)R * INW + 2560 + c0 + 2 * i) = o; else *(GAS half2_*)(P.rwm + (size_t)R * 384 + c0 + 2 * i) = o;
        }
    }
}

#define XB_TMO      128
#define XB_XCNT(j)  (256  + 64 * (j))
#define XB_XSUB(j)  (1280 + 64 * (j))
#define XB_XGEN(j)  (2304 + 64 * (j))
#define XB_TOP      3328
#define XB_TOPGEN   3392
#define XCD_BAR_WORDS 3456
#define XB_SPIN_CAP (1u << 22)
#define LAS __attribute__((address_space(3)))
DEV unsigned xb_ld(GAS unsigned* p)              { return __hip_atomic_load(p, __ATOMIC_RELAXED, __HIP_MEMORY_SCOPE_AGENT); }
DEV unsigned xb_add(GAS unsigned* p, unsigned v) { return __hip_atomic_fetch_add(p, v, __ATOMIC_RELAXED, __HIP_MEMORY_SCOPE_AGENT); }
DEV unsigned xb_xcc_id() { return (unsigned)__builtin_amdgcn_s_getreg((3 << 11) | 20) & 0xFu; }
#define XB_SPIN(cond, bar) do { unsigned _sp = 0; while (cond) { __builtin_amdgcn_s_sleep(1); \
    if ((++_sp & 255u) == 0u) { if (xb_ld(&(bar)[XB_TMO])) break; if (_sp > XB_SPIN_CAP) { (void)xb_add(&(bar)[XB_TMO], 1u); break; } } } } while (0)
struct XcdBarrier { GAS unsigned* bar; unsigned x; volatile LAS unsigned* st; };
DEV XcdBarrier xcd_barrier_post(GAS unsigned* bar, volatile LAS unsigned* st) {
    XcdBarrier b; b.bar = bar; b.x = xb_xcc_id(); b.st = st;
    if (threadIdx.x == 0) (void)xb_add(&bar[XB_XCNT(b.x)], 1u);
    return b;
}
DEV void xcd_barrier_complete(GAS unsigned* bar, unsigned x, unsigned& nloc, unsigned& nx) {
    const unsigned G = gridDim.x * gridDim.y * gridDim.z;
    unsigned sum, cnt, mine, sp = 0u;
    for (;;) {
        sum = 0u; cnt = 0u; mine = 0u;
#pragma unroll
        for (unsigned j = 0; j < 16; ++j) { const unsigned c = xb_ld(&bar[XB_XCNT(j)]); sum += c; cnt += (c > 0u) ? 1u : 0u; mine = (j == x) ? c : mine; }
        if (sum == G) break;
        __builtin_amdgcn_s_sleep(1);
        if ((++sp & 255u) == 0u) { if (xb_ld(&bar[XB_TMO])) break; if (sp > XB_SPIN_CAP) { (void)xb_add(&bar[XB_TMO], 1u); break; } }
    }
    nloc = mine > 0u ? mine : 1u; nx = cnt > 0u ? cnt : 1u;
}
DEV void xcd_barrier(const XcdBarrier& b, GAS unsigned* bar_) {
    asm volatile("s_waitcnt vmcnt(0)" ::: "memory");
    __syncthreads();
    if (threadIdx.x == 0) {
        GAS unsigned* bar = bar_;
        __builtin_amdgcn_s_waitcnt(0);
        unsigned nloc = b.st[0], nx = b.st[1];
        if (nloc == 0u) { xcd_barrier_complete(bar, b.x, nloc, nx); b.st[0] = nloc; b.st[1] = nx; }
        const unsigned old = xb_add(&bar[XB_XSUB(b.x)], 1u);
        const unsigned gen = old / nloc;
        if (old + 1u == (gen + 1u) * nloc) {
            __builtin_amdgcn_fence(__ATOMIC_RELEASE, "agent");
            asm volatile("s_waitcnt vmcnt(0)" ::: "memory");
            const unsigned og = xb_add(&bar[XB_TOP], 1u);
            const unsigned tg = og / nx;
            if (og + 1u == (tg + 1u) * nx) xb_add(&bar[XB_TOPGEN], 1u);
            else XB_SPIN(xb_ld(&bar[XB_TOPGEN]) == tg, bar);
            __builtin_amdgcn_fence(__ATOMIC_ACQUIRE, "agent");
            xb_add(&bar[XB_XGEN(b.x)], 1u);
            asm volatile("s_waitcnt vmcnt(0)" ::: "memory");
        } else {
            XB_SPIN(xb_ld(&bar[XB_XGEN(b.x)]) == gen, bar);
            __builtin_amdgcn_fence(__ATOMIC_ACQUIRE, "agent");
            asm volatile("s_waitcnt vmcnt(0)" ::: "memory");
        }
    }
    __syncthreads();
}


DEV void sub_barrier(GAS unsigned* cnt, unsigned nmemb, unsigned round) {
    asm volatile("s_waitcnt vmcnt(0)" ::: "memory");
    __syncthreads();
    if (threadIdx.x == 0) {
        __builtin_amdgcn_fence(__ATOMIC_RELEASE, "agent");
        asm volatile("s_waitcnt vmcnt(0)" ::: "memory");
        (void)xb_add(cnt, 1u);
        unsigned sp = 0;
        while (xb_ld(cnt) < nmemb * round) { __builtin_amdgcn_s_sleep(1); if (++sp > (1u << 24)) break; }
        __builtin_amdgcn_fence(__ATOMIC_ACQUIRE, "agent");
        asm volatile("s_waitcnt vmcnt(0)" ::: "memory");
    }
    __syncthreads();
}

constexpr size_t al256(size_t x) { return (x + 255) & ~(size_t)255; }
constexpr size_t WS_MODS = 0;
constexpr size_t WS_P = al256(WS_MODS + 2 * 3 * 3072 * 4);
constexpr size_t WS_Y = al256(WS_P + (size_t)NROWS * INW * 2);
constexpr size_t WS_Q = al256(WS_Y + (size_t)2 * NROWS * 384 * 4);
constexpr size_t WS_Q_BYTES = (size_t)NROWS * 1152 * 4;
constexpr size_t WS_GATES = al256(WS_Q + WS_Q_BYTES);
constexpr size_t WS_BON = al256(WS_GATES + (size_t)NROWS * 16 * 4);
constexpr size_t WS_YG = al256(WS_BON + (size_t)2 * NROWS * 6 * 4);
constexpr size_t WS_S5H = al256(WS_YG + (size_t)NROWS * 256 * 2);
constexpr size_t WS_S5PAR = al256(WS_S5H + (size_t)64 * NCHUNK * 128 * 4);
constexpr size_t WS_S5BB = al256(WS_S5PAR + (size_t)64 * S5PW * 64 * 4);
constexpr size_t WS_S5CC = al256(WS_S5BB + (size_t)64 * 128 * 16 * 2);
constexpr size_t WS_GLUT = al256(WS_S5CC + (size_t)64 * 16 * 128 * 2);
constexpr size_t WS_CTX1 = al256(WS_GLUT + (size_t)2 * 256 * 256 * 2);
constexpr size_t WS_WTIN = al256(WS_CTX1 + (size_t)NCTX * D * 4);
constexpr size_t WS_WTOUT = al256(WS_WTIN + (size_t)2 * INW * D * 2);
constexpr size_t WS_RWLT = al256(WS_WTOUT + (size_t)2 * D * D * 2);
constexpr size_t WS_GP = al256(WS_RWLT + (size_t)2 * 2 * 2 * 384 * 32 * 2);
constexpr size_t WS_XBAR = al256(WS_GP + 1024);
constexpr size_t WS_END = al256(WS_XBAR + (XCD_BAR_WORDS + 256) * 4);
static_assert(3 * RWM_STRIDE * 2 <= WS_Q_BYTES, "rwkv chunk matrices");
static_assert(al256((size_t)NROWS * 1152 * 2) + al256((size_t)16 * NSC * MLE * 4) + 16 * NSC * 4 <= WS_Q_BYTES, "ml region");

static void fill_params(Params& P, void* const* d_in, void* d_out, void* d_ws) {
    const GAS float** pp = (const GAS float**)&P;
    for (int i = 0; i < 41; ++i) pp[i] = (const GAS float*)d_in[i];
    unsigned char* ws = (unsigned char*)d_ws;
    P.out = (GAS float*)d_out;
    P.mods = (GAS float*)(ws + WS_MODS); P.p = (GAS f16*)(ws + WS_P); P.Yh = (GAS f16*)(ws + WS_Y);
    P.gates = (GAS float*)(ws + WS_GATES); P.bon = (GAS float*)(ws + WS_BON); P.ctx1 = (GAS float*)(ws + WS_CTX1);
    P.hx = (GAS f16*)(ws + WS_Q); P.rwm = (GAS f16*)(ws + WS_Q); P.qkv16 = (GAS f16*)(ws + WS_Q);
    P.mlC = (GAS float*)(ws + WS_Q + al256((size_t)NROWS * 1152 * 2)); P.mlG = (GAS float*)(ws + WS_Q + al256((size_t)NROWS * 1152 * 2) + al256((size_t)16 * NSC * MLE * 4));
    P.wt_in = (GAS f16*)(ws + WS_WTIN); P.wt_out = (GAS f16*)(ws + WS_WTOUT); P.glut = (GAS f16*)(ws + WS_GLUT);
    P.yg = (GAS f16*)(ws + WS_YG); P.s5h = (GAS float*)(ws + WS_S5H); P.s5par = (GAS float*)(ws + WS_S5PAR); P.s5bb = (GAS f16*)(ws + WS_S5BB); P.s5cc = (GAS f16*)(ws + WS_S5CC);
    P.rwlt = (GAS bf16*)(ws + WS_RWLT); P.gp = (GAS Params*)(ws + WS_GP); P.xbar = (GAS unsigned*)(ws + WS_XBAR);
}

constexpr int cmax(int a, int b) { return a > b ? a : b; }
constexpr int MEGA_LDS_BYTES = cmax(cmax(RWP1_LDS_BYTES, S5_LDS_BYTES), cmax(cmax(GEMM_LDS_BYTES, ML_LDS_BYTES), (1152 * 20 + NW * 1152) * 4));

__global__ void __launch_bounds__(NT) mega_fwd(Params Pk) {
    __shared__ __attribute__((aligned(16))) unsigned char smraw[MEGA_LDS_BYTES + 16];
    float* sm = (float*)smraw;
    cg::grid_group grid = cg::this_grid();
    const int bid = blockIdx.x, nblk = gridDim.x;
    if (threadIdx.x == 0) {
        GAS unsigned long long* dstw = (GAS unsigned long long*)Pk.gp; const unsigned long long* srcw = (const unsigned long long*)&Pk;
#pragma unroll
        for (int i = 0; i < (int)(sizeof(Params) / 8); ++i) dstw[i] = srcw[i];
        *(uintx4*)(smraw + MEGA_LDS_BYTES) = (uintx4){0u, 0u, 0u, 0u};
    }
    asm volatile("s_waitcnt vmcnt(0)" ::: "memory");
    __syncthreads();
    const XcdBarrier xb = xcd_barrier_post(Pk.xbar, (volatile LAS unsigned*)(smraw + MEGA_LDS_BYTES));
    const GAS Params* pg = Pk.gp;
    asm volatile("" : "+s"(pg) :: "memory");
    PRef P = *pg;
    ph_mods2(P, lsgpr(bid), nblk, sm);
    ph_wprep(P, lsgpr(bid), nblk, sm);
    ph_tables(P, lsgpr(bid), nblk);
    grid.sync();
    for (int l = 0; l < 2; ++l) {
        for (int rep = 0; rep < REP_HX; ++rep) ph_hx(P, l, lsgpr(bid), nblk);
        xcd_barrier(xb, P.xbar);
        for (int rep = 0; rep < REP_G1; ++rep) ph_gemm_mfma<1>(P, l, lsgpr(bid), nblk, smraw, rep + 1 < REP_G1);
        for (int rep = 0; rep < REP_SYNC; ++rep) xcd_barrier(xb, P.xbar);
        for (int rep = 0; rep < REP_P1; ++rep) ph_rw_p1(P, l, lsgpr(bid), nblk, smraw);
        for (int rep = 0; rep < REP_S5A; ++rep) ph_s5_a(P, l, lsgpr(bid), nblk, smraw);
        xcd_barrier(xb, P.xbar);
        if (bid < 96) {
            for (int rep = 0; rep < REP_ST; ++rep) ph_rw_stream(P, l, lsgpr(bid), 96, smraw, rep + 1 < REP_ST);
        } else {
            ph_s5_b(P, l, lsgpr(bid) - 96, nblk - 96);
            sub_barrier(P.xbar + 3456 + 64, nblk - 96, 1u + l);
            for (int rep = 0; rep < REP_S5C; ++rep) ph_s5_c(P, l, lsgpr(bid) - 96, nblk - 96, smraw);
        }
        xcd_barrier(xb, P.xbar);
        for (int rep = 0; rep < REP_RWF; ++rep) ph_rwkv_fin2(P, l, lsgpr(bid), nblk, rep + 1 < REP_RWF);
        ph_gemm_mfma<3>(P, l, lsgpr(bid), nblk, smraw);
        for (int rep = 0; rep < REP_MLA; ++rep) ph_ml_a(P, l, lsgpr(bid), nblk, sm);
        xcd_barrier(xb, P.xbar);
        for (int rep = 0; rep < REP_ML1; ++rep) ph_ml_1(P, l, lsgpr(bid), nblk, smraw);
        xcd_barrier(xb, P.xbar);
        ph_ml_2(P, lsgpr(bid), nblk);
        xcd_barrier(xb, P.xbar);
        for (int rep = 0; rep < REP_ML3; ++rep) ph_ml_3(P, l, lsgpr(bid), nblk, smraw);
        xcd_barrier(xb, P.xbar);
        for (int rep = 0; rep < REP_MLF; ++rep) ph_ml_fin2(P, l, lsgpr(bid), nblk, rep + 1 < REP_MLF);
        xcd_barrier(xb, P.xbar);
        for (int rep = 0; rep < (l == 0 ? REP_G2 : 1); ++rep) ph_gemm_mfma<2>(P, l, lsgpr(bid), nblk, smraw);
        xcd_barrier(xb, P.xbar);
    }
    ph_final2(P, lsgpr(bid), nblk);
}

extern "C" void kernel_launch(void* const* d_in, const int* in_sizes, int n_in, void* d_out, int out_size, void* d_ws, size_t ws_size, hipStream_t stream) {
    if (ws_size < WS_END) { fprintf(stderr, "workspace too small: %zu < %zu\n", ws_size, (size_t)WS_END); return; }
    static int grid_blocks = 0;
    if (!grid_blocks) {
        int dev = 0, cus = 0, per_cu = 0;
        hipGetDevice(&dev);
        hipDeviceGetAttribute(&cus, hipDeviceAttributeMultiprocessorCount, dev);
        hipOccupancyMaxActiveBlocksPerMultiprocessor(&per_cu, mega_fwd, NT, 0);
        if (per_cu < 1) per_cu = 1;
        grid_blocks = cus * per_cu;
        fprintf(stderr, "mega_fwd: %d CUs x %d blocks/CU\n", cus, per_cu);
    }
    Params P{};
    fill_params(P, d_in, d_out, d_ws);
    hipMemsetAsync((unsigned char*)d_ws + WS_XBAR, 0, (XCD_BAR_WORDS + 256) * 4, stream);
    void* args[] = {&P};
    hipError_t e = hipLaunchCooperativeKernel((void*)mega_fwd, dim3(grid_blocks), dim3(NT), args, 0, stream);
    if (e != hipSuccess) fprintf(stderr, "cooperative launch failed: %s (grid %d)\n", hipGetErrorString(e), grid_blocks);
}
```

```cpp
#include <hip/hip_runtime.h>
#include <hip/hip_cooperative_groups.h>
#include <cstdint>
#include <cmath>
#include <cstdio>
namespace cg = cooperative_groups;

#ifndef SEQ
#define SEQ 16384
#endif
#ifndef CTX
#define CTX 256
#endif
#ifndef REP_G1
#define REP_G1 1
#endif
#ifndef REP_G2
#define REP_G2 1
#endif
#ifndef REP_P1
#define REP_P1 1
#endif
#ifndef REP_S5A
#define REP_S5A 1
#endif
#ifndef REP_S5C
#define REP_S5C 1
#endif
#ifndef REP_MLA
#define REP_MLA 1
#endif
#ifndef REP_ML1
#define REP_ML1 1
#endif
#ifndef REP_ML3
#define REP_ML3 1
#endif
#ifndef REP_HX
#define REP_HX 1
#endif
#ifndef REP_ST
#define REP_ST 1
#endif
#ifndef REP_RWF
#define REP_RWF 1
#endif
#ifndef REP_MLF
#define REP_MLF 1
#endif
#ifndef REP_G3
#define REP_G3 1
#endif
#ifndef ST_VARIANT
#define ST_VARIANT 0
#endif
#ifndef G_VARIANT
#define G_VARIANT 0
#endif
#ifndef REP_SYNC
#define REP_SYNC 1
#endif

typedef _Float16 f16;
typedef __bf16 bf16;
typedef _Float16 half8 __attribute__((ext_vector_type(8)));
typedef _Float16 half4 __attribute__((ext_vector_type(4)));
typedef __bf16 bf16x8 __attribute__((ext_vector_type(8)));
typedef __bf16 bf16x4 __attribute__((ext_vector_type(4)));
typedef float floatx16 __attribute__((ext_vector_type(16)));
typedef float floatx4 __attribute__((ext_vector_type(4)));
typedef unsigned uintx4 __attribute__((ext_vector_type(4)));

constexpr int D = 1024, NB = 2, INW = 2944;
constexpr int NCTX = NB * CTX, NLAT = NB * SEQ, NROWS = NCTX + NLAT;
constexpr int TSCAN = CTX + SEQ, NCHUNK = TSCAN / 64;
constexpr int NT = 512, NW = NT / 64;
#define DEV __device__ __forceinline__
#define LAS __attribute__((address_space(3)))
#define GAS __attribute__((address_space(1)))
#define BAR_LDS() asm volatile("s_waitcnt lgkmcnt(0)\n\ts_barrier" ::: "memory")

DEV int ltid(int wvs) { int lane; asm volatile("v_mbcnt_lo_u32_b32 %0, -1, 0\n\tv_mbcnt_hi_u32_b32 %0, -1, %0" : "=v"(lane)); return (wvs << 6) | lane; }
DEV int lsgpr(int x) { asm volatile("" : "+s"(x)); return x; }

struct Params;
typedef const GAS Params& PRef;
struct Params {
    const GAS float *x, *c, *ctx, *c_ctx, *ada_w, *ada_b, *norm_g, *w_in, *w_out;
    const GAS float *rw_mu, *rw_w0, *rw_w_up, *rw_a0, *rw_a_up, *rw_k_k, *rw_k_a, *rw_r_k, *rw_ln_g, *rw_ln_b;
    const GAS float *s5_a_re, *s5_a_im, *s5_log_dt, *s5_b_re, *s5_b_im, *s5_c_re, *s5_c_im, *s5_d, *s5_glu_w, *s5_glu_b;
    const GAS float *ml_conv_w, *ml_conv_b, *ml_wq, *ml_wk, *ml_wv, *ml_wi, *ml_bi, *ml_wf, *ml_bf, *ml_norm_g, *ml_skip;
    const GAS float* final_g;
    GAS float* out;
    GAS float* mods;
    GAS f16* p;
    GAS f16* Yh;
    GAS float* gates;
    GAS float* bon;
    GAS float* ctx1;
    GAS f16* hx;
    GAS f16* rwm;
    GAS f16* qkv16;
    GAS float* mlC;
    GAS float* mlG;
    GAS f16* wt_in;
    GAS f16* wt_out;
    GAS f16* glut;
    GAS f16* yg;
    GAS float* s5h;
    GAS float* s5par;
    GAS f16* s5bb;
    GAS f16* s5cc;
    GAS bf16* rwlt;
    GAS unsigned* xbar;
    GAS Params* gp;
};

DEV float sigmoidf_(float x) { return 1.f / (1.f + expf(-x)); }
DEV float siluf_(float x) { return x / (1.f + expf(-x)); }
DEV float frcp(float x) { return __builtin_amdgcn_rcpf(x); }
DEV float fsigmoid(float x) { return frcp(1.f + __expf(-x)); }
DEV float fsilu(float x) { return x * frcp(1.f + __expf(-x)); }
DEV float ftanh(float x) { x = fminf(fmaxf(x, -15.f), 15.f); const float e = __expf(2.f * x); return (e - 1.f) * frcp(e + 1.f); }
DEV float log_sigmoidf_(float x) { return fminf(x, 0.f) - log1pf(expf(-fabsf(x))); }
template <int CTRL> DEV float dpp_f(float v) { return __builtin_bit_cast(float, __builtin_amdgcn_update_dpp(0, __builtin_bit_cast(int, v), CTRL, 0xF, 0xF, false)); }
DEV float row16_sum(float v) {
    v += dpp_f<0xB1>(v); v += dpp_f<0x4E>(v); v += dpp_f<0x141>(v); v += dpp_f<0x140>(v);
    return v;
}
DEV float wave_sum(float v) {
    v = row16_sum(v);
    v += __shfl_xor(v, 16); v += __shfl_xor(v, 32);
    return v;
}
DEV int scan_row(int z, int b, int s) {
    if (s < CTX) { int t = z ? CTX - 1 - s : s; return b * CTX + t; }
    int u = s - CTX; int t = z ? SEQ - 1 - u : u; return NCTX + b * SEQ + t;
}
DEV int mirror_chunk(int tc) { return tc < CTX / 64 ? CTX / 64 - 1 - tc : CTX / 64 + (SEQ / 64 - 1) - (tc - CTX / 64); }
DEV int row_mod(int R) { return R < NCTX ? 2 : (R - NCTX) / SEQ; }
DEV const GAS float* xrow(PRef P, int l, int R) {
    const GAS float* xl = l == 0 ? P.x : P.out; const GAS float* xc = l == 0 ? P.ctx : P.ctx1;
    return R < NCTX ? xc + (size_t)R * D : xl + (size_t)(R - NCTX) * D;
}
DEV int nbr_row(int R, int c) {
    if (R < NCTX) { int t = R % CTX; if ((c & 1) == 0) return t > 0 ? R - 1 : -1; return t < CTX - 1 ? R + 1 : -1; }
    int t = (R - NCTX) % SEQ; int m = c & 3, col = t & 63;
    if (m == 0) return col > 0 ? R - 1 : -1;
    if (m == 1) return col < 63 ? R + 1 : -1;
    if (m == 2) return t >= 64 ? R - 64 : -1;
    return t < SEQ - 64 ? R + 64 : -1;
}
DEV float shl(PRef P, int l, int R, int c) {
    float pv = (float)P.p[(size_t)R * INW + c];
    int nb = nbr_row(R, c);
    float nv = nb >= 0 ? (float)P.p[(size_t)nb * INW + c] : 0.f;
    return pv + (nv - pv) * P.rw_mu[l * 1280 + c];
}
DEV int a2col(int k) { return k < 384 ? 1280 + k : (k < 640 ? 1920 + (k - 384) : 2560 + (k - 640)); }
DEV float ml_xm(PRef P, int R, int c) { return (float)P.p[(size_t)R * INW + 2176 + c]; }
DEV float ml_xc(PRef P, int l, int R, int c) {
    int t, len; if (R < NCTX) { t = R % CTX; len = CTX; } else { t = (R - NCTX) % SEQ; len = SEQ; }
    float a = P.ml_conv_b[l * 384 + c] + P.ml_conv_w[(l * 3 + 1) * 384 + c] * ml_xm(P, R, c);
    if (t > 0) a += P.ml_conv_w[(l * 3 + 0) * 384 + c] * ml_xm(P, R - 1, c);
    if (t < len - 1) a += P.ml_conv_w[(l * 3 + 2) * 384 + c] * ml_xm(P, R + 1, c);
    return fsilu(a);
}

DEV void ph_mods2(PRef P, int wvs, int bid, int nblk, float* sm) {
    const int tid = ltid(wvs), cl = tid & 15, kq = tid >> 4;
    for (int g = bid; g < 2 * 3 * 3072 / 16; g += nblk) {
        const int idx = g * 16 + cl; const int l = idx / 9216, rem = idx % 9216, j = rem / 3072, col = rem % 3072;
        const GAS float* cin = j < 2 ? P.c + j * D : P.c_ctx;
        float acc = 0.f;
        for (int k = kq * 32; k < kq * 32 + 32; ++k) acc += siluf_(cin[k]) * P.ada_w[((size_t)l * D + k) * 3072 + col];
        sm[kq * 16 + cl] = acc;
        __syncthreads();
        if (tid < 16) { float s = P.ada_b[l * 3072 + col]; for (int q = 0; q < 32; ++q) s += sm[q * 16 + tid]; P.mods[idx] = s; }
        __syncthreads();
    }
}
DEV void ph_wprep(PRef P, int wvs, int bid, int nblk, float* sm) {
    const int tid = ltid(wvs);
    constexpr int T_IN = 16 * 48, T_OUT = 16 * 16, T_GLU = 4 * 4;
    for (int t = bid; t < 2 * (T_IN + T_OUT + T_GLU); t += nblk) {
        int l = t / (T_IN + T_OUT + T_GLU), r = t % (T_IN + T_OUT + T_GLU);
        const GAS float* W; GAS f16* Wt; int N, tk, tn, KW = D;
        if (r < T_IN) { W = P.w_in + (size_t)l * D * INW; Wt = P.wt_in + (size_t)l * 3072 * D; N = INW; tk = r / 48; tn = r % 48; }
        else if (r < T_IN + T_OUT) { r -= T_IN; W = P.w_out + (size_t)l * D * D; Wt = P.wt_out + (size_t)l * D * D; N = D; tk = r / 16; tn = r % 16; }
        else { r -= T_IN + T_OUT; W = P.s5_glu_w + (size_t)l * 256 * 256; Wt = P.glut + (size_t)l * 256 * 256; N = 256; tk = r / 4; tn = r % 4; KW = 256; }
#pragma unroll
        for (int i = 0; i < 2; ++i) {
            int k = (tid >> 4) + 32 * i, n4 = (tid & 15) * 4;
            floatx4 v = {0.f, 0.f, 0.f, 0.f};
            if (tn * 64 + n4 < N) v = *(const GAS floatx4*)(W + (size_t)(tk * 64 + k) * N + tn * 64 + n4);
            sm[k * 65 + n4] = v[0]; sm[k * 65 + n4 + 1] = v[1]; sm[k * 65 + n4 + 2] = v[2]; sm[k * 65 + n4 + 3] = v[3];
        }
        __syncthreads();
        {
            int n = tid >> 3, k8 = (tid & 7) * 8;
            half8 h;
#pragma unroll
            for (int j = 0; j < 8; ++j) h[j] = (f16)sm[(k8 + j) * 65 + n];
            *(half8*)(Wt + (size_t)(tn * 64 + n) * KW + tk * 64 + k8) = h;
        }
        __syncthreads();
    }
}
constexpr int S5PW = 38;
DEV void ph_tables(PRef P, int wvs, int bid, int nblk) {
    for (int idx = bid * NT + ltid(wvs); idx < 2 * 2 * 16 * 64; idx += nblk * NT) {
        const int n = idx & 63, lzg = idx >> 6;
        const int pi = lzg * 64 + n;
        const float are_ = P.s5_a_re[pi], aim_ = P.s5_a_im[pi], dt = expf(P.s5_log_dt[pi]);
        const float mag = expf(are_ * dt), abr = mag * cosf(aim_ * dt), abi = mag * sinf(aim_ * dt);
        const float den = are_ * are_ + aim_ * aim_;
        const float qre = ((abr - 1.f) * are_ + abi * aim_) / den, qim = (abi * are_ - (abr - 1.f) * aim_) / den;
        GAS float* tb = P.s5par + (size_t)lzg * S5PW * 64 + n;
        tb[0] = abr; tb[64] = abi;
        for (int pp = 0; pp < 16; ++pp) {
            const float br = P.s5_b_re[(size_t)pi * 16 + pp], bi = P.s5_b_im[(size_t)pi * 16 + pp];
            P.s5bb[((size_t)lzg * 128 + n) * 16 + pp] = (f16)(qre * br - qim * bi);
            P.s5bb[((size_t)lzg * 128 + 64 + n) * 16 + pp] = (f16)(qre * bi + qim * br);
            P.s5cc[((size_t)lzg * 16 + pp) * 128 + n] = (f16)P.s5_c_re[((size_t)lzg * 16 + pp) * 64 + n];
            P.s5cc[((size_t)lzg * 16 + pp) * 128 + 64 + n] = (f16)(-P.s5_c_im[((size_t)lzg * 16 + pp) * 64 + n]);
        }
        const float m64 = expf(64.f * are_ * dt);
        tb[34 * 64] = m64 * cosf(64.f * aim_ * dt); tb[35 * 64] = m64 * sinf(64.f * aim_ * dt);
    }
    for (int idx = bid * NT + ltid(wvs); idx < 2 * 2 * 2 * 384 * 32; idx += nblk * NT) {
        const int r = idx & 31, c = (idx >> 5) % 384, wa = (idx / (32 * 384)) & 1, lz = idx / (2 * 32 * 384);
        const GAS float* src_ = wa ? P.rw_a_up : P.rw_w_up;
        P.rwlt[idx] = (bf16)src_[((size_t)lz * 32 + r) * 384 + c];
    }
}
DEV void ph_hx(PRef P, int wvs, int l, int bid, int nblk) {
    const int tid_ = ltid(wvs); const int lane = tid_ & 63, wv = tid_ >> 6;
    for (int R = bid * NW + wv; R < NROWS; R += nblk * NW) {
        const GAS float* xr = xrow(P, l, R);
        floatx4 v[4]; float ss = 0.f;
#pragma unroll
        for (int i = 0; i < 4; ++i) { v[i] = *(const floatx4*)(xr + i * 256 + lane * 4); ss += v[i][0] * v[i][0] + v[i][1] * v[i][1] + v[i][2] * v[i][2] + v[i][3] * v[i][3]; }
        ss = wave_sum(ss);
        const float rs = 1.f / sqrtf(ss * (1.f / D) + 1e-6f);
        const GAS float* m = P.mods + (l * 3 + row_mod(R)) * 3072; const GAS float* g = P.norm_g + l * D;
#pragma unroll
        for (int i = 0; i < 4; ++i) {
            int k = i * 256 + lane * 4; half4 h;
#pragma unroll
            for (int j = 0; j < 4; ++j) h[j] = (f16)(v[i][j] * rs * g[k + j] * (1.f + m[D + k + j]) + m[k + j]);
            *(half4*)(P.hx + (size_t)R * D + k) = h;
        }
    }
}
DEV void ph_final2(PRef P, int wvs, int bid, int nblk) {
    const int tid_ = ltid(wvs); const int lane = tid_ & 63, wv = tid_ >> 6;
    for (int r = bid * NW + wv; r < NLAT; r += nblk * NW) {
        GAS float* xr = P.out + (size_t)r * D; floatx4 v[4]; float ss = 0.f;
#pragma unroll
        for (int i = 0; i < 4; ++i) { v[i] = *(const floatx4*)(xr + i * 256 + lane * 4); ss += v[i][0] * v[i][0] + v[i][1] * v[i][1] + v[i][2] * v[i][2] + v[i][3] * v[i][3]; }
        ss = wave_sum(ss);
        const float rs = 1.f / sqrtf(ss * (1.f / D) + 1e-6f);
#pragma unroll
        for (int i = 0; i < 4; ++i) {
            const floatx4 g = *(const floatx4*)(P.final_g + i * 256 + lane * 4); floatx4 o;
#pragma unroll
            for (int j = 0; j < 4; ++j) o[j] = v[i][j] * rs * g[j];
            *(floatx4*)(xr + i * 256 + lane * 4) = o;
        }
    }
}

constexpr int G_LDA = 72;
constexpr int G_STAGE = (256 + 128) * G_LDA;
constexpr int GEMM_LDS_BYTES = 2 * G_STAGE * 2;
template <int MODE>
DEV void gemm_epi_tile(PRef P, int l, const floatx16 acc, int R0, int n0, int lane) {
#pragma unroll
    for (int r = 0; r < 16; ++r) {
        const int R = R0 + (r & 3) + 8 * (r >> 2) + 4 * (lane >> 5), n = n0 + (lane & 31);
        if (MODE == 1) P.p[(size_t)R * INW + n] = (f16)acc[r];
        else if (MODE == 2) {
            const int j = row_mod(R); const float g = P.mods[(l * 3 + j) * 3072 + 2 * D + n];
            const float xo = xrow(P, l, R)[n];
            GAS float* dst = R < NCTX ? P.ctx1 + (size_t)R * D + n : P.out + (size_t)(R - NCTX) * D + n;
            *dst = xo + g * acc[r];
        } else {
            const float yv = (float)P.yg[(size_t)R * 256 + n]; const float gt = (float)P.p[(size_t)R * INW + 1920 + n];
            P.p[(size_t)R * INW + 1920 + n] = (f16)(yv * fsigmoid(acc[r] + P.s5_glu_b[l * 256 + n]) * fsilu(gt));
        }
    }
}
template <int MODE>
DEV void ph_gemm_mfma(PRef P, int wvs, int l, int bid, int nblk, unsigned char* smraw, bool dry = false) {
    constexpr int N = MODE == 1 ? INW : (MODE == 2 ? D : 256), K = MODE == 3 ? 256 : D;
    const GAS f16* Bt = MODE == 1 ? P.wt_in + (size_t)l * INW * D : (MODE == 2 ? P.wt_out + (size_t)l * D * D : P.glut + (size_t)l * 256 * 256);
    const int tm0 = (MODE != 1 && l == 1) ? NCTX / 256 : 0;
    const int ntm = NROWS / 256 - tm0, ntn = N / 128;
    const int tid = ltid(wvs), lane = tid & 63, wv = tid >> 6, wm = wv & 3, wn = wv >> 2;
    f16* sbase = (f16*)smraw;
    const int ldrow = tid >> 3, ldch = tid & 7;
    constexpr int GM = 8;
    for (int t = bid; t < ntm * ntn; t += nblk) {
        int sg = t / (GM * ntn), rem = t % (GM * ntn);
        int gsz = ntm - sg * GM < GM ? ntm - sg * GM : GM;
        const int tm = tm0 + sg * GM + rem % gsz, tn = rem / gsz;
        floatx16 acc00, acc01, acc10, acc11;
#pragma unroll
        for (int r = 0; r < 16; ++r) { acc00[r] = 0.f; acc01[r] = 0.f; acc10[r] = 0.f; acc11[r] = 0.f; }
        uintx4 pa0, pa1, pa2, pa3, pb0, pb1, qa0, qa1, qa2, qa3, qb0, qb1;
        const GAS f16* arow = MODE == 1 ? P.hx + (size_t)(tm * 256 + ldrow) * D + ldch * 8 : (MODE == 2 ? P.p + (size_t)(tm * 256 + ldrow) * INW + ldch * 8 : P.yg + (size_t)(tm * 256 + ldrow) * 256 + ldch * 8);
        const size_t astr = (size_t)64 * (MODE == 1 ? D : (MODE == 2 ? INW : 256));
        const GAS f16* brow = Bt + (size_t)(tn * 128 + ldrow) * K + ldch * 8;
#define GLOAD(S, kt_) if (!(dry && G_VARIANT == 3 && (kt_) > 1)) { const int ka = MODE == 2 ? a2col((kt_) * 64) : (kt_) * 64; const int kb = (kt_) * 64; \
            S##a0 = *(const uintx4*)(arow + ka); S##a1 = *(const uintx4*)(arow + astr + ka); S##a2 = *(const uintx4*)(arow + 2 * astr + ka); S##a3 = *(const uintx4*)(arow + 3 * astr + ka); \
            S##b0 = *(const uintx4*)(brow + kb); S##b1 = *(const uintx4*)(brow + (size_t)64 * K + kb); }
#define SWRITE(S, st_) if (!(dry && G_VARIANT == 4)) { f16* sA_ = sbase + (st_) * G_STAGE + ldrow * G_LDA + ldch * 8; f16* sB_ = sbase + (st_) * G_STAGE + 256 * G_LDA + ldrow * G_LDA + ldch * 8; \
            *(uintx4*)(sA_) = S##a0; *(uintx4*)(sA_ + 64 * G_LDA) = S##a1; *(uintx4*)(sA_ + 128 * G_LDA) = S##a2; *(uintx4*)(sA_ + 192 * G_LDA) = S##a3; \
            *(uintx4*)(sB_) = S##b0; *(uintx4*)(sB_ + 64 * G_LDA) = S##b1; }
#define GFRAG(ks_, b_) { fa0[b_] = *(const half8*)(sA_ + (ks_) * 16); fa1[b_] = *(const half8*)(sA_ + 32 * G_LDA + (ks_) * 16); \
            fb0[b_] = *(const half8*)(sB_ + (ks_) * 16); fb1[b_] = *(const half8*)(sB_ + 32 * G_LDA + (ks_) * 16); }
#define GMMA(b_) { acc00 = __builtin_amdgcn_mfma_f32_32x32x16_f16(fb0[b_], fa0[b_], acc00, 0, 0, 0); acc01 = __builtin_amdgcn_mfma_f32_32x32x16_f16(fb1[b_], fa0[b_], acc01, 0, 0, 0); \
            acc10 = __builtin_amdgcn_mfma_f32_32x32x16_f16(fb0[b_], fa1[b_], acc10, 0, 0, 0); acc11 = __builtin_amdgcn_mfma_f32_32x32x16_f16(fb1[b_], fa1[b_], acc11, 0, 0, 0); }
#define GCOMPUTE(st_) { const f16* sA_ = sbase + (st_) * G_STAGE + (wm * 64 + (lane & 31)) * G_LDA + (lane >> 5) * 8; \
            const f16* sB_ = sbase + (st_) * G_STAGE + 256 * G_LDA + (wn * 64 + (lane & 31)) * G_LDA + (lane >> 5) * 8; \
            half8 fa0[2], fa1[2], fb0[2], fb1[2]; \
            GFRAG(0, 0); GFRAG(1, 1); __builtin_amdgcn_sched_barrier(0); \
            GMMA(0); GFRAG(2, 0); __builtin_amdgcn_sched_barrier(0); \
            GMMA(1); GFRAG(3, 1); __builtin_amdgcn_sched_barrier(0); \
            GMMA(0); __builtin_amdgcn_sched_barrier(0); GMMA(1); }
        constexpr int NK = K / 64;
        BAR_LDS();
        GLOAD(p, 0); SWRITE(p, 0); GLOAD(q, 1); if (2 < NK) GLOAD(p, 2);
        BAR_LDS();
        for (int kt = 0; kt < NK; kt += 2) {
            SWRITE(q, 1);
            if (kt + 3 < NK) GLOAD(q, kt + 3);
            GCOMPUTE(0);
            BAR_LDS();
            if (kt + 2 < NK) { SWRITE(p, 0); if (kt + 4 < NK) GLOAD(p, kt + 4); }
            GCOMPUTE(1);
            BAR_LDS();
        }
#undef GLOAD
#undef SWRITE
#undef GCOMPUTE
#undef GFRAG
#undef GMMA
        if (dry) continue;
        if (MODE != 2) {
            f16* Cs = (f16*)smraw;
#define CSTORE(acc_, mi_, ni_) { const int m_ = wm * 64 + (mi_) * 32 + (lane & 31); \
                _Pragma("unroll") for (int g = 0; g < 4; ++g) { half4 h_; h_[0] = (f16)acc_[4 * g]; h_[1] = (f16)acc_[4 * g + 1]; h_[2] = (f16)acc_[4 * g + 2]; h_[3] = (f16)acc_[4 * g + 3]; \
                    *(half4*)(Cs + m_ * 136 + wn * 64 + (ni_) * 32 + 8 * g + 4 * (lane >> 5)) = h_; } }
            CSTORE(acc00, 0, 0); CSTORE(acc01, 0, 1); CSTORE(acc10, 1, 0); CSTORE(acc11, 1, 1);
#undef CSTORE
            BAR_LDS();
#pragma unroll 2
            for (int i = 0; i < 8; ++i) {
                const int row = (tid >> 4) + 32 * i, ch = tid & 15; const int R = tm * 256 + row, n = tn * 128 + ch * 8;
                const half8 v = *(const half8*)(Cs + row * 136 + ch * 8);
                if (MODE == 1) *(GAS half8*)(P.p + (size_t)R * INW + n) = v;
                else {
                    const half8 yv = *(const GAS half8*)(P.yg + (size_t)R * 256 + n); const half8 gt = *(const GAS half8*)(P.p + (size_t)R * INW + 1920 + n);
                    const floatx4 b0 = *(const GAS floatx4*)(P.s5_glu_b + l * 256 + n), b1 = *(const GAS floatx4*)(P.s5_glu_b + l * 256 + n + 4);
                    half8 o;
#pragma unroll
                    for (int e = 0; e < 8; ++e) o[e] = (f16)((float)yv[e] * fsigmoid((float)v[e] + (e < 4 ? b0[e] : b1[e - 4])) * fsilu((float)gt[e]));
                    *(GAS half8*)(P.p + (size_t)R * INW + 1920 + n) = o;
                }
            }
        } else {
            float* Cs = (float*)smraw;
#pragma unroll 1
            for (int hm = 0; hm < 2; ++hm) {
                if ((wm >> 1) == hm) {
#define CSTORE(acc_, mi_, ni_) { const int m_ = (wm & 1) * 64 + (mi_) * 32 + (lane & 31); \
                    _Pragma("unroll") for (int g = 0; g < 4; ++g) { floatx4 f_; f_[0] = acc_[4 * g]; f_[1] = acc_[4 * g + 1]; f_[2] = acc_[4 * g + 2]; f_[3] = acc_[4 * g + 3]; \
                        *(floatx4*)(Cs + m_ * 132 + wn * 64 + (ni_) * 32 + 8 * g + 4 * (lane >> 5)) = f_; } }
                    CSTORE(acc00, 0, 0); CSTORE(acc01, 0, 1); CSTORE(acc10, 1, 0); CSTORE(acc11, 1, 1);
#undef CSTORE
                }
                BAR_LDS();
#pragma unroll 2
                for (int i = 0; i < 8; ++i) {
                    const int row = (tid >> 5) + 16 * i, ch = tid & 31; const int R = tm * 256 + hm * 128 + row, n = tn * 128 + ch * 4;
                    const floatx4 a4 = *(const floatx4*)(Cs + row * 132 + ch * 4);
                    const floatx4 g4 = *(const GAS floatx4*)(P.mods + (l * 3 + row_mod(R)) * 3072 + 2 * D + n);
                    const floatx4 x4 = *(const GAS floatx4*)(xrow(P, l, R) + n);
                    GAS float* dst = R < NCTX ? P.ctx1 + (size_t)R * D + n : P.out + (size_t)(R - NCTX) * D + n;
                    floatx4 o;
#pragma unroll
                    for (int e = 0; e < 4; ++e) o[e] = x4[e] + g4[e] * a4[e];
                    *(GAS floatx4*)dst = o;
                }
                BAR_LDS();
            }
        }
    }
}

constexpr int G8_HT = 128 * 64;
DEV int g8_lds_byte(int r, int c) { const int st = (r >> 4) * 2 + (c >> 5), rr = r & 15, cc = c & 31, ob = rr * 64 + cc * 2; return st * 1024 + (ob ^ (((ob >> 9) & 1) << 5)); }
DEV void g8_stage_rc(int b, int& R, int& C) { const int st = b / 1024, sb = b % 1024, swz = sb ^ (((sb >> 9) & 1) << 5); R = (st >> 1) * 16 + swz / 64; C = (st & 1) * 32 + (swz % 64) / 2; }
DEV void ph_gemm1_8p(PRef P, int wvs, int l, int bid, int nblk, unsigned char* smraw) {
    constexpr int K = D, NPAD = 3072, nM = NROWS / 256, nN = NPAD / 256, nt = K / 64;
    const GAS f16* A = P.hx; const GAS f16* Bt = P.wt_in + (size_t)l * NPAD * D;
    f16* shm = (f16*)smraw;
#define SA(b, h) (shm + ((b) * 2 + (h)) * G8_HT)
#define SB(b, h) (shm + (4 + (b) * 2 + (h)) * G8_HT)
#define STAGE(Pd, BASE, br, kt) do { const long g_ = (long)(br) * K + (long)(kt) * 64; \
        _Pragma("unroll") for (int i_ = 0; i_ < 2; ++i_) { const int b_ = tid * 16 + i_ * 8192; int r_, c_; g8_stage_rc(b_, r_, c_); \
            __builtin_amdgcn_global_load_lds((const GAS unsigned*)(BASE + g_ + (long)r_ * K + c_), (LAS unsigned*)((LAS char*)(Pd) + b_), 16, 0, 0); } } while (0)
#define LDA(dst, b, h) _Pragma("unroll") for (int m = 0; m < 4; ++m) _Pragma("unroll") for (int k = 0; k < 2; ++k) \
        dst[m][k] = *(const half8*)((const char*)SA(b, h) + g8_lds_byte(wr * 64 + m * 16 + fr, k * 32 + fq * 8))
#define LDB(dst, b, h) _Pragma("unroll") for (int n = 0; n < 2; ++n) _Pragma("unroll") for (int k = 0; k < 2; ++k) \
        dst[n][k] = *(const half8*)((const char*)SB(b, h) + g8_lds_byte(wc * 32 + n * 16 + fr, k * 32 + fq * 8))
#define MMA(ai, bj, At_, Bt_) do { __builtin_amdgcn_s_setprio(1); \
        _Pragma("unroll") for (int m = 0; m < 4; ++m) _Pragma("unroll") for (int n = 0; n < 2; ++n) _Pragma("unroll") for (int k = 0; k < 2; ++k) \
            acc[ai][bj][m][n] = __builtin_amdgcn_mfma_f32_16x16x32_f16(Bt_[n][k], At_[m][k], acc[ai][bj][m][n], 0, 0, 0); \
        __builtin_amdgcn_s_setprio(0); } while (0)
#define WAIT_V(n) asm volatile("s_waitcnt vmcnt(" #n ")" ::: "memory")
#define WAIT_L(n) asm volatile("s_waitcnt lgkmcnt(" #n ")" ::: "memory")
#define BARR __builtin_amdgcn_s_barrier()
#define SCHED __builtin_amdgcn_sched_barrier(0)
    constexpr int GM = 8;
    for (int t0 = bid; t0 < nM * nN; t0 += nblk) {
        const int tid = ltid(wvs), wid = tid >> 6, lane = tid & 63, wr = wid >> 2, wc = wid & 3, fr = lane & 15, fq = lane >> 4;
        const int sg = t0 / (GM * nN), rem = t0 % (GM * nN), gsz = nM - sg * GM < GM ? nM - sg * GM : GM;
        const int pm = sg * GM + rem % gsz, pn = rem / gsz, brow = pm * 256, bcol = pn * 256;
        floatx4 acc[2][2][4][2];
#pragma unroll
        for (int a = 0; a < 2; ++a)
#pragma unroll
            for (int b = 0; b < 2; ++b)
#pragma unroll
                for (int m = 0; m < 4; ++m)
#pragma unroll
                    for (int n = 0; n < 2; ++n) acc[a][b][m][n] = (floatx4){0.f, 0.f, 0.f, 0.f};
        half8 At[4][2], B0[2][2], B1[2][2];
        asm volatile("s_waitcnt vmcnt(0) lgkmcnt(0)" ::: "memory");
        BARR;
        STAGE(SB(0, 0), Bt, bcol, 0); STAGE(SA(0, 0), A, brow, 0);
        STAGE(SB(0, 1), Bt, bcol + 128, 0); STAGE(SA(0, 1), A, brow + 128, 0);
        if (wr == 1) BARR;
        WAIT_V(4); BARR;
        STAGE(SB(1, 0), Bt, bcol, 1); STAGE(SA(1, 0), A, brow, 1); STAGE(SB(1, 1), Bt, bcol + 128, 1);
        WAIT_V(6); BARR;
        for (int t = 0; t < nt - 2; t += 2) {
            LDB(B0, 0, 0); SCHED; LDA(At, 0, 0); STAGE(SA(1, 1), A, brow + 128, t + 1);
            WAIT_L(8); BARR; WAIT_L(0); MMA(0, 0, At, B0); BARR; SCHED;
            LDB(B1, 0, 1); STAGE(SB(0, 0), Bt, bcol, t + 2);
            BARR; WAIT_L(0); MMA(0, 1, At, B1); BARR;
            LDA(At, 0, 1); STAGE(SA(0, 0), A, brow, t + 2);
            BARR; WAIT_L(0); MMA(1, 0, At, B0); BARR; SCHED;
            STAGE(SB(0, 1), Bt, bcol + 128, t + 2);
            WAIT_V(6); BARR; MMA(1, 1, At, B1); BARR;
            LDB(B0, 1, 0); SCHED; LDA(At, 1, 0); STAGE(SA(0, 1), A, brow + 128, t + 2);
            WAIT_L(8); BARR; WAIT_L(0); MMA(0, 0, At, B0); BARR; SCHED;
            LDB(B1, 1, 1); STAGE(SB(1, 0), Bt, bcol, t + 3);
            BARR; WAIT_L(0); MMA(0, 1, At, B1); BARR;
            LDA(At, 1, 1); STAGE(SA(1, 0), A, brow, t + 3);
            BARR; WAIT_L(0); MMA(1, 0, At, B0); BARR; SCHED;
            STAGE(SB(1, 1), Bt, bcol + 128, t + 3);
            WAIT_V(6); BARR; MMA(1, 1, At, B1); BARR;
        }
        { LDB(B0, 0, 0); LDA(At, 0, 0); STAGE(SA(1, 1), A, brow + 128, nt - 1);
          BARR; WAIT_L(0); MMA(0, 0, At, B0); BARR;
          LDB(B1, 0, 1); BARR; WAIT_L(0); MMA(0, 1, At, B1); BARR;
          LDA(At, 0, 1); WAIT_V(4); BARR; WAIT_L(0); MMA(1, 0, At, B0); MMA(1, 1, At, B1); BARR; }
        { LDB(B0, 1, 0); LDA(At, 1, 0); WAIT_V(2); BARR; WAIT_L(0); MMA(0, 0, At, B0); BARR;
          LDB(B1, 1, 1); WAIT_V(0); BARR; WAIT_L(0); MMA(0, 1, At, B1); BARR;
          LDA(At, 1, 1); BARR; WAIT_L(0); MMA(1, 0, At, B0); MMA(1, 1, At, B1); BARR; }
        if (wr == 0) BARR;
        {
            f16* Cs = shm;
#pragma unroll
            for (int ai = 0; ai < 2; ++ai)
#pragma unroll
                for (int bj = 0; bj < 2; ++bj)
#pragma unroll
                    for (int m = 0; m < 4; ++m)
#pragma unroll
                        for (int n = 0; n < 2; ++n) {
                            const floatx4 v = acc[ai][bj][m][n]; half4 h; h[0] = (f16)v[0]; h[1] = (f16)v[1]; h[2] = (f16)v[2]; h[3] = (f16)v[3];
                            *(half4*)(Cs + (ai * 128 + wr * 64 + m * 16 + fr) * 264 + bj * 128 + wc * 32 + n * 16 + fq * 4) = h;
                        }
            asm volatile("s_waitcnt lgkmcnt(0)" ::: "memory"); BARR;
#pragma unroll 4
            for (int i = 0; i < 16; ++i) {
                const int row = (tid >> 5) + 16 * i, ch = tid & 31; const int n = bcol + ch * 8;
                if (n < INW) *(GAS half8*)(P.p + (size_t)(brow + row) * INW + n) = *(const half8*)(Cs + row * 264 + ch * 8);
            }
        }
    }
#undef SA
#undef SB
#undef STAGE
#undef LDA
#undef LDB
#undef MMA
#undef WAIT_V
#undef WAIT_L
#undef BARR
#undef SCHED
}

constexpr int RLD = 72;
constexpr int RSLOT = 64 * RLD;
constexpr int RWP1_LDS_BYTES = 11 * RSLOT * 2 + 2 * 64 * 65 * 4 + 1536 * 4 + 128 * 4;
constexpr size_t RWM_STRIDE = (size_t)24 * NCHUNK * 4096;

DEV bf16x8 ldfrag(const bf16* M, int rowbase, int lane, int ks) {
    return *(const bf16x8*)(M + (rowbase + (lane & 31)) * RLD + ks * 16 + (lane >> 5) * 8);
}
DEV floatx16 mm64(const bf16* A, const bf16* Bt, int wm, int wn, int lane) {
    floatx16 acc;
#pragma unroll
    for (int r = 0; r < 16; ++r) acc[r] = 0.f;
#pragma unroll
    for (int ks = 0; ks < 4; ++ks) acc = __builtin_amdgcn_mfma_f32_32x32x16_bf16(ldfrag(A, wm * 32, lane, ks), ldfrag(Bt, wn * 32, lane, ks), acc, 0, 0, 0);
    return acc;
}
DEV void storeT(bf16* dst, const floatx16 c, int wm, int wn, int lane) {
    const int n = wn * 32 + (lane & 31);
#pragma unroll
    for (int g = 0; g < 4; ++g) {
        const int m0 = wm * 32 + 8 * g + 4 * (lane >> 5);
        bf16x4 v; v[0] = (bf16)c[4 * g]; v[1] = (bf16)c[4 * g + 1]; v[2] = (bf16)c[4 * g + 2]; v[3] = (bf16)c[4 * g + 3];
        *(bf16x4*)(dst + n * RLD + m0) = v;
    }
}

DEV void ph_rw_p1(PRef P, int wvs, int l, int bid, int nblk, unsigned char* smraw) {
    bf16* sl = (bf16*)smraw;
    bf16 *Am = sl, *AmT = sl + RSLOT, *Bp = sl + 2 * RSLOT, *Kp = sl + 3 * RSLOT, *Rt = sl + 4 * RSLOT, *VT = sl + 5 * RSLOT,
         *BendT = sl + 6 * RSLOT, *KendT = sl + 7 * RSLOT, *Nak = sl + 8 * RSLOT, *Mrb = sl + 9 * RSLOT, *Mrk = sl + 10 * RSLOT;
    bf16 *UtT = Am, *WmT = Bp, *NVT = Kp;
    float* Nf = (float*)(smraw + 11 * RSLOT * 2); float* Tf = Nf + 64 * 65; float* Wb = Tf + 64 * 65; float* gl = Wb + 1536;
    bf16* Noff = (bf16*)Nf; float* Nfull = Nf + 2304;
    bf16* Td = (bf16*)(Nf + 2304 + 4096); bf16* Zs = (bf16*)Wb;
    float* av = Nf; float* lwb = Tf;
    f16* Sr = (f16*)Nak; f16* Sk = (f16*)Mrb; f16* Sv = (f16*)Mrk; bf16* lt = KendT;
    float* part = Wb;
    GAS f16* PTg = P.rwm; GAS f16* RPg = PTg + RWM_STRIDE; GAS f16* Qg = RPg + RWM_STRIDE;
    for (int item = bid; item < 24 * NCHUNK; item += nblk) {
        const int tid = ltid(wvs), lane = tid & 63, wv = tid >> 6, q4 = wv & 3, wm = q4 & 1, wn = q4 >> 1, hs = wv >> 2;
        const int chain = item / NCHUNK, ck = item % NCHUNK;
        const int z = chain / 12, b = (chain / 6) % 2, h = chain % 6, s0 = ck * 64;
        const int j = lane, tq = wv, c = h * 64 + j;
#pragma unroll 4
        for (int i = 0; i < 4; ++i) {
            const int task = tid + NT * i, c8 = task & 7, t = (task >> 3) & 63, q = task >> 9;
            const int col0 = q < 3 ? q * 384 + h * 64 + c8 * 8 : (c8 < 4 ? 1152 + z * 32 + c8 * 8 : 1216 + z * 32 + (c8 - 4) * 8);
            const int R = scan_row(z, b, s0 + t);
            const GAS f16* pr = P.p + (size_t)R * INW + col0;
            const half8 own = *(const half8*)pr;
            half8 n0, n1, n2, n3;
#pragma unroll
            for (int e = 0; e < 8; ++e) { n0[e] = (f16)0.f; n1[e] = (f16)0.f; n2[e] = (f16)0.f; n3[e] = (f16)0.f; }
            if (R < NCTX) {
                const int tt = R % CTX;
                if (tt > 0) n0 = *(const half8*)(pr - INW);
                if (tt < CTX - 1) n1 = *(const half8*)(pr + INW);
                n2 = n0; n3 = n1;
            } else {
                const int tt = (R - NCTX) % SEQ, col = tt & 63;
                if (col > 0) n0 = *(const half8*)(pr - INW);
                if (col < 63) n1 = *(const half8*)(pr + INW);
                if (tt >= 64) n2 = *(const half8*)(pr - 64 * INW);
                if (tt < SEQ - 64) n3 = *(const half8*)(pr + 64 * INW);
            }
            const floatx4 mu0 = *(const floatx4*)(P.rw_mu + l * 1280 + col0), mu1 = *(const floatx4*)(P.rw_mu + l * 1280 + col0 + 4);
            float s[8];
#pragma unroll
            for (int e = 0; e < 8; ++e) {
                const float pv = (float)own[e];
                const float nv = (float)((e & 3) == 0 ? n0[e] : (e & 3) == 1 ? n1[e] : (e & 3) == 2 ? n2[e] : n3[e]);
                s[e] = pv + (nv - pv) * (e < 4 ? mu0[e] : mu1[e - 4]);
            }
            if (q < 3) {
                half8 o;
#pragma unroll
                for (int e = 0; e < 8; ++e) o[e] = (f16)s[e];
                *(half8*)((q == 0 ? Sr : q == 1 ? Sk : Sv) + t * RLD + c8 * 8) = o;
            } else {
                bf16x8 o;
#pragma unroll
                for (int e = 0; e < 8; ++e) o[e] = (bf16)(c8 < 4 ? ftanh(s[e]) : s[e]);
                *(bf16x8*)(lt + t * RLD + c8 * 8) = o;
            }
        }
        BAR_LDS();
        {
            const GAS bf16* tab = P.rwlt + ((size_t)((l * 2 + z) * 2 + hs) * 384 + h * 64 + wn * 32 + (lane & 31)) * 32 + (lane >> 5) * 8;
            floatx16 aw;
#pragma unroll
            for (int r = 0; r < 16; ++r) aw[r] = 0.f;
#pragma unroll
            for (int ks = 0; ks < 2; ++ks) aw = __builtin_amdgcn_mfma_f32_32x32x16_bf16(ldfrag(lt + hs * 32, wm * 32, lane, ks), *(const bf16x8*)(tab + ks * 16), aw, 0, 0, 0);
            const int cc = h * 64 + wn * 32 + (lane & 31);
            const float bias = hs ? P.rw_a0[(l * 2 + z) * 384 + cc] : P.rw_w0[(l * 2 + z) * 384 + cc];
#pragma unroll
            for (int r = 0; r < 16; ++r) {
                const int m = wm * 32 + (r & 3) + 8 * (r >> 2) + 4 * (lane >> 5), n = wn * 32 + (lane & 31);
                const float sg = fsigmoid(aw[r] + bias);
                if (hs) av[m * 65 + n] = sg; else lwb[m * 65 + n] = -0.6065306597126334f * sg;
            }
        }
        BAR_LDS();
        float gpre, gtot;
        {
            float run = 0.f, gv[8];
#pragma unroll
            for (int tt = 0; tt < 8; ++tt) { run += lwb[(tq * 8 + tt) * 65 + j]; gv[tt] = run; }
            part[tq * 64 + j] = run;
            const int t = lane, q8 = wv;
            float ss = 0.f, bn = 0.f;
#pragma unroll
            for (int e = 0; e < 8; ++e) {
                const int jj = q8 * 8 + e, c2 = h * 64 + jj;
                const float k_ = (float)Sk[t * RLD + jj], r_ = (float)Sr[t * RLD + jj], a = av[t * 65 + jj];
                const float kku = k_ * P.rw_k_k[l * 384 + c2];
                ss += kku * kku; bn += r_ * k_ * (1.f + (a - 1.f) * P.rw_k_a[l * 384 + c2]) * P.rw_r_k[l * 384 + c2];
            }
            part[512 + q8 * 64 + t] = ss; part[1024 + q8 * 64 + t] = bn;
            BAR_LDS();
            gpre = 0.f; gtot = 0.f;
#pragma unroll
            for (int q = 0; q < 8; ++q) { const float x = part[q * 64 + j]; gtot += x; if (q < tq) gpre += x; }
#pragma unroll
            for (int tt = 0; tt < 8; ++tt) lwb[(tq * 8 + tt) * 65 + j] = gv[tt] + gpre;
            if (tq == 0) {
                gl[j] = __expf(gtot);
                float sst = 0.f, bnt = 0.f;
#pragma unroll
                for (int q = 0; q < 8; ++q) { sst += part[512 + q * 64 + lane]; bnt += part[1024 + q * 64 + lane]; }
                gl[64 + lane] = __builtin_amdgcn_rsqf(sst + 1e-6f);
                P.bon[((size_t)z * NROWS + scan_row(z, b, s0 + lane)) * 6 + h] = bnt;
            }
        }
        BAR_LDS();
        {
            const float kkc = P.rw_k_k[l * 384 + c], kac = P.rw_k_a[l * 384 + c];
            const float Gt = __expf(gtot);
            float e_prev = __expf(gpre);
            bf16x8 amT, vT, beT, keT;
#pragma unroll
            for (int tt = 0; tt < 8; ++tt) {
                const int t = tq * 8 + tt;
                const float r_ = (float)Sr[t * RLD + j], k_ = (float)Sk[t * RLD + j], v_ = (float)Sv[t * RLD + j];
                const float a = av[t * 65 + j], g = lwb[t * 65 + j], sinv = gl[64 + t];
                const float e_t = __expf(g), e_p = frcp(e_t), e_m = e_prev, e_e = Gt * e_p;
                e_prev = e_t;
                const float kkn = k_ * kkc * sinv, kd = k_ * (1.f + (a - 1.f) * kac), bb = a * kkn;
                const bf16 am = (bf16)(kkn * e_m);
                Am[t * RLD + j] = am; Bp[t * RLD + j] = (bf16)(bb * e_p); Kp[t * RLD + j] = (bf16)(kd * e_p); Rt[t * RLD + j] = (bf16)(r_ * e_t);
                amT[tt] = am; vT[tt] = (bf16)v_; beT[tt] = (bf16)(bb * e_e); keT[tt] = (bf16)(kd * e_e);
            }
            BAR_LDS();
            const int to = j * RLD + tq * 8;
            *(bf16x8*)(AmT + to) = amT; *(bf16x8*)(VT + to) = vT; *(bf16x8*)(BendT + to) = beT; *(bf16x8*)(KendT + to) = keT;
        }
        BAR_LDS();
        {
            floatx16 c1, c2;
#pragma unroll
            for (int r = 0; r < 16; ++r) { c1[r] = 0.f; c2[r] = 0.f; }
            if (!(wm == 0 && wn == 1)) {
                const bf16* Aop = hs ? Rt : Am;
#pragma unroll
                for (int ks = 0; ks < 4; ++ks) {
                    const bf16x8 a1 = ldfrag(Aop, wm * 32, lane, ks), b1 = ldfrag(Bp, wn * 32, lane, ks), b2 = ldfrag(Kp, wn * 32, lane, ks);
                    c1 = __builtin_amdgcn_mfma_f32_32x32x16_bf16(a1, b1, c1, 0, 0, 0);
                    c2 = __builtin_amdgcn_mfma_f32_32x32x16_bf16(a1, b2, c2, 0, 0, 0);
                }
            }
#pragma unroll
            for (int r = 0; r < 16; ++r) {
                const int m = wm * 32 + (r & 3) + 8 * (r >> 2) + 4 * (lane >> 5), n = wn * 32 + (lane & 31);
                if (hs == 0) {
                    const float nv_ = n < m ? c1[r] : 0.f;
                    Noff[m * RLD + n] = (bf16)(((n >> 4) != (m >> 4)) ? nv_ : 0.f);
                    Nfull[m * 64 + n] = nv_;
                    Nak[m * RLD + n] = (bf16)(n < m ? c2[r] : 0.f);
                }
                else { Mrb[m * RLD + n] = (bf16)(n <= m ? c1[r] : 0.f); Mrk[m * RLD + n] = (bf16)(n <= m ? c2[r] : 0.f); }
            }
        }
        BAR_LDS();
        if (tid < 64) {
            const int i = tid >> 4, jc = tid & 15; float x[16];
#pragma unroll
            for (int row = 0; row < 16; ++row) {
                float s = row == jc ? 1.f : 0.f;
#pragma unroll
                for (int m = 0; m < row; ++m) s -= Nfull[(16 * i + row) * 64 + 16 * i + m] * x[m];
                x[row] = s;
                if ((row & 3) == 3) __builtin_amdgcn_sched_barrier(0);
            }
#pragma unroll
            for (int row = 0; row < 16; ++row) { Td[(i * 16 + row) * 32 + jc] = (bf16)x[row]; Td[(i * 16 + row) * 32 + 16 + jc] = (bf16)0.f; }
        }
        if (hs == 1) { const floatx16 c2 = mm64(Nak, VT, wm, wn, lane); storeT(NVT, c2, wm, wn, lane); }
        BAR_LDS();
        {
            bf16* XT = hs ? UtT : WmT;
            const bf16* RT = hs ? NVT : AmT;
            bf16* ZT = Zs + wv * 256;
            const int cn = 16 * q4 + (lane & 15);
            {
                bf16x8 zz;
#pragma unroll
                for (int e = 0; e < 8; ++e) zz[e] = (bf16)0.f;
                *(bf16x8*)(XT + (16 * q4 + (lane >> 2)) * RLD + (lane & 3) * 16) = zz; *(bf16x8*)(XT + (16 * q4 + (lane >> 2)) * RLD + (lane & 3) * 16 + 8) = zz;
            }
#pragma unroll 1
            for (int i = 0; i < 4; ++i) {
                floatx4 acc = {0.f, 0.f, 0.f, 0.f};
                if (i > 0) {
#pragma unroll
                    for (int ks = 0; ks < 2; ++ks) {
                        if (ks * 32 < 16 * i) {
                            const bf16x8 a = *(const bf16x8*)(Noff + (16 * i + (lane & 15)) * RLD + 32 * ks + 8 * (lane >> 4));
                            const bf16x8 bq = *(const bf16x8*)(XT + cn * RLD + 32 * ks + 8 * (lane >> 4));
                            acc = __builtin_amdgcn_mfma_f32_16x16x32_bf16(a, bq, acc, 0, 0, 0);
                        }
                    }
                }
                {
                    const bf16x4 rh = *(const bf16x4*)(RT + cn * RLD + 16 * i + 4 * (lane >> 4));
                    bf16x4 zv; zv[0] = (bf16)((float)rh[0] - acc[0]); zv[1] = (bf16)((float)rh[1] - acc[1]); zv[2] = (bf16)((float)rh[2] - acc[2]); zv[3] = (bf16)((float)rh[3] - acc[3]);
                    *(bf16x4*)(ZT + (lane & 15) * 16 + 4 * (lane >> 4)) = zv;
                }
                {
                    const bf16x8 a = *(const bf16x8*)(Td + (i * 16 + (lane & 15)) * 32 + 8 * (lane >> 4));
                    bf16x8 bz;
#pragma unroll
                    for (int e = 0; e < 8; ++e) bz[e] = (bf16)0.f;
                    if ((lane >> 4) < 2) bz = *(const bf16x8*)(ZT + (lane & 15) * 16 + 8 * (lane >> 4));
                    floatx4 xo = {0.f, 0.f, 0.f, 0.f};
                    xo = __builtin_amdgcn_mfma_f32_16x16x32_bf16(a, bz, xo, 0, 0, 0);
                    bf16x4 xv; xv[0] = (bf16)xo[0]; xv[1] = (bf16)xo[1]; xv[2] = (bf16)xo[2]; xv[3] = (bf16)xo[3];
                    *(bf16x4*)(XT + cn * RLD + 16 * i + 4 * (lane >> 4)) = xv;
                }
            }
        }
        BAR_LDS();
        {
            f16* T0 = (f16*)AmT; f16* T1 = (f16*)Kp; f16* T2 = (f16*)Nak; f16* T3 = (f16*)Nf;
            const int n = wn * 32 + (lane & 31);
            if (hs == 0) {
                {
                    const floatx16 c1 = mm64(WmT, Mrb, wm, wn, lane);
#pragma unroll
                    for (int g = 0; g < 4; ++g) {
                        const int m0 = wm * 32 + 8 * g + 4 * (lane >> 5);
                        const bf16x4 rt = *(const bf16x4*)(Rt + n * RLD + m0);
                        half4 v; v[0] = (f16)((float)rt[0] - c1[4 * g]); v[1] = (f16)((float)rt[1] - c1[4 * g + 1]); v[2] = (f16)((float)rt[2] - c1[4 * g + 2]); v[3] = (f16)((float)rt[3] - c1[4 * g + 3]);
                        *(half4*)(T0 + n * RLD + m0) = v;
                    }
                }
                __builtin_amdgcn_sched_barrier(0);
                {
                    const floatx16 c2 = mm64(VT, Mrk, wm, wn, lane); __builtin_amdgcn_sched_barrier(0); const floatx16 c3 = mm64(UtT, Mrb, wm, wn, lane);
#pragma unroll
                    for (int g = 0; g < 4; ++g) {
                        const int m0 = wm * 32 + 8 * g + 4 * (lane >> 5);
                        half4 v; v[0] = (f16)(c2[4 * g] - c3[4 * g]); v[1] = (f16)(c2[4 * g + 1] - c3[4 * g + 1]); v[2] = (f16)(c2[4 * g + 2] - c3[4 * g + 2]); v[3] = (f16)(c2[4 * g + 3] - c3[4 * g + 3]);
                        *(half4*)(T1 + n * RLD + m0) = v;
                    }
                }
            } else {
                {
                    const floatx16 c4 = mm64(WmT, BendT, wm, wn, lane);
                    const float gd = gl[n];
#pragma unroll
                    for (int g = 0; g < 4; ++g) {
                        const int m0 = wm * 32 + 8 * g + 4 * (lane >> 5);
                        half4 v;
#pragma unroll
                        for (int e = 0; e < 4; ++e) v[e] = (f16)((m0 + e == n ? gd : 0.f) - c4[4 * g + e]);
                        *(half4*)(T2 + n * RLD + m0) = v;
                    }
                }
                __builtin_amdgcn_sched_barrier(0);
                {
                    const floatx16 c5 = mm64(KendT, VT, wm, wn, lane); __builtin_amdgcn_sched_barrier(0); const floatx16 c6 = mm64(BendT, UtT, wm, wn, lane);
#pragma unroll
                    for (int g = 0; g < 4; ++g) {
                        const int m0 = wm * 32 + 8 * g + 4 * (lane >> 5);
                        half4 v; v[0] = (f16)(c5[4 * g] - c6[4 * g]); v[1] = (f16)(c5[4 * g + 1] - c6[4 * g + 1]); v[2] = (f16)(c5[4 * g + 2] - c6[4 * g + 2]); v[3] = (f16)(c5[4 * g + 3] - c6[4 * g + 3]);
                        *(half4*)(T3 + n * RLD + m0) = v;
                    }
                }
            }
            BAR_LDS();
            {
                const size_t gb = (size_t)item * 4096;
                const int row = tid >> 3, ch = tid & 7;
                const half8 v0 = *(const half8*)(T0 + row * RLD + ch * 8), v1 = *(const half8*)(T1 + row * RLD + ch * 8);
                const half8 v2 = *(const half8*)(T2 + row * RLD + ch * 8), v3 = *(const half8*)(T3 + row * RLD + ch * 8);
                *(GAS half8*)(RPg + gb + row * 64 + ch * 8) = v0;
                *(GAS half8*)(P.Yh + ((size_t)z * NROWS + scan_row(z, b, s0 + row)) * 384 + h * 64 + ch * 8) = v1;
                *(GAS half8*)(PTg + gb + row * 64 + ch * 8) = v2;
                *(GAS half8*)(Qg + gb + row * 64 + ch * 8) = v3;
            }
        }
        BAR_LDS();
    }
}

DEV void ph_rw_stream(PRef P, int wvs, int l, int bid, int nblk, unsigned char* smraw, bool dry = false) {
    const int tid = ltid(wvs), lane = tid & 63, wv = tid >> 6, w4 = wv & 3, role = wv >> 2;
    f16* S16 = (f16*)smraw;
    const GAS f16* PTg = P.rwm; const GAS f16* RPg = PTg + RWM_STRIDE; const GAS f16* Qg = RPg + RWM_STRIDE;
    for (int item = bid; item < 96; item += nblk) {
        const int chain = item >> 2, vs = item & 3;
        const int z = chain / 12, b = (chain / 6) % 2, h = chain % 6;
        __syncthreads();
        for (int idx = tid; idx < 2 * 16 * 72; idx += NT) S16[idx] = (f16)0.f;
        __syncthreads();
        const size_t cb = (size_t)chain * NCHUNK * 4096;
        const int rowA = 16 * w4 + (lane & 15), kof = 8 * (lane >> 4);
        const int qoff = (vs * 16 + (lane & 15)) * 64 + 16 * w4 + (lane >> 4) * 4;
        const GAS f16* Ag = role ? RPg : PTg;
        GAS f16* ycol = P.Yh + ((size_t)(2 + z) * NROWS) * 384 + h * 64 + vs * 16 + (lane & 15);
        const int trow = 16 * w4 + (lane >> 4) * 4;
        const int rstep = z ? -384 : 384;
        half8 a0[8], a1[8]; half4 qv[8];
#define RW_LOAD(slot_, ck_) { const size_t gb_ = cb + (size_t)(ck_) * 4096; \
            a0[slot_] = *(const GAS half8*)(Ag + gb_ + rowA * 64 + kof); a1[slot_] = *(const GAS half8*)(Ag + gb_ + rowA * 64 + 32 + kof); \
            if (role == 0) qv[slot_] = *(const GAS half4*)(Qg + gb_ + qoff); }
#define RW_STEP(slot_, ck_) { const f16* Sc_ = S16 + ((ck_) & 1) * 16 * 72; f16* Sn_ = S16 + (((ck_) + 1) & 1) * 16 * 72; \
            const half8 b0_ = *(const half8*)(Sc_ + (lane & 15) * 72 + kof); const half8 b1_ = *(const half8*)(Sc_ + (lane & 15) * 72 + 32 + kof); \
            floatx4 acc_ = {0.f, 0.f, 0.f, 0.f}; \
            if (role == 0) { acc_[0] = (float)qv[slot_][0]; acc_[1] = (float)qv[slot_][1]; acc_[2] = (float)qv[slot_][2]; acc_[3] = (float)qv[slot_][3]; } \
            acc_ = __builtin_amdgcn_mfma_f32_16x16x32_f16(a0[slot_], b0_, acc_, 0, 0, 0); acc_ = __builtin_amdgcn_mfma_f32_16x16x32_f16(a1[slot_], b1_, acc_, 0, 0, 0); \
            half4 sn_; sn_[0] = (f16)acc_[0]; sn_[1] = (f16)acc_[1]; sn_[2] = (f16)acc_[2]; sn_[3] = (f16)acc_[3]; \
            if (role == 0) *(half4*)(Sn_ + (lane & 15) * 72 + trow) = sn_; \
            else if (!dry) { GAS f16* yp_ = ycol + (size_t)scan_row(z, b, (ck_) * 64 + trow) * 384; \
                _Pragma("unroll") for (int r_ = 0; r_ < 4; ++r_) yp_[r_ * rstep] = sn_[r_]; } \
            BAR_LDS(); }
        RW_LOAD(0, 0); RW_LOAD(1, 1); RW_LOAD(2, 2); RW_LOAD(3, 3); RW_LOAD(4, 4); RW_LOAD(5, 5); RW_LOAD(6, 6);
        for (int ck = 0; ck < NCHUNK; ck += 8) {
            RW_LOAD(7, ck + 7 < NCHUNK ? ck + 7 : NCHUNK - 1); RW_STEP(0, ck);
            RW_LOAD(0, ck + 8 < NCHUNK ? ck + 8 : NCHUNK - 1); RW_STEP(1, ck + 1);
            RW_LOAD(1, ck + 9 < NCHUNK ? ck + 9 : NCHUNK - 1); RW_STEP(2, ck + 2);
            RW_LOAD(2, ck + 10 < NCHUNK ? ck + 10 : NCHUNK - 1); RW_STEP(3, ck + 3);
            if (ck + 4 < NCHUNK) {
                RW_LOAD(3, ck + 11 < NCHUNK ? ck + 11 : NCHUNK - 1); RW_STEP(4, ck + 4);
                RW_LOAD(4, ck + 12 < NCHUNK ? ck + 12 : NCHUNK - 1); RW_STEP(5, ck + 5);
                RW_LOAD(5, ck + 13 < NCHUNK ? ck + 13 : NCHUNK - 1); RW_STEP(6, ck + 6);
                RW_LOAD(6, ck + 14 < NCHUNK ? ck + 14 : NCHUNK - 1); RW_STEP(7, ck + 7);
            }
        }
#undef RW_LOAD
#undef RW_STEP
    }
}
DEV void ph_rwkv_fin2(PRef P, int wvs, int l, int bid, int nblk, bool dry = false) {
    const int tid_ = ltid(wvs); const int lane = tid_ & 63, wv = tid_ >> 6;
    floatx4 mu_[2], lg_[2], lb_[2];
#pragma unroll
    for (int pass = 0; pass < 2; ++pass) {
        const int hc = pass * 4 + (lane >> 4), cc = (hc < 6 ? hc : 0) * 64 + (lane & 15) * 4;
        mu_[pass] = *(const GAS floatx4*)(P.rw_mu + l * 1280 + 768 + cc); lg_[pass] = *(const GAS floatx4*)(P.rw_ln_g + l * 384 + cc); lb_[pass] = *(const GAS floatx4*)(P.rw_ln_b + l * 384 + cc);
    }
    for (int R = (l == 1 ? NCTX : 0) + bid * NW + wv; R < NROWS; R += nblk * NW) {
#pragma unroll
        for (int pass = 0; pass < 2; ++pass) {
            const int h = pass * 4 + (lane >> 4);
            if (h < 6) {
                const int c = h * 64 + (lane & 15) * 4;
                const half4 y0 = *(const GAS half4*)(P.Yh + (size_t)R * 384 + c), y1 = *(const GAS half4*)(P.Yh + ((size_t)NROWS + R) * 384 + c);
                const half4 y2 = *(const GAS half4*)(P.Yh + ((size_t)2 * NROWS + R) * 384 + c), y3 = *(const GAS half4*)(P.Yh + ((size_t)3 * NROWS + R) * 384 + c);
                const half4 gt = *(const GAS half4*)(P.p + (size_t)R * INW + 1280 + c);
                const half4 vo = *(const GAS half4*)(P.p + (size_t)R * INW + 768 + c);
                const floatx4 mu4 = mu_[pass], lg = lg_[pass], lb = lb_[pass];
                float nv[4];
#pragma unroll
                for (int e = 0; e < 4; ++e) { const int nb = nbr_row(R, 768 + c + e); nv[e] = nb >= 0 ? (float)P.p[(size_t)nb * INW + 768 + c + e] : 0.f; }
                float y[4], s = 0.f;
#pragma unroll
                for (int e = 0; e < 4; ++e) { y[e] = ((float)y0[e] + (float)y1[e]) + ((float)y2[e] + (float)y3[e]); s += y[e]; }
                const float mu = row16_sum(s) * (1.f / 64.f); float q = 0.f;
#pragma unroll
                for (int e = 0; e < 4; ++e) { y[e] -= mu; q += y[e] * y[e]; }
                const float rs = __builtin_amdgcn_rsqf(row16_sum(q) * (1.f / 64.f) + 64e-5f);
                const float bonus = P.bon[(size_t)R * 6 + h] + P.bon[((size_t)NROWS + R) * 6 + h];
                half4 o;
#pragma unroll
                for (int e = 0; e < 4; ++e) {
                    const float pv = (float)vo[e], vs = pv + (nv[e] - pv) * mu4[e];
                    o[e] = (f16)((y[e] * rs * lg[e] + lb[e] + bonus * vs) * fsilu((float)gt[e]));
                }
                if (!dry) *(GAS half4*)(P.p + (size_t)R * INW + 1280 + c) = o; else *(GAS half4*)(P.rwm + (size_t)R * 384 + c) = o;
            }
        }
    }
}
constexpr int HLD = 136;
constexpr int S5_LDS_BYTES = NW * 64 * HLD * 2;
struct S5Ops { half8 au0, au1, bb0, bb1, bb2, bb3; float hre, him; };
DEV void s5_load(PRef P, int l, int z, int b, int g, int tc, int lane, S5Ops& o) {
    const int lzg = (l * 2 + z) * 16 + g;
    o.au0 = *(const GAS half8*)(P.p + (size_t)scan_row(0, b, tc * 64 + (lane & 31)) * INW + 1664 + g * 16 + (lane >> 5) * 8);
    o.au1 = *(const GAS half8*)(P.p + (size_t)scan_row(0, b, tc * 64 + 32 + (lane & 31)) * INW + 1664 + g * 16 + (lane >> 5) * 8);
    const GAS f16* bbp = P.s5bb + ((size_t)lzg * 128 + (lane & 31)) * 16 + (lane >> 5) * 8;
    o.bb0 = *(const GAS half8*)bbp; o.bb1 = *(const GAS half8*)(bbp + 32 * 16); o.bb2 = *(const GAS half8*)(bbp + 64 * 16); o.bb3 = *(const GAS half8*)(bbp + 96 * 16);
}
DEV void s5_wave_scan(PRef P, int l, int z, int g, const S5Ops& o, float& hre, float& him, f16* hb, int lane, bool store) {
    const int lzg = (l * 2 + z) * 16 + g;
#pragma unroll
    for (int nt = 0; nt < 4; ++nt) {
        const half8 bb = nt == 0 ? o.bb0 : nt == 1 ? o.bb1 : nt == 2 ? o.bb2 : o.bb3;
#pragma unroll
        for (int mt = 0; mt < 2; ++mt) {
            floatx16 acc;
#pragma unroll
            for (int r = 0; r < 16; ++r) acc[r] = 0.f;
            acc = __builtin_amdgcn_mfma_f32_32x32x16_f16(mt == 0 ? o.au0 : o.au1, bb, acc, 0, 0, 0);
#pragma unroll
            for (int r = 0; r < 16; ++r) hb[(32 * mt + (r & 3) + 8 * (r >> 2) + 4 * (lane >> 5)) * HLD + 32 * nt + (lane & 31)] = (f16)acc[r];
        }
    }
    const GAS float* tb = P.s5par + (size_t)lzg * S5PW * 64 + lane;
    const float abr = tb[0], abi = tb[64];
#pragma unroll 1
    for (int s0 = 0; s0 < 64; s0 += 16) {
        float br[16], bi[16];
#pragma unroll
        for (int i = 0; i < 16; ++i) { const int tt = z ? 63 - (s0 + i) : s0 + i; br[i] = (float)hb[tt * HLD + lane]; bi[i] = (float)hb[tt * HLD + 64 + lane]; }
#pragma unroll
        for (int i = 0; i < 16; ++i) {
            const float nr = abr * hre - abi * him + br[i], ni = abr * him + abi * hre + bi[i];
            hre = nr; him = ni; br[i] = hre; bi[i] = him;
        }
        if (store) {
#pragma unroll
            for (int i = 0; i < 16; ++i) { const int tt = z ? 63 - (s0 + i) : s0 + i; hb[tt * HLD + lane] = (f16)br[i]; hb[tt * HLD + 64 + lane] = (f16)bi[i]; }
        }
    }
}
DEV void ph_s5_a(PRef P, int wvs, int l, int bid, int nblk, unsigned char* smraw) {
    const int tid_ = ltid(wvs); const int lane = tid_ & 63, wv = tid_ >> 6;
    f16* hb = (f16*)smraw + wv * 64 * HLD;
    constexpr int NI = 2 * 2 * 16 * NCHUNK;
    int item = bid * NW + wv;
    S5Ops nx;
    if (item < NI) { const int tc = item % NCHUNK, zbg = item / NCHUNK; s5_load(P, l, zbg >> 5, (zbg >> 4) & 1, zbg & 15, tc, lane, nx); }
    for (; item < NI; item += nblk * NW) {
        const int tc = item % NCHUNK, zbg = item / NCHUNK, g = zbg & 15, z = zbg >> 5;
        const S5Ops cur = nx;
        const int nitem = item + nblk * NW;
        if (nitem < NI) { const int tc2 = nitem % NCHUNK, zbg2 = nitem / NCHUNK; s5_load(P, l, zbg2 >> 5, (zbg2 >> 4) & 1, zbg2 & 15, tc2, lane, nx); }
        float hre = 0.f, him = 0.f;
        s5_wave_scan(P, l, z, g, cur, hre, him, hb, lane, false);
        const int ck = z ? mirror_chunk(tc) : tc;
        GAS float* ho = P.s5h + ((size_t)zbg * NCHUNK + ck) * 128;
        ho[lane] = hre; ho[64 + lane] = him;
    }
}
DEV void ph_s5_b(PRef P, int wvs, int l, int bid, int nblk) {
    for (int idx = bid * NT + ltid(wvs); idx < 2 * 2 * 16 * 64; idx += nblk * NT) {
        const int n = idx & 63, zbg = idx >> 6, g = zbg & 15, z = zbg >> 5;
        const GAS float* tb = P.s5par + (size_t)((l * 2 + z) * 16 + g) * S5PW * 64 + n;
        const float a64r = tb[34 * 64], a64i = tb[35 * 64];
        float hr = 0.f, hi = 0.f;
        GAS float* hp = P.s5h + (size_t)zbg * NCHUNK * 128 + n;
        for (int c0 = 0; c0 < NCHUNK; c0 += 20) {
            float lr[20], li[20];
#pragma unroll
            for (int i = 0; i < 20; ++i) { lr[i] = hp[(c0 + i) * 128]; li[i] = hp[(c0 + i) * 128 + 64]; }
#pragma unroll
            for (int i = 0; i < 20; ++i) {
                hp[(c0 + i) * 128] = hr; hp[(c0 + i) * 128 + 64] = hi;
                const float nr = a64r * hr - a64i * hi + lr[i], ni = a64r * hi + a64i * hr + li[i];
                hr = nr; hi = ni;
            }
        }
    }
}
DEV void ph_s5_c(PRef P, int wvs, int l, int bid, int nblk, unsigned char* smraw) {
    const int tid = ltid(wvs), lane = tid & 63, wv = tid >> 6, ci = wv >> 1, z = wv & 1;
    f16* base = (f16*)smraw;
    constexpr int NG = NCHUNK / 4, NI = 2 * 16 * NG;
    int it = bid; if (l == 1 && it < NI && it % NG == 0) it += nblk;
    S5Ops nx;
#define S5C_LOAD(it_, o_) { const int grp_ = (it_) % NG, bg_ = (it_) / NG, tc_ = grp_ * 4 + ci; \
        s5_load(P, l, z, bg_ >> 4, bg_ & 15, tc_, lane, o_); \
        const GAS float* hi_ = P.s5h + ((size_t)((z * 2 + (bg_ >> 4)) * 16 + (bg_ & 15)) * NCHUNK + (z ? mirror_chunk(tc_) : tc_)) * 128; \
        o_.hre = hi_[lane]; o_.him = hi_[64 + lane]; }
    if (it < NI) S5C_LOAD(it, nx);
    while (it < NI) {
        const int grp = it % NG, bg = it / NG, g = bg & 15, b = bg >> 4;
        const S5Ops cur = nx;
        int nit = it + nblk; if (l == 1 && nit < NI && nit % NG == 0) nit += nblk;
        if (nit < NI) S5C_LOAD(nit, nx);
        BAR_LDS();
        const int tc = grp * 4 + ci;
        {
            float hre = cur.hre, him = cur.him;
            s5_wave_scan(P, l, z, g, cur, hre, him, base + wv * 64 * HLD, lane, true);
        }
        BAR_LDS();
        {
            half8 bf[2][4];
#pragma unroll
            for (int z2 = 0; z2 < 2; ++z2)
#pragma unroll
                for (int ks = 0; ks < 4; ++ks) bf[z2][ks] = *(const half8*)(P.s5cc + ((size_t)((l * 2 + z2) * 16 + g) * 16 + (lane & 15)) * 128 + 32 * ks + 8 * (lane >> 4));
            const int pch = g * 16 + (lane & 15);
            const float dsk = P.s5_d[l * 256 + pch];
#pragma unroll
            for (int mi = 0; mi < 2; ++mi) {
                const int mt = 2 * z + mi;
                floatx4 acc = {0.f, 0.f, 0.f, 0.f};
#pragma unroll
                for (int z2 = 0; z2 < 2; ++z2) {
                    const f16* hbz = base + (2 * ci + z2) * 64 * HLD;
#pragma unroll
                    for (int ks = 0; ks < 4; ++ks) {
                        const half8 a = *(const half8*)(hbz + (16 * mt + (lane & 15)) * HLD + 32 * ks + 8 * (lane >> 4));
                        acc = __builtin_amdgcn_mfma_f32_16x16x32_f16(a, bf[z2][ks], acc, 0, 0, 0);
                    }
                }
#pragma unroll
                for (int r = 0; r < 4; ++r) {
                    const int tt = 16 * mt + (lane >> 4) * 4 + r; const int R = scan_row(0, b, tc * 64 + tt);
                    const float u = (float)P.p[(size_t)R * INW + 1664 + pch];
                    const float y = acc[r] + dsk * u;
                    P.yg[(size_t)R * 256 + pch] = (f16)(0.5f * y * (1.f + ftanh(0.7978845608028654f * (y + 0.044715f * y * y * y))));
                }
            }
        }
        it = nit;
    }
#undef S5C_LOAD
}

constexpr int NSC = TSCAN / 256;
constexpr int QLD = 104, SLD = 72;
constexpr int MLE = 97 * 96;
template <int KSTEPS>
DEV floatx16 mmh(const f16* A, int lda, int arow0, const f16* Bt, int ldb, int brow0, int lane, floatx16 acc) {
#pragma unroll
    for (int ks = 0; ks < KSTEPS; ++ks) {
        const half8 a = *(const half8*)(A + (arow0 + (lane & 31)) * lda + ks * 16 + (lane >> 5) * 8);
        const half8 b = *(const half8*)(Bt + (brow0 + (lane & 31)) * ldb + ks * 16 + (lane >> 5) * 8);
        acc = __builtin_amdgcn_mfma_f32_32x32x16_f16(a, b, acc, 0, 0, 0);
    }
    return acc;
}
DEV void ph_ml_a(PRef P, int wvs, int l, int bid, int nblk, float* sm) {
    const int tid_ = ltid(wvs); const int lane = tid_ & 63, wv = tid_ >> 6;
    float* gin = sm + 1152 * 20 + wv * 1152;
    __syncthreads();
    for (int idx = tid_; idx < 1152 * 16; idx += NT) {
        const int c = idx >> 4, o = idx & 15, z = o >> 3, hh = (o >> 1) & 3, which = o & 1;
        sm[c * 20 + o] = (which ? P.ml_wf : P.ml_wi)[((size_t)(l * 2 + z) * 1152 + c) * 4 + hh];
    }
    __syncthreads();
    const int lc = lane < 48 ? lane : 0;
    float cvb[8], cv0[8], cv1[8], cv2[8], bq[2][16], bk[2][16], bv[2][16];
#pragma unroll
    for (int i = 0; i < 8; ++i) { const int c = lc * 8 + i; cvb[i] = P.ml_conv_b[l * 384 + c]; cv0[i] = P.ml_conv_w[(l * 3 + 0) * 384 + c]; cv1[i] = P.ml_conv_w[(l * 3 + 1) * 384 + c]; cv2[i] = P.ml_conv_w[(l * 3 + 2) * 384 + c]; }
#pragma unroll
    for (int blk = 0; blk < 2; ++blk)
#pragma unroll
        for (int e = 0; e < 16; ++e) { const int wi = (l * 96 + lc * 2 + blk) * 16 + e; bq[blk][e] = P.ml_wq[wi]; bk[blk][e] = P.ml_wk[wi]; bv[blk][e] = P.ml_wv[wi]; }
    for (int R = bid * NW + wv; R < NROWS; R += nblk * NW) {
        if (lane < 48) {
            const int c0 = lane * 8;
            int t, len; if (R < NCTX) { t = R % CTX; len = CTX; } else { t = (R - NCTX) % SEQ; len = SEQ; }
            const half8 x0 = *(const half8*)(P.p + (size_t)R * INW + 2176 + c0);
            half8 xm_, xp_;
#pragma unroll
            for (int i = 0; i < 8; ++i) { xm_[i] = (f16)0.f; xp_[i] = (f16)0.f; }
            if (t > 0) xm_ = *(const half8*)(P.p + (size_t)(R - 1) * INW + 2176 + c0);
            if (t < len - 1) xp_ = *(const half8*)(P.p + (size_t)(R + 1) * INW + 2176 + c0);
            half8 hq, hk, hv;
#pragma unroll
            for (int blk = 0; blk < 2; ++blk) {
                float xc[4], xm[4];
#pragma unroll
                for (int i = 0; i < 4; ++i) {
                    xm[i] = (float)x0[4 * blk + i];
                    const float a = cvb[4 * blk + i] + cv1[4 * blk + i] * xm[i] + cv0[4 * blk + i] * (float)xm_[4 * blk + i] + cv2[4 * blk + i] * (float)xp_[4 * blk + i];
                    xc[i] = fsilu(a);
                }
#pragma unroll
                for (int i = 0; i < 4; ++i) {
                    float qq = 0.f, kk = 0.f, vv = 0.f;
#pragma unroll
                    for (int jj = 0; jj < 4; ++jj) {
                        qq += xc[jj] * bq[blk][jj * 4 + i]; kk += xc[jj] * bk[blk][jj * 4 + i]; vv += xm[jj] * bv[blk][jj * 4 + i];
                    }
                    const int c = c0 + 4 * blk + i;
                    gin[c] = qq; gin[384 + c] = kk; gin[768 + c] = vv;
                    hq[4 * blk + i] = (f16)qq; hk[4 * blk + i] = (f16)(kk * 0.10206207261596577f); hv[4 * blk + i] = (f16)vv;
                }
            }
            GAS f16* o = P.qkv16 + (size_t)R * 1152 + c0;
            *(half8*)o = hq; *(half8*)(o + 384) = hk; *(half8*)(o + 768) = hv;
        }
        float acc[16];
#pragma unroll
        for (int o = 0; o < 16; ++o) acc[o] = 0.f;
#pragma unroll 3
        for (int i = 0; i < 18; ++i) {
            const int c = lane + 64 * i;
            const float gval = gin[c];
            const float* wr = sm + c * 20;
            const floatx4 w0 = *(const floatx4*)wr, w1 = *(const floatx4*)(wr + 4), w2 = *(const floatx4*)(wr + 8), w3 = *(const floatx4*)(wr + 12);
#pragma unroll
            for (int o2 = 0; o2 < 4; ++o2) { acc[o2] += gval * w0[o2]; acc[4 + o2] += gval * w1[o2]; acc[8 + o2] += gval * w2[o2]; acc[12 + o2] += gval * w3[o2]; }
        }
        float mine = 0.f;
#pragma unroll
        for (int o = 0; o < 16; ++o) { const float s = wave_sum(acc[o]); if (lane == o) mine = s; }
        if (lane < 16) {
            const int z = lane >> 3, hh = (lane >> 1) & 3, which = lane & 1;
            const float val = mine + (which ? P.ml_bf : P.ml_bi)[(l * 2 + z) * 4 + hh];
            P.gates[(size_t)R * 16 + lane] = which ? log_sigmoidf_(val) : val;
        }
    }
}
DEV void ml_load_T(PRef P, int z, int b, int hh, int s0, const float* wgt, f16* VT, f16* KeT, int tid) {
#pragma unroll
    for (int i = 0; i < 3; ++i) {
        const int e = tid + NT * i, which = e / 768, rem = e % 768, c8 = rem >> 6, t = rem & 63;
        const int R = scan_row(z, b, s0 + t);
        const half8 x = *(const half8*)(P.qkv16 + (size_t)R * 1152 + (which ? 384 : 768) + hh * 96 + c8 * 8);
        if (which == 0) {
#pragma unroll
            for (int j = 0; j < 8; ++j) VT[(c8 * 8 + j) * SLD + t] = x[j];
        } else {
            const float w = wgt[t];
#pragma unroll
            for (int j = 0; j < 8; ++j) KeT[(c8 * 8 + j) * SLD + t] = (f16)((float)x[j] * w);
        }
    }
}
constexpr int ML_VT_OFF = 0, ML_KE_OFF = 128 * SLD, ML_QS_OFF = ML_KE_OFF + 96 * SLD, ML_KS_OFF = ML_QS_OFF + 64 * QLD, ML_C16_OFF = ML_KS_OFF + 64 * QLD,
              ML_AM_OFF = ML_C16_OFF + 128 * QLD, ML_F_OFF_BYTES = (ML_AM_OFF + 64 * SLD) * 2;
constexpr int ML_LDS_BYTES = ML_F_OFF_BYTES + 320 * 4;
DEV void ph_ml_1(PRef P, int wvs, int l, int bid, int nblk, unsigned char* smraw) {
    f16* VT = (f16*)smraw + ML_VT_OFF; f16* KeT = (f16*)smraw + ML_KE_OFF; float* fb = (float*)(smraw + ML_F_OFF_BYTES);
    for (int item = bid; item < 16 * NSC; item += nblk) {
        const int tid = ltid(wvs), lane = tid & 63, wv = tid >> 6;
        const int chain = item / NSC, sc = item % NSC, z = chain / 8, b = (chain / 4) % 2, hh = chain % 4;
        BAR_LDS();
        for (int idx = tid; idx < 32 * SLD; idx += NT) VT[96 * SLD + idx] = (f16)((idx < SLD) ? 1.f : 0.f);
        float x = 0.f, li = 0.f;
        if (tid < 256) {
            const int R = scan_row(z, b, sc * 256 + tid);
            li = P.gates[(size_t)R * 16 + z * 8 + hh * 2]; x = P.gates[(size_t)R * 16 + z * 8 + hh * 2 + 1];
#pragma unroll
            for (int o = 1; o < 64; o <<= 1) { const float y = __shfl_up(x, o); if (lane >= o) x += y; }
            if (lane == 63) fb[256 + wv] = x;
        }
        BAR_LDS();
        if (tid < 256) {
            float off = 0.f, tot = 0.f;
#pragma unroll
            for (int w = 0; w < 4; ++w) { const float q = fb[256 + w]; tot += q; if (w < wv) off += q; }
            fb[tid] = __expf(li + tot - (x + off));
            if (tid == 0) P.mlG[item] = __expf(tot);
        }
        floatx16 c0, c1, c2;
#pragma unroll
        for (int r = 0; r < 16; ++r) { c0[r] = 0.f; c1[r] = 0.f; c2[r] = 0.f; }
#pragma unroll 1
        for (int cc = 0; cc < 4; ++cc) {
            BAR_LDS();
            ml_load_T(P, z, b, hh, sc * 256 + cc * 64, fb + cc * 64, VT, KeT, tid);
            BAR_LDS();
            if (wv < 4) {
                c0 = mmh<4>(VT, SLD, 32 * wv, KeT, SLD, 0, lane, c0);
                c1 = mmh<4>(VT, SLD, 32 * wv, KeT, SLD, 32, lane, c1);
                c2 = mmh<4>(VT, SLD, 32 * wv, KeT, SLD, 64, lane, c2);
            }
        }
        if (wv < 4) {
            GAS float* dst = P.mlC + (size_t)item * MLE;
#pragma unroll
            for (int r = 0; r < 16; ++r) {
                const int v = 32 * wv + (r & 3) + 8 * (r >> 2) + 4 * (lane >> 5), k = lane & 31;
                if (v <= 96) { dst[v * 96 + k] = c0[r]; dst[v * 96 + 32 + k] = c1[r]; dst[v * 96 + 64 + k] = c2[r]; }
            }
        }
    }
}
DEV void ph_ml_2(PRef P, int wvs, int bid, int nblk) {
    for (int idx = bid * NT + ltid(wvs); idx < 16 * MLE; idx += nblk * NT) {
        const int chain = idx / MLE, e = idx % MLE; float run = 0.f;
        for (int s0 = 0; s0 < NSC; s0 += 13) {
            float loc[13], gg[13];
#pragma unroll
            for (int i = 0; i < 13; ++i) { loc[i] = P.mlC[((size_t)chain * NSC + s0 + i) * MLE + e]; gg[i] = P.mlG[chain * NSC + s0 + i]; }
#pragma unroll
            for (int i = 0; i < 13; ++i) { P.mlC[((size_t)chain * NSC + s0 + i) * MLE + e] = run; run = gg[i] * run + loc[i]; }
        }
    }
}
DEV void ph_ml_3(PRef P, int wvs, int l, int bid, int nblk, unsigned char* smraw) {
    f16* sh = (f16*)smraw;
    f16 *VT = sh + ML_VT_OFF, *KeT = sh + ML_KE_OFF, *Qs = sh + ML_QS_OFF, *Ks = sh + ML_KS_OFF, *C16 = sh + ML_C16_OFF, *Am = sh + ML_AM_OFF;
    float* fb = (float*)(smraw + ML_F_OFF_BYTES);
    for (int item = bid; item < 16 * NSC; item += nblk) {
        const int tid = ltid(wvs), lane = tid & 63, wv = tid >> 6, w4 = wv & 3, wm = w4 & 1, wn = w4 >> 1;
        const int chain = item / NSC, sc = item % NSC, z = chain / 8, b = (chain / 4) % 2, hh = chain % 4;
        if (l == 1 && sc == 0) continue;
        BAR_LDS();
        for (int idx = tid; idx < 32 * SLD; idx += NT) VT[96 * SLD + idx] = (f16)((idx < SLD) ? 1.f : 0.f);
        floatx16 c0, c1, c2;
#pragma unroll
        for (int r = 0; r < 16; ++r) { c0[r] = 0.f; c1[r] = 0.f; c2[r] = 0.f; }
        if (wv < 4) {
            const GAS float* srcC = P.mlC + (size_t)item * MLE;
#pragma unroll
            for (int r = 0; r < 16; ++r) {
                const int v = 32 * wv + (r & 3) + 8 * (r >> 2) + 4 * (lane >> 5), k = lane & 31;
                const bool ok = v <= 96;
                c0[r] = ok ? srcC[v * 96 + k] : 0.f; c1[r] = ok ? srcC[v * 96 + 32 + k] : 0.f; c2[r] = ok ? srcC[v * 96 + 64 + k] : 0.f;
            }
        }
#pragma unroll 1
        for (int cc = 0; cc < 4; ++cc) {
            const int s0 = sc * 256 + cc * 64;
            BAR_LDS();
            if (wv == 7) {
                const int R = scan_row(z, b, s0 + lane);
                const float li = P.gates[(size_t)R * 16 + z * 8 + hh * 2], lf = P.gates[(size_t)R * 16 + z * 8 + hh * 2 + 1];
                float F = lf;
#pragma unroll
                for (int o = 1; o < 64; o <<= 1) { const float y = __shfl_up(F, o); if (lane >= o) F += y; }
                const float FL = __shfl(F, 63);
                fb[lane] = __expf(F); fb[64 + lane] = __expf(fminf(li - F, 10.f)); fb[128 + lane] = __expf(li + FL - F);
                if (lane == 63) fb[192] = __expf(FL);
            }
            if (wv < 4) {
#pragma unroll
                for (int r = 0; r < 16; ++r) {
                    const int v = 32 * wv + (r & 3) + 8 * (r >> 2) + 4 * (lane >> 5), k = lane & 31;
                    C16[v * QLD + k] = (f16)c0[r]; C16[v * QLD + 32 + k] = (f16)c1[r]; C16[v * QLD + 64 + k] = (f16)c2[r];
                }
            }
            BAR_LDS();
#pragma unroll
            for (int i = 0; i < 3; ++i) {
                const int e = tid + NT * i, which = e / 768, rem = e % 768, t = rem / 12, c8 = rem % 12;
                const int R = scan_row(z, b, s0 + t);
                const half8 x = *(const half8*)(P.qkv16 + (size_t)R * 1152 + (which ? 384 : 0) + hh * 96 + c8 * 8);
                const float w = which ? fb[64 + t] : fb[t];
                half8 y;
#pragma unroll
                for (int jj = 0; jj < 8; ++jj) y[jj] = (f16)((float)x[jj] * w);
                *(half8*)((which ? Ks : Qs) + t * QLD + c8 * 8) = y;
            }
            ml_load_T(P, z, b, hh, s0, fb + 128, VT, KeT, tid);
            BAR_LDS();
            if (wv >= 4) {
#pragma unroll
                for (int r = 0; r < 16; ++r) c2[r] = 0.f;
                if (!(wm == 0 && wn == 1)) c2 = mmh<6>(Qs, QLD, wm * 32, Ks, QLD, wn * 32, lane, c2);
#pragma unroll
                for (int r = 0; r < 16; ++r) {
                    const int m = wm * 32 + (r & 3) + 8 * (r >> 2) + 4 * (lane >> 5), n = wn * 32 + (lane & 31);
                    Am[m * SLD + n] = (f16)(n <= m ? c2[r] : 0.f);
                }
            } else {
                const float gL = fb[192];
#pragma unroll
                for (int r = 0; r < 16; ++r) { c0[r] *= gL; c1[r] *= gL; c2[r] *= gL; }
                c0 = mmh<4>(VT, SLD, 32 * wv, KeT, SLD, 0, lane, c0); __builtin_amdgcn_sched_barrier(0);
                c1 = mmh<4>(VT, SLD, 32 * wv, KeT, SLD, 32, lane, c1); __builtin_amdgcn_sched_barrier(0);
                c2 = mmh<4>(VT, SLD, 32 * wv, KeT, SLD, 64, lane, c2);
            }
            BAR_LDS();
            if (wv >= 4) {
#pragma unroll
                for (int r = 0; r < 16; ++r) { c0[r] = 0.f; c1[r] = 0.f; }
                c0 = mmh<4>(Am, SLD, 0, VT, SLD, 32 * w4, lane, c0); __builtin_amdgcn_sched_barrier(0); c0 = mmh<6>(Qs, QLD, 0, C16, QLD, 32 * w4, lane, c0); __builtin_amdgcn_sched_barrier(0);
                c1 = mmh<4>(Am, SLD, 32, VT, SLD, 32 * w4, lane, c1); __builtin_amdgcn_sched_barrier(0); c1 = mmh<6>(Qs, QLD, 32, C16, QLD, 32 * w4, lane, c1); __builtin_amdgcn_sched_barrier(0);
                if (wv == 7 && (lane & 31) == 0) {
#pragma unroll
                    for (int r = 0; r < 16; ++r) { const int t = (r & 3) + 8 * (r >> 2) + 4 * (lane >> 5); fb[256 + t] = c0[r]; fb[256 + 32 + t] = c1[r]; }
                }
            }
            BAR_LDS();
            if (wv >= 4 && wv < 7) {
#pragma unroll
                for (int r = 0; r < 16; ++r) {
                    const int t = (r & 3) + 8 * (r >> 2) + 4 * (lane >> 5);
                    const int R0 = scan_row(z, b, s0 + t), R1 = scan_row(z, b, s0 + 32 + t);
                    const float d0 = fmaxf(fabsf(fb[256 + t]), 1.f), d1 = fmaxf(fabsf(fb[256 + 32 + t]), 1.f);
                    P.Yh[((size_t)z * NROWS + R0) * 384 + hh * 96 + 32 * w4 + (lane & 31)] = (f16)(c0[r] * frcp(d0));
                    P.Yh[((size_t)z * NROWS + R1) * 384 + hh * 96 + 32 * w4 + (lane & 31)] = (f16)(c1[r] * frcp(d1));
                    if ((r & 3) == 3) __builtin_amdgcn_sched_barrier(0);
                }
            }
        }
    }
}
DEV void ph_ml_fin2(PRef P, int wvs, int l, int bid, int nblk, bool dry = false) {
    typedef _Float16 half2_ __attribute__((ext_vector_type(2)));
    const int tid_ = ltid(wvs); const int lane = tid_ & 63, wv = tid_ >> 6;
    const int c0 = lane * 6;
    float ng[6], sk[6], cb[6], w0[6], w1[6], w2[6];
#pragma unroll
    for (int i = 0; i < 6; ++i) {
        ng[i] = P.ml_norm_g[l * 384 + c0 + i]; sk[i] = P.ml_skip[l * 384 + c0 + i]; cb[i] = P.ml_conv_b[l * 384 + c0 + i];
        w0[i] = P.ml_conv_w[(l * 3 + 0) * 384 + c0 + i]; w1[i] = P.ml_conv_w[(l * 3 + 1) * 384 + c0 + i]; w2[i] = P.ml_conv_w[(l * 3 + 2) * 384 + c0 + i];
    }
    for (int R = (l == 1 ? NCTX : 0) + bid * NW + wv; R < NROWS; R += nblk * NW) {
        int t, len; if (R < NCTX) { t = R % CTX; len = CTX; } else { t = (R - NCTX) % SEQ; len = SEQ; }
        float y[6], xm[6], xa[6], xb[6], zg[6]; float s = 0.f;
#pragma unroll
        for (int i = 0; i < 3; ++i) {
            const half2_ a = *(const GAS half2_*)(P.Yh + (size_t)R * 384 + c0 + 2 * i), b2 = *(const GAS half2_*)(P.Yh + ((size_t)NROWS + R) * 384 + c0 + 2 * i);
            const half2_ m = *(const GAS half2_*)(P.p + (size_t)R * INW + 2176 + c0 + 2 * i), zz = *(const GAS half2_*)(P.p + (size_t)R * INW + 2560 + c0 + 2 * i);
            half2_ pa, pb; pa[0] = (f16)0.f; pa[1] = (f16)0.f; pb = pa;
            if (t > 0) pa = *(const GAS half2_*)(P.p + (size_t)(R - 1) * INW + 2176 + c0 + 2 * i);
            if (t < len - 1) pb = *(const GAS half2_*)(P.p + (size_t)(R + 1) * INW + 2176 + c0 + 2 * i);
#pragma unroll
            for (int e = 0; e < 2; ++e) {
                y[2 * i + e] = (float)a[e] + (float)b2[e]; s += y[2 * i + e];
                xm[2 * i + e] = (float)m[e]; xa[2 * i + e] = (float)pa[e]; xb[2 * i + e] = (float)pb[e]; zg[2 * i + e] = (float)zz[e];
            }
        }
        s = row16_sum(s);
        const float mu = s * (1.f / 96.f); float q = 0.f;
#pragma unroll
        for (int i = 0; i < 6; ++i) { y[i] -= mu; q += y[i] * y[i]; }
        q = row16_sum(q);
        const float rs = __builtin_amdgcn_rsqf(q * (1.f / 96.f) + 1e-6f);
#pragma unroll
        for (int i = 0; i < 3; ++i) {
            half2_ o;
#pragma unroll
            for (int e = 0; e < 2; ++e) {
                const int k = 2 * i + e;
                const float xc = fsilu(cb[k] + w1[k] * xm[k] + w0[k] * xa[k] + w2[k] * xb[k]);
                o[e] = (f16)((y[k] * rs * ng[k] + sk[k] * xc) * fsilu(zg[k]));
            }
            if (!dry) *(GAS half2_*)(P.p + (size_t)R * INW + 2560 + c0 + 2 * i) = o; else *(GAS half2_*)(P.rwm + (size_t)R * 384 + c0 + 2 * i) = o;
        }
    }
}

#define XB_TMO      128
#define XB_XCNT(j)  (256  + 64 * (j))
#define XB_XSUB(j)  (1280 + 64 * (j))
#define XB_XGEN(j)  (2304 + 64 * (j))
#define XB_TOP      3328
#define XB_TOPGEN   3392
#define XCD_BAR_WORDS 3456
#define XB_SPIN_CAP (1u << 22)
DEV unsigned xb_ld(GAS unsigned* p)              { return __hip_atomic_load(p, __ATOMIC_RELAXED, __HIP_MEMORY_SCOPE_AGENT); }
DEV unsigned xb_add(GAS unsigned* p, unsigned v) { return __hip_atomic_fetch_add(p, v, __ATOMIC_RELAXED, __HIP_MEMORY_SCOPE_AGENT); }
DEV unsigned xb_xcc_id() { return (unsigned)__builtin_amdgcn_s_getreg((3 << 11) | 20) & 0xFu; }
#define XB_SPIN(cond, bar) do { unsigned _sp = 0; while (cond) { __builtin_amdgcn_s_sleep(1); \
    if ((++_sp & 255u) == 0u) { if (xb_ld(&(bar)[XB_TMO])) break; if (_sp > XB_SPIN_CAP) { (void)xb_add(&(bar)[XB_TMO], 1u); break; } } } } while (0)
struct XcdBarrier { GAS unsigned* bar; unsigned x; volatile LAS unsigned* st; };
DEV XcdBarrier xcd_barrier_post(GAS unsigned* bar, volatile LAS unsigned* st) {
    XcdBarrier b; b.bar = bar; b.x = xb_xcc_id(); b.st = st;
    if (threadIdx.x == 0) (void)xb_add(&bar[XB_XCNT(b.x)], 1u);
    return b;
}
DEV void xcd_barrier_complete(GAS unsigned* bar, unsigned x, unsigned& nloc, unsigned& nx) {
    const unsigned G = gridDim.x * gridDim.y * gridDim.z;
    unsigned sum, cnt, mine, sp = 0u;
    for (;;) {
        sum = 0u; cnt = 0u; mine = 0u;
#pragma unroll
        for (unsigned j = 0; j < 16; ++j) { const unsigned c = xb_ld(&bar[XB_XCNT(j)]); sum += c; cnt += (c > 0u) ? 1u : 0u; mine = (j == x) ? c : mine; }
        if (sum == G) break;
        __builtin_amdgcn_s_sleep(1);
        if ((++sp & 255u) == 0u) { if (xb_ld(&bar[XB_TMO])) break; if (sp > XB_SPIN_CAP) { (void)xb_add(&bar[XB_TMO], 1u); break; } }
    }
    nloc = mine > 0u ? mine : 1u; nx = cnt > 0u ? cnt : 1u;
}
DEV bool is_thread0(int wvs) { return wvs == 0 && __builtin_amdgcn_mbcnt_hi(~0u, __builtin_amdgcn_mbcnt_lo(~0u, 0u)) == 0u; }
DEV void xcd_barrier(const XcdBarrier& b, GAS unsigned* bar_, int wvs) {
    asm volatile("s_waitcnt vmcnt(0)" ::: "memory");
    __syncthreads();
    if (is_thread0(wvs)) {
        GAS unsigned* bar = bar_;
        __builtin_amdgcn_s_waitcnt(0);
        unsigned nloc = b.st[0], nx = b.st[1];
        if (nloc == 0u) { xcd_barrier_complete(bar, b.x, nloc, nx); b.st[0] = nloc; b.st[1] = nx; }
        const unsigned old = xb_add(&bar[XB_XSUB(b.x)], 1u);
        const unsigned gen = old / nloc;
        if (old + 1u == (gen + 1u) * nloc) {
            __builtin_amdgcn_fence(__ATOMIC_RELEASE, "agent");
            asm volatile("s_waitcnt vmcnt(0)" ::: "memory");
            const unsigned og = xb_add(&bar[XB_TOP], 1u);
            const unsigned tg = og / nx;
            if (og + 1u == (tg + 1u) * nx) xb_add(&bar[XB_TOPGEN], 1u);
            else XB_SPIN(xb_ld(&bar[XB_TOPGEN]) == tg, bar);
            __builtin_amdgcn_fence(__ATOMIC_ACQUIRE, "agent");
            xb_add(&bar[XB_XGEN(b.x)], 1u);
            asm volatile("s_waitcnt vmcnt(0)" ::: "memory");
        } else {
            XB_SPIN(xb_ld(&bar[XB_XGEN(b.x)]) == gen, bar);
            __builtin_amdgcn_fence(__ATOMIC_ACQUIRE, "agent");
            asm volatile("s_waitcnt vmcnt(0)" ::: "memory");
        }
    }
    __syncthreads();
}


DEV void sub_barrier(GAS unsigned* cnt, unsigned nmemb, unsigned round, int wvs) {
    asm volatile("s_waitcnt vmcnt(0)" ::: "memory");
    __syncthreads();
    if (is_thread0(wvs)) {
        __builtin_amdgcn_fence(__ATOMIC_RELEASE, "agent");
        asm volatile("s_waitcnt vmcnt(0)" ::: "memory");
        (void)xb_add(cnt, 1u);
        unsigned sp = 0;
        while (xb_ld(cnt) < nmemb * round) { __builtin_amdgcn_s_sleep(1); if (++sp > (1u << 24)) break; }
        __builtin_amdgcn_fence(__ATOMIC_ACQUIRE, "agent");
        asm volatile("s_waitcnt vmcnt(0)" ::: "memory");
    }
    __syncthreads();
}

constexpr size_t al256(size_t x) { return (x + 255) & ~(size_t)255; }
constexpr size_t WS_MODS = 0;
constexpr size_t WS_P = al256(WS_MODS + 2 * 3 * 3072 * 4);
constexpr size_t WS_Y = al256(WS_P + (size_t)NROWS * INW * 2);
constexpr size_t WS_Q = al256(WS_Y + (size_t)2 * NROWS * 384 * 4);
constexpr size_t WS_Q_BYTES = (size_t)NROWS * 1152 * 4;
constexpr size_t WS_GATES = al256(WS_Q + WS_Q_BYTES);
constexpr size_t WS_BON = al256(WS_GATES + (size_t)NROWS * 16 * 4);
constexpr size_t WS_YG = al256(WS_BON + (size_t)2 * NROWS * 6 * 4);
constexpr size_t WS_S5H = al256(WS_YG + (size_t)NROWS * 256 * 2);
constexpr size_t WS_S5PAR = al256(WS_S5H + (size_t)64 * NCHUNK * 128 * 4);
constexpr size_t WS_S5BB = al256(WS_S5PAR + (size_t)64 * S5PW * 64 * 4);
constexpr size_t WS_S5CC = al256(WS_S5BB + (size_t)64 * 128 * 16 * 2);
constexpr size_t WS_GLUT = al256(WS_S5CC + (size_t)64 * 16 * 128 * 2);
constexpr size_t WS_CTX1 = al256(WS_GLUT + (size_t)2 * 256 * 256 * 2);
constexpr size_t WS_WTIN = al256(WS_CTX1 + (size_t)NCTX * D * 4);
constexpr size_t WS_WTOUT = al256(WS_WTIN + (size_t)2 * 3072 * D * 2);
constexpr size_t WS_RWLT = al256(WS_WTOUT + (size_t)2 * D * D * 2);
constexpr size_t WS_GP = al256(WS_RWLT + (size_t)2 * 2 * 2 * 384 * 32 * 2);
constexpr size_t WS_XBAR = al256(WS_GP + 1024);
constexpr size_t WS_END = al256(WS_XBAR + (XCD_BAR_WORDS + 256) * 4);
static_assert(3 * RWM_STRIDE * 2 <= WS_Q_BYTES, "rwkv chunk matrices");
static_assert(al256((size_t)NROWS * 1152 * 2) + al256((size_t)16 * NSC * MLE * 4) + 16 * NSC * 4 <= WS_Q_BYTES, "ml region");

static void fill_params(Params& P, void* const* d_in, void* d_out, void* d_ws) {
    const GAS float** pp = (const GAS float**)&P;
    for (int i = 0; i < 41; ++i) pp[i] = (const GAS float*)d_in[i];
    unsigned char* ws = (unsigned char*)d_ws;
    P.out = (GAS float*)d_out;
    P.mods = (GAS float*)(ws + WS_MODS); P.p = (GAS f16*)(ws + WS_P); P.Yh = (GAS f16*)(ws + WS_Y);
    P.gates = (GAS float*)(ws + WS_GATES); P.bon = (GAS float*)(ws + WS_BON); P.ctx1 = (GAS float*)(ws + WS_CTX1);
    P.hx = (GAS f16*)(ws + WS_Q); P.rwm = (GAS f16*)(ws + WS_Q); P.qkv16 = (GAS f16*)(ws + WS_Q);
    P.mlC = (GAS float*)(ws + WS_Q + al256((size_t)NROWS * 1152 * 2)); P.mlG = (GAS float*)(ws + WS_Q + al256((size_t)NROWS * 1152 * 2) + al256((size_t)16 * NSC * MLE * 4));
    P.wt_in = (GAS f16*)(ws + WS_WTIN); P.wt_out = (GAS f16*)(ws + WS_WTOUT); P.glut = (GAS f16*)(ws + WS_GLUT);
    P.yg = (GAS f16*)(ws + WS_YG); P.s5h = (GAS float*)(ws + WS_S5H); P.s5par = (GAS float*)(ws + WS_S5PAR); P.s5bb = (GAS f16*)(ws + WS_S5BB); P.s5cc = (GAS f16*)(ws + WS_S5CC);
    P.rwlt = (GAS bf16*)(ws + WS_RWLT); P.gp = (GAS Params*)(ws + WS_GP); P.xbar = (GAS unsigned*)(ws + WS_XBAR);
}

constexpr int cmax(int a, int b) { return a > b ? a : b; }
constexpr int MEGA_LDS_BYTES = cmax(cmax(RWP1_LDS_BYTES, S5_LDS_BYTES), cmax(cmax(GEMM_LDS_BYTES, ML_LDS_BYTES), (1152 * 20 + NW * 1152) * 4));

template <int l>
DEV void layer_body(PRef P, const int wvs, const int bid, const int nblk, unsigned char* smraw, float* sm, const XcdBarrier& xb) {
        for (int rep = 0; rep < REP_HX; ++rep) ph_hx(P, wvs, l, lsgpr(bid), nblk);
        xcd_barrier(xb, P.xbar, wvs);
        for (int rep = 0; rep < REP_G1; ++rep) ph_gemm1_8p(P, wvs, l, lsgpr(bid), nblk, smraw);
        for (int rep = 0; rep < REP_SYNC; ++rep) xcd_barrier(xb, P.xbar, wvs);
        for (int rep = 0; rep < REP_P1; ++rep) ph_rw_p1(P, wvs, l, lsgpr(bid), nblk, smraw);
        for (int rep = 0; rep < REP_S5A; ++rep) ph_s5_a(P, wvs, l, lsgpr(bid), nblk, smraw);
        xcd_barrier(xb, P.xbar, wvs);
        if (bid < 96) {
            for (int rep = 0; rep < REP_ST; ++rep) ph_rw_stream(P, wvs, l, lsgpr(bid), 96, smraw, rep + 1 < REP_ST);
        } else {
            ph_s5_b(P, wvs, l, lsgpr(bid) - 96, nblk - 96);
            sub_barrier(P.xbar + 3456 + 64, nblk - 96, 1u + l, wvs);
            for (int rep = 0; rep < REP_S5C; ++rep) ph_s5_c(P, wvs, l, lsgpr(bid) - 96, nblk - 96, smraw);
        }
        xcd_barrier(xb, P.xbar, wvs);
        for (int rep = 0; rep < REP_RWF; ++rep) ph_rwkv_fin2(P, wvs, l, lsgpr(bid), nblk, rep + 1 < REP_RWF);
        ph_gemm_mfma<3>(P, wvs, l, lsgpr(bid), nblk, smraw);
        for (int rep = 0; rep < REP_MLA; ++rep) ph_ml_a(P, wvs, l, lsgpr(bid), nblk, sm);
        xcd_barrier(xb, P.xbar, wvs);
        for (int rep = 0; rep < REP_ML1; ++rep) ph_ml_1(P, wvs, l, lsgpr(bid), nblk, smraw);
        xcd_barrier(xb, P.xbar, wvs);
        ph_ml_2(P, wvs, lsgpr(bid), nblk);
        xcd_barrier(xb, P.xbar, wvs);
        for (int rep = 0; rep < REP_ML3; ++rep) ph_ml_3(P, wvs, l, lsgpr(bid), nblk, smraw);
        xcd_barrier(xb, P.xbar, wvs);
        for (int rep = 0; rep < REP_MLF; ++rep) ph_ml_fin2(P, wvs, l, lsgpr(bid), nblk, rep + 1 < REP_MLF);
        xcd_barrier(xb, P.xbar, wvs);
        for (int rep = 0; rep < (l == 0 ? REP_G2 : 1); ++rep) ph_gemm_mfma<2>(P, wvs, l, lsgpr(bid), nblk, smraw);
        xcd_barrier(xb, P.xbar, wvs);
}

__global__ void __launch_bounds__(NT) mega_fwd(Params Pk) {
    __shared__ __attribute__((aligned(16))) unsigned char smraw[MEGA_LDS_BYTES + 16];
    float* sm = (float*)smraw;
    cg::grid_group grid = cg::this_grid();
    const int bid = blockIdx.x, nblk = gridDim.x;
    const int wvs = __builtin_amdgcn_readfirstlane((int)(threadIdx.x >> 6));
    if (threadIdx.x == 0) {
        GAS unsigned long long* dstw = (GAS unsigned long long*)Pk.gp; const unsigned long long* srcw = (const unsigned long long*)&Pk;
#pragma unroll
        for (int i = 0; i < (int)(sizeof(Params) / 8); ++i) dstw[i] = srcw[i];
        *(uintx4*)(smraw + MEGA_LDS_BYTES) = (uintx4){0u, 0u, 0u, 0u};
    }
    asm volatile("s_waitcnt vmcnt(0)" ::: "memory");
    __syncthreads();
    const XcdBarrier xb = xcd_barrier_post(Pk.xbar, (volatile LAS unsigned*)(smraw + MEGA_LDS_BYTES));
    const GAS Params* pg = Pk.gp;
    asm volatile("" : "+s"(pg) :: "memory");
    PRef P = *pg;
    ph_mods2(P, wvs, lsgpr(bid), nblk, sm);
    ph_wprep(P, wvs, lsgpr(bid), nblk, sm);
    ph_tables(P, wvs, lsgpr(bid), nblk);
    grid.sync();
    layer_body<0>(P, wvs, bid, nblk, smraw, sm, xb);
    layer_body<1>(P, wvs, bid, nblk, smraw, sm, xb);
    ph_final2(P, wvs, lsgpr(bid), nblk);
}

extern "C" void kernel_launch(void* const* d_in, const int* in_sizes, int n_in, void* d_out, int out_size, void* d_ws, size_t ws_size, hipStream_t stream) {
    if (ws_size < WS_END) { fprintf(stderr, "workspace too small: %zu < %zu\n", ws_size, (size_t)WS_END); return; }
    static int grid_blocks = 0;
    if (!grid_blocks) {
        int dev = 0, cus = 0, per_cu = 0;
        hipGetDevice(&dev);
        hipDeviceGetAttribute(&cus, hipDeviceAttributeMultiprocessorCount, dev);
        hipOccupancyMaxActiveBlocksPerMultiprocessor(&per_cu, mega_fwd, NT, 0);
        if (per_cu < 1) per_cu = 1;
        grid_blocks = cus * per_cu;
        fprintf(stderr, "mega_fwd: %d CUs x %d blocks/CU\n", cus, per_cu);
    }
    Params P{};
    fill_params(P, d_in, d_out, d_ws);
    hipMemsetAsync((unsigned char*)d_ws + WS_XBAR, 0, (XCD_BAR_WORDS + 256) * 4, stream);
    void* args[] = {&P};
    hipError_t e = hipLaunchCooperativeKernel((void*)mega_fwd, dim3(grid_blocks), dim3(NT), args, 0, stream);
    if (e != hipSuccess) fprintf(stderr, "cooperative launch failed: %s (grid %d)\n", hipGetErrorString(e), grid_blocks);
}
```

```cpp
#include <hip/hip_runtime.h>
#include <hip/hip_cooperative_groups.h>
#include <cstdint>
#include <cmath>
#include <cstdio>
namespace cg = cooperative_groups;

#ifndef SEQ
#define SEQ 16384
#endif
#ifndef CTX
#define CTX 256
#endif
#ifndef REP_G1
#define REP_G1 1
#endif
#ifndef REP_G2
#define REP_G2 1
#endif
#ifndef REP_P1
#define REP_P1 1
#endif
#ifndef REP_S5A
#define REP_S5A 1
#endif
#ifndef REP_S5C
#define REP_S5C 1
#endif
#ifndef REP_MLA
#define REP_MLA 1
#endif
#ifndef REP_ML1
#define REP_ML1 1
#endif
#ifndef REP_ML3
#define REP_ML3 1
#endif
#ifndef REP_HX
#define REP_HX 1
#endif
#ifndef REP_ST
#define REP_ST 1
#endif
#ifndef REP_RWF
#define REP_RWF 1
#endif
#ifndef REP_MLF
#define REP_MLF 1
#endif
#ifndef REP_G3
#define REP_G3 1
#endif
#ifndef ST_VARIANT
#define ST_VARIANT 0
#endif
#ifndef G_VARIANT
#define G_VARIANT 0
#endif
#ifndef P_VARIANT
#define P_VARIANT 0
#endif
#ifndef REP_SYNC
#define REP_SYNC 1
#endif

typedef _Float16 f16;
typedef __bf16 bf16;
typedef _Float16 half8 __attribute__((ext_vector_type(8)));
typedef _Float16 half4 __attribute__((ext_vector_type(4)));
typedef __bf16 bf16x8 __attribute__((ext_vector_type(8)));
typedef __bf16 bf16x4 __attribute__((ext_vector_type(4)));
typedef float floatx16 __attribute__((ext_vector_type(16)));
typedef float floatx4 __attribute__((ext_vector_type(4)));
typedef unsigned uintx4 __attribute__((ext_vector_type(4)));

constexpr int D = 1024, NB = 2, INW = 2944;
constexpr int NCTX = NB * CTX, NLAT = NB * SEQ, NROWS = NCTX + NLAT;
constexpr int TSCAN = CTX + SEQ, NCHUNK = TSCAN / 64;
constexpr int NT = 512, NW = NT / 64;
#define DEV __device__ __forceinline__
#define LAS __attribute__((address_space(3)))
#define GAS __attribute__((address_space(1)))
#define BAR_LDS() asm volatile("s_waitcnt lgkmcnt(0)\n\ts_barrier" ::: "memory")

DEV int ltid(int wvs) { int lane; asm volatile("v_mbcnt_lo_u32_b32 %0, -1, 0\n\tv_mbcnt_hi_u32_b32 %0, -1, %0" : "=v"(lane)); return (wvs << 6) | lane; }
DEV int lsgpr(int x) { asm volatile("" : "+s"(x)); return x; }

struct Params;
typedef const GAS Params& PRef;
struct Params {
    const GAS float *x, *c, *ctx, *c_ctx, *ada_w, *ada_b, *norm_g, *w_in, *w_out;
    const GAS float *rw_mu, *rw_w0, *rw_w_up, *rw_a0, *rw_a_up, *rw_k_k, *rw_k_a, *rw_r_k, *rw_ln_g, *rw_ln_b;
    const GAS float *s5_a_re, *s5_a_im, *s5_log_dt, *s5_b_re, *s5_b_im, *s5_c_re, *s5_c_im, *s5_d, *s5_glu_w, *s5_glu_b;
    const GAS float *ml_conv_w, *ml_conv_b, *ml_wq, *ml_wk, *ml_wv, *ml_wi, *ml_bi, *ml_wf, *ml_bf, *ml_norm_g, *ml_skip;
    const GAS float* final_g;
    GAS float* out;
    GAS float* mods;
    GAS f16* p;
    GAS f16* Yh;
    GAS float* gates;
    GAS float* bon;
    GAS float* ctx1;
    GAS f16* hx;
    GAS f16* rwm;
    GAS f16* qkv16;
    GAS float* mlC;
    GAS float* mlG;
    GAS f16* wt_in;
    GAS f16* wt_out;
    GAS f16* glut;
    GAS f16* yg;
    GAS float* s5h;
    GAS float* s5par;
    GAS f16* s5bb;
    GAS f16* s5cc;
    GAS bf16* rwlt;
    GAS f16* mlgw;
    GAS unsigned* xbar;
    GAS Params* gp;
};

DEV float sigmoidf_(float x) { return 1.f / (1.f + expf(-x)); }
DEV float siluf_(float x) { return x / (1.f + expf(-x)); }
DEV float frcp(float x) { return __builtin_amdgcn_rcpf(x); }
DEV float fsigmoid(float x) { return frcp(1.f + __expf(-x)); }
DEV float fsilu(float x) { return x * frcp(1.f + __expf(-x)); }
DEV float ftanh(float x) { x = fminf(fmaxf(x, -15.f), 15.f); const float e = __expf(2.f * x); return (e - 1.f) * frcp(e + 1.f); }
DEV float log_sigmoidf_(float x) { return fminf(x, 0.f) - log1pf(expf(-fabsf(x))); }
template <int CTRL> DEV float dpp_f(float v) { return __builtin_bit_cast(float, __builtin_amdgcn_update_dpp(0, __builtin_bit_cast(int, v), CTRL, 0xF, 0xF, false)); }
DEV float row16_sum(float v) {
    v += dpp_f<0xB1>(v); v += dpp_f<0x4E>(v); v += dpp_f<0x141>(v); v += dpp_f<0x140>(v);
    return v;
}
DEV float wave_sum(float v) {
    v = row16_sum(v);
    v += __shfl_xor(v, 16); v += __shfl_xor(v, 32);
    return v;
}
DEV int scan_row(int z, int b, int s) {
    if (s < CTX) { int t = z ? CTX - 1 - s : s; return b * CTX + t; }
    int u = s - CTX; int t = z ? SEQ - 1 - u : u; return NCTX + b * SEQ + t;
}
DEV int mirror_chunk(int tc) { return tc < CTX / 64 ? CTX / 64 - 1 - tc : CTX / 64 + (SEQ / 64 - 1) - (tc - CTX / 64); }
DEV int row_mod(int R) { return R < NCTX ? 2 : (R - NCTX) / SEQ; }
DEV const GAS float* xrow(PRef P, int l, int R) {
    const GAS float* xl = l == 0 ? P.x : P.out; const GAS float* xc = l == 0 ? P.ctx : P.ctx1;
    return R < NCTX ? xc + (size_t)R * D : xl + (size_t)(R - NCTX) * D;
}
DEV int nbr_row(int R, int c) {
    if (R < NCTX) { int t = R % CTX; if ((c & 1) == 0) return t > 0 ? R - 1 : -1; return t < CTX - 1 ? R + 1 : -1; }
    int t = (R - NCTX) % SEQ; int m = c & 3, col = t & 63;
    if (m == 0) return col > 0 ? R - 1 : -1;
    if (m == 1) return col < 63 ? R + 1 : -1;
    if (m == 2) return t >= 64 ? R - 64 : -1;
    return t < SEQ - 64 ? R + 64 : -1;
}
DEV float shl(PRef P, int l, int R, int c) {
    float pv = (float)P.p[(size_t)R * INW + c];
    int nb = nbr_row(R, c);
    float nv = nb >= 0 ? (float)P.p[(size_t)nb * INW + c] : 0.f;
    return pv + (nv - pv) * P.rw_mu[l * 1280 + c];
}
DEV int a2col(int k) { return k < 384 ? 1280 + k : (k < 640 ? 1920 + (k - 384) : 2560 + (k - 640)); }
DEV float ml_xm(PRef P, int R, int c) { return (float)P.p[(size_t)R * INW + 2176 + c]; }
DEV float ml_xc(PRef P, int l, int R, int c) {
    int t, len; if (R < NCTX) { t = R % CTX; len = CTX; } else { t = (R - NCTX) % SEQ; len = SEQ; }
    float a = P.ml_conv_b[l * 384 + c] + P.ml_conv_w[(l * 3 + 1) * 384 + c] * ml_xm(P, R, c);
    if (t > 0) a += P.ml_conv_w[(l * 3 + 0) * 384 + c] * ml_xm(P, R - 1, c);
    if (t < len - 1) a += P.ml_conv_w[(l * 3 + 2) * 384 + c] * ml_xm(P, R + 1, c);
    return fsilu(a);
}

DEV void ph_mods2(PRef P, int wvs, int bid, int nblk, float* sm) {
    const int tid = ltid(wvs), cl = tid & 15, kq = tid >> 4;
    for (int g = bid; g < 2 * 3 * 3072 / 16; g += nblk) {
        const int idx = g * 16 + cl; const int l = idx / 9216, rem = idx % 9216, j = rem / 3072, col = rem % 3072;
        const GAS float* cin = j < 2 ? P.c + j * D : P.c_ctx;
        float acc = 0.f;
        for (int k = kq * 32; k < kq * 32 + 32; ++k) acc += siluf_(cin[k]) * P.ada_w[((size_t)l * D + k) * 3072 + col];
        sm[kq * 16 + cl] = acc;
        __syncthreads();
        if (tid < 16) { float s = P.ada_b[l * 3072 + col]; for (int q = 0; q < 32; ++q) s += sm[q * 16 + tid]; P.mods[idx] = s; }
        __syncthreads();
    }
}
DEV void ph_wprep(PRef P, int wvs, int bid, int nblk, float* sm) {
    const int tid = ltid(wvs);
    constexpr int T_IN = 16 * 48, T_OUT = 16 * 16, T_GLU = 4 * 4;
    for (int t = bid; t < 2 * (T_IN + T_OUT + T_GLU); t += nblk) {
        int l = t / (T_IN + T_OUT + T_GLU), r = t % (T_IN + T_OUT + T_GLU);
        const GAS float* W; GAS f16* Wt; int N, tk, tn, KW = D;
        if (r < T_IN) { W = P.w_in + (size_t)l * D * INW; Wt = P.wt_in + (size_t)l * 3072 * D; N = INW; tk = r / 48; tn = r % 48; }
        else if (r < T_IN + T_OUT) { r -= T_IN; W = P.w_out + (size_t)l * D * D; Wt = P.wt_out + (size_t)l * D * D; N = D; tk = r / 16; tn = r % 16; }
        else { r -= T_IN + T_OUT; W = P.s5_glu_w + (size_t)l * 256 * 256; Wt = P.glut + (size_t)l * 256 * 256; N = 256; tk = r / 4; tn = r % 4; KW = 256; }
#pragma unroll
        for (int i = 0; i < 2; ++i) {
            int k = (tid >> 4) + 32 * i, n4 = (tid & 15) * 4;
            floatx4 v = {0.f, 0.f, 0.f, 0.f};
            if (tn * 64 + n4 < N) v = *(const GAS floatx4*)(W + (size_t)(tk * 64 + k) * N + tn * 64 + n4);
            sm[k * 65 + n4] = v[0]; sm[k * 65 + n4 + 1] = v[1]; sm[k * 65 + n4 + 2] = v[2]; sm[k * 65 + n4 + 3] = v[3];
        }
        __syncthreads();
        {
            int n = tid >> 3, k8 = (tid & 7) * 8;
            half8 h;
#pragma unroll
            for (int j = 0; j < 8; ++j) h[j] = (f16)sm[(k8 + j) * 65 + n];
            *(half8*)(Wt + (size_t)(tn * 64 + n) * KW + tk * 64 + k8) = h;
        }
        __syncthreads();
    }
}
constexpr int S5PW = 38;
DEV void ph_tables(PRef P, int wvs, int bid, int nblk) {
    for (int idx = bid * NT + ltid(wvs); idx < 2 * 2 * 16 * 64; idx += nblk * NT) {
        const int n = idx & 63, lzg = idx >> 6;
        const int pi = lzg * 64 + n;
        const float are_ = P.s5_a_re[pi], aim_ = P.s5_a_im[pi], dt = expf(P.s5_log_dt[pi]);
        const float mag = expf(are_ * dt), abr = mag * cosf(aim_ * dt), abi = mag * sinf(aim_ * dt);
        const float den = are_ * are_ + aim_ * aim_;
        const float qre = ((abr - 1.f) * are_ + abi * aim_) / den, qim = (abi * are_ - (abr - 1.f) * aim_) / den;
        GAS float* tb = P.s5par + (size_t)lzg * S5PW * 64 + n;
        tb[0] = abr; tb[64] = abi;
        for (int pp = 0; pp < 16; ++pp) {
            const float br = P.s5_b_re[(size_t)pi * 16 + pp], bi = P.s5_b_im[(size_t)pi * 16 + pp];
            P.s5bb[((size_t)lzg * 128 + n) * 16 + pp] = (f16)(qre * br - qim * bi);
            P.s5bb[((size_t)lzg * 128 + 64 + n) * 16 + pp] = (f16)(qre * bi + qim * br);
            P.s5cc[((size_t)lzg * 16 + pp) * 128 + n] = (f16)P.s5_c_re[((size_t)lzg * 16 + pp) * 64 + n];
            P.s5cc[((size_t)lzg * 16 + pp) * 128 + 64 + n] = (f16)(-P.s5_c_im[((size_t)lzg * 16 + pp) * 64 + n]);
        }
        const float m64 = expf(64.f * are_ * dt);
        tb[34 * 64] = m64 * cosf(64.f * aim_ * dt); tb[35 * 64] = m64 * sinf(64.f * aim_ * dt);
    }
    for (int idx = bid * NT + ltid(wvs); idx < 2 * 16 * 1152; idx += nblk * NT) {
        const int c = idx % 1152, o = (idx / 1152) & 15, l = idx / (16 * 1152), z = o >> 3, hh = (o >> 1) & 3, which = o & 1;
        const float w = (which ? P.ml_wf : P.ml_wi)[((size_t)(l * 2 + z) * 1152 + c) * 4 + hh];
        P.mlgw[idx] = (f16)((c >= 384 && c < 768) ? w * 9.797958971132712f : w);
    }
    for (int idx = bid * NT + ltid(wvs); idx < 2 * 2 * 2 * 384 * 32; idx += nblk * NT) {
        const int r = idx & 31, c = (idx >> 5) % 384, wa = (idx / (32 * 384)) & 1, lz = idx / (2 * 32 * 384);
        const GAS float* src_ = wa ? P.rw_a_up : P.rw_w_up;
        P.rwlt[idx] = (bf16)src_[((size_t)lz * 32 + r) * 384 + c];
    }
}
DEV void ph_hx(PRef P, int wvs, int l, int bid, int nblk) {
    const int tid_ = ltid(wvs); const int lane = tid_ & 63, wv = tid_ >> 6;
    for (int R = bid * NW + wv; R < NROWS; R += nblk * NW) {
        const GAS float* xr = xrow(P, l, R);
        floatx4 v[4]; float ss = 0.f;
#pragma unroll
        for (int i = 0; i < 4; ++i) { v[i] = *(const floatx4*)(xr + i * 256 + lane * 4); ss += v[i][0] * v[i][0] + v[i][1] * v[i][1] + v[i][2] * v[i][2] + v[i][3] * v[i][3]; }
        ss = wave_sum(ss);
        const float rs = 1.f / sqrtf(ss * (1.f / D) + 1e-6f);
        const GAS float* m = P.mods + (l * 3 + row_mod(R)) * 3072; const GAS float* g = P.norm_g + l * D;
#pragma unroll
        for (int i = 0; i < 4; ++i) {
            int k = i * 256 + lane * 4; half4 h;
#pragma unroll
            for (int j = 0; j < 4; ++j) h[j] = (f16)(v[i][j] * rs * g[k + j] * (1.f + m[D + k + j]) + m[k + j]);
            *(half4*)(P.hx + (size_t)R * D + k) = h;
        }
    }
}
DEV void ph_final2(PRef P, int wvs, int bid, int nblk) {
    const int tid_ = ltid(wvs); const int lane = tid_ & 63, wv = tid_ >> 6;
    for (int r = bid * NW + wv; r < NLAT; r += nblk * NW) {
        GAS float* xr = P.out + (size_t)r * D; floatx4 v[4]; float ss = 0.f;
#pragma unroll
        for (int i = 0; i < 4; ++i) { v[i] = *(const floatx4*)(xr + i * 256 + lane * 4); ss += v[i][0] * v[i][0] + v[i][1] * v[i][1] + v[i][2] * v[i][2] + v[i][3] * v[i][3]; }
        ss = wave_sum(ss);
        const float rs = 1.f / sqrtf(ss * (1.f / D) + 1e-6f);
#pragma unroll
        for (int i = 0; i < 4; ++i) {
            const floatx4 g = *(const floatx4*)(P.final_g + i * 256 + lane * 4); floatx4 o;
#pragma unroll
            for (int j = 0; j < 4; ++j) o[j] = v[i][j] * rs * g[j];
            *(floatx4*)(xr + i * 256 + lane * 4) = o;
        }
    }
}

constexpr int G_LDA = 72;
constexpr int G_STAGE = (256 + 128) * G_LDA;
constexpr int GEMM_LDS_BYTES = 2 * G_STAGE * 2;
template <int MODE>
DEV void gemm_epi_tile(PRef P, int l, const floatx16 acc, int R0, int n0, int lane) {
#pragma unroll
    for (int r = 0; r < 16; ++r) {
        const int R = R0 + (r & 3) + 8 * (r >> 2) + 4 * (lane >> 5), n = n0 + (lane & 31);
        if (MODE == 1) P.p[(size_t)R * INW + n] = (f16)acc[r];
        else if (MODE == 2) {
            const int j = row_mod(R); const float g = P.mods[(l * 3 + j) * 3072 + 2 * D + n];
            const float xo = xrow(P, l, R)[n];
            GAS float* dst = R < NCTX ? P.ctx1 + (size_t)R * D + n : P.out + (size_t)(R - NCTX) * D + n;
            *dst = xo + g * acc[r];
        } else {
            const float yv = (float)P.yg[(size_t)R * 256 + n]; const float gt = (float)P.p[(size_t)R * INW + 1920 + n];
            P.p[(size_t)R * INW + 1920 + n] = (f16)(yv * fsigmoid(acc[r] + P.s5_glu_b[l * 256 + n]) * fsilu(gt));
        }
    }
}
template <int MODE>
DEV void ph_gemm_mfma(PRef P, int wvs, int l, int bid, int nblk, unsigned char* smraw, bool dry = false, int ntm_limit = 1 << 30) {
    constexpr int N = MODE == 1 ? INW : (MODE == 2 ? D : 256), K = MODE == 3 ? 256 : D;
    const GAS f16* Bt = MODE == 1 ? P.wt_in + (size_t)l * INW * D : (MODE == 2 ? P.wt_out + (size_t)l * D * D : P.glut + (size_t)l * 256 * 256);
    const int tm0 = (MODE != 1 && l == 1) ? NCTX / 256 : 0;
    const int ntm = (NROWS / 256 - tm0) < ntm_limit ? (NROWS / 256 - tm0) : ntm_limit, ntn = N / 128;
    const int tid = ltid(wvs), lane = tid & 63, wv = tid >> 6, wm = wv & 3, wn = wv >> 2;
    f16* sbase = (f16*)smraw;
    const int ldrow = tid >> 3, ldch = tid & 7;
    constexpr int GM = 8;
    for (int t = bid; t < ntm * ntn; t += nblk) {
        int sg = t / (GM * ntn), rem = t % (GM * ntn);
        int gsz = ntm - sg * GM < GM ? ntm - sg * GM : GM;
        const int tm = tm0 + sg * GM + rem % gsz, tn = rem / gsz;
        floatx16 acc00, acc01, acc10, acc11;
#pragma unroll
        for (int r = 0; r < 16; ++r) { acc00[r] = 0.f; acc01[r] = 0.f; acc10[r] = 0.f; acc11[r] = 0.f; }
        uintx4 pa0, pa1, pa2, pa3, pb0, pb1, qa0, qa1, qa2, qa3, qb0, qb1;
        const GAS f16* arow = MODE == 1 ? P.hx + (size_t)(tm * 256 + ldrow) * D + ldch * 8 : (MODE == 2 ? P.p + (size_t)(tm * 256 + ldrow) * INW + ldch * 8 : P.yg + (size_t)(tm * 256 + ldrow) * 256 + ldch * 8);
        const size_t astr = (size_t)64 * (MODE == 1 ? D : (MODE == 2 ? INW : 256));
        const GAS f16* brow = Bt + (size_t)(tn * 128 + ldrow) * K + ldch * 8;
#define GLOAD(S, kt_) if (!(dry && G_VARIANT == 3 && (kt_) > 1)) { const int ka = MODE == 2 ? a2col((kt_) * 64) : (kt_) * 64; const int kb = (kt_) * 64; \
            S##a0 = *(const uintx4*)(arow + ka); S##a1 = *(const uintx4*)(arow + astr + ka); S##a2 = *(const uintx4*)(arow + 2 * astr + ka); S##a3 = *(const uintx4*)(arow + 3 * astr + ka); \
            S##b0 = *(const uintx4*)(brow + kb); S##b1 = *(const uintx4*)(brow + (size_t)64 * K + kb); }
#define SWRITE(S, st_) if (!(dry && G_VARIANT == 4)) { f16* sA_ = sbase + (st_) * G_STAGE + ldrow * G_LDA + ldch * 8; f16* sB_ = sbase + (st_) * G_STAGE + 256 * G_LDA + ldrow * G_LDA + ldch * 8; \
            *(uintx4*)(sA_) = S##a0; *(uintx4*)(sA_ + 64 * G_LDA) = S##a1; *(uintx4*)(sA_ + 128 * G_LDA) = S##a2; *(uintx4*)(sA_ + 192 * G_LDA) = S##a3; \
            *(uintx4*)(sB_) = S##b0; *(uintx4*)(sB_ + 64 * G_LDA) = S##b1; }
#define GFRAG(ks_, b_) { fa0[b_] = *(const half8*)(sA_ + (ks_) * 16); fa1[b_] = *(const half8*)(sA_ + 32 * G_LDA + (ks_) * 16); \
            fb0[b_] = *(const half8*)(sB_ + (ks_) * 16); fb1[b_] = *(const half8*)(sB_ + 32 * G_LDA + (ks_) * 16); }
#define GMMA(b_) { acc00 = __builtin_amdgcn_mfma_f32_32x32x16_f16(fb0[b_], fa0[b_], acc00, 0, 0, 0); acc01 = __builtin_amdgcn_mfma_f32_32x32x16_f16(fb1[b_], fa0[b_], acc01, 0, 0, 0); \
            acc10 = __builtin_amdgcn_mfma_f32_32x32x16_f16(fb0[b_], fa1[b_], acc10, 0, 0, 0); acc11 = __builtin_amdgcn_mfma_f32_32x32x16_f16(fb1[b_], fa1[b_], acc11, 0, 0, 0); }
#define GCOMPUTE(st_) { const f16* sA_ = sbase + (st_) * G_STAGE + (wm * 64 + (lane & 31)) * G_LDA + (lane >> 5) * 8; \
            const f16* sB_ = sbase + (st_) * G_STAGE + 256 * G_LDA + (wn * 64 + (lane & 31)) * G_LDA + (lane >> 5) * 8; \
            half8 fa0[2], fa1[2], fb0[2], fb1[2]; \
            GFRAG(0, 0); GFRAG(1, 1); __builtin_amdgcn_sched_barrier(0); \
            GMMA(0); GFRAG(2, 0); __builtin_amdgcn_sched_barrier(0); \
            GMMA(1); GFRAG(3, 1); __builtin_amdgcn_sched_barrier(0); \
            GMMA(0); __builtin_amdgcn_sched_barrier(0); GMMA(1); }
        constexpr int NK = K / 64;
        BAR_LDS();
        GLOAD(p, 0); SWRITE(p, 0); GLOAD(q, 1); if (2 < NK) GLOAD(p, 2);
        BAR_LDS();
        for (int kt = 0; kt < NK; kt += 2) {
            SWRITE(q, 1);
            if (kt + 3 < NK) GLOAD(q, kt + 3);
            GCOMPUTE(0);
            BAR_LDS();
            if (kt + 2 < NK) { SWRITE(p, 0); if (kt + 4 < NK) GLOAD(p, kt + 4); }
            GCOMPUTE(1);
            BAR_LDS();
        }
#undef GLOAD
#undef SWRITE
#undef GCOMPUTE
#undef GFRAG
#undef GMMA
        if (dry) continue;
        if (MODE != 2) {
            f16* Cs = (f16*)smraw;
#define CSTORE(acc_, mi_, ni_) { const int m_ = wm * 64 + (mi_) * 32 + (lane & 31); \
                _Pragma("unroll") for (int g = 0; g < 4; ++g) { half4 h_; h_[0] = (f16)acc_[4 * g]; h_[1] = (f16)acc_[4 * g + 1]; h_[2] = (f16)acc_[4 * g + 2]; h_[3] = (f16)acc_[4 * g + 3]; \
                    *(half4*)(Cs + m_ * 136 + wn * 64 + (ni_) * 32 + 8 * g + 4 * (lane >> 5)) = h_; } }
            CSTORE(acc00, 0, 0); CSTORE(acc01, 0, 1); CSTORE(acc10, 1, 0); CSTORE(acc11, 1, 1);
#undef CSTORE
            BAR_LDS();
#pragma unroll 2
            for (int i = 0; i < 8; ++i) {
                const int row = (tid >> 4) + 32 * i, ch = tid & 15; const int R = tm * 256 + row, n = tn * 128 + ch * 8;
                const half8 v = *(const half8*)(Cs + row * 136 + ch * 8);
                if (MODE == 1) *(GAS half8*)(P.p + (size_t)R * INW + n) = v;
                else {
                    const half8 yv = *(const GAS half8*)(P.yg + (size_t)R * 256 + n); const half8 gt = *(const GAS half8*)(P.p + (size_t)R * INW + 1920 + n);
                    const floatx4 b0 = *(const GAS floatx4*)(P.s5_glu_b + l * 256 + n), b1 = *(const GAS floatx4*)(P.s5_glu_b + l * 256 + n + 4);
                    half8 o;
#pragma unroll
                    for (int e = 0; e < 8; ++e) o[e] = (f16)((float)yv[e] * fsigmoid((float)v[e] + (e < 4 ? b0[e] : b1[e - 4])) * fsilu((float)gt[e]));
                    *(GAS half8*)(P.p + (size_t)R * INW + 1920 + n) = o;
                }
            }
        } else {
            float* Cs = (float*)smraw;
#pragma unroll 1
            for (int hm = 0; hm < 2; ++hm) {
                if ((wm >> 1) == hm) {
#define CSTORE(acc_, mi_, ni_) { const int m_ = (wm & 1) * 64 + (mi_) * 32 + (lane & 31); \
                    _Pragma("unroll") for (int g = 0; g < 4; ++g) { floatx4 f_; f_[0] = acc_[4 * g]; f_[1] = acc_[4 * g + 1]; f_[2] = acc_[4 * g + 2]; f_[3] = acc_[4 * g + 3]; \
                        *(floatx4*)(Cs + m_ * 132 + wn * 64 + (ni_) * 32 + 8 * g + 4 * (lane >> 5)) = f_; } }
                    CSTORE(acc00, 0, 0); CSTORE(acc01, 0, 1); CSTORE(acc10, 1, 0); CSTORE(acc11, 1, 1);
#undef CSTORE
                }
                BAR_LDS();
#pragma unroll 2
                for (int i = 0; i < 8; ++i) {
                    const int row = (tid >> 5) + 16 * i, ch = tid & 31; const int R = tm * 256 + hm * 128 + row, n = tn * 128 + ch * 4;
                    const floatx4 a4 = *(const floatx4*)(Cs + row * 132 + ch * 4);
                    const floatx4 g4 = *(const GAS floatx4*)(P.mods + (l * 3 + row_mod(R)) * 3072 + 2 * D + n);
                    const floatx4 x4 = *(const GAS floatx4*)(xrow(P, l, R) + n);
                    GAS float* dst = R < NCTX ? P.ctx1 + (size_t)R * D + n : P.out + (size_t)(R - NCTX) * D + n;
                    floatx4 o;
#pragma unroll
                    for (int e = 0; e < 4; ++e) o[e] = x4[e] + g4[e] * a4[e];
                    *(GAS floatx4*)dst = o;
                }
                BAR_LDS();
            }
        }
    }
}

constexpr int G8_HT = 128 * 64;
DEV int g8_lds_byte(int r, int c) { const int st = (r >> 4) * 2 + (c >> 5), rr = r & 15, cc = c & 31, ob = rr * 64 + cc * 2; return st * 1024 + (ob ^ (((ob >> 9) & 1) << 5)); }
DEV void g8_stage_rc(int b, int& R, int& C) { const int st = b / 1024, sb = b % 1024, swz = sb ^ (((sb >> 9) & 1) << 5); R = (st >> 1) * 16 + swz / 64; C = (st & 1) * 32 + (swz % 64) / 2; }
template <int MODE>
DEV void ph_gemm_8p(PRef P, int wvs, int l, int bid, int nblk, unsigned char* smraw) {
    constexpr int K = D, NPAD = MODE == 1 ? 3072 : D, LDA_ = MODE == 1 ? D : INW, PM0 = MODE == 1 ? 0 : NCTX / 256, nM = NROWS / 256 - PM0, nN = NPAD / 256, nt = K / 64;
    const GAS f16* A = MODE == 1 ? P.hx : P.p; const GAS f16* Bt = MODE == 1 ? P.wt_in + (size_t)l * NPAD * D : P.wt_out + (size_t)l * D * D;
    f16* shm = (f16*)smraw;
#define SA(b, h) (shm + ((b) * 2 + (h)) * G8_HT)
#define SB(b, h) (shm + (4 + (b) * 2 + (h)) * G8_HT)
#define STAGE_G(Pd, BASE, ld_, br, col_) do { const GAS unsigned char* sb_ = (const GAS unsigned char*)((BASE) + (long)(br) * (ld_) + (col_)); \
        _Pragma("unroll") for (int i_ = 0; i_ < 2; ++i_) { const int b_ = tid * 16 + i_ * 8192; int r_, c_; g8_stage_rc(b_, r_, c_); \
            const unsigned vo_ = (unsigned)(r_ * (ld_) + c_) * 2u; \
            __builtin_amdgcn_global_load_lds((const GAS unsigned*)(sb_ + vo_), (LAS unsigned*)((LAS char*)(Pd) + b_), 16, 0, 0); } } while (0)
#define STAGE_A(Pd, br, kt) STAGE_G(Pd, A, LDA_, br, (MODE == 1 ? (kt) * 64 : a2col((kt) * 64)))
#define STAGE_B(Pd, br, kt) STAGE_G(Pd, Bt, K, br, (kt) * 64)
#define LDA(dst, b, h) _Pragma("unroll") for (int m = 0; m < 4; ++m) _Pragma("unroll") for (int k = 0; k < 2; ++k) \
        dst[m][k] = *(const half8*)((const char*)SA(b, h) + g8_lds_byte(wr * 64 + m * 16 + fr, k * 32 + fq * 8))
#define LDB(dst, b, h) _Pragma("unroll") for (int n = 0; n < 2; ++n) _Pragma("unroll") for (int k = 0; k < 2; ++k) \
        dst[n][k] = *(const half8*)((const char*)SB(b, h) + g8_lds_byte(wc * 32 + n * 16 + fr, k * 32 + fq * 8))
#define MMA(ai, bj, At_, Bt_) do { __builtin_amdgcn_s_setprio(1); \
        _Pragma("unroll") for (int m = 0; m < 4; ++m) _Pragma("unroll") for (int n = 0; n < 2; ++n) _Pragma("unroll") for (int k = 0; k < 2; ++k) \
            acc[ai][bj][m][n] = __builtin_amdgcn_mfma_f32_16x16x32_f16(Bt_[n][k], At_[m][k], acc[ai][bj][m][n], 0, 0, 0); \
        __builtin_amdgcn_s_setprio(0); } while (0)
#define WAIT_V(n) asm volatile("s_waitcnt vmcnt(" #n ")" ::: "memory")
#define WAIT_L(n) asm volatile("s_waitcnt lgkmcnt(" #n ")" ::: "memory")
#define BARR __builtin_amdgcn_s_barrier()
#define SCHED __builtin_amdgcn_sched_barrier(0)
    constexpr int GM = 8;
    constexpr int nNf = MODE == 1 ? nN - 1 : nN, NFULL = nM * nNf, NHALF = MODE == 1 ? nM : 0;
    const int nfull_mine = (NFULL - bid + nblk - 1) / nblk;
    const int first_short = NFULL % nblk;
    int nh_mine = 0, h0 = 0, h1 = 0;
    if (MODE == 1 && nblk == 256) {
        const int ns = nblk - first_short;
        if (bid >= first_short) { h0 = bid - first_short; nh_mine = h0 < NHALF ? 1 : 0; if (ns + h0 < NHALF) { h1 = ns + h0; nh_mine = 2; } }
    } else if (MODE == 1) { for (int hh = bid; hh < NHALF; hh += nblk) { if (nh_mine == 0) h0 = hh; else h1 = hh; ++nh_mine; } }
    for (int ti = 0; ti < nfull_mine + nh_mine; ++ti) {
        const int tid = ltid(wvs), wid = tid >> 6, lane = tid & 63, wr = wid >> 2, wc = wid & 3, fr = lane & 15, fq = lane >> 4;
        const bool halfw = ti >= nfull_mine;
        int pm, pn;
        if (!halfw) {
            const int t0 = bid + ti * nblk;
            const int sg = t0 / (GM * nNf), rem = t0 % (GM * nNf), gsz = nM - sg * GM < GM ? nM - sg * GM : GM;
            pm = PM0 + sg * GM + rem % gsz; pn = rem / gsz;
        } else { pm = (ti == nfull_mine ? h0 : h1); pn = nNf; }
        const int brow = pm * 256, bcol = pn * 256;
        floatx4 acc[2][2][4][2];
#pragma unroll
        for (int a = 0; a < 2; ++a)
#pragma unroll
            for (int b = 0; b < 2; ++b)
#pragma unroll
                for (int m = 0; m < 4; ++m)
#pragma unroll
                    for (int n = 0; n < 2; ++n) acc[a][b][m][n] = (floatx4){0.f, 0.f, 0.f, 0.f};
        half8 At[4][2], B0[2][2], B1[2][2];
        asm volatile("s_waitcnt vmcnt(0) lgkmcnt(0)" ::: "memory");
        BARR;
        STAGE_B(SB(0, 0), bcol, 0); STAGE_A(SA(0, 0), brow, 0);
        STAGE_B(SB(0, 1), bcol + 128, 0); STAGE_A(SA(0, 1), brow + 128, 0);
        if (wr == 1) BARR;
        WAIT_V(4); BARR;
        STAGE_B(SB(1, 0), bcol, 1); STAGE_A(SA(1, 0), brow, 1); STAGE_B(SB(1, 1), bcol + 128, 1);
        WAIT_V(6); BARR;
        for (int t = 0; t < nt - 2; t += 2) {
            LDB(B0, 0, 0); SCHED; LDA(At, 0, 0); STAGE_A(SA(1, 1), brow + 128, t + 1);
            WAIT_L(8); BARR; WAIT_L(0); MMA(0, 0, At, B0); BARR; SCHED;
            LDB(B1, 0, 1); STAGE_B(SB(0, 0), bcol, t + 2);
            BARR; WAIT_L(0); if (!halfw) MMA(0, 1, At, B1); BARR;
            LDA(At, 0, 1); STAGE_A(SA(0, 0), brow, t + 2);
            BARR; WAIT_L(0); MMA(1, 0, At, B0); BARR; SCHED;
            STAGE_B(SB(0, 1), bcol + 128, t + 2);
            WAIT_V(6); BARR; if (!halfw) MMA(1, 1, At, B1); BARR;
            LDB(B0, 1, 0); SCHED; LDA(At, 1, 0); STAGE_A(SA(0, 1), brow + 128, t + 2);
            WAIT_L(8); BARR; WAIT_L(0); MMA(0, 0, At, B0); BARR; SCHED;
            LDB(B1, 1, 1); STAGE_B(SB(1, 0), bcol, t + 3);
            BARR; WAIT_L(0); if (!halfw) MMA(0, 1, At, B1); BARR;
            LDA(At, 1, 1); STAGE_A(SA(1, 0), brow, t + 3);
            BARR; WAIT_L(0); MMA(1, 0, At, B0); BARR; SCHED;
            STAGE_B(SB(1, 1), bcol + 128, t + 3);
            WAIT_V(6); BARR; if (!halfw) MMA(1, 1, At, B1); BARR;
        }
        { LDB(B0, 0, 0); LDA(At, 0, 0); STAGE_A(SA(1, 1), brow + 128, nt - 1);
          BARR; WAIT_L(0); MMA(0, 0, At, B0); BARR;
          LDB(B1, 0, 1); BARR; WAIT_L(0); if (!halfw) MMA(0, 1, At, B1); BARR;
          LDA(At, 0, 1); WAIT_V(4); BARR; WAIT_L(0); MMA(1, 0, At, B0); if (!halfw) MMA(1, 1, At, B1); BARR; }
        { LDB(B0, 1, 0); LDA(At, 1, 0); WAIT_V(2); BARR; WAIT_L(0); MMA(0, 0, At, B0); BARR;
          LDB(B1, 1, 1); WAIT_V(0); BARR; WAIT_L(0); if (!halfw) MMA(0, 1, At, B1); BARR;
          LDA(At, 1, 1); BARR; WAIT_L(0); MMA(1, 0, At, B0); if (!halfw) MMA(1, 1, At, B1); BARR; }
        if (wr == 0) BARR;
        if (MODE == 1) {
            f16* Cs = shm;
#pragma unroll
            for (int ai = 0; ai < 2; ++ai)
#pragma unroll
                for (int bj = 0; bj < 2; ++bj)
#pragma unroll
                    for (int m = 0; m < 4; ++m)
#pragma unroll
                        for (int n = 0; n < 2; ++n) {
                            const floatx4 v = acc[ai][bj][m][n]; half4 h; h[0] = (f16)v[0]; h[1] = (f16)v[1]; h[2] = (f16)v[2]; h[3] = (f16)v[3];
                            *(half4*)(Cs + (ai * 128 + wr * 64 + m * 16 + fr) * 264 + bj * 128 + wc * 32 + n * 16 + fq * 4) = h;
                        }
            asm volatile("s_waitcnt lgkmcnt(0)" ::: "memory"); BARR;
#pragma unroll 4
            for (int i = 0; i < 16; ++i) {
                const int row = (tid >> 5) + 16 * i, ch = tid & 31; const int n = bcol + ch * 8;
                if (n < INW) *(GAS half8*)(P.p + (size_t)(brow + row) * INW + n) = *(const half8*)(Cs + row * 264 + ch * 8);
            }
        } else {
            float* Cs = (float*)shm;
#pragma unroll
            for (int ai = 0; ai < 2; ++ai) {
                if (ai == 1) { asm volatile("s_waitcnt lgkmcnt(0)" ::: "memory"); BARR; }
#pragma unroll
                for (int bj = 0; bj < 2; ++bj)
#pragma unroll
                    for (int m = 0; m < 4; ++m)
#pragma unroll
                        for (int n = 0; n < 2; ++n) *(floatx4*)(Cs + (wr * 64 + m * 16 + fr) * 264 + bj * 128 + wc * 32 + n * 16 + fq * 4) = acc[ai][bj][m][n];
                asm volatile("s_waitcnt lgkmcnt(0)" ::: "memory"); BARR;
#pragma unroll 1
                for (int i = 0; i < 16; ++i) {
                    const int row = (tid >> 6) + 8 * i, ch = tid & 63; const int R = brow + ai * 128 + row, n = bcol + ch * 4;
                    const floatx4 a4 = *(const floatx4*)(Cs + row * 264 + ch * 4);
                    const floatx4 g4 = *(const GAS floatx4*)(P.mods + (l * 3 + row_mod(R)) * 3072 + 2 * D + n);
                    const floatx4 x4 = *(const GAS floatx4*)(xrow(P, l, R) + n);
                    floatx4 o;
#pragma unroll
                    for (int e = 0; e < 4; ++e) o[e] = x4[e] + g4[e] * a4[e];
                    *(GAS floatx4*)(P.out + (size_t)(R - NCTX) * D + n) = o;
                }
            }
        }
    }
#undef SA
#undef SB
#undef STAGE_G
#undef STAGE_A
#undef STAGE_B
#undef LDA
#undef LDB
#undef MMA
#undef WAIT_V
#undef WAIT_L
#undef BARR
#undef SCHED
}

constexpr int RLD = 72;
constexpr int RSLOT = 64 * RLD;
constexpr int RWP1_LDS_BYTES = 11 * RSLOT * 2 + 2 * 64 * 65 * 4 + 1536 * 4 + 128 * 4 + 3968 * 4 + 2560;
constexpr size_t RWM_STRIDE = (size_t)24 * NCHUNK * 4096;

DEV bf16x8 ldfrag(const bf16* M, int rowbase, int lane, int ks) {
    return *(const bf16x8*)(M + (rowbase + (lane & 31)) * RLD + ks * 16 + (lane >> 5) * 8);
}
DEV floatx16 mm64(const bf16* A, const bf16* Bt, int wm, int wn, int lane) {
    floatx16 acc;
#pragma unroll
    for (int r = 0; r < 16; ++r) acc[r] = 0.f;
#pragma unroll
    for (int ks = 0; ks < 4; ++ks) acc = __builtin_amdgcn_mfma_f32_32x32x16_bf16(ldfrag(A, wm * 32, lane, ks), ldfrag(Bt, wn * 32, lane, ks), acc, 0, 0, 0);
    return acc;
}
DEV void storeT(bf16* dst, const floatx16 c, int wm, int wn, int lane) {
    const int n = wn * 32 + (lane & 31);
#pragma unroll
    for (int g = 0; g < 4; ++g) {
        const int m0 = wm * 32 + 8 * g + 4 * (lane >> 5);
        bf16x4 v; v[0] = (bf16)c[4 * g]; v[1] = (bf16)c[4 * g + 1]; v[2] = (bf16)c[4 * g + 2]; v[3] = (bf16)c[4 * g + 3];
        *(bf16x4*)(dst + n * RLD + m0) = v;
    }
}

DEV void ph_rw_p1(PRef P, int wvs, int l, int bid, int nblk, unsigned char* smraw, bool dry = false) {
    bf16* sl = (bf16*)smraw;
    bf16 *Am = sl, *AmT = sl + RSLOT, *Bp = sl + 2 * RSLOT, *Kp = sl + 3 * RSLOT, *Rt = sl + 4 * RSLOT, *VT = sl + 5 * RSLOT,
         *BendT = sl + 6 * RSLOT, *KendT = sl + 7 * RSLOT, *Nak = sl + 8 * RSLOT, *Mrb = sl + 9 * RSLOT, *Mrk = sl + 10 * RSLOT;
    bf16 *UtT = Am, *WmT = Bp, *NVT = Kp;
    float* Nf = (float*)(smraw + 11 * RSLOT * 2); float* Tf = Nf + 64 * 65; float* Wb = Tf + 64 * 65; float* gl = Wb + 1536;
    bf16* Noff = (bf16*)Nf; float* Nfull = Nf + 2304;
    bf16* Td = (bf16*)(Nf + 2304 + 4096); bf16* Zs = (bf16*)Wb;
    float* av = Nf; float* lwb = Tf;
    f16* Sr = (f16*)Nak; f16* Sk = (f16*)Mrb; f16* Sv = (f16*)Mrk; bf16* lt = KendT;
    float* part = Wb;
    GAS f16* PTg = P.rwm; GAS f16* RPg = PTg + RWM_STRIDE; GAS f16* Qg = RPg + RWM_STRIDE;
    float* prm = gl + 128; f16* mu16 = (f16*)(prm + 3968);
    {
        const int tid0 = ltid(wvs);
        __syncthreads();
        for (int i = tid0; i < 1280; i += NT) mu16[i] = (f16)P.rw_mu[l * 1280 + i];
        for (int i = tid0; i < 768; i += NT) { prm[1280 + i] = P.rw_w0[l * 768 + i]; prm[2048 + i] = P.rw_a0[l * 768 + i]; }
        for (int i = tid0; i < 384; i += NT) { prm[2816 + i] = P.rw_k_k[l * 384 + i]; prm[3200 + i] = P.rw_k_a[l * 384 + i]; prm[3584 + i] = P.rw_r_k[l * 384 + i]; }
        __syncthreads();
    }
    half8 rown[4], rn0[4], rn1[4], rn2[4], rn3[4]; bf16x8 tabf[2];
#define P1_ISSUE(i_, item_) { const int tid_ = ltid(wvs); const int c8_ = tid_ & 7, t_ = (tid_ >> 3) & 63; \
        const int chain_ = (item_) / NCHUNK, ck_ = (item_) % NCHUNK, z_ = chain_ / 12, b_ = (chain_ / 6) % 2, h_ = chain_ % 6; \
        const int col0_ = (i_) < 3 ? (i_) * 384 + h_ * 64 + c8_ * 8 : (c8_ < 4 ? 1152 + z_ * 32 + c8_ * 8 : 1216 + z_ * 32 + (c8_ - 4) * 8); \
        const int R_ = scan_row(z_, b_, ck_ * 64 + t_); const GAS f16* pr_ = P.p + (size_t)R_ * INW + col0_; \
        half8 zz_; _Pragma("unroll") for (int e = 0; e < 8; ++e) zz_[e] = (f16)0.f; \
        rown[i_] = *(const GAS half8*)pr_; rn0[i_] = zz_; rn1[i_] = zz_; rn2[i_] = zz_; rn3[i_] = zz_; \
        if (R_ < NCTX) { const int tt_ = R_ % CTX; if (tt_ > 0) rn0[i_] = *(const GAS half8*)(pr_ - INW); if (tt_ < CTX - 1) rn1[i_] = *(const GAS half8*)(pr_ + INW); } \
        else { const int tt_ = (R_ - NCTX) % SEQ, col_ = tt_ & 63; \
            if (col_ > 0) rn0[i_] = *(const GAS half8*)(pr_ - INW); if (col_ < 63) rn1[i_] = *(const GAS half8*)(pr_ + INW); \
            if (tt_ >= 64) rn2[i_] = *(const GAS half8*)(pr_ - 64 * INW); if (tt_ < SEQ - 64) rn3[i_] = *(const GAS half8*)(pr_ + 64 * INW); } }
#define P1_ISSUE_TAB(item_) { const int tid_ = ltid(wvs); const int lane_ = tid_ & 63, wv_ = tid_ >> 6; \
        const int chain_ = (item_) / NCHUNK, z_ = chain_ / 12, h_ = chain_ % 6; \
        const GAS bf16* tab_ = P.rwlt + ((size_t)((l * 2 + z_) * 2 + (wv_ >> 2)) * 384 + h_ * 64 + ((wv_ & 3) >> 1) * 32 + (lane_ & 31)) * 32 + (lane_ >> 5) * 8; \
        tabf[0] = *(const GAS bf16x8*)tab_; tabf[1] = *(const GAS bf16x8*)(tab_ + 16); }
    if (bid < 24 * NCHUNK) { P1_ISSUE(0, bid); P1_ISSUE(1, bid); P1_ISSUE(2, bid); P1_ISSUE(3, bid); P1_ISSUE_TAB(bid); }
    for (int item = bid; item < 24 * NCHUNK; item += nblk) {
        const int tid = ltid(wvs), lane = tid & 63, wv = tid >> 6, q4 = wv & 3, wm = q4 & 1, wn = q4 >> 1, hs = wv >> 2;
        const int chain = item / NCHUNK, ck = item % NCHUNK;
        const int z = chain / 12, b = (chain / 6) % 2, h = chain % 6, s0 = ck * 64;
        const int j = lane, tq = wv, c = h * 64 + j;
        const int nitem = item + nblk;
        const bf16x8 tab0 = tabf[0], tab1 = tabf[1];
        if (!(dry && P_VARIANT == 1)) {
#pragma unroll
        for (int i = 0; i < 4; ++i) {
            const int c8 = tid & 7, t = (tid >> 3) & 63, q = i;
            const int col0 = q < 3 ? q * 384 + h * 64 + c8 * 8 : (c8 < 4 ? 1152 + z * 32 + c8 * 8 : 1216 + z * 32 + (c8 - 4) * 8);
            const int R = scan_row(z, b, s0 + t);
            const half8 own = rown[i], n0 = rn0[i], n1 = rn1[i];
            const half8 n2 = R < NCTX ? n0 : rn2[i], n3 = R < NCTX ? n1 : rn3[i];
            if (nitem < 24 * NCHUNK) { P1_ISSUE(i, nitem); }
            half8 nsel;
#pragma unroll
            for (int e = 0; e < 8; ++e) nsel[e] = (e & 3) == 0 ? n0[e] : (e & 3) == 1 ? n1[e] : (e & 3) == 2 ? n2[e] : n3[e];
            const half8 mu8 = *(const half8*)(mu16 + col0);
            const half8 sv = own + (nsel - own) * mu8;
            if (q < 3) {
                *(half8*)((q == 0 ? Sr : q == 1 ? Sk : Sv) + t * RLD + c8 * 8) = sv;
            } else {
                bf16x8 o;
#pragma unroll
                for (int e = 0; e < 8; ++e) o[e] = (bf16)(c8 < 4 ? ftanh((float)sv[e]) : (float)sv[e]);
                *(bf16x8*)(lt + t * RLD + c8 * 8) = o;
            }
        }
        }
        if (nitem < 24 * NCHUNK) { P1_ISSUE_TAB(nitem); }
        BAR_LDS();
        if (!(dry && P_VARIANT == 2)) {
        {
            floatx16 aw;
#pragma unroll
            for (int r = 0; r < 16; ++r) aw[r] = 0.f;
            aw = __builtin_amdgcn_mfma_f32_32x32x16_bf16(ldfrag(lt + hs * 32, wm * 32, lane, 0), tab0, aw, 0, 0, 0);
            aw = __builtin_amdgcn_mfma_f32_32x32x16_bf16(ldfrag(lt + hs * 32, wm * 32, lane, 1), tab1, aw, 0, 0, 0);
            const int cc = h * 64 + wn * 32 + (lane & 31);
            const float bias = hs ? prm[2048 + z * 384 + cc] : prm[1280 + z * 384 + cc];
#pragma unroll
            for (int r = 0; r < 16; ++r) {
                const int m = wm * 32 + (r & 3) + 8 * (r >> 2) + 4 * (lane >> 5), n = wn * 32 + (lane & 31);
                const float sg = fsigmoid(aw[r] + bias);
                if (hs) av[m * 65 + n] = sg; else lwb[m * 65 + n] = -0.6065306597126334f * sg;
            }
        }
        }
        BAR_LDS();
        float gpre = 0.f, gtot = 0.f;
        if (!(dry && P_VARIANT == 3)) {
        {
            float run = 0.f, gv[8];
#pragma unroll
            for (int tt = 0; tt < 8; ++tt) { run += lwb[(tq * 8 + tt) * 65 + j]; gv[tt] = run; }
            part[tq * 64 + j] = run;
            const int t = lane, q8 = wv;
            float ss = 0.f, bn = 0.f;
#pragma unroll
            for (int e = 0; e < 8; ++e) {
                const int jj = q8 * 8 + e, c2 = h * 64 + jj;
                const float k_ = (float)Sk[t * RLD + jj], r_ = (float)Sr[t * RLD + jj], a = av[t * 65 + jj];
                const float kku = k_ * prm[2816 + c2];
                ss += kku * kku; bn += r_ * k_ * (1.f + (a - 1.f) * prm[3200 + c2]) * prm[3584 + c2];
            }
            part[512 + q8 * 64 + t] = ss; part[1024 + q8 * 64 + t] = bn;
            BAR_LDS();
            gpre = 0.f; gtot = 0.f;
#pragma unroll
            for (int q = 0; q < 8; ++q) { const float x = part[q * 64 + j]; gtot += x; if (q < tq) gpre += x; }
#pragma unroll
            for (int tt = 0; tt < 8; ++tt) lwb[(tq * 8 + tt) * 65 + j] = gv[tt] + gpre;
            if (tq == 0) {
                gl[j] = __expf(gtot);
                float sst = 0.f, bnt = 0.f;
#pragma unroll
                for (int q = 0; q < 8; ++q) { sst += part[512 + q * 64 + lane]; bnt += part[1024 + q * 64 + lane]; }
                gl[64 + lane] = __builtin_amdgcn_rsqf(sst + 1e-6f);
                if (!dry) P.bon[((size_t)z * NROWS + scan_row(z, b, s0 + lane)) * 6 + h] = bnt;
            }
        }
        BAR_LDS();
        {
            const float kkc = prm[2816 + c], kac = prm[3200 + c];
            const float Gt = __expf(gtot);
            float e_prev = __expf(gpre);
            bf16x8 amT, vT, beT, keT;
#pragma unroll
            for (int tt = 0; tt < 8; ++tt) {
                const int t = tq * 8 + tt;
                const float r_ = (float)Sr[t * RLD + j], k_ = (float)Sk[t * RLD + j], v_ = (float)Sv[t * RLD + j];
                const float a = av[t * 65 + j], g = lwb[t * 65 + j], sinv = gl[64 + t];
                const float e_t = __expf(g), e_p = frcp(e_t), e_m = e_prev, e_e = Gt * e_p;
                e_prev = e_t;
                const float kkn = k_ * kkc * sinv, kd = k_ * (1.f + (a - 1.f) * kac), bb = a * kkn;
                const bf16 am = (bf16)(kkn * e_m);
                Am[t * RLD + j] = am; Bp[t * RLD + j] = (bf16)(bb * e_p); Kp[t * RLD + j] = (bf16)(kd * e_p); Rt[t * RLD + j] = (bf16)(r_ * e_t);
                amT[tt] = am; vT[tt] = (bf16)v_; beT[tt] = (bf16)(bb * e_e); keT[tt] = (bf16)(kd * e_e);
            }
            BAR_LDS();
            const int to = j * RLD + tq * 8;
            *(bf16x8*)(AmT + to) = amT; *(bf16x8*)(VT + to) = vT; *(bf16x8*)(BendT + to) = beT; *(bf16x8*)(KendT + to) = keT;
        }
        BAR_LDS();
        }
        if (!(dry && P_VARIANT == 4)) {
        {
            floatx16 c1, c2;
#pragma unroll
            for (int r = 0; r < 16; ++r) { c1[r] = 0.f; c2[r] = 0.f; }
            if (!(wm == 0 && wn == 1)) {
                const bf16* Aop = hs ? Rt : Am;
#pragma unroll
                for (int ks = 0; ks < 4; ++ks) {
                    const bf16x8 a1 = ldfrag(Aop, wm * 32, lane, ks), b1 = ldfrag(Bp, wn * 32, lane, ks), b2 = ldfrag(Kp, wn * 32, lane, ks);
                    c1 = __builtin_amdgcn_mfma_f32_32x32x16_bf16(a1, b1, c1, 0, 0, 0);
                    c2 = __builtin_amdgcn_mfma_f32_32x32x16_bf16(a1, b2, c2, 0, 0, 0);
                }
            }
#pragma unroll
            for (int r = 0; r < 16; ++r) {
                const int m = wm * 32 + (r & 3) + 8 * (r >> 2) + 4 * (lane >> 5), n = wn * 32 + (lane & 31);
                if (hs == 0) {
                    const float nv_ = n < m ? c1[r] : 0.f;
                    Noff[m * RLD + n] = (bf16)(((n >> 4) != (m >> 4)) ? nv_ : 0.f);
                    Nfull[m * 64 + n] = nv_;
                    Nak[m * RLD + n] = (bf16)(n < m ? c2[r] : 0.f);
                }
                else { Mrb[m * RLD + n] = (bf16)(n <= m ? c1[r] : 0.f); Mrk[m * RLD + n] = (bf16)(n <= m ? c2[r] : 0.f); }
            }
        }
        }
        BAR_LDS();
        if (!(dry && P_VARIANT == 5)) {
        if (tid < 64) {
            const int i = tid >> 4, jc = tid & 15; float x[16];
#pragma unroll
            for (int row = 0; row < 16; ++row) {
                float s = row == jc ? 1.f : 0.f;
#pragma unroll
                for (int m = 0; m < row; ++m) s -= Nfull[(16 * i + row) * 64 + 16 * i + m] * x[m];
                x[row] = s;
                if ((row & 3) == 3) __builtin_amdgcn_sched_barrier(0);
            }
#pragma unroll
            for (int row = 0; row < 16; ++row) { Td[(i * 16 + row) * 32 + jc] = (bf16)x[row]; Td[(i * 16 + row) * 32 + 16 + jc] = (bf16)0.f; }
        }
        if (hs == 1) { const floatx16 c2 = mm64(Nak, VT, wm, wn, lane); storeT(NVT, c2, wm, wn, lane); }
        BAR_LDS();
        }
        if (!(dry && P_VARIANT == 6)) {
        {
            bf16* XT = hs ? UtT : WmT;
            const bf16* RT = hs ? NVT : AmT;
            bf16* ZT = Zs + wv * 256;
            const int cn = 16 * q4 + (lane & 15);
            {
                bf16x8 zz;
#pragma unroll
                for (int e = 0; e < 8; ++e) zz[e] = (bf16)0.f;
                *(bf16x8*)(XT + (16 * q4 + (lane >> 2)) * RLD + (lane & 3) * 16) = zz; *(bf16x8*)(XT + (16 * q4 + (lane >> 2)) * RLD + (lane & 3) * 16 + 8) = zz;
            }
#pragma unroll 1
            for (int i = 0; i < 4; ++i) {
                floatx4 acc = {0.f, 0.f, 0.f, 0.f};
                if (i > 0) {
#pragma unroll
                    for (int ks = 0; ks < 2; ++ks) {
                        if (ks * 32 < 16 * i) {
                            const bf16x8 a = *(const bf16x8*)(Noff + (16 * i + (lane & 15)) * RLD + 32 * ks + 8 * (lane >> 4));
                            const bf16x8 bq = *(const bf16x8*)(XT + cn * RLD + 32 * ks + 8 * (lane >> 4));
                            acc = __builtin_amdgcn_mfma_f32_16x16x32_bf16(a, bq, acc, 0, 0, 0);
                        }
                    }
                }
                {
                    const bf16x4 rh = *(const bf16x4*)(RT + cn * RLD + 16 * i + 4 * (lane >> 4));
                    bf16x4 zv; zv[0] = (bf16)((float)rh[0] - acc[0]); zv[1] = (bf16)((float)rh[1] - acc[1]); zv[2] = (bf16)((float)rh[2] - acc[2]); zv[3] = (bf16)((float)rh[3] - acc[3]);
                    *(bf16x4*)(ZT + (lane & 15) * 16 + 4 * (lane >> 4)) = zv;
                }
                {
                    const bf16x8 a = *(const bf16x8*)(Td + (i * 16 + (lane & 15)) * 32 + 8 * (lane >> 4));
                    bf16x8 bz;
#pragma unroll
                    for (int e = 0; e < 8; ++e) bz[e] = (bf16)0.f;
                    if ((lane >> 4) < 2) bz = *(const bf16x8*)(ZT + (lane & 15) * 16 + 8 * (lane >> 4));
                    floatx4 xo = {0.f, 0.f, 0.f, 0.f};
                    xo = __builtin_amdgcn_mfma_f32_16x16x32_bf16(a, bz, xo, 0, 0, 0);
                    bf16x4 xv; xv[0] = (bf16)xo[0]; xv[1] = (bf16)xo[1]; xv[2] = (bf16)xo[2]; xv[3] = (bf16)xo[3];
                    *(bf16x4*)(XT + cn * RLD + 16 * i + 4 * (lane >> 4)) = xv;
                }
            }
        }
        BAR_LDS();
        }
        if (!(dry && P_VARIANT == 7)) {
        {
            f16* T0 = (f16*)AmT; f16* T1 = (f16*)Kp; f16* T2 = (f16*)Nak; f16* T3 = (f16*)Nf;
            const int n = wn * 32 + (lane & 31);
            if (hs == 0) {
                {
                    const floatx16 c1 = mm64(WmT, Mrb, wm, wn, lane);
#pragma unroll
                    for (int g = 0; g < 4; ++g) {
                        const int m0 = wm * 32 + 8 * g + 4 * (lane >> 5);
                        const bf16x4 rt = *(const bf16x4*)(Rt + n * RLD + m0);
                        half4 v; v[0] = (f16)((float)rt[0] - c1[4 * g]); v[1] = (f16)((float)rt[1] - c1[4 * g + 1]); v[2] = (f16)((float)rt[2] - c1[4 * g + 2]); v[3] = (f16)((float)rt[3] - c1[4 * g + 3]);
                        *(half4*)(T0 + n * RLD + m0) = v;
                    }
                }
                __builtin_amdgcn_sched_barrier(0);
                {
                    const floatx16 c2 = mm64(VT, Mrk, wm, wn, lane); __builtin_amdgcn_sched_barrier(0); const floatx16 c3 = mm64(UtT, Mrb, wm, wn, lane);
#pragma unroll
                    for (int g = 0; g < 4; ++g) {
                        const int m0 = wm * 32 + 8 * g + 4 * (lane >> 5);
                        half4 v; v[0] = (f16)(c2[4 * g] - c3[4 * g]); v[1] = (f16)(c2[4 * g + 1] - c3[4 * g + 1]); v[2] = (f16)(c2[4 * g + 2] - c3[4 * g + 2]); v[3] = (f16)(c2[4 * g + 3] - c3[4 * g + 3]);
                        *(half4*)(T1 + n * RLD + m0) = v;
                    }
                }
            } else {
                {
                    const floatx16 c4 = mm64(WmT, BendT, wm, wn, lane);
                    const float gd = gl[n];
#pragma unroll
                    for (int g = 0; g < 4; ++g) {
                        const int m0 = wm * 32 + 8 * g + 4 * (lane >> 5);
                        half4 v;
#pragma unroll
                        for (int e = 0; e < 4; ++e) v[e] = (f16)((m0 + e == n ? gd : 0.f) - c4[4 * g + e]);
                        *(half4*)(T2 + n * RLD + m0) = v;
                    }
                }
                __builtin_amdgcn_sched_barrier(0);
                {
                    const floatx16 c5 = mm64(KendT, VT, wm, wn, lane); __builtin_amdgcn_sched_barrier(0); const floatx16 c6 = mm64(BendT, UtT, wm, wn, lane);
#pragma unroll
                    for (int g = 0; g < 4; ++g) {
                        const int m0 = wm * 32 + 8 * g + 4 * (lane >> 5);
                        half4 v; v[0] = (f16)(c5[4 * g] - c6[4 * g]); v[1] = (f16)(c5[4 * g + 1] - c6[4 * g + 1]); v[2] = (f16)(c5[4 * g + 2] - c6[4 * g + 2]); v[3] = (f16)(c5[4 * g + 3] - c6[4 * g + 3]);
                        *(half4*)(T3 + n * RLD + m0) = v;
                    }
                }
            }
            BAR_LDS();
            {
                const size_t gb = (size_t)item * 4096;
                const int row = tid >> 3, ch = tid & 7;
                const half8 v0 = *(const half8*)(T0 + row * RLD + ch * 8), v1 = *(const half8*)(T1 + row * RLD + ch * 8);
                const half8 v2 = *(const half8*)(T2 + row * RLD + ch * 8), v3 = *(const half8*)(T3 + row * RLD + ch * 8);
                if (!dry) {
                *(GAS half8*)(RPg + gb + row * 64 + ch * 8) = v0;
                *(GAS half8*)(P.Yh + ((size_t)z * NROWS + scan_row(z, b, s0 + row)) * 384 + h * 64 + ch * 8) = v1;
                *(GAS half8*)(PTg + gb + row * 64 + ch * 8) = v2;
                *(GAS half8*)(Qg + gb + row * 64 + ch * 8) = v3;
                }
            }
        }
        }
        BAR_LDS();
    }
}

DEV void ph_rw_stream(PRef P, int wvs, int l, int bid, int nblk, unsigned char* smraw, bool dry = false) {
    const int tid = ltid(wvs), lane = tid & 63, wv = tid >> 6, w4 = wv & 3, role = wv >> 2;
    f16* S16 = (f16*)smraw;
    const GAS f16* PTg = P.rwm; const GAS f16* RPg = PTg + RWM_STRIDE; const GAS f16* Qg = RPg + RWM_STRIDE;
    for (int item = bid; item < 96; item += nblk) {
        const int chain = item >> 2, vs = item & 3;
        const int z = chain / 12, b = (chain / 6) % 2, h = chain % 6;
        __syncthreads();
        for (int idx = tid; idx < 2 * 16 * 72; idx += NT) S16[idx] = (f16)0.f;
        __syncthreads();
        const size_t cb = (size_t)chain * NCHUNK * 4096;
        const int rowA = 16 * w4 + (lane & 15), kof = 8 * (lane >> 4);
        const int qoff = (vs * 16 + (lane & 15)) * 64 + 16 * w4 + (lane >> 4) * 4;
        const GAS f16* Ag = role ? RPg : PTg;
        GAS f16* ycol = P.Yh + ((size_t)(2 + z) * NROWS) * 384 + h * 64 + vs * 16 + (lane & 15);
        const int trow = 16 * w4 + (lane >> 4) * 4;
        const int rstep = z ? -384 : 384;
        half8 a0[8], a1[8]; half4 qv[8];
#define RW_LOAD(slot_, ck_) { const size_t gb_ = cb + (size_t)(ck_) * 4096; \
            a0[slot_] = *(const GAS half8*)(Ag + gb_ + rowA * 64 + kof); a1[slot_] = *(const GAS half8*)(Ag + gb_ + rowA * 64 + 32 + kof); \
            if (role == 0) qv[slot_] = *(const GAS half4*)(Qg + gb_ + qoff); }
#define RW_STEP(slot_, ck_) { const f16* Sc_ = S16 + ((ck_) & 1) * 16 * 72; f16* Sn_ = S16 + (((ck_) + 1) & 1) * 16 * 72; \
            const half8 b0_ = *(const half8*)(Sc_ + (lane & 15) * 72 + kof); const half8 b1_ = *(const half8*)(Sc_ + (lane & 15) * 72 + 32 + kof); \
            floatx4 acc_ = {0.f, 0.f, 0.f, 0.f}; \
            if (role == 0) { acc_[0] = (float)qv[slot_][0]; acc_[1] = (float)qv[slot_][1]; acc_[2] = (float)qv[slot_][2]; acc_[3] = (float)qv[slot_][3]; } \
            acc_ = __builtin_amdgcn_mfma_f32_16x16x32_f16(a0[slot_], b0_, acc_, 0, 0, 0); acc_ = __builtin_amdgcn_mfma_f32_16x16x32_f16(a1[slot_], b1_, acc_, 0, 0, 0); \
            half4 sn_; sn_[0] = (f16)acc_[0]; sn_[1] = (f16)acc_[1]; sn_[2] = (f16)acc_[2]; sn_[3] = (f16)acc_[3]; \
            if (role == 0) *(half4*)(Sn_ + (lane & 15) * 72 + trow) = sn_; \
            else if (!dry) { GAS f16* yp_ = ycol + (size_t)scan_row(z, b, (ck_) * 64 + trow) * 384; \
                _Pragma("unroll") for (int r_ = 0; r_ < 4; ++r_) yp_[r_ * rstep] = sn_[r_]; } \
            BAR_LDS(); }
        RW_LOAD(0, 0); RW_LOAD(1, 1); RW_LOAD(2, 2); RW_LOAD(3, 3); RW_LOAD(4, 4); RW_LOAD(5, 5); RW_LOAD(6, 6);
        for (int ck = 0; ck < NCHUNK; ck += 8) {
            RW_LOAD(7, ck + 7 < NCHUNK ? ck + 7 : NCHUNK - 1); RW_STEP(0, ck);
            RW_LOAD(0, ck + 8 < NCHUNK ? ck + 8 : NCHUNK - 1); RW_STEP(1, ck + 1);
            RW_LOAD(1, ck + 9 < NCHUNK ? ck + 9 : NCHUNK - 1); RW_STEP(2, ck + 2);
            RW_LOAD(2, ck + 10 < NCHUNK ? ck + 10 : NCHUNK - 1); RW_STEP(3, ck + 3);
            if (ck + 4 < NCHUNK) {
                RW_LOAD(3, ck + 11 < NCHUNK ? ck + 11 : NCHUNK - 1); RW_STEP(4, ck + 4);
                RW_LOAD(4, ck + 12 < NCHUNK ? ck + 12 : NCHUNK - 1); RW_STEP(5, ck + 5);
                RW_LOAD(5, ck + 13 < NCHUNK ? ck + 13 : NCHUNK - 1); RW_STEP(6, ck + 6);
                RW_LOAD(6, ck + 14 < NCHUNK ? ck + 14 : NCHUNK - 1); RW_STEP(7, ck + 7);
            }
        }
#undef RW_LOAD
#undef RW_STEP
    }
}
DEV void ph_rwkv_fin2(PRef P, int wvs, int l, int bid, int nblk, bool dry = false) {
    const int tid_ = ltid(wvs); const int lane = tid_ & 63, wv = tid_ >> 6;
    floatx4 mu_[2], lg_[2], lb_[2];
#pragma unroll
    for (int pass = 0; pass < 2; ++pass) {
        const int hc = pass * 4 + (lane >> 4), cc = (hc < 6 ? hc : 0) * 64 + (lane & 15) * 4;
        mu_[pass] = *(const GAS floatx4*)(P.rw_mu + l * 1280 + 768 + cc); lg_[pass] = *(const GAS floatx4*)(P.rw_ln_g + l * 384 + cc); lb_[pass] = *(const GAS floatx4*)(P.rw_ln_b + l * 384 + cc);
    }
    for (int R = (l == 1 ? NCTX : 0) + bid * NW + wv; R < NROWS; R += nblk * NW) {
#pragma unroll
        for (int pass = 0; pass < 2; ++pass) {
            const int h = pass * 4 + (lane >> 4);
            if (h < 6) {
                const int c = h * 64 + (lane & 15) * 4;
                const half4 y0 = *(const GAS half4*)(P.Yh + (size_t)R * 384 + c), y1 = *(const GAS half4*)(P.Yh + ((size_t)NROWS + R) * 384 + c);
                const half4 y2 = *(const GAS half4*)(P.Yh + ((size_t)2 * NROWS + R) * 384 + c), y3 = *(const GAS half4*)(P.Yh + ((size_t)3 * NROWS + R) * 384 + c);
                const half4 gt = *(const GAS half4*)(P.p + (size_t)R * INW + 1280 + c);
                const half4 vo = *(const GAS half4*)(P.p + (size_t)R * INW + 768 + c);
                const floatx4 mu4 = mu_[pass], lg = lg_[pass], lb = lb_[pass];
                float nv[4];
#pragma unroll
                for (int e = 0; e < 4; ++e) { const int nb = nbr_row(R, 768 + c + e); nv[e] = nb >= 0 ? (float)P.p[(size_t)nb * INW + 768 + c + e] : 0.f; }
                float y[4], s = 0.f;
#pragma unroll
                for (int e = 0; e < 4; ++e) { y[e] = ((float)y0[e] + (float)y1[e]) + ((float)y2[e] + (float)y3[e]); s += y[e]; }
                const float mu = row16_sum(s) * (1.f / 64.f); float q = 0.f;
#pragma unroll
                for (int e = 0; e < 4; ++e) { y[e] -= mu; q += y[e] * y[e]; }
                const float rs = __builtin_amdgcn_rsqf(row16_sum(q) * (1.f / 64.f) + 64e-5f);
                const float bonus = P.bon[(size_t)R * 6 + h] + P.bon[((size_t)NROWS + R) * 6 + h];
                half4 o;
#pragma unroll
                for (int e = 0; e < 4; ++e) {
                    const float pv = (float)vo[e], vs = pv + (nv[e] - pv) * mu4[e];
                    o[e] = (f16)((y[e] * rs * lg[e] + lb[e] + bonus * vs) * fsilu((float)gt[e]));
                }
                if (!dry) *(GAS half4*)(P.p + (size_t)R * INW + 1280 + c) = o; else *(GAS half4*)(P.rwm + (size_t)R * 384 + c) = o;
            }
        }
    }
}
constexpr int HLD = 136;
constexpr int S5_LDS_BYTES = NW * 64 * HLD * 2;
struct S5Ops { half8 au0, au1, bb0, bb1, bb2, bb3; float hre, him; };
DEV void s5_load(PRef P, int l, int z, int b, int g, int tc, int lane, S5Ops& o) {
    const int lzg = (l * 2 + z) * 16 + g;
    o.au0 = *(const GAS half8*)(P.p + (size_t)scan_row(0, b, tc * 64 + (lane & 31)) * INW + 1664 + g * 16 + (lane >> 5) * 8);
    o.au1 = *(const GAS half8*)(P.p + (size_t)scan_row(0, b, tc * 64 + 32 + (lane & 31)) * INW + 1664 + g * 16 + (lane >> 5) * 8);
    const GAS f16* bbp = P.s5bb + ((size_t)lzg * 128 + (lane & 31)) * 16 + (lane >> 5) * 8;
    o.bb0 = *(const GAS half8*)bbp; o.bb1 = *(const GAS half8*)(bbp + 32 * 16); o.bb2 = *(const GAS half8*)(bbp + 64 * 16); o.bb3 = *(const GAS half8*)(bbp + 96 * 16);
}
DEV void s5_wave_scan(PRef P, int l, int z, int g, const S5Ops& o, float& hre, float& him, f16* hb, int lane, bool store) {
    const int lzg = (l * 2 + z) * 16 + g;
#pragma unroll
    for (int nt = 0; nt < 4; ++nt) {
        const half8 bb = nt == 0 ? o.bb0 : nt == 1 ? o.bb1 : nt == 2 ? o.bb2 : o.bb3;
#pragma unroll
        for (int mt = 0; mt < 2; ++mt) {
            floatx16 acc;
#pragma unroll
            for (int r = 0; r < 16; ++r) acc[r] = 0.f;
            acc = __builtin_amdgcn_mfma_f32_32x32x16_f16(mt == 0 ? o.au0 : o.au1, bb, acc, 0, 0, 0);
#pragma unroll
            for (int r = 0; r < 16; ++r) hb[(32 * mt + (r & 3) + 8 * (r >> 2) + 4 * (lane >> 5)) * HLD + 32 * nt + (lane & 31)] = (f16)acc[r];
        }
    }
    const GAS float* tb = P.s5par + (size_t)lzg * S5PW * 64 + lane;
    const float abr = tb[0], abi = tb[64];
#pragma unroll 1
    for (int s0 = 0; s0 < 64; s0 += 16) {
        float br[16], bi[16];
#pragma unroll
        for (int i = 0; i < 16; ++i) { const int tt = z ? 63 - (s0 + i) : s0 + i; br[i] = (float)hb[tt * HLD + lane]; bi[i] = (float)hb[tt * HLD + 64 + lane]; }
#pragma unroll
        for (int i = 0; i < 16; ++i) {
            const float nr = abr * hre - abi * him + br[i], ni = abr * him + abi * hre + bi[i];
            hre = nr; him = ni; br[i] = hre; bi[i] = him;
        }
        if (store) {
#pragma unroll
            for (int i = 0; i < 16; ++i) { const int tt = z ? 63 - (s0 + i) : s0 + i; hb[tt * HLD + lane] = (f16)br[i]; hb[tt * HLD + 64 + lane] = (f16)bi[i]; }
        }
    }
}
DEV void ph_s5_a(PRef P, int wvs, int l, int bid, int nblk, unsigned char* smraw) {
    const int tid_ = ltid(wvs); const int lane = tid_ & 63, wv = tid_ >> 6;
    f16* hb = (f16*)smraw + wv * 64 * HLD;
    constexpr int NI = 2 * 2 * 16 * NCHUNK;
    int item = bid * NW + wv;
    S5Ops nx;
    if (item < NI) { const int tc = item % NCHUNK, zbg = item / NCHUNK; s5_load(P, l, zbg >> 5, (zbg >> 4) & 1, zbg & 15, tc, lane, nx); }
    for (; item < NI; item += nblk * NW) {
        const int tc = item % NCHUNK, zbg = item / NCHUNK, g = zbg & 15, z = zbg >> 5;
        const S5Ops cur = nx;
        const int nitem = item + nblk * NW;
        if (nitem < NI) { const int tc2 = nitem % NCHUNK, zbg2 = nitem / NCHUNK; s5_load(P, l, zbg2 >> 5, (zbg2 >> 4) & 1, zbg2 & 15, tc2, lane, nx); }
        float hre = 0.f, him = 0.f;
        s5_wave_scan(P, l, z, g, cur, hre, him, hb, lane, false);
        const int ck = z ? mirror_chunk(tc) : tc;
        GAS float* ho = P.s5h + ((size_t)zbg * NCHUNK + ck) * 128;
        ho[lane] = hre; ho[64 + lane] = him;
    }
}
DEV void ph_s5_b(PRef P, int wvs, int l, int bid, int nblk) {
    for (int idx = bid * NT + ltid(wvs); idx < 2 * 2 * 16 * 64; idx += nblk * NT) {
        const int n = idx & 63, zbg = idx >> 6, g = zbg & 15, z = zbg >> 5;
        const GAS float* tb = P.s5par + (size_t)((l * 2 + z) * 16 + g) * S5PW * 64 + n;
        const float a64r = tb[34 * 64], a64i = tb[35 * 64];
        float hr = 0.f, hi = 0.f;
        GAS float* hp = P.s5h + (size_t)zbg * NCHUNK * 128 + n;
        for (int c0 = 0; c0 < NCHUNK; c0 += 20) {
            float lr[20], li[20];
#pragma unroll
            for (int i = 0; i < 20; ++i) { lr[i] = hp[(c0 + i) * 128]; li[i] = hp[(c0 + i) * 128 + 64]; }
#pragma unroll
            for (int i = 0; i < 20; ++i) {
                hp[(c0 + i) * 128] = hr; hp[(c0 + i) * 128 + 64] = hi;
                const float nr = a64r * hr - a64i * hi + lr[i], ni = a64r * hi + a64i * hr + li[i];
                hr = nr; hi = ni;
            }
        }
    }
}
DEV void ph_s5_c(PRef P, int wvs, int l, int bid, int nblk, unsigned char* smraw) {
    const int tid = ltid(wvs), lane = tid & 63, wv = tid >> 6, ci = wv >> 1, z = wv & 1;
    f16* base = (f16*)smraw;
    constexpr int NG = NCHUNK / 4, NI = 2 * 16 * NG;
    int it = bid; if (l == 1 && it < NI && it % NG == 0) it += nblk;
    S5Ops nx;
#define S5C_LOAD(it_, o_) { const int grp_ = (it_) % NG, bg_ = (it_) / NG, tc_ = grp_ * 4 + ci; \
        s5_load(P, l, z, bg_ >> 4, bg_ & 15, tc_, lane, o_); \
        const GAS float* hi_ = P.s5h + ((size_t)((z * 2 + (bg_ >> 4)) * 16 + (bg_ & 15)) * NCHUNK + (z ? mirror_chunk(tc_) : tc_)) * 128; \
        o_.hre = hi_[lane]; o_.him = hi_[64 + lane]; }
    if (it < NI) S5C_LOAD(it, nx);
    while (it < NI) {
        const int grp = it % NG, bg = it / NG, g = bg & 15, b = bg >> 4;
        const S5Ops cur = nx;
        int nit = it + nblk; if (l == 1 && nit < NI && nit % NG == 0) nit += nblk;
        if (nit < NI) S5C_LOAD(nit, nx);
        BAR_LDS();
        const int tc = grp * 4 + ci;
        {
            float hre = cur.hre, him = cur.him;
            s5_wave_scan(P, l, z, g, cur, hre, him, base + wv * 64 * HLD, lane, true);
        }
        BAR_LDS();
        {
            half8 bf[2][4];
#pragma unroll
            for (int z2 = 0; z2 < 2; ++z2)
#pragma unroll
                for (int ks = 0; ks < 4; ++ks) bf[z2][ks] = *(const half8*)(P.s5cc + ((size_t)((l * 2 + z2) * 16 + g) * 16 + (lane & 15)) * 128 + 32 * ks + 8 * (lane >> 4));
            const int pch = g * 16 + (lane & 15);
            const float dsk = P.s5_d[l * 256 + pch];
#pragma unroll
            for (int mi = 0; mi < 2; ++mi) {
                const int mt = 2 * z + mi;
                floatx4 acc = {0.f, 0.f, 0.f, 0.f};
#pragma unroll
                for (int z2 = 0; z2 < 2; ++z2) {
                    const f16* hbz = base + (2 * ci + z2) * 64 * HLD;
#pragma unroll
                    for (int ks = 0; ks < 4; ++ks) {
                        const half8 a = *(const half8*)(hbz + (16 * mt + (lane & 15)) * HLD + 32 * ks + 8 * (lane >> 4));
                        acc = __builtin_amdgcn_mfma_f32_16x16x32_f16(a, bf[z2][ks], acc, 0, 0, 0);
                    }
                }
#pragma unroll
                for (int r = 0; r < 4; ++r) {
                    const int tt = 16 * mt + (lane >> 4) * 4 + r; const int R = scan_row(0, b, tc * 64 + tt);
                    const float u = (float)P.p[(size_t)R * INW + 1664 + pch];
                    const float y = acc[r] + dsk * u;
                    P.yg[(size_t)R * 256 + pch] = (f16)(0.5f * y * (1.f + ftanh(0.7978845608028654f * (y + 0.044715f * y * y * y))));
                }
            }
        }
        it = nit;
    }
#undef S5C_LOAD
}

constexpr int NSC = TSCAN / 256;
constexpr int QLD = 104, SLD = 72;
constexpr int MLE = 97 * 96;
template <int KSTEPS>
DEV floatx16 mmh(const f16* A, int lda, int arow0, const f16* Bt, int ldb, int brow0, int lane, floatx16 acc) {
#pragma unroll
    for (int ks = 0; ks < KSTEPS; ++ks) {
        const half8 a = *(const half8*)(A + (arow0 + (lane & 31)) * lda + ks * 16 + (lane >> 5) * 8);
        const half8 b = *(const half8*)(Bt + (brow0 + (lane & 31)) * ldb + ks * 16 + (lane >> 5) * 8);
        acc = __builtin_amdgcn_mfma_f32_32x32x16_f16(a, b, acc, 0, 0, 0);
    }
    return acc;
}
DEV void ph_ml_a(PRef P, int wvs, int l, int bid, int nblk, float* sm) {
    const int tid_ = ltid(wvs); const int lane = tid_ & 63, wv = tid_ >> 6;
    const int lc = lane < 48 ? lane : 0;
    float cvb[8], cv0[8], cv1[8], cv2[8], bq[2][16], bk[2][16], bv[2][16];
#pragma unroll
    for (int i = 0; i < 8; ++i) { const int c = lc * 8 + i; cvb[i] = P.ml_conv_b[l * 384 + c]; cv0[i] = P.ml_conv_w[(l * 3 + 0) * 384 + c]; cv1[i] = P.ml_conv_w[(l * 3 + 1) * 384 + c]; cv2[i] = P.ml_conv_w[(l * 3 + 2) * 384 + c]; }
#pragma unroll
    for (int blk = 0; blk < 2; ++blk)
#pragma unroll
        for (int e = 0; e < 16; ++e) { const int wi = (l * 96 + lc * 2 + blk) * 16 + e; bq[blk][e] = P.ml_wq[wi]; bk[blk][e] = P.ml_wk[wi]; bv[blk][e] = P.ml_wv[wi]; }
    const float gbias = lane < 16 ? ((lane & 1) ? P.ml_bf : P.ml_bi)[(l * 2 + (lane >> 3)) * 4 + ((lane >> 1) & 3)] : 0.f;
    for (int R0 = (bid * NW + wv) * 16; R0 < NROWS; R0 += nblk * NW * 16) {
        if (lane < 48) {
            const int c0 = lane * 8;
#pragma unroll 4
            for (int rr = 0; rr < 16; ++rr) {
                const int R = R0 + rr;
                int t, len; if (R < NCTX) { t = R % CTX; len = CTX; } else { t = (R - NCTX) % SEQ; len = SEQ; }
                const half8 x0 = *(const GAS half8*)(P.p + (size_t)R * INW + 2176 + c0);
                half8 xm_, xp_;
#pragma unroll
                for (int i = 0; i < 8; ++i) { xm_[i] = (f16)0.f; xp_[i] = (f16)0.f; }
                if (t > 0) xm_ = *(const GAS half8*)(P.p + (size_t)(R - 1) * INW + 2176 + c0);
                if (t < len - 1) xp_ = *(const GAS half8*)(P.p + (size_t)(R + 1) * INW + 2176 + c0);
                half8 hq, hk, hv;
#pragma unroll
                for (int blk = 0; blk < 2; ++blk) {
                    float xc[4], xm[4];
#pragma unroll
                    for (int i = 0; i < 4; ++i) {
                        xm[i] = (float)x0[4 * blk + i];
                        const float a = cvb[4 * blk + i] + cv1[4 * blk + i] * xm[i] + cv0[4 * blk + i] * (float)xm_[4 * blk + i] + cv2[4 * blk + i] * (float)xp_[4 * blk + i];
                        xc[i] = fsilu(a);
                    }
#pragma unroll
                    for (int i = 0; i < 4; ++i) {
                        float qq = 0.f, kk = 0.f, vv = 0.f;
#pragma unroll
                        for (int jj = 0; jj < 4; ++jj) { qq += xc[jj] * bq[blk][jj * 4 + i]; kk += xc[jj] * bk[blk][jj * 4 + i]; vv += xm[jj] * bv[blk][jj * 4 + i]; }
                        hq[4 * blk + i] = (f16)qq; hk[4 * blk + i] = (f16)(kk * 0.10206207261596577f); hv[4 * blk + i] = (f16)vv;
                    }
                }
                GAS f16* o = P.qkv16 + (size_t)R * 1152 + c0;
                *(GAS half8*)o = hq; *(GAS half8*)(o + 384) = hk; *(GAS half8*)(o + 768) = hv;
            }
        }
        asm volatile("s_waitcnt vmcnt(0)" ::: "memory");
        floatx4 acc = {0.f, 0.f, 0.f, 0.f};
        const GAS f16* ap = P.qkv16 + (size_t)(R0 + (lane & 15)) * 1152 + 8 * (lane >> 4);
        const GAS f16* bp = P.mlgw + ((size_t)l * 16 + (lane & 15)) * 1152 + 8 * (lane >> 4);
#pragma unroll 12
        for (int ks = 0; ks < 36; ++ks) {
            const half8 a = *(const GAS half8*)(ap + ks * 32), bb = *(const GAS half8*)(bp + ks * 32);
            acc = __builtin_amdgcn_mfma_f32_16x16x32_f16(a, bb, acc, 0, 0, 0);
        }
        const int o = lane & 15, which = o & 1;
        const float bs = __shfl(gbias, o);
#pragma unroll
        for (int r = 0; r < 4; ++r) {
            const float val = acc[r] + bs;
            P.gates[(size_t)(R0 + 4 * (lane >> 4) + r) * 16 + o] = which ? log_sigmoidf_(val) : val;
        }
    }
}
DEV void ml_load_T(PRef P, int z, int b, int hh, int s0, const float* wgt, f16* VT, f16* KeT, int tid) {
#pragma unroll
    for (int i = 0; i < 3; ++i) {
        const int e = tid + NT * i, which = e / 768, rem = e % 768, c8 = rem >> 6, t = rem & 63;
        const int R = scan_row(z, b, s0 + t);
        const half8 x = *(const half8*)(P.qkv16 + (size_t)R * 1152 + (which ? 384 : 768) + hh * 96 + c8 * 8);
        if (which == 0) {
#pragma unroll
            for (int j = 0; j < 8; ++j) VT[(c8 * 8 + j) * SLD + t] = x[j];
        } else {
            const float w = wgt[t];
#pragma unroll
            for (int j = 0; j < 8; ++j) KeT[(c8 * 8 + j) * SLD + t] = (f16)((float)x[j] * w);
        }
    }
}
constexpr int ML_VT_OFF = 0, ML_KE_OFF = 128 * SLD, ML_QS_OFF = ML_KE_OFF + 96 * SLD, ML_KS_OFF = ML_QS_OFF + 64 * QLD, ML_C16_OFF = ML_KS_OFF + 64 * QLD,
              ML_AM_OFF = ML_C16_OFF + 128 * QLD, ML_F_OFF_BYTES = (ML_AM_OFF + 64 * SLD) * 2;
constexpr int ML_LDS_BYTES = ML_F_OFF_BYTES + 320 * 4;
DEV void ph_ml_1(PRef P, int wvs, int l, int bid, int nblk, unsigned char* smraw) {
    f16* VT = (f16*)smraw + ML_VT_OFF; f16* KeT = (f16*)smraw + ML_KE_OFF; float* fb = (float*)(smraw + ML_F_OFF_BYTES);
    for (int item = bid; item < 16 * NSC; item += nblk) {
        const int tid = ltid(wvs), lane = tid & 63, wv = tid >> 6;
        const int chain = item / NSC, sc = item % NSC, z = chain / 8, b = (chain / 4) % 2, hh = chain % 4;
        BAR_LDS();
        for (int idx = tid; idx < 32 * SLD; idx += NT) VT[96 * SLD + idx] = (f16)((idx < SLD) ? 1.f : 0.f);
        float x = 0.f, li = 0.f;
        if (tid < 256) {
            const int R = scan_row(z, b, sc * 256 + tid);
            li = P.gates[(size_t)R * 16 + z * 8 + hh * 2]; x = P.gates[(size_t)R * 16 + z * 8 + hh * 2 + 1];
#pragma unroll
            for (int o = 1; o < 64; o <<= 1) { const float y = __shfl_up(x, o); if (lane >= o) x += y; }
            if (lane == 63) fb[256 + wv] = x;
        }
        BAR_LDS();
        if (tid < 256) {
            float off = 0.f, tot = 0.f;
#pragma unroll
            for (int w = 0; w < 4; ++w) { const float q = fb[256 + w]; tot += q; if (w < wv) off += q; }
            fb[tid] = __expf(li + tot - (x + off));
            if (tid == 0) P.mlG[item] = __expf(tot);
        }
        floatx16 c0, c1, c2;
#pragma unroll
        for (int r = 0; r < 16; ++r) { c0[r] = 0.f; c1[r] = 0.f; c2[r] = 0.f; }
#pragma unroll 1
        for (int cc = 0; cc < 4; ++cc) {
            BAR_LDS();
            ml_load_T(P, z, b, hh, sc * 256 + cc * 64, fb + cc * 64, VT, KeT, tid);
            BAR_LDS();
            if (wv < 4) {
                c0 = mmh<4>(VT, SLD, 32 * wv, KeT, SLD, 0, lane, c0);
                c1 = mmh<4>(VT, SLD, 32 * wv, KeT, SLD, 32, lane, c1);
                c2 = mmh<4>(VT, SLD, 32 * wv, KeT, SLD, 64, lane, c2);
            }
        }
        if (wv < 4) {
            GAS float* dst = P.mlC + (size_t)item * MLE;
#pragma unroll
            for (int r = 0; r < 16; ++r) {
                const int v = 32 * wv + (r & 3) + 8 * (r >> 2) + 4 * (lane >> 5), k = lane & 31;
                if (v <= 96) { dst[v * 96 + k] = c0[r]; dst[v * 96 + 32 + k] = c1[r]; dst[v * 96 + 64 + k] = c2[r]; }
            }
        }
    }
}
DEV void ph_ml_2(PRef P, int wvs, int bid, int nblk) {
    for (int idx = bid * NT + ltid(wvs); idx < 16 * MLE; idx += nblk * NT) {
        const int chain = idx / MLE, e = idx % MLE; float run = 0.f;
        for (int s0 = 0; s0 < NSC; s0 += 13) {
            float loc[13], gg[13];
#pragma unroll
            for (int i = 0; i < 13; ++i) { loc[i] = P.mlC[((size_t)chain * NSC + s0 + i) * MLE + e]; gg[i] = P.mlG[chain * NSC + s0 + i]; }
#pragma unroll
            for (int i = 0; i < 13; ++i) { P.mlC[((size_t)chain * NSC + s0 + i) * MLE + e] = run; run = gg[i] * run + loc[i]; }
        }
    }
}
DEV void ph_ml_3(PRef P, int wvs, int l, int bid, int nblk, unsigned char* smraw) {
    f16* sh = (f16*)smraw;
    f16 *VT = sh + ML_VT_OFF, *KeT = sh + ML_KE_OFF, *Qs = sh + ML_QS_OFF, *Ks = sh + ML_KS_OFF, *C16 = sh + ML_C16_OFF, *Am = sh + ML_AM_OFF;
    float* fb = (float*)(smraw + ML_F_OFF_BYTES);
    for (int item = bid; item < 16 * NSC; item += nblk) {
        const int tid = ltid(wvs), lane = tid & 63, wv = tid >> 6, w4 = wv & 3, wm = w4 & 1, wn = w4 >> 1;
        const int chain = item / NSC, sc = item % NSC, z = chain / 8, b = (chain / 4) % 2, hh = chain % 4;
        if (l == 1 && sc == 0) continue;
        BAR_LDS();
        for (int idx = tid; idx < 32 * SLD; idx += NT) VT[96 * SLD + idx] = (f16)((idx < SLD) ? 1.f : 0.f);
        floatx16 c0, c1, c2;
#pragma unroll
        for (int r = 0; r < 16; ++r) { c0[r] = 0.f; c1[r] = 0.f; c2[r] = 0.f; }
        if (wv < 4) {
            const GAS float* srcC = P.mlC + (size_t)item * MLE;
#pragma unroll
            for (int r = 0; r < 16; ++r) {
                const int v = 32 * wv + (r & 3) + 8 * (r >> 2) + 4 * (lane >> 5), k = lane & 31;
                const bool ok = v <= 96;
                c0[r] = ok ? srcC[v * 96 + k] : 0.f; c1[r] = ok ? srcC[v * 96 + 32 + k] : 0.f; c2[r] = ok ? srcC[v * 96 + 64 + k] : 0.f;
            }
        }
#pragma unroll 1
        for (int cc = 0; cc < 4; ++cc) {
            const int s0 = sc * 256 + cc * 64;
            BAR_LDS();
            if (wv == 7) {
                const int R = scan_row(z, b, s0 + lane);
                const float li = P.gates[(size_t)R * 16 + z * 8 + hh * 2], lf = P.gates[(size_t)R * 16 + z * 8 + hh * 2 + 1];
                float F = lf;
#pragma unroll
                for (int o = 1; o < 64; o <<= 1) { const float y = __shfl_up(F, o); if (lane >= o) F += y; }
                const float FL = __shfl(F, 63);
                fb[lane] = __expf(F); fb[64 + lane] = __expf(fminf(li - F, 10.f)); fb[128 + lane] = __expf(li + FL - F);
                if (lane == 63) fb[192] = __expf(FL);
            }
            if (wv < 4) {
#pragma unroll
                for (int r = 0; r < 16; ++r) {
                    const int v = 32 * wv + (r & 3) + 8 * (r >> 2) + 4 * (lane >> 5), k = lane & 31;
                    C16[v * QLD + k] = (f16)c0[r]; C16[v * QLD + 32 + k] = (f16)c1[r]; C16[v * QLD + 64 + k] = (f16)c2[r];
                }
            }
            BAR_LDS();
#pragma unroll
            for (int i = 0; i < 3; ++i) {
                const int e = tid + NT * i, which = e / 768, rem = e % 768, t = rem / 12, c8 = rem % 12;
                const int R = scan_row(z, b, s0 + t);
                const half8 x = *(const half8*)(P.qkv16 + (size_t)R * 1152 + (which ? 384 : 0) + hh * 96 + c8 * 8);
                const float w = which ? fb[64 + t] : fb[t];
                half8 y;
#pragma unroll
                for (int jj = 0; jj < 8; ++jj) y[jj] = (f16)((float)x[jj] * w);
                *(half8*)((which ? Ks : Qs) + t * QLD + c8 * 8) = y;
            }
            ml_load_T(P, z, b, hh, s0, fb + 128, VT, KeT, tid);
            BAR_LDS();
            if (wv >= 4) {
#pragma unroll
                for (int r = 0; r < 16; ++r) c2[r] = 0.f;
                if (!(wm == 0 && wn == 1)) c2 = mmh<6>(Qs, QLD, wm * 32, Ks, QLD, wn * 32, lane, c2);
#pragma unroll
                for (int r = 0; r < 16; ++r) {
                    const int m = wm * 32 + (r & 3) + 8 * (r >> 2) + 4 * (lane >> 5), n = wn * 32 + (lane & 31);
                    Am[m * SLD + n] = (f16)(n <= m ? c2[r] : 0.f);
                }
            } else {
                const float gL = fb[192];
#pragma unroll
                for (int r = 0; r < 16; ++r) { c0[r] *= gL; c1[r] *= gL; c2[r] *= gL; }
                c0 = mmh<4>(VT, SLD, 32 * wv, KeT, SLD, 0, lane, c0); __builtin_amdgcn_sched_barrier(0);
                c1 = mmh<4>(VT, SLD, 32 * wv, KeT, SLD, 32, lane, c1); __builtin_amdgcn_sched_barrier(0);
                c2 = mmh<4>(VT, SLD, 32 * wv, KeT, SLD, 64, lane, c2);
            }
            BAR_LDS();
            if (wv >= 4) {
#pragma unroll
                for (int r = 0; r < 16; ++r) { c0[r] = 0.f; c1[r] = 0.f; }
                c0 = mmh<4>(Am, SLD, 0, VT, SLD, 32 * w4, lane, c0); __builtin_amdgcn_sched_barrier(0); c0 = mmh<6>(Qs, QLD, 0, C16, QLD, 32 * w4, lane, c0); __builtin_amdgcn_sched_barrier(0);
                c1 = mmh<4>(Am, SLD, 32, VT, SLD, 32 * w4, lane, c1); __builtin_amdgcn_sched_barrier(0); c1 = mmh<6>(Qs, QLD, 32, C16, QLD, 32 * w4, lane, c1); __builtin_amdgcn_sched_barrier(0);
                if (wv == 7 && (lane & 31) == 0) {
#pragma unroll
                    for (int r = 0; r < 16; ++r) { const int t = (r & 3) + 8 * (r >> 2) + 4 * (lane >> 5); fb[256 + t] = c0[r]; fb[256 + 32 + t] = c1[r]; }
                }
            }
            BAR_LDS();
            if (wv >= 4 && wv < 7) {
#pragma unroll
                for (int r = 0; r < 16; ++r) {
                    const int t = (r & 3) + 8 * (r >> 2) + 4 * (lane >> 5);
                    const int R0 = scan_row(z, b, s0 + t), R1 = scan_row(z, b, s0 + 32 + t);
                    const float d0 = fmaxf(fabsf(fb[256 + t]), 1.f), d1 = fmaxf(fabsf(fb[256 + 32 + t]), 1.f);
                    P.Yh[((size_t)z * NROWS + R0) * 384 + hh * 96 + 32 * w4 + (lane & 31)] = (f16)(c0[r] * frcp(d0));
                    P.Yh[((size_t)z * NROWS + R1) * 384 + hh * 96 + 32 * w4 + (lane & 31)] = (f16)(c1[r] * frcp(d1));
                    if ((r & 3) == 3) __builtin_amdgcn_sched_barrier(0);
                }
            }
        }
    }
}
DEV void ph_ml_fin2(PRef P, int wvs, int l, int bid, int nblk, bool dry = false) {
    typedef _Float16 half2_ __attribute__((ext_vector_type(2)));
    const int tid_ = ltid(wvs); const int lane = tid_ & 63, wv = tid_ >> 6;
    const int c0 = lane * 6;
    float ng[6], sk[6], cb[6], w0[6], w1[6], w2[6];
#pragma unroll
    for (int i = 0; i < 6; ++i) {
        ng[i] = P.ml_norm_g[l * 384 + c0 + i]; sk[i] = P.ml_skip[l * 384 + c0 + i]; cb[i] = P.ml_conv_b[l * 384 + c0 + i];
        w0[i] = P.ml_conv_w[(l * 3 + 0) * 384 + c0 + i]; w1[i] = P.ml_conv_w[(l * 3 + 1) * 384 + c0 + i]; w2[i] = P.ml_conv_w[(l * 3 + 2) * 384 + c0 + i];
    }
    for (int R = (l == 1 ? NCTX : 0) + bid * NW + wv; R < NROWS; R += nblk * NW) {
        int t, len; if (R < NCTX) { t = R % CTX; len = CTX; } else { t = (R - NCTX) % SEQ; len = SEQ; }
        float y[6], xm[6], xa[6], xb[6], zg[6]; float s = 0.f;
#pragma unroll
        for (int i = 0; i < 3; ++i) {
            const half2_ a = *(const GAS half2_*)(P.Yh + (size_t)R * 384 + c0 + 2 * i), b2 = *(const GAS half2_*)(P.Yh + ((size_t)NROWS + R) * 384 + c0 + 2 * i);
            const half2_ m = *(const GAS half2_*)(P.p + (size_t)R * INW + 2176 + c0 + 2 * i), zz = *(const GAS half2_*)(P.p + (size_t)R * INW + 2560 + c0 + 2 * i);
            half2_ pa, pb; pa[0] = (f16)0.f; pa[1] = (f16)0.f; pb = pa;
            if (t > 0) pa = *(const GAS half2_*)(P.p + (size_t)(R - 1) * INW + 2176 + c0 + 2 * i);
            if (t < len - 1) pb = *(const GAS half2_*)(P.p + (size_t)(R + 1) * INW + 2176 + c0 + 2 * i);
#pragma unroll
            for (int e = 0; e < 2; ++e) {
                y[2 * i + e] = (float)a[e] + (float)b2[e]; s += y[2 * i + e];
                xm[2 * i + e] = (float)m[e]; xa[2 * i + e] = (float)pa[e]; xb[2 * i + e] = (float)pb[e]; zg[2 * i + e] = (float)zz[e];
            }
        }
        s = row16_sum(s);
        const float mu = s * (1.f / 96.f); float q = 0.f;
#pragma unroll
        for (int i = 0; i < 6; ++i) { y[i] -= mu; q += y[i] * y[i]; }
        q = row16_sum(q);
        const float rs = __builtin_amdgcn_rsqf(q * (1.f / 96.f) + 1e-6f);
#pragma unroll
        for (int i = 0; i < 3; ++i) {
            half2_ o;
#pragma unroll
            for (int e = 0; e < 2; ++e) {
                const int k = 2 * i + e;
                const float xc = fsilu(cb[k] + w1[k] * xm[k] + w0[k] * xa[k] + w2[k] * xb[k]);
                o[e] = (f16)((y[k] * rs * ng[k] + sk[k] * xc) * fsilu(zg[k]));
            }
            if (!dry) *(GAS half2_*)(P.p + (size_t)R * INW + 2560 + c0 + 2 * i) = o; else *(GAS half2_*)(P.rwm + (size_t)R * 384 + c0 + 2 * i) = o;
        }
    }
}

#define XB_TMO      128
#define XB_XCNT(j)  (256  + 64 * (j))
#define XB_XSUB(j)  (1280 + 64 * (j))
#define XB_XGEN(j)  (2304 + 64 * (j))
#define XB_TOP      3328
#define XB_TOPGEN   3392
#define XCD_BAR_WORDS 3456
#define XB_SPIN_CAP (1u << 22)
DEV unsigned xb_ld(GAS unsigned* p)              { return __hip_atomic_load(p, __ATOMIC_RELAXED, __HIP_MEMORY_SCOPE_AGENT); }
DEV unsigned xb_add(GAS unsigned* p, unsigned v) { return __hip_atomic_fetch_add(p, v, __ATOMIC_RELAXED, __HIP_MEMORY_SCOPE_AGENT); }
DEV unsigned xb_xcc_id() { return (unsigned)__builtin_amdgcn_s_getreg((3 << 11) | 20) & 0xFu; }
#define XB_SPIN(cond, bar) do { unsigned _sp = 0; while (cond) { __builtin_amdgcn_s_sleep(1); \
    if ((++_sp & 255u) == 0u) { if (xb_ld(&(bar)[XB_TMO])) break; if (_sp > XB_SPIN_CAP) { (void)xb_add(&(bar)[XB_TMO], 1u); break; } } } } while (0)
struct XcdBarrier { GAS unsigned* bar; unsigned x; volatile LAS unsigned* st; };
DEV XcdBarrier xcd_barrier_post(GAS unsigned* bar, volatile LAS unsigned* st) {
    XcdBarrier b; b.bar = bar; b.x = xb_xcc_id(); b.st = st;
    if (threadIdx.x == 0) (void)xb_add(&bar[XB_XCNT(b.x)], 1u);
    return b;
}
DEV void xcd_barrier_complete(GAS unsigned* bar, unsigned x, unsigned& nloc, unsigned& nx) {
    const unsigned G = gridDim.x * gridDim.y * gridDim.z;
    unsigned sum, cnt, mine, sp = 0u;
    for (;;) {
        sum = 0u; cnt = 0u; mine = 0u;
#pragma unroll
        for (unsigned j = 0; j < 16; ++j) { const unsigned c = xb_ld(&bar[XB_XCNT(j)]); sum += c; cnt += (c > 0u) ? 1u : 0u; mine = (j == x) ? c : mine; }
        if (sum == G) break;
        __builtin_amdgcn_s_sleep(1);
        if ((++sp & 255u) == 0u) { if (xb_ld(&bar[XB_TMO])) break; if (sp > XB_SPIN_CAP) { (void)xb_add(&bar[XB_TMO], 1u); break; } }
    }
    nloc = mine > 0u ? mine : 1u; nx = cnt > 0u ? cnt : 1u;
}
DEV bool is_thread0(int wvs) { return wvs == 0 && __builtin_amdgcn_mbcnt_hi(~0u, __builtin_amdgcn_mbcnt_lo(~0u, 0u)) == 0u; }
DEV void xcd_barrier(const XcdBarrier& b, GAS unsigned* bar_, int wvs) {
    asm volatile("s_waitcnt vmcnt(0)" ::: "memory");
    __syncthreads();
    if (is_thread0(wvs)) {
        GAS unsigned* bar = bar_;
        __builtin_amdgcn_s_waitcnt(0);
        unsigned nloc = b.st[0], nx = b.st[1];
        if (nloc == 0u) { xcd_barrier_complete(bar, b.x, nloc, nx); b.st[0] = nloc; b.st[1] = nx; }
        const unsigned old = xb_add(&bar[XB_XSUB(b.x)], 1u);
        const unsigned gen = old / nloc;
        if (old + 1u == (gen + 1u) * nloc) {
            __builtin_amdgcn_fence(__ATOMIC_RELEASE, "agent");
            asm volatile("s_waitcnt vmcnt(0)" ::: "memory");
            const unsigned og = xb_add(&bar[XB_TOP], 1u);
            const unsigned tg = og / nx;
            if (og + 1u == (tg + 1u) * nx) xb_add(&bar[XB_TOPGEN], 1u);
            else XB_SPIN(xb_ld(&bar[XB_TOPGEN]) == tg, bar);
            __builtin_amdgcn_fence(__ATOMIC_ACQUIRE, "agent");
            xb_add(&bar[XB_XGEN(b.x)], 1u);
            asm volatile("s_waitcnt vmcnt(0)" ::: "memory");
        } else {
            XB_SPIN(xb_ld(&bar[XB_XGEN(b.x)]) == gen, bar);
            __builtin_amdgcn_fence(__ATOMIC_ACQUIRE, "agent");
            asm volatile("s_waitcnt vmcnt(0)" ::: "memory");
        }
    }
    __syncthreads();
}


DEV void sub_barrier(GAS unsigned* cnt, unsigned nmemb, unsigned round, int wvs) {
    asm volatile("s_waitcnt vmcnt(0)" ::: "memory");
    __syncthreads();
    if (is_thread0(wvs)) {
        __builtin_amdgcn_fence(__ATOMIC_RELEASE, "agent");
        asm volatile("s_waitcnt vmcnt(0)" ::: "memory");
        (void)xb_add(cnt, 1u);
        unsigned sp = 0;
        while (xb_ld(cnt) < nmemb * round) { __builtin_amdgcn_s_sleep(1); if (++sp > (1u << 24)) break; }
        __builtin_amdgcn_fence(__ATOMIC_ACQUIRE, "agent");
        asm volatile("s_waitcnt vmcnt(0)" ::: "memory");
    }
    __syncthreads();
}

constexpr size_t al256(size_t x) { return (x + 255) & ~(size_t)255; }
constexpr size_t WS_MODS = 0;
constexpr size_t WS_P = al256(WS_MODS + 2 * 3 * 3072 * 4);
constexpr size_t WS_Y = al256(WS_P + (size_t)NROWS * INW * 2);
constexpr size_t WS_Q = al256(WS_Y + (size_t)2 * NROWS * 384 * 4);
constexpr size_t WS_Q_BYTES = (size_t)NROWS * 1152 * 4;
constexpr size_t WS_GATES = al256(WS_Q + WS_Q_BYTES);
constexpr size_t WS_BON = al256(WS_GATES + (size_t)NROWS * 16 * 4);
constexpr size_t WS_YG = al256(WS_BON + (size_t)2 * NROWS * 6 * 4);
constexpr size_t WS_S5H = al256(WS_YG + (size_t)NROWS * 256 * 2);
constexpr size_t WS_S5PAR = al256(WS_S5H + (size_t)64 * NCHUNK * 128 * 4);
constexpr size_t WS_S5BB = al256(WS_S5PAR + (size_t)64 * S5PW * 64 * 4);
constexpr size_t WS_S5CC = al256(WS_S5BB + (size_t)64 * 128 * 16 * 2);
constexpr size_t WS_GLUT = al256(WS_S5CC + (size_t)64 * 16 * 128 * 2);
constexpr size_t WS_CTX1 = al256(WS_GLUT + (size_t)2 * 256 * 256 * 2);
constexpr size_t WS_WTIN = al256(WS_CTX1 + (size_t)NCTX * D * 4);
constexpr size_t WS_WTOUT = al256(WS_WTIN + (size_t)2 * 3072 * D * 2);
constexpr size_t WS_RWLT = al256(WS_WTOUT + (size_t)2 * D * D * 2);
constexpr size_t WS_MLGW = al256(WS_RWLT + (size_t)2 * 2 * 2 * 384 * 32 * 2);
constexpr size_t WS_GP = al256(WS_MLGW + (size_t)2 * 16 * 1152 * 2);
constexpr size_t WS_XBAR = al256(WS_GP + 1024);
constexpr size_t WS_END = al256(WS_XBAR + (XCD_BAR_WORDS + 256) * 4);
static_assert(3 * RWM_STRIDE * 2 <= WS_Q_BYTES, "rwkv chunk matrices");
static_assert(al256((size_t)NROWS * 1152 * 2) + al256((size_t)16 * NSC * MLE * 4) + 16 * NSC * 4 <= WS_Q_BYTES, "ml region");

static void fill_params(Params& P, void* const* d_in, void* d_out, void* d_ws) {
    const GAS float** pp = (const GAS float**)&P;
    for (int i = 0; i < 41; ++i) pp[i] = (const GAS float*)d_in[i];
    unsigned char* ws = (unsigned char*)d_ws;
    P.out = (GAS float*)d_out;
    P.mods = (GAS float*)(ws + WS_MODS); P.p = (GAS f16*)(ws + WS_P); P.Yh = (GAS f16*)(ws + WS_Y);
    P.gates = (GAS float*)(ws + WS_GATES); P.bon = (GAS float*)(ws + WS_BON); P.ctx1 = (GAS float*)(ws + WS_CTX1);
    P.hx = (GAS f16*)(ws + WS_Q); P.rwm = (GAS f16*)(ws + WS_Q); P.qkv16 = (GAS f16*)(ws + WS_Q);
    P.mlC = (GAS float*)(ws + WS_Q + al256((size_t)NROWS * 1152 * 2)); P.mlG = (GAS float*)(ws + WS_Q + al256((size_t)NROWS * 1152 * 2) + al256((size_t)16 * NSC * MLE * 4));
    P.wt_in = (GAS f16*)(ws + WS_WTIN); P.wt_out = (GAS f16*)(ws + WS_WTOUT); P.glut = (GAS f16*)(ws + WS_GLUT);
    P.yg = (GAS f16*)(ws + WS_YG); P.s5h = (GAS float*)(ws + WS_S5H); P.s5par = (GAS float*)(ws + WS_S5PAR); P.s5bb = (GAS f16*)(ws + WS_S5BB); P.s5cc = (GAS f16*)(ws + WS_S5CC);
    P.rwlt = (GAS bf16*)(ws + WS_RWLT); P.mlgw = (GAS f16*)(ws + WS_MLGW); P.gp = (GAS Params*)(ws + WS_GP); P.xbar = (GAS unsigned*)(ws + WS_XBAR);
}

constexpr int cmax(int a, int b) { return a > b ? a : b; }
constexpr int MEGA_LDS_BYTES = cmax(cmax(RWP1_LDS_BYTES, S5_LDS_BYTES), cmax(GEMM_LDS_BYTES, ML_LDS_BYTES));

template <int l>
DEV void layer_body(PRef P, const int wvs, const int bid, const int nblk, unsigned char* smraw, float* sm, const XcdBarrier& xb) {
        for (int rep = 0; rep < REP_HX; ++rep) ph_hx(P, wvs, l, lsgpr(bid), nblk);
        xcd_barrier(xb, P.xbar, wvs);
        for (int rep = 0; rep < REP_G1; ++rep) ph_gemm_8p<1>(P, wvs, l, lsgpr(bid), nblk, smraw);
        for (int rep = 0; rep < REP_SYNC; ++rep) xcd_barrier(xb, P.xbar, wvs);
        for (int rep = 0; rep < REP_P1; ++rep) ph_rw_p1(P, wvs, l, lsgpr(bid), nblk, smraw, rep + 1 < REP_P1);
        for (int rep = 0; rep < REP_S5A; ++rep) ph_s5_a(P, wvs, l, lsgpr(bid), nblk, smraw);
        xcd_barrier(xb, P.xbar, wvs);
        if (bid < 96) {
            for (int rep = 0; rep < REP_ST; ++rep) ph_rw_stream(P, wvs, l, lsgpr(bid), 96, smraw, rep + 1 < REP_ST);
        } else {
            ph_s5_b(P, wvs, l, lsgpr(bid) - 96, nblk - 96);
            sub_barrier(P.xbar + 3456 + 64, nblk - 96, 1u + l, wvs);
            for (int rep = 0; rep < REP_S5C; ++rep) ph_s5_c(P, wvs, l, lsgpr(bid) - 96, nblk - 96, smraw);
        }
        xcd_barrier(xb, P.xbar, wvs);
        for (int rep = 0; rep < REP_RWF; ++rep) ph_rwkv_fin2(P, wvs, l, lsgpr(bid), nblk, rep + 1 < REP_RWF);
        ph_gemm_mfma<3>(P, wvs, l, lsgpr(bid), nblk, smraw);
        for (int rep = 0; rep < REP_MLA; ++rep) ph_ml_a(P, wvs, l, lsgpr(bid), nblk, sm);
        xcd_barrier(xb, P.xbar, wvs);
        for (int rep = 0; rep < REP_ML1; ++rep) ph_ml_1(P, wvs, l, lsgpr(bid), nblk, smraw);
        xcd_barrier(xb, P.xbar, wvs);
        ph_ml_2(P, wvs, lsgpr(bid), nblk);
        xcd_barrier(xb, P.xbar, wvs);
        for (int rep = 0; rep < REP_ML3; ++rep) ph_ml_3(P, wvs, l, lsgpr(bid), nblk, smraw);
        xcd_barrier(xb, P.xbar, wvs);
        for (int rep = 0; rep < REP_MLF; ++rep) ph_ml_fin2(P, wvs, l, lsgpr(bid), nblk, rep + 1 < REP_MLF);
        xcd_barrier(xb, P.xbar, wvs);
        for (int rep = 0; rep < (l == 0 ? REP_G2 : 1); ++rep) ph_gemm_8p<2>(P, wvs, l, lsgpr(bid), nblk, smraw);
        if (l == 0) ph_gemm_mfma<2>(P, wvs, l, lsgpr(bid), nblk, smraw, false, NCTX / 256);
        xcd_barrier(xb, P.xbar, wvs);
}

__global__ void __launch_bounds__(NT) mega_fwd(Params Pk) {
    __shared__ __attribute__((aligned(16))) unsigned char smraw[MEGA_LDS_BYTES + 16];
    float* sm = (float*)smraw;
    cg::grid_group grid = cg::this_grid();
    const int bid = blockIdx.x, nblk = gridDim.x;
    const int wvs = __builtin_amdgcn_readfirstlane((int)(threadIdx.x >> 6));
    if (threadIdx.x == 0) {
        GAS unsigned long long* dstw = (GAS unsigned long long*)Pk.gp; const unsigned long long* srcw = (const unsigned long long*)&Pk;
#pragma unroll
        for (int i = 0; i < (int)(sizeof(Params) / 8); ++i) dstw[i] = srcw[i];
        *(uintx4*)(smraw + MEGA_LDS_BYTES) = (uintx4){0u, 0u, 0u, 0u};
    }
    asm volatile("s_waitcnt vmcnt(0)" ::: "memory");
    __syncthreads();
    const XcdBarrier xb = xcd_barrier_post(Pk.xbar, (volatile LAS unsigned*)(smraw + MEGA_LDS_BYTES));
    const GAS Params* pg = Pk.gp;
    asm volatile("" : "+s"(pg) :: "memory");
    PRef P = *pg;
    ph_mods2(P, wvs, lsgpr(bid), nblk, sm);
    ph_wprep(P, wvs, lsgpr(bid), nblk, sm);
    ph_tables(P, wvs, lsgpr(bid), nblk);
    grid.sync();
    layer_body<0>(P, wvs, bid, nblk, smraw, sm, xb);
    layer_body<1>(P, wvs, bid, nblk, smraw, sm, xb);
    ph_final2(P, wvs, lsgpr(bid), nblk);
}

extern "C" void kernel_launch(void* const* d_in, const int* in_sizes, int n_in, void* d_out, int out_size, void* d_ws, size_t ws_size, hipStream_t stream) {
    if (ws_size < WS_END) { fprintf(stderr, "workspace too small: %zu < %zu\n", ws_size, (size_t)WS_END); return; }
    static int grid_blocks = 0;
    if (!grid_blocks) {
        int dev = 0, cus = 0, per_cu = 0;
        hipGetDevice(&dev);
        hipDeviceGetAttribute(&cus, hipDeviceAttributeMultiprocessorCount, dev);
        hipOccupancyMaxActiveBlocksPerMultiprocessor(&per_cu, mega_fwd, NT, 0);
        if (per_cu < 1) per_cu = 1;
        grid_blocks = cus * per_cu;
        fprintf(stderr, "mega_fwd: %d CUs x %d blocks/CU\n", cus, per_cu);
    }
    Params P{};
    fill_params(P, d_in, d_out, d_ws);
    hipMemsetAsync((unsigned char*)d_ws + WS_XBAR, 0, (XCD_BAR_WORDS + 256) * 4, stream);
    void* args[] = {&P};
    hipError_t e = hipLaunchCooperativeKernel((void*)mega_fwd, dim3(grid_blocks), dim3(NT), args, 0, stream);
    if (e != hipSuccess) fprintf(stderr, "cooperative launch failed: %s (grid %d)\n", hipGetErrorString(e), grid_blocks);
}
```

```cpp
#include <hip/hip_runtime.h>
#include <hip/hip_cooperative_groups.h>
#include <cstdint>
#include <cmath>
#include <cstdio>
namespace cg = cooperative_groups;

#ifndef SEQ
#define SEQ 16384
#endif
#ifndef CTX
#define CTX 256
#endif
#ifndef REP_G1
#define REP_G1 1
#endif
#ifndef REP_G2
#define REP_G2 1
#endif
#ifndef REP_P1
#define REP_P1 1
#endif
#ifndef REP_S5A
#define REP_S5A 1
#endif
#ifndef REP_S5C
#define REP_S5C 1
#endif
#ifndef REP_MLA
#define REP_MLA 1
#endif
#ifndef REP_ML1
#define REP_ML1 1
#endif
#ifndef REP_ML3
#define REP_ML3 1
#endif
#ifndef REP_HX
#define REP_HX 1
#endif
#ifndef REP_ST
#define REP_ST 1
#endif
#ifndef REP_RWF
#define REP_RWF 1
#endif
#ifndef REP_MLF
#define REP_MLF 1
#endif
#ifndef REP_G3
#define REP_G3 1
#endif
#ifndef ST_VARIANT
#define ST_VARIANT 0
#endif
#ifndef G_VARIANT
#define G_VARIANT 0
#endif
#ifndef P_VARIANT
#define P_VARIANT 0
#endif
#ifndef REP_SYNC
#define REP_SYNC 1
#endif

typedef _Float16 f16;
typedef __bf16 bf16;
typedef _Float16 half8 __attribute__((ext_vector_type(8)));
typedef _Float16 half4 __attribute__((ext_vector_type(4)));
typedef __bf16 bf16x8 __attribute__((ext_vector_type(8)));
typedef __bf16 bf16x4 __attribute__((ext_vector_type(4)));
typedef float floatx16 __attribute__((ext_vector_type(16)));
typedef float floatx4 __attribute__((ext_vector_type(4)));
typedef short v4i16_t __attribute__((ext_vector_type(4)));
typedef float floatx2 __attribute__((ext_vector_type(2)));
typedef unsigned uintx4 __attribute__((ext_vector_type(4)));

constexpr int D = 1024, NB = 2, INW = 2944;
constexpr int NCTX = NB * CTX, NLAT = NB * SEQ, NROWS = NCTX + NLAT;
constexpr int TSCAN = CTX + SEQ, NCHUNK = TSCAN / 64;
constexpr int NT = 512, NW = NT / 64;
#define DEV __device__ __forceinline__
#define LAS __attribute__((address_space(3)))
#define GAS __attribute__((address_space(1)))
#define BAR_LDS() asm volatile("s_waitcnt lgkmcnt(0)\n\ts_barrier" ::: "memory")

DEV int ltid(int wvs) { int lane; asm volatile("v_mbcnt_lo_u32_b32 %0, -1, 0\n\tv_mbcnt_hi_u32_b32 %0, -1, %0" : "=v"(lane)); return (wvs << 6) | lane; }
DEV int lsgpr(int x) { asm volatile("" : "+s"(x)); return x; }

struct Params;
typedef const GAS Params& PRef;
struct Params {
    const GAS float *x, *c, *ctx, *c_ctx, *ada_w, *ada_b, *norm_g, *w_in, *w_out;
    const GAS float *rw_mu, *rw_w0, *rw_w_up, *rw_a0, *rw_a_up, *rw_k_k, *rw_k_a, *rw_r_k, *rw_ln_g, *rw_ln_b;
    const GAS float *s5_a_re, *s5_a_im, *s5_log_dt, *s5_b_re, *s5_b_im, *s5_c_re, *s5_c_im, *s5_d, *s5_glu_w, *s5_glu_b;
    const GAS float *ml_conv_w, *ml_conv_b, *ml_wq, *ml_wk, *ml_wv, *ml_wi, *ml_bi, *ml_wf, *ml_bf, *ml_norm_g, *ml_skip;
    const GAS float* final_g;
    GAS float* out;
    GAS float* mods;
    GAS f16* p;
    GAS f16* Yh;
    GAS float* gates;
    GAS float* bon;
    GAS float* ctx1;
    GAS f16* hx;
    GAS f16* rwm;
    GAS f16* qkv16;
    GAS float* mlC;
    GAS float* mlG;
    GAS f16* wt_in;
    GAS f16* wt_out;
    GAS f16* glut;
    GAS f16* yg;
    GAS float* s5h;
    GAS float* s5par;
    GAS f16* s5bb;
    GAS f16* s5cc;
    GAS bf16* rwlt;
    GAS f16* mlgw;
    GAS unsigned* xbar;
    GAS Params* gp;
};

DEV float sigmoidf_(float x) { return 1.f / (1.f + expf(-x)); }
DEV float siluf_(float x) { return x / (1.f + expf(-x)); }
DEV float frcp(float x) { return __builtin_amdgcn_rcpf(x); }
DEV float fsigmoid(float x) { return frcp(1.f + __expf(-x)); }
DEV float fsilu(float x) { return x * frcp(1.f + __expf(-x)); }
DEV float ftanh(float x) { return 1.f - 2.f * frcp(__expf(2.f * x) + 1.f); }
DEV float log_sigmoidf_(float x) { return fminf(x, 0.f) - log1pf(expf(-fabsf(x))); }
template <int CTRL> DEV float dpp_f(float v) { return __builtin_bit_cast(float, __builtin_amdgcn_update_dpp(0, __builtin_bit_cast(int, v), CTRL, 0xF, 0xF, false)); }
DEV float row16_sum(float v) {
    v += dpp_f<0xB1>(v); v += dpp_f<0x4E>(v); v += dpp_f<0x141>(v); v += dpp_f<0x140>(v);
    return v;
}
DEV float wave_sum(float v) {
    v = row16_sum(v);
    v += __shfl_xor(v, 16); v += __shfl_xor(v, 32);
    return v;
}
DEV int scan_row(int z, int b, int s) {
    if (s < CTX) { int t = z ? CTX - 1 - s : s; return b * CTX + t; }
    int u = s - CTX; int t = z ? SEQ - 1 - u : u; return NCTX + b * SEQ + t;
}
DEV int mirror_chunk(int tc) { return tc < CTX / 64 ? CTX / 64 - 1 - tc : CTX / 64 + (SEQ / 64 - 1) - (tc - CTX / 64); }
DEV int row_mod(int R) { return R < NCTX ? 2 : (R - NCTX) / SEQ; }
DEV const GAS float* xrow(PRef P, int l, int R) {
    const GAS float* xl = l == 0 ? P.x : P.out; const GAS float* xc = l == 0 ? P.ctx : P.ctx1;
    return R < NCTX ? xc + (size_t)R * D : xl + (size_t)(R - NCTX) * D;
}
DEV int nbr_row(int R, int c) {
    if (R < NCTX) { int t = R % CTX; if ((c & 1) == 0) return t > 0 ? R - 1 : -1; return t < CTX - 1 ? R + 1 : -1; }
    int t = (R - NCTX) % SEQ; int m = c & 3, col = t & 63;
    if (m == 0) return col > 0 ? R - 1 : -1;
    if (m == 1) return col < 63 ? R + 1 : -1;
    if (m == 2) return t >= 64 ? R - 64 : -1;
    return t < SEQ - 64 ? R + 64 : -1;
}
DEV float shl(PRef P, int l, int R, int c) {
    float pv = (float)P.p[(size_t)R * INW + c];
    int nb = nbr_row(R, c);
    float nv = nb >= 0 ? (float)P.p[(size_t)nb * INW + c] : 0.f;
    return pv + (nv - pv) * P.rw_mu[l * 1280 + c];
}
DEV int a2col(int k) { return k < 384 ? 1280 + k : (k < 640 ? 1920 + (k - 384) : 2560 + (k - 640)); }
DEV float ml_xm(PRef P, int R, int c) { return (float)P.p[(size_t)R * INW + 2176 + c]; }
DEV float ml_xc(PRef P, int l, int R, int c) {
    int t, len; if (R < NCTX) { t = R % CTX; len = CTX; } else { t = (R - NCTX) % SEQ; len = SEQ; }
    float a = P.ml_conv_b[l * 384 + c] + P.ml_conv_w[(l * 3 + 1) * 384 + c] * ml_xm(P, R, c);
    if (t > 0) a += P.ml_conv_w[(l * 3 + 0) * 384 + c] * ml_xm(P, R - 1, c);
    if (t < len - 1) a += P.ml_conv_w[(l * 3 + 2) * 384 + c] * ml_xm(P, R + 1, c);
    return fsilu(a);
}

DEV void ph_mods2(PRef P, int wvs, int bid, int nblk, float* sm) {
    const int tid = ltid(wvs), cl = tid & 15, kq = tid >> 4;
    for (int g = bid; g < 2 * 3 * 3072 / 16; g += nblk) {
        const int idx = g * 16 + cl; const int l = idx / 9216, rem = idx % 9216, j = rem / 3072, col = rem % 3072;
        const GAS float* cin = j < 2 ? P.c + j * D : P.c_ctx;
        float acc = 0.f;
        for (int k = kq * 32; k < kq * 32 + 32; ++k) acc += siluf_(cin[k]) * P.ada_w[((size_t)l * D + k) * 3072 + col];
        sm[kq * 16 + cl] = acc;
        __syncthreads();
        if (tid < 16) { float s = P.ada_b[l * 3072 + col]; for (int q = 0; q < 32; ++q) s += sm[q * 16 + tid]; P.mods[idx] = s; }
        __syncthreads();
    }
}
DEV void ph_wprep(PRef P, int wvs, int bid, int nblk, float* sm) {
    const int tid = ltid(wvs);
    constexpr int T_IN = 16 * 48, T_OUT = 16 * 16, T_GLU = 4 * 4;
    for (int t = bid; t < 2 * (T_IN + T_OUT + T_GLU); t += nblk) {
        int l = t / (T_IN + T_OUT + T_GLU), r = t % (T_IN + T_OUT + T_GLU);
        const GAS float* W; GAS f16* Wt; int N, tk, tn, KW = D;
        if (r < T_IN) { W = P.w_in + (size_t)l * D * INW; Wt = P.wt_in + (size_t)l * 3072 * D; N = INW; tk = r / 48; tn = r % 48; }
        else if (r < T_IN + T_OUT) { r -= T_IN; W = P.w_out + (size_t)l * D * D; Wt = P.wt_out + (size_t)l * D * D; N = D; tk = r / 16; tn = r % 16; }
        else { r -= T_IN + T_OUT; W = P.s5_glu_w + (size_t)l * 256 * 256; Wt = P.glut + (size_t)l * 256 * 256; N = 256; tk = r / 4; tn = r % 4; KW = 256; }
#pragma unroll
        for (int i = 0; i < 2; ++i) {
            int k = (tid >> 4) + 32 * i, n4 = (tid & 15) * 4;
            floatx4 v = {0.f, 0.f, 0.f, 0.f};
            if (tn * 64 + n4 < N) v = *(const GAS floatx4*)(W + (size_t)(tk * 64 + k) * N + tn * 64 + n4);
            sm[k * 65 + n4] = v[0]; sm[k * 65 + n4 + 1] = v[1]; sm[k * 65 + n4 + 2] = v[2]; sm[k * 65 + n4 + 3] = v[3];
        }
        __syncthreads();
        {
            int n = tid >> 3, k8 = (tid & 7) * 8;
            half8 h;
#pragma unroll
            for (int j = 0; j < 8; ++j) h[j] = (f16)sm[(k8 + j) * 65 + n];
            *(half8*)(Wt + (size_t)(tn * 64 + n) * KW + tk * 64 + k8) = h;
        }
        __syncthreads();
    }
}
constexpr int S5PW = 38;
DEV void ph_tables(PRef P, int wvs, int bid, int nblk) {
    for (int idx = bid * NT + ltid(wvs); idx < 2 * 2 * 16 * 64; idx += nblk * NT) {
        const int n = idx & 63, lzg = idx >> 6;
        const int pi = lzg * 64 + n;
        const float are_ = P.s5_a_re[pi], aim_ = P.s5_a_im[pi], dt = expf(P.s5_log_dt[pi]);
        const float mag = expf(are_ * dt), abr = mag * cosf(aim_ * dt), abi = mag * sinf(aim_ * dt);
        const float den = are_ * are_ + aim_ * aim_;
        const float qre = ((abr - 1.f) * are_ + abi * aim_) / den, qim = (abi * are_ - (abr - 1.f) * aim_) / den;
        GAS float* tb = P.s5par + (size_t)lzg * S5PW * 64 + n;
        tb[0] = abr; tb[64] = abi;
        for (int pp = 0; pp < 16; ++pp) {
            const float br = P.s5_b_re[(size_t)pi * 16 + pp], bi = P.s5_b_im[(size_t)pi * 16 + pp];
            P.s5bb[((size_t)lzg * 128 + n) * 16 + pp] = (f16)(qre * br - qim * bi);
            P.s5bb[((size_t)lzg * 128 + 64 + n) * 16 + pp] = (f16)(qre * bi + qim * br);
            P.s5cc[((size_t)lzg * 16 + pp) * 128 + n] = (f16)P.s5_c_re[((size_t)lzg * 16 + pp) * 64 + n];
            P.s5cc[((size_t)lzg * 16 + pp) * 128 + 64 + n] = (f16)(-P.s5_c_im[((size_t)lzg * 16 + pp) * 64 + n]);
        }
        const float m64 = expf(64.f * are_ * dt);
        tb[34 * 64] = m64 * cosf(64.f * aim_ * dt); tb[35 * 64] = m64 * sinf(64.f * aim_ * dt);
    }
    for (int idx = bid * NT + ltid(wvs); idx < 2 * 16 * 1152; idx += nblk * NT) {
        const int c = idx % 1152, o = (idx / 1152) & 15, l = idx / (16 * 1152), z = o >> 3, hh = (o >> 1) & 3, which = o & 1;
        const float w = (which ? P.ml_wf : P.ml_wi)[((size_t)(l * 2 + z) * 1152 + c) * 4 + hh];
        P.mlgw[idx] = (f16)((c >= 384 && c < 768) ? w * 9.797958971132712f : w);
    }
    for (int idx = bid * NT + ltid(wvs); idx < 2 * 2 * 2 * 384 * 32; idx += nblk * NT) {
        const int r = idx & 31, c = (idx >> 5) % 384, wa = (idx / (32 * 384)) & 1, lz = idx / (2 * 32 * 384);
        const GAS float* src_ = wa ? P.rw_a_up : P.rw_w_up;
        P.rwlt[idx] = (bf16)src_[((size_t)lz * 32 + r) * 384 + c];
    }
}
DEV void ph_hx(PRef P, int wvs, int l, int bid, int nblk) {
    const int tid_ = ltid(wvs); const int lane = tid_ & 63, wv = tid_ >> 6;
    const GAS float* g = P.norm_g + l * D;
    for (int Ra = bid * NW + wv; Ra < NROWS; Ra += 2 * nblk * NW) {
        const bool two = Ra + nblk * NW < NROWS;
        floatx4 v[2][4];
#pragma unroll
        for (int u = 0; u < 2; ++u) {
            const int Rl = (u == 1 && two) ? Ra + nblk * NW : Ra;
            if (l == 1 && Rl >= NCTX) {
                const GAS f16* xh = (const GAS f16*)P.out + (size_t)(Rl - NCTX) * D;
#pragma unroll
                for (int i = 0; i < 2; ++i) {
                    const half8 hv = *(const GAS half8*)(xh + i * 512 + lane * 8);
#pragma unroll
                    for (int e = 0; e < 4; ++e) { v[u][2 * i][e] = (float)hv[e]; v[u][2 * i + 1][e] = (float)hv[4 + e]; }
                }
            } else {
                const GAS float* xr = xrow(P, l, Rl);
#pragma unroll
                for (int i = 0; i < 2; ++i) { v[u][2 * i] = *(const floatx4*)(xr + i * 512 + lane * 8); v[u][2 * i + 1] = *(const floatx4*)(xr + i * 512 + lane * 8 + 4); }
            }
        }
#pragma unroll
        for (int u = 0; u < 2; ++u) {
            const int R = u == 1 ? Ra + nblk * NW : Ra;
            float ss = 0.f;
#pragma unroll
            for (int i = 0; i < 4; ++i) ss += v[u][i][0] * v[u][i][0] + v[u][i][1] * v[u][i][1] + v[u][i][2] * v[u][i][2] + v[u][i][3] * v[u][i][3];
            ss = wave_sum(ss);
            const float rs = 1.f / sqrtf(ss * (1.f / D) + 1e-6f);
            if (u == 0 || two) {
                const GAS float* m = P.mods + (l * 3 + row_mod(R)) * 3072;
#pragma unroll
                for (int i = 0; i < 2; ++i) {
                    const int k = i * 512 + lane * 8; half8 h;
#pragma unroll
                    for (int j = 0; j < 8; ++j) h[j] = (f16)(v[u][2 * i + (j >> 2)][j & 3] * rs * g[k + j] * (1.f + m[D + k + j]) + m[k + j]);
                    *(half8*)(P.hx + (size_t)R * D + k) = h;
                }
            }
        }
    }
}
DEV void ph_final2(PRef P, int wvs, int bid, int nblk) {
    const int tid_ = ltid(wvs); const int lane = tid_ & 63, wv = tid_ >> 6;
    floatx4 g[4];
#pragma unroll
    for (int i = 0; i < 2; ++i) { g[2 * i] = *(const GAS floatx4*)(P.final_g + i * 512 + lane * 8); g[2 * i + 1] = *(const GAS floatx4*)(P.final_g + i * 512 + lane * 8 + 4); }
    static_assert(NLAT % (4 * 2048) == 0, "final norm: 4 rows per wave and iteration");
    for (int r0 = (bid * NW + wv) * 4; r0 < NLAT; r0 += nblk * NW * 4) {
        half8 v[4][2];
#pragma unroll
        for (int u = 0; u < 4; ++u)
#pragma unroll
            for (int i = 0; i < 2; ++i) v[u][i] = *(const GAS half8*)(P.hx + (size_t)(NCTX + r0 + u) * D + i * 512 + lane * 8);
#pragma unroll
        for (int u = 0; u < 4; ++u) {
            float ss = 0.f;
#pragma unroll
            for (int i = 0; i < 2; ++i)
#pragma unroll
                for (int e = 0; e < 8; ++e) ss += (float)v[u][i][e] * (float)v[u][i][e];
            ss = wave_sum(ss);
            const float rs = 1.f / sqrtf(ss * (1.f / D) + 1e-6f);
            GAS float* orow = P.out + (size_t)(r0 + u) * D;
#pragma unroll
            for (int i = 0; i < 2; ++i) {
                floatx4 o0, o1;
#pragma unroll
                for (int j = 0; j < 4; ++j) { o0[j] = (float)v[u][i][j] * rs * g[2 * i][j]; o1[j] = (float)v[u][i][4 + j] * rs * g[2 * i + 1][j]; }
                *(GAS floatx4*)(orow + i * 512 + lane * 8) = o0; *(GAS floatx4*)(orow + i * 512 + lane * 8 + 4) = o1;
            }
        }
    }
}

constexpr int G_LDA = 72;
constexpr int G_STAGE = (256 + 128) * G_LDA;
constexpr int GEMM_LDS_BYTES = 2 * G_STAGE * 2;
template <int MODE>
DEV void gemm_epi_tile(PRef P, int l, const floatx16 acc, int R0, int n0, int lane) {
#pragma unroll
    for (int r = 0; r < 16; ++r) {
        const int R = R0 + (r & 3) + 8 * (r >> 2) + 4 * (lane >> 5), n = n0 + (lane & 31);
        if (MODE == 1) P.p[(size_t)R * INW + n] = (f16)acc[r];
        else if (MODE == 2) {
            const int j = row_mod(R); const float g = P.mods[(l * 3 + j) * 3072 + 2 * D + n];
            const float xo = xrow(P, l, R)[n];
            GAS float* dst = R < NCTX ? P.ctx1 + (size_t)R * D + n : P.out + (size_t)(R - NCTX) * D + n;
            *dst = xo + g * acc[r];
        } else {
            const float yv = (float)P.yg[(size_t)R * 256 + n]; const float gt = (float)P.p[(size_t)R * INW + 1920 + n];
            P.p[(size_t)R * INW + 1920 + n] = (f16)(yv * fsigmoid(acc[r] + P.s5_glu_b[l * 256 + n]) * fsilu(gt));
        }
    }
}
template <int MODE>
DEV void ph_gemm_mfma(PRef P, int wvs, int l, int bid, int nblk, unsigned char* smraw, bool dry = false, int ntm_limit = 1 << 30) {
    constexpr int N = MODE == 1 ? INW : (MODE == 2 ? D : 256), K = MODE == 3 ? 256 : D;
    const GAS f16* Bt = MODE == 1 ? P.wt_in + (size_t)l * INW * D : (MODE == 2 ? P.wt_out + (size_t)l * D * D : P.glut + (size_t)l * 256 * 256);
    const int tm0 = (MODE != 1 && l == 1) ? NCTX / 256 : 0;
    const int ntm = (NROWS / 256 - tm0) < ntm_limit ? (NROWS / 256 - tm0) : ntm_limit, ntn = N / 128;
    const int tid = ltid(wvs), lane = tid & 63, wv = tid >> 6, wm = wv & 3, wn = wv >> 2;
    f16* sbase = (f16*)smraw;
    const int ldrow = tid >> 3, ldch = tid & 7;
    constexpr int GM = 8;
    for (int t = bid; t < ntm * ntn; t += nblk) {
        int sg = t / (GM * ntn), rem = t % (GM * ntn);
        int gsz = ntm - sg * GM < GM ? ntm - sg * GM : GM;
        const int tm = tm0 + sg * GM + rem % gsz, tn = rem / gsz;
        floatx16 acc00, acc01, acc10, acc11;
#pragma unroll
        for (int r = 0; r < 16; ++r) { acc00[r] = 0.f; acc01[r] = 0.f; acc10[r] = 0.f; acc11[r] = 0.f; }
        uintx4 pa0, pa1, pa2, pa3, pb0, pb1, qa0, qa1, qa2, qa3, qb0, qb1;
        const GAS f16* arow = MODE == 1 ? P.hx + (size_t)(tm * 256 + ldrow) * D + ldch * 8 : (MODE == 2 ? P.p + (size_t)(tm * 256 + ldrow) * INW + ldch * 8 : P.yg + (size_t)(tm * 256 + ldrow) * 256 + ldch * 8);
        const size_t astr = (size_t)64 * (MODE == 1 ? D : (MODE == 2 ? INW : 256));
        const GAS f16* brow = Bt + (size_t)(tn * 128 + ldrow) * K + ldch * 8;
#define GLOAD(S, kt_) if (!(dry && G_VARIANT == 3 && (kt_) > 1)) { const int ka = MODE == 2 ? a2col((kt_) * 64) : (kt_) * 64; const int kb = (kt_) * 64; \
            S##a0 = *(const uintx4*)(arow + ka); S##a1 = *(const uintx4*)(arow + astr + ka); S##a2 = *(const uintx4*)(arow + 2 * astr + ka); S##a3 = *(const uintx4*)(arow + 3 * astr + ka); \
            S##b0 = *(const uintx4*)(brow + kb); S##b1 = *(const uintx4*)(brow + (size_t)64 * K + kb); }
#define SWRITE(S, st_) if (!(dry && G_VARIANT == 4)) { f16* sA_ = sbase + (st_) * G_STAGE + ldrow * G_LDA + ldch * 8; f16* sB_ = sbase + (st_) * G_STAGE + 256 * G_LDA + ldrow * G_LDA + ldch * 8; \
            *(uintx4*)(sA_) = S##a0; *(uintx4*)(sA_ + 64 * G_LDA) = S##a1; *(uintx4*)(sA_ + 128 * G_LDA) = S##a2; *(uintx4*)(sA_ + 192 * G_LDA) = S##a3; \
            *(uintx4*)(sB_) = S##b0; *(uintx4*)(sB_ + 64 * G_LDA) = S##b1; }
#define GFRAG(ks_, b_) { fa0[b_] = *(const half8*)(sA_ + (ks_) * 16); fa1[b_] = *(const half8*)(sA_ + 32 * G_LDA + (ks_) * 16); \
            fb0[b_] = *(const half8*)(sB_ + (ks_) * 16); fb1[b_] = *(const half8*)(sB_ + 32 * G_LDA + (ks_) * 16); }
#define GMMA(b_) { acc00 = __builtin_amdgcn_mfma_f32_32x32x16_f16(fb0[b_], fa0[b_], acc00, 0, 0, 0); acc01 = __builtin_amdgcn_mfma_f32_32x32x16_f16(fb1[b_], fa0[b_], acc01, 0, 0, 0); \
            acc10 = __builtin_amdgcn_mfma_f32_32x32x16_f16(fb0[b_], fa1[b_], acc10, 0, 0, 0); acc11 = __builtin_amdgcn_mfma_f32_32x32x16_f16(fb1[b_], fa1[b_], acc11, 0, 0, 0); }
#define GCOMPUTE(st_) { const f16* sA_ = sbase + (st_) * G_STAGE + (wm * 64 + (lane & 31)) * G_LDA + (lane >> 5) * 8; \
            const f16* sB_ = sbase + (st_) * G_STAGE + 256 * G_LDA + (wn * 64 + (lane & 31)) * G_LDA + (lane >> 5) * 8; \
            half8 fa0[2], fa1[2], fb0[2], fb1[2]; \
            GFRAG(0, 0); GFRAG(1, 1); __builtin_amdgcn_sched_barrier(0); \
            GMMA(0); GFRAG(2, 0); __builtin_amdgcn_sched_barrier(0); \
            GMMA(1); GFRAG(3, 1); __builtin_amdgcn_sched_barrier(0); \
            GMMA(0); __builtin_amdgcn_sched_barrier(0); GMMA(1); }
        constexpr int NK = K / 64;
        BAR_LDS();
        GLOAD(p, 0); SWRITE(p, 0); GLOAD(q, 1); if (2 < NK) GLOAD(p, 2);
        BAR_LDS();
        for (int kt = 0; kt < NK; kt += 2) {
            SWRITE(q, 1);
            if (kt + 3 < NK) GLOAD(q, kt + 3);
            GCOMPUTE(0);
            BAR_LDS();
            if (kt + 2 < NK) { SWRITE(p, 0); if (kt + 4 < NK) GLOAD(p, kt + 4); }
            GCOMPUTE(1);
            BAR_LDS();
        }
#undef GLOAD
#undef SWRITE
#undef GCOMPUTE
#undef GFRAG
#undef GMMA
        if (dry) continue;
        if (MODE != 2) {
            f16* Cs = (f16*)smraw;
#define CSTORE(acc_, mi_, ni_) { const int m_ = wm * 64 + (mi_) * 32 + (lane & 31); \
                _Pragma("unroll") for (int g = 0; g < 4; ++g) { half4 h_; h_[0] = (f16)acc_[4 * g]; h_[1] = (f16)acc_[4 * g + 1]; h_[2] = (f16)acc_[4 * g + 2]; h_[3] = (f16)acc_[4 * g + 3]; \
                    *(half4*)(Cs + m_ * 136 + wn * 64 + (ni_) * 32 + 8 * g + 4 * (lane >> 5)) = h_; } }
            CSTORE(acc00, 0, 0); CSTORE(acc01, 0, 1); CSTORE(acc10, 1, 0); CSTORE(acc11, 1, 1);
#undef CSTORE
            BAR_LDS();
#pragma unroll 2
            for (int i = 0; i < 8; ++i) {
                const int row = (tid >> 4) + 32 * i, ch = tid & 15; const int R = tm * 256 + row, n = tn * 128 + ch * 8;
                const half8 v = *(const half8*)(Cs + row * 136 + ch * 8);
                if (MODE == 1) *(GAS half8*)(P.p + (size_t)R * INW + n) = v;
                else {
                    const half8 yv = *(const GAS half8*)(P.yg + (size_t)R * 256 + n); const half8 gt = *(const GAS half8*)(P.p + (size_t)R * INW + 1920 + n);
                    const floatx4 b0 = *(const GAS floatx4*)(P.s5_glu_b + l * 256 + n), b1 = *(const GAS floatx4*)(P.s5_glu_b + l * 256 + n + 4);
                    half8 o;
#pragma unroll
                    for (int e = 0; e < 8; ++e) o[e] = (f16)((float)yv[e] * fsigmoid((float)v[e] + (e < 4 ? b0[e] : b1[e - 4])) * fsilu((float)gt[e]));
                    *(GAS half8*)(P.p + (size_t)R * INW + 1920 + n) = o;
                }
            }
        } else {
            float* Cs = (float*)smraw;
#pragma unroll 1
            for (int hm = 0; hm < 2; ++hm) {
                if ((wm >> 1) == hm) {
#define CSTORE(acc_, mi_, ni_) { const int m_ = (wm & 1) * 64 + (mi_) * 32 + (lane & 31); \
                    _Pragma("unroll") for (int g = 0; g < 4; ++g) { floatx4 f_; f_[0] = acc_[4 * g]; f_[1] = acc_[4 * g + 1]; f_[2] = acc_[4 * g + 2]; f_[3] = acc_[4 * g + 3]; \
                        *(floatx4*)(Cs + m_ * 132 + wn * 64 + (ni_) * 32 + 8 * g + 4 * (lane >> 5)) = f_; } }
                    CSTORE(acc00, 0, 0); CSTORE(acc01, 0, 1); CSTORE(acc10, 1, 0); CSTORE(acc11, 1, 1);
#undef CSTORE
                }
                BAR_LDS();
#pragma unroll 2
                for (int i = 0; i < 8; ++i) {
                    const int row = (tid >> 5) + 16 * i, ch = tid & 31; const int R = tm * 256 + hm * 128 + row, n = tn * 128 + ch * 4;
                    const floatx4 a4 = *(const floatx4*)(Cs + row * 132 + ch * 4);
                    const floatx4 g4 = *(const GAS floatx4*)(P.mods + (l * 3 + row_mod(R)) * 3072 + 2 * D + n);
                    const floatx4 x4 = *(const GAS floatx4*)(xrow(P, l, R) + n);
                    GAS float* dst = R < NCTX ? P.ctx1 + (size_t)R * D + n : P.out + (size_t)(R - NCTX) * D + n;
                    floatx4 o;
#pragma unroll
                    for (int e = 0; e < 4; ++e) o[e] = x4[e] + g4[e] * a4[e];
                    *(GAS floatx4*)dst = o;
                }
                BAR_LDS();
            }
        }
    }
}

constexpr int G8_HT = 128 * 64;
DEV int g8_lds_byte(int r, int c) { const int st = (r >> 4) * 2 + (c >> 5), rr = r & 15, cc = c & 31, ob = rr * 64 + cc * 2; return st * 1024 + (ob ^ (((ob >> 9) & 1) << 5)); }
DEV void g8_stage_rc(int b, int& R, int& C) { const int st = b / 1024, sb = b % 1024, swz = sb ^ (((sb >> 9) & 1) << 5); R = (st >> 1) * 16 + swz / 64; C = (st & 1) * 32 + (swz % 64) / 2; }
template <int MODE>
DEV void ph_gemm_8p(PRef P, int wvs, int l, int bid, int nblk, unsigned char* smraw) {
    constexpr int K = D, NPAD = MODE == 1 ? 3072 : D, LDA_ = MODE == 1 ? D : INW, PM0 = MODE == 1 ? 0 : NCTX / 256, nM = NROWS / 256 - PM0, nN = NPAD / 256, nt = K / 64;
    const GAS f16* A = MODE == 1 ? P.hx : P.p; const GAS f16* Bt = MODE == 1 ? P.wt_in + (size_t)l * NPAD * D : P.wt_out + (size_t)l * D * D;
    f16* shm = (f16*)smraw;
#define SA(b, h) (shm + ((b) * 2 + (h)) * G8_HT)
#define SB(b, h) (shm + (4 + (b) * 2 + (h)) * G8_HT)
#define STAGE_G(Pd, BASE, ld_, br, col_) do { const GAS unsigned char* sb_ = (const GAS unsigned char*)((BASE) + (long)(br) * (ld_) + (col_)); \
        _Pragma("unroll") for (int i_ = 0; i_ < 2; ++i_) { const int b_ = tid * 16 + i_ * 8192; int r_, c_; g8_stage_rc(b_, r_, c_); \
            const unsigned vo_ = (unsigned)(r_ * (ld_) + c_) * 2u; \
            __builtin_amdgcn_global_load_lds((const GAS unsigned*)(sb_ + vo_), (LAS unsigned*)((LAS char*)(Pd) + b_), 16, 0, 0); } } while (0)
#define STAGE_A(Pd, br, kt) STAGE_G(Pd, A, LDA_, br, (MODE == 1 ? (kt) * 64 : a2col((kt) * 64)))
#define STAGE_B(Pd, br, kt) STAGE_G(Pd, Bt, K, br, (kt) * 64)
#define LDA(dst, b, h) _Pragma("unroll") for (int m = 0; m < 4; ++m) _Pragma("unroll") for (int k = 0; k < 2; ++k) \
        dst[m][k] = *(const half8*)((const char*)SA(b, h) + g8_lds_byte(wr * 64 + m * 16 + fr, k * 32 + fq * 8))
#define LDB(dst, b, h) _Pragma("unroll") for (int n = 0; n < 2; ++n) _Pragma("unroll") for (int k = 0; k < 2; ++k) \
        dst[n][k] = *(const half8*)((const char*)SB(b, h) + g8_lds_byte(wc * 32 + n * 16 + fr, k * 32 + fq * 8))
#define MMA(ai, bj, At_, Bt_) do { __builtin_amdgcn_s_setprio(1); \
        _Pragma("unroll") for (int m = 0; m < 4; ++m) _Pragma("unroll") for (int n = 0; n < 2; ++n) _Pragma("unroll") for (int k = 0; k < 2; ++k) \
            acc[ai][bj][m][n] = __builtin_amdgcn_mfma_f32_16x16x32_f16(Bt_[n][k], At_[m][k], acc[ai][bj][m][n], 0, 0, 0); \
        __builtin_amdgcn_s_setprio(0); } while (0)
#define WAIT_V(n) asm volatile("s_waitcnt vmcnt(" #n ")" ::: "memory")
#define WAIT_L(n) asm volatile("s_waitcnt lgkmcnt(" #n ")" ::: "memory")
#define BARR __builtin_amdgcn_s_barrier()
#define SCHED __builtin_amdgcn_sched_barrier(0)
    constexpr int GM = 8;
    constexpr int nNf = MODE == 1 ? nN - 1 : nN, NFULL = nM * nNf, NHALF = MODE == 1 ? nM : 0;
    const int nfull_mine = (NFULL - bid + nblk - 1) / nblk;
    const int first_short = NFULL % nblk;
    int nh_mine = 0, h0 = 0, h1 = 0;
    if (MODE == 1 && nblk == 256) {
        const int ns = nblk - first_short;
        if (bid >= first_short) { h0 = bid - first_short; nh_mine = h0 < NHALF ? 1 : 0; if (ns + h0 < NHALF) { h1 = ns + h0; nh_mine = 2; } }
    } else if (MODE == 1) { for (int hh = bid; hh < NHALF; hh += nblk) { if (nh_mine == 0) h0 = hh; else h1 = hh; ++nh_mine; } }
    for (int ti = 0; ti < nfull_mine + nh_mine; ++ti) {
        const int tid = ltid(wvs), wid = tid >> 6, lane = tid & 63, wr = wid >> 2, wc = wid & 3, fr = lane & 15, fq = lane >> 4;
        const bool halfw = ti >= nfull_mine;
        int pm, pn;
        if (!halfw) {
            const int t0 = bid + ti * nblk;
            const int sg = t0 / (GM * nNf), rem = t0 % (GM * nNf), gsz = nM - sg * GM < GM ? nM - sg * GM : GM;
            pm = PM0 + sg * GM + rem % gsz; pn = rem / gsz;
        } else { pm = (ti == nfull_mine ? h0 : h1); pn = nNf; }
        const int brow = pm * 256, bcol = pn * 256;
        floatx4 acc[2][2][4][2];
#pragma unroll
        for (int a = 0; a < 2; ++a)
#pragma unroll
            for (int b = 0; b < 2; ++b)
#pragma unroll
                for (int m = 0; m < 4; ++m)
#pragma unroll
                    for (int n = 0; n < 2; ++n) acc[a][b][m][n] = (floatx4){0.f, 0.f, 0.f, 0.f};
        half8 At[4][2], B0[2][2], B1[2][2];
        asm volatile("s_waitcnt vmcnt(0) lgkmcnt(0)" ::: "memory");
        BARR;
        STAGE_B(SB(0, 0), bcol, 0); STAGE_A(SA(0, 0), brow, 0);
        STAGE_B(SB(0, 1), bcol + 128, 0); STAGE_A(SA(0, 1), brow + 128, 0);
        if (wr == 1) BARR;
        WAIT_V(4); BARR;
        STAGE_B(SB(1, 0), bcol, 1); STAGE_A(SA(1, 0), brow, 1); STAGE_B(SB(1, 1), bcol + 128, 1);
        WAIT_V(6); BARR;
        for (int t = 0; t < nt - 2; t += 2) {
            LDB(B0, 0, 0); SCHED; LDA(At, 0, 0); STAGE_A(SA(1, 1), brow + 128, t + 1);
            WAIT_L(8); BARR; WAIT_L(0); MMA(0, 0, At, B0); BARR; SCHED;
            LDB(B1, 0, 1); STAGE_B(SB(0, 0), bcol, t + 2);
            BARR; WAIT_L(0); if (!halfw) MMA(0, 1, At, B1); BARR;
            LDA(At, 0, 1); STAGE_A(SA(0, 0), brow, t + 2);
            BARR; WAIT_L(0); MMA(1, 0, At, B0); BARR; SCHED;
            STAGE_B(SB(0, 1), bcol + 128, t + 2);
            WAIT_V(6); BARR; if (!halfw) MMA(1, 1, At, B1); BARR;
            LDB(B0, 1, 0); SCHED; LDA(At, 1, 0); STAGE_A(SA(0, 1), brow + 128, t + 2);
            WAIT_L(8); BARR; WAIT_L(0); MMA(0, 0, At, B0); BARR; SCHED;
            LDB(B1, 1, 1); STAGE_B(SB(1, 0), bcol, t + 3);
            BARR; WAIT_L(0); if (!halfw) MMA(0, 1, At, B1); BARR;
            LDA(At, 1, 1); STAGE_A(SA(1, 0), brow, t + 3);
            BARR; WAIT_L(0); MMA(1, 0, At, B0); BARR; SCHED;
            STAGE_B(SB(1, 1), bcol + 128, t + 3);
            WAIT_V(6); BARR; if (!halfw) MMA(1, 1, At, B1); BARR;
        }
        { LDB(B0, 0, 0); LDA(At, 0, 0); STAGE_A(SA(1, 1), brow + 128, nt - 1);
          BARR; WAIT_L(0); MMA(0, 0, At, B0); BARR;
          LDB(B1, 0, 1); BARR; WAIT_L(0); if (!halfw) MMA(0, 1, At, B1); BARR;
          LDA(At, 0, 1); WAIT_V(4); BARR; WAIT_L(0); MMA(1, 0, At, B0); if (!halfw) MMA(1, 1, At, B1); BARR; }
        { LDB(B0, 1, 0); LDA(At, 1, 0); WAIT_V(2); BARR; WAIT_L(0); MMA(0, 0, At, B0); BARR;
          LDB(B1, 1, 1); WAIT_V(0); BARR; WAIT_L(0); if (!halfw) MMA(0, 1, At, B1); BARR;
          LDA(At, 1, 1); BARR; WAIT_L(0); MMA(1, 0, At, B0); if (!halfw) MMA(1, 1, At, B1); BARR; }
        if (wr == 0) BARR;
        if (MODE == 1) {
            f16* Cs = shm;
#pragma unroll
            for (int ai = 0; ai < 2; ++ai)
#pragma unroll
                for (int bj = 0; bj < 2; ++bj)
#pragma unroll
                    for (int m = 0; m < 4; ++m)
#pragma unroll
                        for (int n = 0; n < 2; ++n) {
                            const floatx4 v = acc[ai][bj][m][n]; half4 h; h[0] = (f16)v[0]; h[1] = (f16)v[1]; h[2] = (f16)v[2]; h[3] = (f16)v[3];
                            *(half4*)(Cs + (ai * 128 + wr * 64 + m * 16 + fr) * 264 + bj * 128 + wc * 32 + n * 16 + fq * 4) = h;
                        }
            asm volatile("s_waitcnt lgkmcnt(0)" ::: "memory"); BARR;
#pragma unroll 4
            for (int i = 0; i < 16; ++i) {
                const int row = (tid >> 5) + 16 * i, ch = tid & 31; const int n = bcol + ch * 8;
                if (n < INW) *(GAS half8*)(P.p + (size_t)(brow + row) * INW + n) = *(const half8*)(Cs + row * 264 + ch * 8);
            }
        } else {
            float* Cs = (float*)shm;
#pragma unroll
            for (int ai = 0; ai < 2; ++ai) {
                if (ai == 1) { asm volatile("s_waitcnt lgkmcnt(0)" ::: "memory"); BARR; }
#pragma unroll
                for (int bj = 0; bj < 2; ++bj)
#pragma unroll
                    for (int m = 0; m < 4; ++m)
#pragma unroll
                        for (int n = 0; n < 2; ++n) *(floatx4*)(Cs + (wr * 64 + m * 16 + fr) * 264 + bj * 128 + wc * 32 + n * 16 + fq * 4) = acc[ai][bj][m][n];
                asm volatile("s_waitcnt lgkmcnt(0)" ::: "memory"); BARR;
                const int ch = tid & 31, n = bcol + ch * 8;
                const GAS float* gp_ = P.mods + (l * 3 + row_mod(brow)) * 3072 + 2 * D + n;
                const floatx4 g4a = *(const GAS floatx4*)gp_, g4b = *(const GAS floatx4*)(gp_ + 4);
#pragma unroll 1
                for (int i0 = 0; i0 < 8; i0 += 4) {
                    floatx4 xa[4], xb[4];
#pragma unroll
                    for (int u = 0; u < 4; ++u) {
                        const int R = brow + ai * 128 + (tid >> 5) + 16 * (i0 + u);
                        if (l == 0) { const GAS float* xp_ = P.x + (size_t)(R - NCTX) * D + n; xa[u] = *(const GAS floatx4*)xp_; xb[u] = *(const GAS floatx4*)(xp_ + 4); }
                        else {
                            const half8 hv = *(const GAS half8*)((const GAS f16*)P.out + (size_t)(R - NCTX) * D + n);
#pragma unroll
                            for (int e = 0; e < 4; ++e) { xa[u][e] = (float)hv[e]; xb[u][e] = (float)hv[4 + e]; }
                        }
                    }
#pragma unroll
                    for (int u = 0; u < 4; ++u) {
                        const int row = (tid >> 5) + 16 * (i0 + u); const int R = brow + ai * 128 + row;
                        const floatx4 a4a = *(const floatx4*)(Cs + row * 264 + ch * 8), a4b = *(const floatx4*)(Cs + row * 264 + ch * 8 + 4);
                        half8 oh;
#pragma unroll
                        for (int e = 0; e < 4; ++e) { oh[e] = (f16)(xa[u][e] + g4a[e] * a4a[e]); oh[4 + e] = (f16)(xb[u][e] + g4b[e] * a4b[e]); }
                        if (l == 0) *(GAS half8*)((GAS f16*)P.out + (size_t)(R - NCTX) * D + n) = oh;
                        else *(GAS half8*)(P.hx + (size_t)R * D + n) = oh;
                    }
                }
            }
        }
    }
#undef SA
#undef SB
#undef STAGE_G
#undef STAGE_A
#undef STAGE_B
#undef LDA
#undef LDB
#undef MMA
#undef WAIT_V
#undef WAIT_L
#undef BARR
#undef SCHED
}

constexpr int RLD = 72;
constexpr int RSLOT = 64 * RLD;
constexpr int RWP1_LDS_BYTES = 11 * RSLOT * 2 + 2 * 64 * 65 * 4 + 1536 * 4 + 128 * 4 + 3968 * 4 + 2560;
constexpr size_t RWM_STRIDE = (size_t)24 * NCHUNK * 4096;

DEV bf16x8 ldfrag(const bf16* M, int rowbase, int lane, int ks) {
    return *(const bf16x8*)(M + (rowbase + (lane & 31)) * RLD + ks * 16 + (lane >> 5) * 8);
}
DEV floatx16 mm64(const bf16* A, const bf16* Bt, int wm, int wn, int lane) {
    floatx16 acc;
#pragma unroll
    for (int r = 0; r < 16; ++r) acc[r] = 0.f;
#pragma unroll
    for (int ks = 0; ks < 4; ++ks) acc = __builtin_amdgcn_mfma_f32_32x32x16_bf16(ldfrag(A, wm * 32, lane, ks), ldfrag(Bt, wn * 32, lane, ks), acc, 0, 0, 0);
    return acc;
}
DEV void storeT(bf16* dst, const floatx16 c, int wm, int wn, int lane) {
    const int n = wn * 32 + (lane & 31);
#pragma unroll
    for (int g = 0; g < 4; ++g) {
        const int m0 = wm * 32 + 8 * g + 4 * (lane >> 5);
        bf16x4 v; v[0] = (bf16)c[4 * g]; v[1] = (bf16)c[4 * g + 1]; v[2] = (bf16)c[4 * g + 2]; v[3] = (bf16)c[4 * g + 3];
        *(bf16x4*)(dst + n * RLD + m0) = v;
    }
}

DEV void p1_decode(int u, int& chain, int& ck) {
    const int pair = (u >> 4) * 8 + (u & 7), z = (u >> 3) & 1;
    const int bh = pair / NCHUNK, ck0 = pair % NCHUNK;
    chain = z * 12 + bh; ck = z ? mirror_chunk(ck0) : ck0;
}
static_assert((24 * NCHUNK) % 16 == 0, "pass-1 pairing");
DEV void ph_rw_p1(PRef P, int wvs, int l, int bid, int nblk, unsigned char* smraw, bool dry = false) {
    bf16* sl = (bf16*)smraw;
    bf16 *Am = sl, *AmT = sl + RSLOT, *Bp = sl + 2 * RSLOT, *Kp = sl + 3 * RSLOT, *Rt = sl + 4 * RSLOT, *VT = sl + 5 * RSLOT,
         *BendT = sl + 6 * RSLOT, *KendT = sl + 7 * RSLOT, *Nak = sl + 8 * RSLOT, *Mrb = sl + 9 * RSLOT, *Mrk = sl + 10 * RSLOT;
    bf16 *UtT = Am, *WmT = Bp, *NVT = Kp;
    float* Nf = (float*)(smraw + 11 * RSLOT * 2); float* Tf = Nf + 64 * 65; float* Wb = Tf + 64 * 65; float* gl = Wb + 1536;
    bf16* Noff = (bf16*)Nf; float* Nfull = Nf + 2304;
    bf16* Td = (bf16*)(Nf + 2304 + 4352); bf16* Zs = (bf16*)Wb;
    float* av = Nf; float* lwb = Tf;
    f16* Sr = (f16*)Nak; f16* Sk = (f16*)Mrb; f16* Sv = (f16*)Mrk; bf16* lt = KendT;
    float* part = Wb;
    GAS f16* PTg = P.rwm; GAS f16* RPg = PTg + RWM_STRIDE; GAS f16* Qg = RPg + RWM_STRIDE;
    float* prm = gl + 128; f16* mu16 = (f16*)(prm + 3968);
    {
        const int tid0 = ltid(wvs);
        __syncthreads();
        for (int i = tid0; i < 1280; i += NT) mu16[i] = (f16)P.rw_mu[l * 1280 + i];
        for (int i = tid0; i < 768; i += NT) { prm[1280 + i] = P.rw_w0[l * 768 + i]; prm[2048 + i] = P.rw_a0[l * 768 + i]; }
        for (int i = tid0; i < 384; i += NT) { prm[2816 + i] = P.rw_k_k[l * 384 + i]; prm[3200 + i] = P.rw_k_a[l * 384 + i]; prm[3584 + i] = P.rw_r_k[l * 384 + i]; }
        __syncthreads();
    }
    half8 rown[4], rn0[4], rn1[4], rn2[4], rn3[4]; bf16x8 tabf[2];
    int ri_R, ri_o0, ri_o1, ri_o2, ri_o3, ri_z, ri_h, ri_c8;
#define P1_ROWINFO(item_) { const int tid_ = ltid(wvs); const int t_ = (tid_ >> 3) & 63; ri_c8 = tid_ & 7; \
        int chain_, ck_; p1_decode(item_, chain_, ck_); ri_z = chain_ / 12; ri_h = chain_ % 6; const int b_ = (chain_ / 6) % 2; \
        ri_R = scan_row(ri_z, b_, ck_ * 64 + t_); \
        if (ri_R < NCTX) { const int tt_ = ri_R % CTX; ri_o0 = tt_ > 0 ? -INW : 0; ri_o1 = tt_ < CTX - 1 ? INW : 0; ri_o2 = ri_o0; ri_o3 = ri_o1; }     \
        else { const int tt_ = (ri_R - NCTX) % SEQ, col_ = tt_ & 63; ri_o0 = col_ > 0 ? -INW : 0; ri_o1 = col_ < 63 ? INW : 0; ri_o2 = tt_ >= 64 ? -64 * INW : 0; ri_o3 = tt_ < SEQ - 64 ? 64 * INW : 0; } }
#define P1_ISSUE(i_, item_) { \
        const int col0_ = (i_) < 3 ? (i_) * 384 + ri_h * 64 + ri_c8 * 8 : (ri_c8 < 4 ? 1152 + ri_z * 32 + ri_c8 * 8 : 1216 + ri_z * 32 + (ri_c8 - 4) * 8); \
        const GAS f16* pr_ = P.p + (size_t)ri_R * INW + col0_; \
        rown[i_] = *(const GAS half8*)pr_; rn0[i_] = *(const GAS half8*)(pr_ + ri_o0); rn1[i_] = *(const GAS half8*)(pr_ + ri_o1); \
        rn2[i_] = *(const GAS half8*)(pr_ + ri_o2); rn3[i_] = *(const GAS half8*)(pr_ + ri_o3); }
#define P1_ISSUE_TAB(item_) { const int tid_ = ltid(wvs); const int lane_ = tid_ & 63, wv_ = tid_ >> 6; \
        int chain_, ckx_; p1_decode(item_, chain_, ckx_); const int z_ = chain_ / 12, h_ = chain_ % 6; \
        const GAS bf16* tab_ = P.rwlt + ((size_t)((l * 2 + z_) * 2 + (wv_ >> 2)) * 384 + h_ * 64 + ((wv_ & 3) >> 1) * 32 + (lane_ & 31)) * 32 + (lane_ >> 5) * 8; \
        tabf[0] = *(const GAS bf16x8*)tab_; tabf[1] = *(const GAS bf16x8*)(tab_ + 16); }
    if (bid < 24 * NCHUNK) { P1_ROWINFO(bid); P1_ISSUE(0, bid); P1_ISSUE(1, bid); P1_ISSUE(2, bid); P1_ISSUE(3, bid); P1_ISSUE_TAB(bid); }
    for (int item = bid; item < 24 * NCHUNK; item += nblk) {
        const int tid = ltid(wvs), lane = tid & 63, wv = tid >> 6, q4 = wv & 3, wm = q4 & 1, wn = q4 >> 1, hs = wv >> 2;
        int chain, ck; p1_decode(item, chain, ck);
        const int z = chain / 12, b = (chain / 6) % 2, h = chain % 6, s0 = ck * 64;
        const int j = lane, tq = wv, c = h * 64 + j;
        const int nitem = item + nblk;
        const bf16x8 tab0 = tabf[0], tab1 = tabf[1];
        const int pit = nitem < 24 * NCHUNK ? nitem : item;
        if (!(dry && P_VARIANT == 1)) {
        P1_ROWINFO(pit);
        half8 nmask;
        {
            const int R = scan_row(z, b, s0 + ((tid >> 3) & 63));
            bool v0, v1, v2, v3;
            if (R < NCTX) { const int tt = R % CTX; v0 = tt > 0; v1 = tt < CTX - 1; v2 = v0; v3 = v1; }
            else { const int tt = (R - NCTX) % SEQ, cl = tt & 63; v0 = cl > 0; v1 = cl < 63; v2 = tt >= 64; v3 = tt < SEQ - 64; }
#pragma unroll
            for (int e = 0; e < 8; ++e) nmask[e] = (f16)(((e & 3) == 0 ? v0 : (e & 3) == 1 ? v1 : (e & 3) == 2 ? v2 : v3) ? 1.f : 0.f);
        }
#pragma unroll
        for (int i = 0; i < 4; ++i) {
            const int c8 = tid & 7, t = (tid >> 3) & 63, q = i;
            const int col0 = q < 3 ? q * 384 + h * 64 + c8 * 8 : (c8 < 4 ? 1152 + z * 32 + c8 * 8 : 1216 + z * 32 + (c8 - 4) * 8);
            const half8 own = rown[i];
            half8 nsel;
#pragma unroll
            for (int e = 0; e < 8; ++e) nsel[e] = (e & 3) == 0 ? rn0[i][e] : (e & 3) == 1 ? rn1[i][e] : (e & 3) == 2 ? rn2[i][e] : rn3[i][e];
            nsel = nsel * nmask;
            const half8 mu8 = *(const half8*)(mu16 + col0);
            const half8 sv = own + (nsel - own) * mu8;
            P1_ISSUE(i, pit);
            if (q < 3) {
                *(half8*)((q == 0 ? Sr : q == 1 ? Sk : Sv) + t * RLD + c8 * 8) = sv;
            } else {
                bf16x8 o;
#pragma unroll
                for (int e = 0; e < 8; ++e) o[e] = (bf16)(c8 < 4 ? ftanh((float)sv[e]) : (float)sv[e]);
                *(bf16x8*)(lt + t * RLD + c8 * 8) = o;
            }
        }
        }
        P1_ISSUE_TAB(pit);
        BAR_LDS();
        if (!(dry && P_VARIANT == 2)) {
        {
            floatx16 aw;
#pragma unroll
            for (int r = 0; r < 16; ++r) aw[r] = 0.f;
            aw = __builtin_amdgcn_mfma_f32_32x32x16_bf16(ldfrag(lt + hs * 32, wm * 32, lane, 0), tab0, aw, 0, 0, 0);
            aw = __builtin_amdgcn_mfma_f32_32x32x16_bf16(ldfrag(lt + hs * 32, wm * 32, lane, 1), tab1, aw, 0, 0, 0);
            const int cc = h * 64 + wn * 32 + (lane & 31);
            const float bias = hs ? prm[2048 + z * 384 + cc] : prm[1280 + z * 384 + cc];
#pragma unroll
            for (int r = 0; r < 16; ++r) {
                const int m = wm * 32 + (r & 3) + 8 * (r >> 2) + 4 * (lane >> 5), n = wn * 32 + (lane & 31);
                const float sg = fsigmoid(aw[r] + bias);
                if (hs) av[m * 65 + n] = sg; else lwb[m * 65 + n] = -0.6065306597126334f * sg;
            }
        }
        }
        BAR_LDS();
        float gpre = 0.f, gtot = 0.f;
        if (!(dry && P_VARIANT == 3)) {
        {
            float run = 0.f, gv[8];
#pragma unroll
            for (int tt = 0; tt < 8; ++tt) { run += lwb[(tq * 8 + tt) * 65 + j]; gv[tt] = run; }
            part[tq * 64 + j] = run;
            const int t = lane, q8 = wv;
            float ss = 0.f, bn = 0.f;
#pragma unroll
            for (int e = 0; e < 8; ++e) {
                const int jj = q8 * 8 + e, c2 = h * 64 + jj;
                const float k_ = (float)Sk[t * RLD + jj], r_ = (float)Sr[t * RLD + jj], a = av[t * 65 + jj];
                const float kku = k_ * prm[2816 + c2];
                ss += kku * kku; bn += r_ * k_ * (1.f + (a - 1.f) * prm[3200 + c2]) * prm[3584 + c2];
            }
            part[512 + q8 * 64 + t] = ss; part[1024 + q8 * 64 + t] = bn;
            BAR_LDS();
            gpre = 0.f; gtot = 0.f;
#pragma unroll
            for (int q = 0; q < 8; ++q) { const float x = part[q * 64 + j]; gtot += x; if (q < tq) gpre += x; }
#pragma unroll
            for (int tt = 0; tt < 8; ++tt) lwb[(tq * 8 + tt) * 65 + j] = gv[tt] + gpre;
            if (tq == 0) {
                gl[j] = __expf(gtot);
                float sst = 0.f, bnt = 0.f;
#pragma unroll
                for (int q = 0; q < 8; ++q) { sst += part[512 + q * 64 + lane]; bnt += part[1024 + q * 64 + lane]; }
                gl[64 + lane] = __builtin_amdgcn_rsqf(sst + 1e-6f);
                if (!dry) P.bon[((size_t)z * NROWS + scan_row(z, b, s0 + lane)) * 6 + h] = bnt;
            }
        }
        BAR_LDS();
        {
            const float kkc = prm[2816 + c], kac = prm[3200 + c];
            const float Gt = __expf(gtot);
            float e_prev = __expf(gpre);
            bf16x8 amT, vT, beT, keT;
#pragma unroll
            for (int tt = 0; tt < 8; ++tt) {
                const int t = tq * 8 + tt;
                const float r_ = (float)Sr[t * RLD + j], k_ = (float)Sk[t * RLD + j], v_ = (float)Sv[t * RLD + j];
                const float a = av[t * 65 + j], g = lwb[t * 65 + j], sinv = gl[64 + t];
                const float e_t = __expf(g), e_p = frcp(e_t), e_m = e_prev, e_e = Gt * e_p;
                e_prev = e_t;
                const float kkn = k_ * kkc * sinv, kd = k_ * (1.f + (a - 1.f) * kac), bb = a * kkn;
                const bf16 am = (bf16)(kkn * e_m);
                Am[t * RLD + j] = am; Bp[t * RLD + j] = (bf16)(bb * e_p); Kp[t * RLD + j] = (bf16)(kd * e_p); Rt[t * RLD + j] = (bf16)(r_ * e_t);
                amT[tt] = am; vT[tt] = (bf16)v_; beT[tt] = (bf16)(bb * e_e); keT[tt] = (bf16)(kd * e_e);
            }
            const int to = j * RLD + tq * 8;
            *(bf16x8*)(AmT + to) = amT; *(bf16x8*)(VT + to) = vT; *(bf16x8*)(BendT + to) = beT; *(bf16x8*)(KendT + to) = keT;
        }
        BAR_LDS();
        }
        if (!(dry && P_VARIANT == 4)) {
        {
            floatx16 c1, c2;
#pragma unroll
            for (int r = 0; r < 16; ++r) { c1[r] = 0.f; c2[r] = 0.f; }
            if (!(wm == 0 && wn == 1)) {
                const bf16* Aop = hs ? Rt : Am;
#pragma unroll
                for (int ks = 0; ks < 4; ++ks) {
                    const bf16x8 a1 = ldfrag(Aop, wm * 32, lane, ks), b1 = ldfrag(Bp, wn * 32, lane, ks), b2 = ldfrag(Kp, wn * 32, lane, ks);
                    c1 = __builtin_amdgcn_mfma_f32_32x32x16_bf16(b1, a1, c1, 0, 0, 0);
                    c2 = __builtin_amdgcn_mfma_f32_32x32x16_bf16(b2, a1, c2, 0, 0, 0);
                }
            }
            const int m = wm * 32 + (lane & 31);
            if (hs == 0) {
#pragma unroll
                for (int g = 0; g < 4; ++g) {
                    const int n0 = wn * 32 + 8 * g + 4 * (lane >> 5);
                    floatx4 nf; bf16x4 no, nk;
#pragma unroll
                    for (int e = 0; e < 4; ++e) {
                        const bool lo = n0 + e < m;
                        nf[e] = lo ? c1[4 * g + e] : 0.f;
                        no[e] = (bf16)((((n0 + e) >> 4) != (m >> 4)) ? nf[e] : 0.f);
                        nk[e] = (bf16)(lo ? c2[4 * g + e] : 0.f);
                    }
                    *(bf16x4*)(Noff + m * RLD + n0) = no; *(floatx4*)(Nfull + m * 68 + n0) = nf; *(bf16x4*)(Nak + m * RLD + n0) = nk;
                }
            } else {
#pragma unroll
                for (int g = 0; g < 4; ++g) {
                    const int n0 = wn * 32 + 8 * g + 4 * (lane >> 5);
                    bf16x4 mb, mk;
#pragma unroll
                    for (int e = 0; e < 4; ++e) { const bool le = n0 + e <= m; mb[e] = (bf16)(le ? c1[4 * g + e] : 0.f); mk[e] = (bf16)(le ? c2[4 * g + e] : 0.f); }
                    *(bf16x4*)(Mrb + m * RLD + n0) = mb; *(bf16x4*)(Mrk + m * RLD + n0) = mk;
                }
            }
        }
        }
        BAR_LDS();
        if (!(dry && P_VARIANT == 5)) {
        if (tid < 64) {
            const int i = tid >> 4, jc = tid & 15; float x[16];
#pragma unroll
            for (int row = 0; row < 16; ++row) {
                float s = row == jc ? 1.f : 0.f;
#pragma unroll
                for (int m = 0; m < row; ++m) s -= Nfull[(16 * i + row) * 68 + 16 * i + m] * x[m];
                x[row] = s;
                if ((row & 3) == 3) __builtin_amdgcn_sched_barrier(0);
            }
#pragma unroll
            for (int row = 0; row < 16; ++row) { Td[(i * 16 + row) * 32 + jc] = (bf16)x[row]; Td[(i * 16 + row) * 32 + 16 + jc] = (bf16)0.f; }
        }
        if (hs == 1) { const floatx16 c2 = mm64(Nak, VT, wm, wn, lane); storeT(NVT, c2, wm, wn, lane); }
        BAR_LDS();
        }
        if (!(dry && P_VARIANT == 6)) {
        {
            bf16* XT = hs ? UtT : WmT;
            const bf16* RT = hs ? NVT : AmT;
            bf16* ZT = Zs + wv * 256;
            const int cn = 16 * q4 + (lane & 15);
            {
                bf16x8 zz;
#pragma unroll
                for (int e = 0; e < 8; ++e) zz[e] = (bf16)0.f;
                *(bf16x8*)(XT + (16 * q4 + (lane >> 2)) * RLD + (lane & 3) * 16) = zz; *(bf16x8*)(XT + (16 * q4 + (lane >> 2)) * RLD + (lane & 3) * 16 + 8) = zz;
            }
#pragma unroll 1
            for (int i = 0; i < 4; ++i) {
                floatx4 acc = {0.f, 0.f, 0.f, 0.f};
                if (i > 0) {
#pragma unroll
                    for (int ks = 0; ks < 2; ++ks) {
                        if (ks * 32 < 16 * i) {
                            const bf16x8 a = *(const bf16x8*)(Noff + (16 * i + (lane & 15)) * RLD + 32 * ks + 8 * (lane >> 4));
                            const bf16x8 bq = *(const bf16x8*)(XT + cn * RLD + 32 * ks + 8 * (lane >> 4));
                            acc = __builtin_amdgcn_mfma_f32_16x16x32_bf16(a, bq, acc, 0, 0, 0);
                        }
                    }
                }
                {
                    const bf16x4 rh = *(const bf16x4*)(RT + cn * RLD + 16 * i + 4 * (lane >> 4));
                    bf16x4 zv; zv[0] = (bf16)((float)rh[0] - acc[0]); zv[1] = (bf16)((float)rh[1] - acc[1]); zv[2] = (bf16)((float)rh[2] - acc[2]); zv[3] = (bf16)((float)rh[3] - acc[3]);
                    *(bf16x4*)(ZT + (lane & 15) * 16 + 4 * (lane >> 4)) = zv;
                }
                {
                    const bf16x8 a = *(const bf16x8*)(Td + (i * 16 + (lane & 15)) * 32 + 8 * (lane >> 4));
                    bf16x8 bz;
#pragma unroll
                    for (int e = 0; e < 8; ++e) bz[e] = (bf16)0.f;
                    if ((lane >> 4) < 2) bz = *(const bf16x8*)(ZT + (lane & 15) * 16 + 8 * (lane >> 4));
                    floatx4 xo = {0.f, 0.f, 0.f, 0.f};
                    xo = __builtin_amdgcn_mfma_f32_16x16x32_bf16(a, bz, xo, 0, 0, 0);
                    bf16x4 xv; xv[0] = (bf16)xo[0]; xv[1] = (bf16)xo[1]; xv[2] = (bf16)xo[2]; xv[3] = (bf16)xo[3];
                    *(bf16x4*)(XT + cn * RLD + 16 * i + 4 * (lane >> 4)) = xv;
                }
            }
        }
        BAR_LDS();
        }
        if (!(dry && P_VARIANT == 7)) {
        {
            f16* T0 = (f16*)AmT; f16* T1 = (f16*)Kp; f16* T2 = (f16*)Nak; f16* T3 = (f16*)Nf;
            const int n = wn * 32 + (lane & 31);
            if (hs == 0) {
                {
                    const floatx16 c1 = mm64(WmT, Mrb, wm, wn, lane);
#pragma unroll
                    for (int g = 0; g < 4; ++g) {
                        const int m0 = wm * 32 + 8 * g + 4 * (lane >> 5);
                        const bf16x4 rt = *(const bf16x4*)(Rt + n * RLD + m0);
                        half4 v; v[0] = (f16)((float)rt[0] - c1[4 * g]); v[1] = (f16)((float)rt[1] - c1[4 * g + 1]); v[2] = (f16)((float)rt[2] - c1[4 * g + 2]); v[3] = (f16)((float)rt[3] - c1[4 * g + 3]);
                        *(half4*)(T0 + n * RLD + m0) = v;
                    }
                }
                __builtin_amdgcn_sched_barrier(0);
                {
                    const floatx16 c2 = mm64(VT, Mrk, wm, wn, lane); __builtin_amdgcn_sched_barrier(0); const floatx16 c3 = mm64(UtT, Mrb, wm, wn, lane);
#pragma unroll
                    for (int g = 0; g < 4; ++g) {
                        const int m0 = wm * 32 + 8 * g + 4 * (lane >> 5);
                        half4 v; v[0] = (f16)(c2[4 * g] - c3[4 * g]); v[1] = (f16)(c2[4 * g + 1] - c3[4 * g + 1]); v[2] = (f16)(c2[4 * g + 2] - c3[4 * g + 2]); v[3] = (f16)(c2[4 * g + 3] - c3[4 * g + 3]);
                        *(half4*)(T1 + n * RLD + m0) = v;
                    }
                }
            } else {
                {
                    const floatx16 c4 = mm64(WmT, BendT, wm, wn, lane);
                    const float gd = gl[n];
#pragma unroll
                    for (int g = 0; g < 4; ++g) {
                        const int m0 = wm * 32 + 8 * g + 4 * (lane >> 5);
                        half4 v;
#pragma unroll
                        for (int e = 0; e < 4; ++e) v[e] = (f16)((m0 + e == n ? gd : 0.f) - c4[4 * g + e]);
                        *(half4*)(T2 + n * RLD + m0) = v;
                    }
                }
                __builtin_amdgcn_sched_barrier(0);
                {
                    const floatx16 c5 = mm64(KendT, VT, wm, wn, lane); __builtin_amdgcn_sched_barrier(0); const floatx16 c6 = mm64(BendT, UtT, wm, wn, lane);
#pragma unroll
                    for (int g = 0; g < 4; ++g) {
                        const int m0 = wm * 32 + 8 * g + 4 * (lane >> 5);
                        half4 v; v[0] = (f16)(c5[4 * g] - c6[4 * g]); v[1] = (f16)(c5[4 * g + 1] - c6[4 * g + 1]); v[2] = (f16)(c5[4 * g + 2] - c6[4 * g + 2]); v[3] = (f16)(c5[4 * g + 3] - c6[4 * g + 3]);
                        *(half4*)(T3 + n * RLD + m0) = v;
                    }
                }
            }
            BAR_LDS();
            {
                const size_t gb = (size_t)(chain * NCHUNK + ck) * 4096;
                const int row = tid >> 3, ch = tid & 7;
                const int frow = (tid >> 7) * 16 + (tid & 15), fch = ((tid >> 6) & 1) * 4 + ((tid >> 4) & 3);
                const half8 v0 = *(const half8*)(T0 + frow * RLD + fch * 8), v1 = *(const half8*)(T1 + row * RLD + ch * 8);
                const half8 v2 = *(const half8*)(T2 + frow * RLD + fch * 8);
                half8 v3;
                {
                    const int u = 2 * tid, ln = u & 63, qv_ = (u >> 8) * 16 + (ln & 15), qk_ = 16 * ((u >> 6) & 3) + 4 * (ln >> 4);
                    const half4 q0 = *(const half4*)(T3 + qv_ * RLD + qk_), q1 = *(const half4*)(T3 + (qv_ + 1) * RLD + qk_);
                    v3[0] = q0[0]; v3[1] = q0[1]; v3[2] = q0[2]; v3[3] = q0[3]; v3[4] = q1[0]; v3[5] = q1[1]; v3[6] = q1[2]; v3[7] = q1[3];
                }
                if (!dry) {
                *(GAS half8*)(RPg + gb + tid * 8) = v0;
                *(GAS half8*)(P.Yh + ((size_t)z * NROWS + scan_row(z, b, s0 + row)) * 384 + h * 64 + ch * 8) = v1;
                *(GAS half8*)(PTg + gb + tid * 8) = v2;
                *(GAS half8*)(Qg + gb + tid * 8) = v3;
                }
            }
        }
        }
        BAR_LDS();
    }
}

template <bool DRY>
DEV void ph_rw_stream(PRef P, int wvs, int l, int bid, int nblk, unsigned char* smraw) {
    const int tid = ltid(wvs), lane = tid & 63, w4 = wvs & 3;
    const int role = wvs >> 2;
    f16* S16 = (f16*)smraw;
    f16* Y16 = S16 + 2 * 16 * 72;
    const GAS f16* PTg = P.rwm; const GAS f16* RPg = PTg + RWM_STRIDE; const GAS f16* Qg = RPg + RWM_STRIDE;
    static_assert(NCHUNK % 8 == 4, "stream loop: full groups of 8 steps plus a tail of 4");
    for (int item = bid; item < 96; item += nblk) {
        const int chain = (item & 7) * 3 + (item >> 5), vs = (item >> 3) & 3;
        const int z = chain / 12, b = (chain / 6) % 2, h = chain % 6;
        __syncthreads();
        for (int idx = tid; idx < 2 * 16 * 72; idx += NT) S16[idx] = (f16)0.f;
        __syncthreads();
        if (role == 0) {
            const size_t cb = (size_t)chain * NCHUNK * 4096;
            const int kof = 8 * (lane >> 4), fragA = (w4 * 128 + lane) * 8;
            const int qoff = ((vs * 4 + w4) * 64 + lane) * 4;
            const int trow = 16 * w4 + (lane >> 4) * 4;
            half8 a0[8], a1[8], r0[8], r1[8]; half4 qv[8];
#define RW_LOAD(slot_, ck_) { const size_t gb_ = cb + (size_t)(ck_) * 4096; \
            a0[slot_] = *(const GAS half8*)(PTg + gb_ + fragA); a1[slot_] = *(const GAS half8*)(PTg + gb_ + fragA + 512); \
            r0[slot_] = *(const GAS half8*)(RPg + gb_ + fragA); r1[slot_] = *(const GAS half8*)(RPg + gb_ + fragA + 512); \
            qv[slot_] = *(const GAS half4*)(Qg + gb_ + qoff); }
#define RW_STEP(slot_, ck_) { const f16* Sc_ = S16 + ((ck_) & 1) * 16 * 72; f16* Sn_ = S16 + (((ck_) + 1) & 1) * 16 * 72; f16* Yn_ = Y16 + ((ck_) & 1) * 64 * 20; \
            const half8 b0_ = *(const half8*)(Sc_ + (lane & 15) * 72 + kof); const half8 b1_ = *(const half8*)(Sc_ + (lane & 15) * 72 + 32 + kof); \
            floatx4 acc_; acc_[0] = (float)qv[slot_][0]; acc_[1] = (float)qv[slot_][1]; acc_[2] = (float)qv[slot_][2]; acc_[3] = (float)qv[slot_][3]; \
            floatx4 acy_ = {0.f, 0.f, 0.f, 0.f}; \
            acc_ = __builtin_amdgcn_mfma_f32_16x16x32_f16(a0[slot_], b0_, acc_, 0, 0, 0); acy_ = __builtin_amdgcn_mfma_f32_16x16x32_f16(b0_, r0[slot_], acy_, 0, 0, 0); \
            acc_ = __builtin_amdgcn_mfma_f32_16x16x32_f16(a1[slot_], b1_, acc_, 0, 0, 0); acy_ = __builtin_amdgcn_mfma_f32_16x16x32_f16(b1_, r1[slot_], acy_, 0, 0, 0); \
            half4 sn_; sn_[0] = (f16)acc_[0]; sn_[1] = (f16)acc_[1]; sn_[2] = (f16)acc_[2]; sn_[3] = (f16)acc_[3]; \
            *(half4*)(Sn_ + (lane & 15) * 72 + trow) = sn_; \
            half4 yn_; yn_[0] = (f16)acy_[0]; yn_[1] = (f16)acy_[1]; yn_[2] = (f16)acy_[2]; yn_[3] = (f16)acy_[3];     \
            *(half4*)(Yn_ + (16 * w4 + (lane & 15)) * 20 + 4 * (lane >> 4)) = yn_; \
            BAR_LDS(); }
            RW_LOAD(0, 0); RW_LOAD(1, 1); RW_LOAD(2, 2); RW_LOAD(3, 3); RW_LOAD(4, 4); RW_LOAD(5, 5); RW_LOAD(6, 6);
#pragma unroll 1
            for (int ck = 0; ck < NCHUNK - 4; ck += 8) {
                RW_LOAD(7, ck + 7); RW_STEP(0, ck);
                RW_LOAD(0, ck + 8); RW_STEP(1, ck + 1);
                RW_LOAD(1, ck + 9); RW_STEP(2, ck + 2);
                RW_LOAD(2, ck + 10); RW_STEP(3, ck + 3);
                RW_LOAD(3, ck + 11); RW_STEP(4, ck + 4);
                RW_LOAD(4, ck + 12 < NCHUNK ? ck + 12 : NCHUNK - 1); RW_STEP(5, ck + 5);
                RW_LOAD(5, ck + 13 < NCHUNK ? ck + 13 : NCHUNK - 1); RW_STEP(6, ck + 6);
                RW_LOAD(6, ck + 14 < NCHUNK ? ck + 14 : NCHUNK - 1); RW_STEP(7, ck + 7);
            }
            RW_STEP(0, NCHUNK - 4); RW_STEP(1, NCHUNK - 3); RW_STEP(2, NCHUNK - 2); RW_STEP(3, NCHUNK - 1);
#undef RW_LOAD
#undef RW_STEP
        } else {
            GAS f16* ycol = P.Yh + (size_t)2 * NROWS * 384 + ((size_t)(chain * 4 + vs) * TSCAN + 16 * w4 + (lane & 15)) * 16 + 4 * (lane >> 4);
#pragma unroll 1
            for (int ck = 0; ck < NCHUNK; ++ck) {
                BAR_LDS();
                const half4 yv = *(const half4*)(Y16 + (ck & 1) * 64 * 20 + (16 * w4 + (lane & 15)) * 20 + 4 * (lane >> 4));
                *(GAS half4*)(ycol + (size_t)ck * 64 * 16) = yv;
            }
        }
    }
}
template <int CTRL> DEV float dpp_add(float v) { return v + dpp_f<CTRL>(v); }
DEV float row8_sum(float v) {
    v = dpp_add<0xB1>(v);
    v = dpp_add<0x4E>(v);
    v = dpp_add<0x141>(v);
    return v;
}
DEV void ph_rwkv_fin2(PRef P, int wvs, int l, int bid, int nblk, bool dry = false) {
    const int tid_ = ltid(wvs); const int lane = tid_ & 63, wv = tid_ >> 6;
    floatx4 mu_[2][2], lg_[2][2], lb_[2][2]; int rsel[2], hh[2]; bool act[2];
#pragma unroll
    for (int ps = 0; ps < 2; ++ps) {
        const int slot = ps * 64 + lane; act[ps] = slot < 96; const int sl = act[ps] ? slot : slot - 32;
        rsel[ps] = sl >= 48 ? 1 : 0; hh[ps] = (sl - 48 * rsel[ps]) >> 3;
        const int cc = hh[ps] * 64 + (lane & 7) * 8;
#pragma unroll
        for (int q = 0; q < 2; ++q) {
            mu_[ps][q] = *(const GAS floatx4*)(P.rw_mu + l * 1280 + 768 + cc + 4 * q); lg_[ps][q] = *(const GAS floatx4*)(P.rw_ln_g + l * 384 + cc + 4 * q); lb_[ps][q] = *(const GAS floatx4*)(P.rw_ln_b + l * 384 + cc + 4 * q);
        }
    }
    for (int Rp = (l == 1 ? NCTX : 0) + ((nblk - 1 - bid) * NW + wv) * 2; Rp < NROWS; Rp += nblk * NW * 2) {
        half8 y0[2], y1[2], y2[2], y3[2], gt[2], vo[2], nq[2][4]; float bo[2]; bool nvd[2][4];
#pragma unroll
        for (int ps = 0; ps < 2; ++ps) {
            const int R = Rp + rsel[ps], h = hh[ps], c = h * 64 + (lane & 7) * 8;
            y0[ps] = *(const GAS half8*)(P.Yh + (size_t)R * 384 + c); y1[ps] = *(const GAS half8*)(P.Yh + ((size_t)NROWS + R) * 384 + c);
            {
                int bb, s0_, s1_;
                if (R < NCTX) { bb = R / CTX; const int t = R % CTX; s0_ = t; s1_ = CTX - 1 - t; }
                else { bb = (R - NCTX) / SEQ; const int u = (R - NCTX) % SEQ; s0_ = CTX + u; s1_ = CTX + SEQ - 1 - u; }
                const int vsl = (lane & 7) >> 1, vo8 = (lane & 1) * 8;
                const GAS f16* y2b = P.Yh + (size_t)2 * NROWS * 384;
                y2[ps] = *(const GAS half8*)(y2b + ((size_t)((bb * 6 + h) * 4 + vsl) * TSCAN + s0_) * 16 + vo8);
                y3[ps] = *(const GAS half8*)(y2b + ((size_t)((12 + bb * 6 + h) * 4 + vsl) * TSCAN + s1_) * 16 + vo8);
            }
            gt[ps] = *(const GAS half8*)(P.p + (size_t)R * INW + 1280 + c);
            vo[ps] = *(const GAS half8*)(P.p + (size_t)R * INW + 768 + c);
#pragma unroll
            for (int m = 0; m < 4; ++m) {
                const int nb = nbr_row(R, 768 + c + m); nvd[ps][m] = nb >= 0;
                nq[ps][m] = *(const GAS half8*)(P.p + (size_t)(nb >= 0 ? nb : R) * INW + 768 + c);
            }
            bo[ps] = P.bon[(size_t)R * 6 + h] + P.bon[((size_t)NROWS + R) * 6 + h];
        }
#pragma unroll
        for (int ps = 0; ps < 2; ++ps) {
            const int R = Rp + rsel[ps], h = hh[ps], c = h * 64 + (lane & 7) * 8;
            float y[8], s = 0.f;
#pragma unroll
            for (int e = 0; e < 8; ++e) { y[e] = ((float)y0[ps][e] + (float)y1[ps][e]) + ((float)y2[ps][e] + (float)y3[ps][e]); s += y[e]; }
            const float mu = row8_sum(s) * (1.f / 64.f); float q = 0.f;
#pragma unroll
            for (int e = 0; e < 8; ++e) { y[e] -= mu; q += y[e] * y[e]; }
            const float rs = __builtin_amdgcn_rsqf(row8_sum(q) * (1.f / 64.f) + 64e-5f);
            half8 o;
#pragma unroll
            for (int e = 0; e < 8; ++e) {
                const float pv = (float)vo[ps][e], nv = nvd[ps][e & 3] ? (float)nq[ps][e & 3][e] : 0.f, vs = pv + (nv - pv) * mu_[ps][e >> 2][e & 3];
                o[e] = (f16)((y[e] * rs * lg_[ps][e >> 2][e & 3] + lb_[ps][e >> 2][e & 3] + bo[ps] * vs) * fsilu((float)gt[ps][e]));
            }
            if (act[ps]) { if (!dry) *(GAS half8*)(P.p + (size_t)R * INW + 1280 + c) = o; else *(GAS half8*)(P.rwm + (size_t)R * 384 + c) = o; }
        }
    }
}
constexpr int HLD = 136;
constexpr int S5_LDS_BYTES = NW * 128 * 72 * 2;
struct S5Ops { half8 au0, au1, bb0, bb1, bb2, bb3; float hre, him; half8 u8; floatx4 d0, d1; float abr, abi; };
DEV void s5_load(PRef P, int l, int z, int b, int g, int tc, int lane, S5Ops& o) {
    const int lzg = (l * 2 + z) * 16 + g;
    o.au0 = *(const GAS half8*)(P.p + (size_t)scan_row(0, b, tc * 64 + (lane & 31)) * INW + 1664 + g * 16 + (lane >> 5) * 8);
    o.au1 = *(const GAS half8*)(P.p + (size_t)scan_row(0, b, tc * 64 + 32 + (lane & 31)) * INW + 1664 + g * 16 + (lane >> 5) * 8);
    const GAS f16* bbp = P.s5bb + ((size_t)lzg * 128 + (lane & 31)) * 16 + (lane >> 5) * 8;
    o.bb0 = *(const GAS half8*)bbp; o.bb1 = *(const GAS half8*)(bbp + 32 * 16); o.bb2 = *(const GAS half8*)(bbp + 64 * 16); o.bb3 = *(const GAS half8*)(bbp + 96 * 16);
    const GAS float* tb = P.s5par + (size_t)lzg * S5PW * 64 + lane;
    o.abr = tb[0]; o.abi = tb[64];
}
DEV void s5_wave_scan(PRef P, int l, int z, int g, const S5Ops& o, float& hre, float& him, f16* hb, int lane, bool store) {
    const int lzg = (l * 2 + z) * 16 + g;
#pragma unroll
    for (int nt = 0; nt < 4; ++nt) {
        const half8 bb = nt == 0 ? o.bb0 : nt == 1 ? o.bb1 : nt == 2 ? o.bb2 : o.bb3;
#pragma unroll
        for (int mt = 0; mt < 2; ++mt) {
            floatx16 acc;
#pragma unroll
            for (int r = 0; r < 16; ++r) acc[r] = 0.f;
            acc = __builtin_amdgcn_mfma_f32_32x32x16_f16(mt == 0 ? o.au0 : o.au1, bb, acc, 0, 0, 0);
#pragma unroll
            for (int r = 0; r < 16; ++r) hb[(32 * mt + (r & 3) + 8 * (r >> 2) + 4 * (lane >> 5)) * HLD + 32 * nt + (lane & 31)] = (f16)acc[r];
        }
    }
    const float abr = o.abr, abi = o.abi;
#pragma unroll 1
    for (int s0 = 0; s0 < 64; s0 += 16) {
        typedef _Float16 half2s __attribute__((ext_vector_type(2)));
        float br[16], bi[16];
#pragma unroll
        for (int i = 0; i < 16; ++i) { const int tt = z ? 63 - (s0 + i) : s0 + i; br[i] = (float)hb[tt * HLD + lane]; bi[i] = (float)hb[tt * HLD + 64 + lane]; }
#pragma unroll
        for (int i = 0; i < 16; ++i) {
            const float nr = abr * hre - abi * him + br[i], ni = abr * him + abi * hre + bi[i];
            hre = nr; him = ni; br[i] = hre; bi[i] = him;
        }
        if (store) {
#pragma unroll
            for (int i = 0; i < 16; ++i) { const int tt = z ? 63 - (s0 + i) : s0 + i; hb[tt * HLD + lane] = (f16)br[i]; hb[tt * HLD + 64 + lane] = (f16)bi[i]; }
        }
    }
}
template <int Z>
DEV void s5_recur(float abr, float abi, float& hre, float& him, f16* hbT, int lane, bool store) {
#pragma unroll 1
    for (int s0 = 0; s0 < 64; s0 += 16) {
        const int t0 = Z ? 48 - s0 : s0;
        const half8 r0 = *(const half8*)(hbT + lane * 72 + t0), r1 = *(const half8*)(hbT + lane * 72 + t0 + 8);
        const half8 i0 = *(const half8*)(hbT + (64 + lane) * 72 + t0), i1 = *(const half8*)(hbT + (64 + lane) * 72 + t0 + 8);
        float br[16], bi[16];
#pragma unroll
        for (int e = 0; e < 16; ++e) { br[e] = (float)(e < 8 ? r0[e] : r1[e - 8]); bi[e] = (float)(e < 8 ? i0[e] : i1[e - 8]); }
#pragma unroll
        for (int ii = 0; ii < 16; ++ii) {
            const int i = Z ? 15 - ii : ii;
            float nr = __builtin_fmaf(abr, hre, __builtin_fmaf(-abi, him, br[i])), ni = __builtin_fmaf(abr, him, __builtin_fmaf(abi, hre, bi[i]));
            asm volatile("" : "+v"(nr));
            hre = nr; him = ni; br[i] = nr; bi[i] = ni;
        }
        if (store) {
            half8 o0, o1, p0, p1;
#pragma unroll
            for (int e = 0; e < 8; ++e) { o0[e] = (f16)br[e]; o1[e] = (f16)br[8 + e]; p0[e] = (f16)bi[e]; p1[e] = (f16)bi[8 + e]; }
            *(half8*)(hbT + lane * 72 + t0) = o0; *(half8*)(hbT + lane * 72 + t0 + 8) = o1;
            *(half8*)(hbT + (64 + lane) * 72 + t0) = p0; *(half8*)(hbT + (64 + lane) * 72 + t0 + 8) = p1;
        }
    }
}
DEV void s5_wave_scan_T(PRef P, int l, int zs, int g, const S5Ops& o, float& hre, float& him, f16* hbT, int lane, bool store = false) {
#pragma unroll
    for (int nt = 0; nt < 4; ++nt) {
        const half8 bb = nt == 0 ? o.bb0 : nt == 1 ? o.bb1 : nt == 2 ? o.bb2 : o.bb3;
#pragma unroll
        for (int mt = 0; mt < 2; ++mt) {
            floatx16 acc;
#pragma unroll
            for (int r = 0; r < 16; ++r) acc[r] = 0.f;
            acc = __builtin_amdgcn_mfma_f32_32x32x16_f16(mt == 0 ? o.au0 : o.au1, bb, acc, 0, 0, 0);
#pragma unroll
            for (int gq = 0; gq < 4; ++gq) {
                half4 h; h[0] = (f16)acc[4 * gq]; h[1] = (f16)acc[4 * gq + 1]; h[2] = (f16)acc[4 * gq + 2]; h[3] = (f16)acc[4 * gq + 3];
                *(half4*)(hbT + (32 * nt + (lane & 31)) * 72 + 32 * mt + 8 * gq + 4 * (lane >> 5)) = h;
            }
        }
    }
    if (zs == 0) s5_recur<0>(o.abr, o.abi, hre, him, hbT, lane, store); else s5_recur<1>(o.abr, o.abi, hre, him, hbT, lane, store);
}
DEV void ph_s5_a(PRef P, int wvs, int l, int bid, int nblk, unsigned char* smraw) {
    const int tid_ = ltid(wvs); const int lane = tid_ & 63, wv = tid_ >> 6;
    f16* hb = (f16*)smraw + wv * 128 * 72;
    constexpr int NI = 2 * 2 * 16 * NCHUNK;
    int item = (nblk - 1 - bid) * NW + wv;
    int items = (nblk - 1 - bid) * NW + lsgpr(wvs);
    S5Ops nx;
    if (item < NI) { const int tc = item % NCHUNK, zbg = item / NCHUNK; s5_load(P, l, zbg >> 5, (zbg >> 4) & 1, zbg & 15, tc, lane, nx); }
    for (; item < NI; item += nblk * NW, items += nblk * NW) {
        const int tc = item % NCHUNK, zbg = item / NCHUNK, g = zbg & 15, z = zbg >> 5;
        const S5Ops cur = nx;
        const int nitem = item + nblk * NW;
        if (nitem < NI) { const int tc2 = nitem % NCHUNK, zbg2 = nitem / NCHUNK; s5_load(P, l, zbg2 >> 5, (zbg2 >> 4) & 1, zbg2 & 15, tc2, lane, nx); }
        float hre = 0.f, him = 0.f;
        s5_wave_scan_T(P, l, (items / NCHUNK) >> 5, g, cur, hre, him, hb, lane);
        const int ck = z ? mirror_chunk(tc) : tc;
        GAS float* ho = P.s5h + ((size_t)zbg * NCHUNK + ck) * 128;
        ho[lane] = hre; ho[64 + lane] = him;
    }
}
DEV void ph_s5_b(PRef P, int wvs, int l, int bid, int nblk, float* sm) {
    static_assert(NCHUNK == 4 * 65, "S5 combine pass: 4 segments of 65 chunks");
    const int tid = ltid(wvs), n = tid & 63, wv = tid >> 6, seg = wv & 3, zsel = wv >> 2;
    for (int pair = bid; pair < 32; pair += nblk) {
        const int zbg = pair * 2 + zsel, g = zbg & 15, z = zbg >> 5;
        const GAS float* tb = P.s5par + (size_t)((l * 2 + z) * 16 + g) * S5PW * 64 + n;
        const float ar = tb[34 * 64], ai = tb[35 * 64];
        GAS float* hp = P.s5h + ((size_t)zbg * NCHUNK + seg * 65) * 128 + n;
        float er[65], ei[65];
#pragma unroll
        for (int i = 0; i < 65; ++i) { er[i] = hp[i * 128]; ei[i] = hp[i * 128 + 64]; }
        float hr = 0.f, hi = 0.f;
#pragma unroll
        for (int i = 0; i < 65; ++i) { const float nr = ar * hr - ai * hi + er[i], ni = ar * hi + ai * hr + ei[i]; hr = nr; hi = ni; }
        __syncthreads();
        sm[((zsel * 4 + seg) * 2 + 0) * 64 + n] = hr; sm[((zsel * 4 + seg) * 2 + 1) * 64 + n] = hi;
        __syncthreads();
        float pr = ar, pi = ai;
#pragma unroll
        for (int k = 0; k < 6; ++k) { const float tr = pr * pr - pi * pi, ti = 2.f * pr * pi; pr = tr; pi = ti; }
        { const float tr = pr * ar - pi * ai, ti = pr * ai + pi * ar; pr = tr; pi = ti; }
        hr = 0.f; hi = 0.f;
#pragma unroll
        for (int q = 0; q < 3; ++q) {
            if (q < seg) {
                const float tr = sm[((zsel * 4 + q) * 2 + 0) * 64 + n], ti = sm[((zsel * 4 + q) * 2 + 1) * 64 + n];
                const float nr = pr * hr - pi * hi + tr, ni = pr * hi + pi * hr + ti; hr = nr; hi = ni;
            }
        }
#pragma unroll
        for (int i = 0; i < 65; ++i) {
            hp[i * 128] = hr; hp[i * 128 + 64] = hi;
            const float nr = ar * hr - ai * hi + er[i], ni = ar * hi + ai * hr + ei[i]; hr = nr; hi = ni;
        }
    }
}
DEV void ph_s5_c(PRef P, int wvs, int l, int it0, int stride, int it_end, unsigned char* smraw) {
    const int tid = ltid(wvs), lane = tid & 63, wv = tid >> 6, ci = wv >> 1, z = wv & 1;
    f16* base = (f16*)smraw;
    constexpr int NG = NCHUNK / 4;
    const int ngl = l == 1 ? NG - 1 : NG, gofs = l == 1 ? 1 : 0;
    int it = it0;
    S5Ops nx;
#define S5C_LOAD(it_, o_) { const int grp_ = (it_) % ngl + gofs, bg_ = (it_) / ngl, tc_ = grp_ * 4 + ci; \
        s5_load(P, l, z, bg_ >> 4, bg_ & 15, tc_, lane, o_); \
        const GAS float* hi_ = P.s5h + ((size_t)((z * 2 + (bg_ >> 4)) * 16 + (bg_ & 15)) * NCHUNK + (z ? mirror_chunk(tc_) : tc_)) * 128; \
        o_.hre = hi_[lane]; o_.him = hi_[64 + lane]; \
        o_.u8 = *(const GAS half8*)(P.p + (size_t)scan_row(0, bg_ >> 4, tc_ * 64 + 32 * z + (lane >> 1)) * INW + 1664 + (bg_ & 15) * 16 + 8 * (lane & 1)); \
        o_.d0 = *(const GAS floatx4*)(P.s5_d + l * 256 + (bg_ & 15) * 16 + 8 * (lane & 1)); o_.d1 = *(const GAS floatx4*)(P.s5_d + l * 256 + (bg_ & 15) * 16 + 8 * (lane & 1) + 4); }
    if (it < it_end) S5C_LOAD(it, nx);
    while (it < it_end) {
        const int grp = it % ngl + gofs, bg = it / ngl, g = bg & 15, b = bg >> 4;
        const S5Ops cur = nx;
        const int nit = it + stride;
        if (nit < it_end) S5C_LOAD(nit, nx);
        half8 bf[2][4];
#pragma unroll
        for (int z2 = 0; z2 < 2; ++z2)
#pragma unroll
            for (int ks = 0; ks < 4; ++ks) bf[z2][ks] = *(const half8*)(P.s5cc + ((size_t)((l * 2 + z2) * 16 + g) * 16 + (lane & 15)) * 128 + 32 * ks + 8 * (lane >> 4));
        BAR_LDS();
        const int tc = grp * 4 + ci;
        {
            float hre = cur.hre, him = cur.him;
            s5_wave_scan_T(P, l, lsgpr(wvs) & 1, g, cur, hre, him, base + wv * 128 * 72, lane, true);
        }
        BAR_LDS();
        {
            f16* ys = (f16*)(smraw + 8 * 128 * 72 * 2) + wv * 768;
#pragma unroll
            for (int mi = 0; mi < 2; ++mi) {
                const int mt = 2 * z + mi;
                floatx4 acc = {0.f, 0.f, 0.f, 0.f};
#pragma unroll
                for (int z2 = 0; z2 < 2; ++z2) {
                    const f16* hbz = base + (2 * ci + z2) * 128 * 72;
#pragma unroll
                    for (int ks = 0; ks < 4; ++ks) {
                        const f16* ap = hbz + (32 * ks + 8 * (lane >> 4) + ((lane >> 2) & 3)) * 72 + 16 * mt + 4 * (lane & 3);
                        const half4 lo = __builtin_bit_cast(half4, __builtin_amdgcn_ds_read_tr16_b64_v4i16((LAS v4i16_t*)ap));
                        const half4 hi = __builtin_bit_cast(half4, __builtin_amdgcn_ds_read_tr16_b64_v4i16((LAS v4i16_t*)(ap + 4 * 72)));
                        half8 a; a[0] = lo[0]; a[1] = lo[1]; a[2] = lo[2]; a[3] = lo[3]; a[4] = hi[0]; a[5] = hi[1]; a[6] = hi[2]; a[7] = hi[3];
                        acc = __builtin_amdgcn_mfma_f32_16x16x32_f16(a, bf[z2][ks], acc, 0, 0, 0);
                    }
                }
#pragma unroll
                for (int r = 0; r < 4; ++r) ys[(16 * mi + (lane >> 4) * 4 + r) * 24 + (lane & 15)] = (f16)acc[r];
            }
            asm volatile("s_waitcnt lgkmcnt(0)" ::: "memory");
            {
                const int tw = lane >> 1, hf = lane & 1;
                const half8 yv = *(const half8*)(ys + tw * 24 + 8 * hf);
                const int R = scan_row(0, b, tc * 64 + 32 * z + tw);
                half8 o;
#pragma unroll
                for (int e = 0; e < 8; ++e) {
                    const float y = (float)yv[e] + (e < 4 ? cur.d0[e] : cur.d1[e - 4]) * (float)cur.u8[e];
                    o[e] = (f16)(y * frcp(1.f + __expf(-1.5957691216057308f * (y + 0.044715f * y * y * y))));
                }
                *(GAS half8*)(P.yg + (size_t)R * 256 + g * 16 + 8 * hf) = o;
            }
        }
        it = nit;
    }
#undef S5C_LOAD
}

constexpr int NSC = TSCAN / 256;
constexpr int QLD = 104, SLD = 72;
constexpr int MLE = 97 * 96;
template <int KSTEPS>
DEV floatx16 mmh(const f16* A, int lda, int arow0, const f16* Bt, int ldb, int brow0, int lane, floatx16 acc) {
#pragma unroll
    for (int ks = 0; ks < KSTEPS; ++ks) {
        const half8 a = *(const half8*)(A + (arow0 + (lane & 31)) * lda + ks * 16 + (lane >> 5) * 8);
        const half8 b = *(const half8*)(Bt + (brow0 + (lane & 31)) * ldb + ks * 16 + (lane >> 5) * 8);
        acc = __builtin_amdgcn_mfma_f32_32x32x16_f16(a, b, acc, 0, 0, 0);
    }
    return acc;
}
DEV void ph_ml_a(PRef P, int wvs, int l, int bid, int nblk, float* sm) {
    const int tid_ = ltid(wvs); const int lane = tid_ & 63, wv = tid_ >> 6;
    const int lc = lane < 48 ? lane : 0;
    float cvb[8], cv0[8], cv1[8], cv2[8], bq[2][16], bk[2][16], bv[2][16];
#pragma unroll
    for (int i4 = 0; i4 < 2; ++i4) {
        const int c = lc * 8 + 4 * i4;
        const floatx4 a = *(const GAS floatx4*)(P.ml_conv_b + l * 384 + c), b0 = *(const GAS floatx4*)(P.ml_conv_w + (l * 3 + 0) * 384 + c),
                      b1 = *(const GAS floatx4*)(P.ml_conv_w + (l * 3 + 1) * 384 + c), b2 = *(const GAS floatx4*)(P.ml_conv_w + (l * 3 + 2) * 384 + c);
#pragma unroll
        for (int e = 0; e < 4; ++e) { cvb[4 * i4 + e] = a[e]; cv0[4 * i4 + e] = b0[e]; cv1[4 * i4 + e] = b1[e]; cv2[4 * i4 + e] = b2[e]; }
    }
#pragma unroll
    for (int blk = 0; blk < 2; ++blk)
#pragma unroll
        for (int e4 = 0; e4 < 4; ++e4) {
            const int wi = (l * 96 + lc * 2 + blk) * 16 + 4 * e4;
            const floatx4 q4 = *(const GAS floatx4*)(P.ml_wq + wi), k4 = *(const GAS floatx4*)(P.ml_wk + wi), v4 = *(const GAS floatx4*)(P.ml_wv + wi);
#pragma unroll
            for (int e = 0; e < 4; ++e) { bq[blk][4 * e4 + e] = q4[e]; bk[blk][4 * e4 + e] = k4[e]; bv[blk][4 * e4 + e] = v4[e]; }
        }
    const float gbias = lane < 16 ? ((lane & 1) ? P.ml_bf : P.ml_bi)[(l * 2 + (lane >> 3)) * 4 + ((lane >> 1) & 3)] : 0.f;
    constexpr int NGRP = NROWS / 16;
    const int ngmain = nblk * NW < NGRP ? nblk * NW : NGRP;
#pragma unroll 1
    for (int round = 0; ; ++round) {
        int R0, rlo, rhi; bool gate_wave;
        if (round == 0) { const int g = bid * NW + wv; if (g >= ngmain) continue; R0 = g * 16; rlo = 0; rhi = 16; gate_wave = true; }
        else { const int g = ngmain + (bid + nblk / 2) % nblk + (round - 1) * nblk; if (g >= NGRP) break; R0 = g * 16; rlo = 2 * wv; rhi = 2 * wv + 2; gate_wave = wv == 0; }
        if (lane < 48) {
            const int c0 = lane * 8;
            int t0, len; if (R0 < NCTX) { t0 = R0 % CTX; len = CTX; } else { t0 = (R0 - NCTX) % SEQ; len = SEQ; }
#pragma unroll 1
            for (int rb = rlo; rb < rhi; rb += 4) {
                half8 xw[6];
#pragma unroll
                for (int u = 0; u < 6; ++u) {
                    const int j = rb - 1 + u;
                    const bool ok = !((j < 0 && t0 == 0) || (j > 15 && (j > 16 || t0 + 16 >= len)));
                    half8 x = *(const GAS half8*)(P.p + (size_t)(R0 + (ok ? j : 0)) * INW + 2176 + c0);
                    if (!ok) {
#pragma unroll
                        for (int i = 0; i < 8; ++i) x[i] = (f16)0.f;
                    }
                    xw[u] = x;
                }
#pragma unroll
                for (int u = 0; u < 4; ++u) {
                    if (rb + u < rhi) {
                        const int R = R0 + rb + u;
                        const half8 xm_ = xw[u], x0 = xw[u + 1], xp_ = xw[u + 2];
                        half8 hq, hk, hv;
#pragma unroll
                        for (int blk = 0; blk < 2; ++blk) {
                            float xc[4], xm[4];
#pragma unroll
                            for (int i = 0; i < 4; ++i) {
                                xm[i] = (float)x0[4 * blk + i];
                                const float a = cvb[4 * blk + i] + cv1[4 * blk + i] * xm[i] + cv0[4 * blk + i] * (float)xm_[4 * blk + i] + cv2[4 * blk + i] * (float)xp_[4 * blk + i];
                                xc[i] = fsilu(a);
                            }
#pragma unroll
                            for (int i = 0; i < 4; ++i) {
                                float qq = 0.f, kk = 0.f, vv = 0.f;
#pragma unroll
                                for (int jj = 0; jj < 4; ++jj) { qq += xc[jj] * bq[blk][jj * 4 + i]; kk += xc[jj] * bk[blk][jj * 4 + i]; vv += xm[jj] * bv[blk][jj * 4 + i]; }
                                hq[4 * blk + i] = (f16)qq; hk[4 * blk + i] = (f16)(kk * 0.10206207261596577f); hv[4 * blk + i] = (f16)vv;
                            }
                        }
                        GAS f16* o = P.qkv16 + (size_t)R * 1152 + c0;
                        *(GAS half8*)o = hq; *(GAS half8*)(o + 384) = hk; *(GAS half8*)(o + 768) = hv;
                    }
                }
            }
        }
        asm volatile("s_waitcnt vmcnt(0)" ::: "memory");
        if (round == 1) __syncthreads();
        if (!gate_wave) continue;
        floatx4 acc = {0.f, 0.f, 0.f, 0.f};
        const GAS f16* ap = P.qkv16 + (size_t)(R0 + (lane & 15)) * 1152 + 8 * (lane >> 4);
        const GAS f16* bp = P.mlgw + ((size_t)l * 16 + (lane & 15)) * 1152 + 8 * (lane >> 4);
#pragma unroll 12
        for (int ks = 0; ks < 36; ++ks) {
            const half8 a = *(const GAS half8*)(ap + ks * 32), bb = *(const GAS half8*)(bp + ks * 32);
            acc = __builtin_amdgcn_mfma_f32_16x16x32_f16(a, bb, acc, 0, 0, 0);
        }
        const int o = lane & 15, which = o & 1;
        const float bs = __shfl(gbias, o);
#pragma unroll
        for (int r = 0; r < 4; ++r) {
            const float val = acc[r] + bs;
            P.gates[(size_t)(R0 + 4 * (lane >> 4) + r) * 16 + o] = which ? log_sigmoidf_(val) : val;
        }
    }
}
constexpr int VLD = 160;
DEV half8 frag_tr(const f16* T, int c0, int ks, int lane) {
    const int g = lane >> 4, q = (lane >> 2) & 3, pp = lane & 3;
    const f16* a = T + (16 * ks + 8 * (g >> 1) + q) * VLD + c0 + 16 * (g & 1) + 4 * pp;
    const half4 lo = __builtin_bit_cast(half4, __builtin_amdgcn_ds_read_tr16_b64_v4i16((LAS v4i16_t*)a));
    const half4 hi = __builtin_bit_cast(half4, __builtin_amdgcn_ds_read_tr16_b64_v4i16((LAS v4i16_t*)(a + 4 * VLD)));
    half8 r; r[0] = lo[0]; r[1] = lo[1]; r[2] = lo[2]; r[3] = lo[3]; r[4] = hi[0]; r[5] = hi[1]; r[6] = hi[2]; r[7] = hi[3];
    return r;
}
template <bool TA, bool TB>
DEV floatx16 mmh_t(const f16* A, int lda, int arow0, const f16* Bt, int ldb, int brow0, int lane, floatx16 acc) {
#pragma unroll
    for (int ks = 0; ks < 4; ++ks) {
        const half8 a = TA ? frag_tr(A, arow0, ks, lane) : *(const half8*)(A + (arow0 + (lane & 31)) * lda + ks * 16 + (lane >> 5) * 8);
        const half8 b = TB ? frag_tr(Bt, brow0, ks, lane) : *(const half8*)(Bt + (brow0 + (lane & 31)) * ldb + ks * 16 + (lane >> 5) * 8);
        acc = __builtin_amdgcn_mfma_f32_32x32x16_f16(a, b, acc, 0, 0, 0);
    }
    return acc;
}
DEV void ml_issue_VK(PRef P, int z, int b, int hh, int s0, int tid, half8& x0, half8& x1, half8& x2) {
#pragma unroll
    for (int i = 0; i < 3; ++i) {
        const int e = tid + NT * i, which = e / 768, rem = e % 768, t = rem / 12, c8 = rem % 12;
        const int R = scan_row(z, b, s0 + t);
        const half8 x = *(const half8*)(P.qkv16 + (size_t)R * 1152 + (which ? 384 : 768) + hh * 96 + c8 * 8);
        if (i == 0) x0 = x; else if (i == 1) x1 = x; else x2 = x;
    }
}
DEV void ml_store_VK(const half8 x0, const half8 x1, const half8 x2, const float* wgt, f16* Vrm, f16* Kerm, int tid) {
#pragma unroll
    for (int i = 0; i < 3; ++i) {
        const int e = tid + NT * i, which = e / 768, rem = e % 768, t = rem / 12, c8 = rem % 12;
        const half8 x = i == 0 ? x0 : i == 1 ? x1 : x2;
        if (which == 0) *(half8*)(Vrm + t * VLD + c8 * 8) = x;
        else {
            const float w = wgt[t]; half8 y;
#pragma unroll
            for (int j = 0; j < 8; ++j) y[j] = (f16)((float)x[j] * w);
            *(half8*)(Kerm + t * VLD + c8 * 8) = y;
        }
    }
}
constexpr int ML_VT_OFF = 0, ML_KE_OFF = 64 * VLD, ML_QS_OFF = ML_KE_OFF + 64 * VLD, ML_KS_OFF = ML_QS_OFF + 64 * QLD, ML_C16_OFF = ML_KS_OFF + 64 * QLD,
              ML_AM_OFF = ML_C16_OFF + 128 * QLD, ML_F_OFF_BYTES = (ML_AM_OFF + 64 * SLD) * 2;
constexpr int ML_OS32_OFF_BYTES = ML_F_OFF_BYTES + 320 * 4;
constexpr int ML_LDS_BYTES = ML_OS32_OFF_BYTES + 64 * 100 * 4;
DEV void ph_ml_1(PRef P, int wvs, int l, int bid, int nblk, unsigned char* smraw) {
    f16* VT = (f16*)smraw + ML_VT_OFF; f16* KeT = (f16*)smraw + ML_KE_OFF; float* fb = (float*)(smraw + ML_F_OFF_BYTES);
    for (int it_ = bid; it_ < 16 * (NSC - 1); it_ += nblk) {
        const int tid = ltid(wvs), lane = tid & 63, wv = tid >> 6;
        const int chain = it_ / (NSC - 1), sc = it_ % (NSC - 1), z = chain / 8, b = (chain / 4) % 2, hh = chain % 4;
        const int item = chain * NSC + sc;
        half8 pt0, pt1, pt2;
        ml_issue_VK(P, z, b, hh, sc * 256, tid, pt0, pt1, pt2);
        BAR_LDS();
        for (int idx = tid; idx < 64 * 32; idx += NT) VT[(idx >> 5) * VLD + 96 + (idx & 31)] = (f16)(((idx & 31) == 0) ? 1.f : 0.f);
        float x = 0.f, li = 0.f;
        if (tid < 256) {
            const int R = scan_row(z, b, sc * 256 + tid);
            const floatx2 g2 = *(const GAS floatx2*)(P.gates + (size_t)R * 16 + z * 8 + hh * 2); li = g2[0]; x = g2[1];
#pragma unroll
            for (int o = 1; o < 64; o <<= 1) { const float y = __shfl_up(x, o); if (lane >= o) x += y; }
            if (lane == 63) fb[256 + wv] = x;
        }
        BAR_LDS();
        if (tid < 256) {
            float off = 0.f, tot = 0.f;
#pragma unroll
            for (int w = 0; w < 4; ++w) { const float q = fb[256 + w]; tot += q; if (w < wv) off += q; }
            fb[tid] = __expf(li + tot - (x + off));
            if (tid == 0) P.mlG[item] = __expf(tot);
        }
        floatx16 c0, c1, c2;
#pragma unroll
        for (int r = 0; r < 16; ++r) { c0[r] = 0.f; c1[r] = 0.f; c2[r] = 0.f; }
#pragma unroll 1
        for (int cc = 0; cc < 4; ++cc) {
            BAR_LDS();
            ml_store_VK(pt0, pt1, pt2, fb + cc * 64, VT, KeT, tid);
            if (cc < 3) ml_issue_VK(P, z, b, hh, sc * 256 + cc * 64 + 64, tid, pt0, pt1, pt2);
            BAR_LDS();
            if (wv < 4) {
                c0 = mmh_t<true, true>(VT, 0, 32 * wv, KeT, 0, 0, lane, c0);
                c1 = mmh_t<true, true>(VT, 0, 32 * wv, KeT, 0, 32, lane, c1);
                c2 = mmh_t<true, true>(VT, 0, 32 * wv, KeT, 0, 64, lane, c2);
            }
        }
        if (wv < 4) {
            GAS float* dst = P.mlC + (size_t)item * MLE;
#pragma unroll
            for (int r = 0; r < 16; ++r) {
                const int v = 32 * wv + (r & 3) + 8 * (r >> 2) + 4 * (lane >> 5), k = lane & 31;
                if (v <= 96) { dst[v * 96 + k] = c0[r]; dst[v * 96 + 32 + k] = c1[r]; dst[v * 96 + 64 + k] = c2[r]; }
            }
        }
    }
}
DEV void ph_ml_2(PRef P, int wvs, int bid, int nblk) {
    static_assert(MLE % 4 == 0, "ml pass 2: four consecutive state elements per thread");
    constexpr int Q4 = MLE / 4;
    for (int idx = bid * NT + ltid(wvs); idx < 16 * Q4; idx += nblk * NT) {
        const int chain = idx / Q4, e = (idx % Q4) * 4;
        GAS float* c1 = P.mlC + (size_t)chain * NSC * MLE + e;
        const GAS float* g1 = P.mlG + chain * NSC;
        floatx4 run = {0.f, 0.f, 0.f, 0.f};
        for (int s0 = 0; s0 < NSC - 1; s0 += 16) {
            floatx4 loc[16]; float gg[16];
#pragma unroll
            for (int i = 0; i < 16; ++i) { loc[i] = *(const GAS floatx4*)(c1 + (size_t)(s0 + i) * MLE); gg[i] = g1[s0 + i]; }
#pragma unroll
            for (int i = 0; i < 16; ++i) {
                *(GAS floatx4*)(c1 + (size_t)(s0 + i) * MLE) = run;
#pragma unroll
                for (int q = 0; q < 4; ++q) run[q] = gg[i] * run[q] + loc[i][q];
            }
        }
        *(GAS floatx4*)(c1 + (size_t)(NSC - 1) * MLE) = run;
    }
}
DEV void ph_ml_3(PRef P, int wvs, int l, int bid, int nblk, unsigned char* smraw) {
    f16* sh = (f16*)smraw;
    f16 *VT = sh + ML_VT_OFF, *KeT = sh + ML_KE_OFF, *Qs = sh + ML_QS_OFF, *Ks = sh + ML_KS_OFF, *C16 = sh + ML_C16_OFF, *Am = sh + ML_AM_OFF;
    float* Os32 = (float*)(smraw + ML_OS32_OFF_BYTES);
    float* fb = (float*)(smraw + ML_F_OFF_BYTES);
    const int nsc3 = l == 1 ? NSC - 1 : NSC;
    half8 pq0, pq1, pq2, pt0, pt1; float pli = 0.f, plf = 0.f;
#define ML3_ISSUE(z_, b_, hh_, s0_) { \
            _Pragma("unroll") for (int i = 0; i < 3; ++i) { \
                const int e = tid + NT * i, which = e / 768, rem = e % 768, t = rem / 12, c8 = rem % 12; \
                const int R = scan_row(z_, b_, (s0_) + t); \
                const half8 x = *(const half8*)(P.qkv16 + (size_t)R * 1152 + (which ? 384 : 0) + (hh_) * 96 + c8 * 8); \
                if (i == 0) pq0 = x; else if (i == 1) pq1 = x; else pq2 = x; } \
            _Pragma("unroll") for (int i = 0; i < 2; ++i) { \
                const int e = (tid + NT * i) < 768 ? tid + NT * i : tid, t = e / 12, c8 = e % 12; \
                const int R = scan_row(z_, b_, (s0_) + t); \
                const half8 x = *(const half8*)(P.qkv16 + (size_t)R * 1152 + 768 + (hh_) * 96 + c8 * 8); \
                if (i == 0) pt0 = x; else pt1 = x; } \
            { const int R = scan_row(z_, b_, (s0_) + lane); const floatx2 g2_ = *(const GAS floatx2*)(P.gates + (size_t)R * 16 + (z_) * 8 + (hh_) * 2); pli = g2_[0]; plf = g2_[1]; } }
    for (int it_ = bid; it_ < 16 * nsc3; it_ += nblk) {
        const int tid = ltid(wvs), lane = tid & 63, wv = tid >> 6, w4 = wv & 3, wm = w4 & 1, wn = w4 >> 1;
        const int chain = it_ / nsc3, sc = it_ % nsc3 + (l == 1 ? 1 : 0), z = chain / 8, b = (chain / 4) % 2, hh = chain % 4;
        const int item = chain * NSC + sc;
        if (it_ == bid) ML3_ISSUE(z, b, hh, sc * 256);
        BAR_LDS();
        for (int idx = tid; idx < 64 * 32; idx += NT) VT[(idx >> 5) * VLD + 96 + (idx & 31)] = (f16)(((idx & 31) == 0) ? 1.f : 0.f);
        floatx16 c0, c1, c2;
        {
            const GAS float* srcC = P.mlC + (size_t)item * MLE;
#pragma unroll
            for (int r = 0; r < 16; ++r) {
                const int v = 32 * w4 + (r & 3) + 8 * (r >> 2) + 4 * (lane >> 5), k = lane & 31;
                const bool ok = v <= 96 && wv < 4; const int vv = ok ? v : 96;
                const float x0 = srcC[vv * 96 + k], x1 = srcC[vv * 96 + (ok ? 32 : 0) + k], x2 = srcC[vv * 96 + (ok ? 64 : 0) + k];
                c0[r] = ok ? x0 : 0.f; c1[r] = ok ? x1 : 0.f; c2[r] = ok ? x2 : 0.f;
            }
        }
#pragma unroll 1
        for (int cc = 0; cc < 4; ++cc) {
            const int s0 = sc * 256 + cc * 64;
            if (wv == 7) {
                const float li = pli, lf = plf;
                float F = lf;
#pragma unroll
                for (int o = 1; o < 64; o <<= 1) { const float y = __shfl_up(F, o); if (lane >= o) F += y; }
                const float FL = __shfl(F, 63);
                fb[lane] = __expf(F); fb[64 + lane] = __expf(fminf(li - F, 10.f)); fb[128 + lane] = __expf(li + FL - F);
                if (lane == 63) fb[192] = __expf(FL);
            }
            if (wv < 4) {
#pragma unroll
                for (int r = 0; r < 16; ++r) {
                    const int v = 32 * wv + (r & 3) + 8 * (r >> 2) + 4 * (lane >> 5), k = lane & 31;
                    C16[v * QLD + k] = (f16)c0[r]; C16[v * QLD + 32 + k] = (f16)c1[r]; C16[v * QLD + 64 + k] = (f16)c2[r];
                }
            }
            BAR_LDS();
#pragma unroll
            for (int i = 0; i < 3; ++i) {
                const int e = tid + NT * i, which = e / 768, rem = e % 768, t = rem / 12, c8 = rem % 12;
                const half8 x = i == 0 ? pq0 : i == 1 ? pq1 : pq2;
                const float w = which ? fb[64 + t] : fb[t];
                half8 y;
#pragma unroll
                for (int jj = 0; jj < 8; ++jj) y[jj] = (f16)((float)x[jj] * w);
                *(half8*)((which ? Ks : Qs) + t * QLD + c8 * 8) = y;
                if (which) {
                    const float w2 = fb[128 + t]; half8 y2;
#pragma unroll
                    for (int jj = 0; jj < 8; ++jj) y2[jj] = (f16)((float)x[jj] * w2);
                    *(half8*)(KeT + t * VLD + c8 * 8) = y2;
                }
            }
#pragma unroll
            for (int i = 0; i < 2; ++i) {
                const int e = (tid + NT * i) < 768 ? tid + NT * i : tid, t = e / 12, c8 = e % 12;
                *(half8*)(VT + t * VLD + c8 * 8) = i == 0 ? pt0 : pt1;
            }
            {
                int nz = z, nb = b, nh = hh, ns0 = s0 + 64;
                if (cc == 3) {
                    const int nit = it_ + nblk < 16 * nsc3 ? it_ + nblk : it_;
                    const int nch = nit / nsc3, nsc = nit % nsc3 + (l == 1 ? 1 : 0);
                    nz = nch / 8; nb = (nch / 4) % 2; nh = nch % 4; ns0 = nsc * 256;
                }
                ML3_ISSUE(nz, nb, nh, ns0);
            }
            BAR_LDS();
            if (wv >= 4) {
#pragma unroll
                for (int r = 0; r < 16; ++r) c2[r] = 0.f;
                if (!(wm == 0 && wn == 1)) c2 = mmh<6>(Qs, QLD, wm * 32, Ks, QLD, wn * 32, lane, c2);
#pragma unroll
                for (int r = 0; r < 16; ++r) {
                    const int m = wm * 32 + (r & 3) + 8 * (r >> 2) + 4 * (lane >> 5), n = wn * 32 + (lane & 31);
                    Am[m * SLD + n] = (f16)(n <= m ? c2[r] : 0.f);
                }
            } else {
                const float gL = fb[192];
#pragma unroll
                for (int r = 0; r < 16; ++r) { c0[r] *= gL; c1[r] *= gL; c2[r] *= gL; }
                c0 = mmh_t<true, true>(VT, 0, 32 * wv, KeT, 0, 0, lane, c0); __builtin_amdgcn_sched_barrier(0);
                c1 = mmh_t<true, true>(VT, 0, 32 * wv, KeT, 0, 32, lane, c1); __builtin_amdgcn_sched_barrier(0);
                c2 = mmh_t<true, true>(VT, 0, 32 * wv, KeT, 0, 64, lane, c2);
            }
            BAR_LDS();
            {
                const int th = wv < 4 ? 32 : 0;
                floatx16 cn;
#pragma unroll
                for (int r = 0; r < 16; ++r) cn[r] = 0.f;
                cn = mmh_t<false, true>(Am, SLD, th, VT, 0, 32 * w4, lane, cn); __builtin_amdgcn_sched_barrier(0);
                cn = mmh<6>(Qs, QLD, th, C16, QLD, 32 * w4, lane, cn); __builtin_amdgcn_sched_barrier(0);
                if (w4 == 3) {
                    if ((lane & 31) == 0) {
#pragma unroll
                        for (int r = 0; r < 16; ++r) { const int t = (r & 3) + 8 * (r >> 2) + 4 * (lane >> 5); fb[256 + th + t] = cn[r]; }
                    }
                } else {
#pragma unroll
                    for (int r = 0; r < 16; ++r) {
                        const int t = (r & 3) + 8 * (r >> 2) + 4 * (lane >> 5);
                        Os32[(th + t) * 100 + 32 * w4 + (lane & 31)] = cn[r];
                    }
                }
            }
            BAR_LDS();
#pragma unroll
            for (int i = 0; i < 3; ++i) {
                const int task = tid + NT * i, row = task / 24, c4 = task % 24;
                const floatx4 nv = *(const floatx4*)(Os32 + row * 100 + c4 * 4);
                const float rd = frcp(fmaxf(fabsf(fb[256 + row]), 1.f));
                half4 v; v[0] = (f16)(nv[0] * rd); v[1] = (f16)(nv[1] * rd); v[2] = (f16)(nv[2] * rd); v[3] = (f16)(nv[3] * rd);
                *(GAS half4*)(P.Yh + ((size_t)z * NROWS + scan_row(z, b, s0 + row)) * 384 + hh * 96 + c4 * 4) = v;
            }
        }
    }
}
#undef ML3_ISSUE
DEV void ph_ml_fin2(PRef P, int wvs, int l, int bid, int nblk, bool dry = false) {
    const int tid_ = ltid(wvs); const int lane = tid_ & 63, wv = tid_ >> 6;
    const int l16 = lane & 15; const bool act = l16 < 12;
    const int c0 = (lane >> 4) * 96 + (act ? l16 : 11) * 8;
    float ng[8], sk[8], cb[8], w0[8], w1[8], w2[8];
#pragma unroll
    for (int i = 0; i < 8; ++i) {
        ng[i] = P.ml_norm_g[l * 384 + c0 + i]; sk[i] = P.ml_skip[l * 384 + c0 + i]; cb[i] = P.ml_conv_b[l * 384 + c0 + i];
        w0[i] = P.ml_conv_w[(l * 3 + 0) * 384 + c0 + i]; w1[i] = P.ml_conv_w[(l * 3 + 1) * 384 + c0 + i]; w2[i] = P.ml_conv_w[(l * 3 + 2) * 384 + c0 + i];
    }
    for (int Ra = (l == 1 ? NCTX : 0) + bid * NW + wv; Ra < NROWS; Ra += 2 * nblk * NW) {
        const bool two = Ra + nblk * NW < NROWS;
        half8 ya[2], yb[2], hm[2], hz[2], hpa[2], hpb[2]; bool va[2], vb[2];
#pragma unroll
        for (int u = 0; u < 2; ++u) {
            const int R = (u == 1 && two) ? Ra + nblk * NW : Ra;
            int t, len; if (R < NCTX) { t = R % CTX; len = CTX; } else { t = (R - NCTX) % SEQ; len = SEQ; }
            va[u] = t > 0; vb[u] = t < len - 1;
            ya[u] = *(const GAS half8*)(P.Yh + (size_t)R * 384 + c0); yb[u] = *(const GAS half8*)(P.Yh + ((size_t)NROWS + R) * 384 + c0);
            hm[u] = *(const GAS half8*)(P.p + (size_t)R * INW + 2176 + c0); hz[u] = *(const GAS half8*)(P.p + (size_t)R * INW + 2560 + c0);
            hpa[u] = *(const GAS half8*)(P.p + (size_t)(va[u] ? R - 1 : R) * INW + 2176 + c0);
            hpb[u] = *(const GAS half8*)(P.p + (size_t)(vb[u] ? R + 1 : R) * INW + 2176 + c0);
        }
#pragma unroll
        for (int u = 0; u < 2; ++u) {
            const int R = u == 1 ? Ra + nblk * NW : Ra;
            float y[8]; float s = 0.f;
#pragma unroll
            for (int e = 0; e < 8; ++e) { y[e] = act ? (float)ya[u][e] + (float)yb[u][e] : 0.f; s += y[e]; }
            s = row16_sum(s);
            const float mu = s * (1.f / 96.f); float q = 0.f;
#pragma unroll
            for (int e = 0; e < 8; ++e) { y[e] = act ? y[e] - mu : 0.f; q += y[e] * y[e]; }
            q = row16_sum(q);
            const float rs = __builtin_amdgcn_rsqf(q * (1.f / 96.f) + 1e-6f);
            half8 o;
#pragma unroll
            for (int e = 0; e < 8; ++e) {
                const float xa = va[u] ? (float)hpa[u][e] : 0.f, xb = vb[u] ? (float)hpb[u][e] : 0.f;
                const float xc = fsilu(cb[e] + w1[e] * (float)hm[u][e] + w0[e] * xa + w2[e] * xb);
                o[e] = (f16)((y[e] * rs * ng[e] + sk[e] * xc) * fsilu((float)hz[u][e]));
            }
            if (act && (u == 0 || two)) {
                if (!dry) *(GAS half8*)(P.p + (size_t)R * INW + 2560 + c0) = o; else *(GAS half8*)(P.rwm + (size_t)R * 384 + c0) = o;
            }
        }
    }
}

#define XB_TMO      128
#define XB_XCNT(j)  (256  + 64 * (j))
#define XB_XSUB(j)  (1280 + 64 * (j))
#define XB_XGEN(j)  (2304 + 64 * (j))
#define XB_TOP      3328
#define XB_TOPGEN   3392
#define XCD_BAR_WORDS 3456
#define XB_SPIN_CAP (1u << 22)
DEV unsigned xb_ld(GAS unsigned* p)              { return __hip_atomic_load(p, __ATOMIC_RELAXED, __HIP_MEMORY_SCOPE_AGENT); }
DEV unsigned xb_add(GAS unsigned* p, unsigned v) { return __hip_atomic_fetch_add(p, v, __ATOMIC_RELAXED, __HIP_MEMORY_SCOPE_AGENT); }
DEV unsigned xb_xcc_id() { return (unsigned)__builtin_amdgcn_s_getreg((3 << 11) | 20) & 0xFu; }
#define XB_SPIN(cond, bar) do { unsigned _sp = 0; while (cond) { __builtin_amdgcn_s_sleep(1); \
    if ((++_sp & 255u) == 0u) { if (xb_ld(&(bar)[XB_TMO])) break; if (_sp > XB_SPIN_CAP) { (void)xb_add(&(bar)[XB_TMO], 1u); break; } } } } while (0)
struct XcdBarrier { GAS unsigned* bar; unsigned x; volatile LAS unsigned* st; };
DEV XcdBarrier xcd_barrier_post(GAS unsigned* bar, volatile LAS unsigned* st) {
    XcdBarrier b; b.bar = bar; b.x = xb_xcc_id(); b.st = st;
    if (threadIdx.x == 0) (void)xb_add(&bar[XB_XCNT(b.x)], 1u);
    return b;
}
DEV void xcd_barrier_complete(GAS unsigned* bar, unsigned x, unsigned& nloc, unsigned& nx) {
    const unsigned G = gridDim.x * gridDim.y * gridDim.z;
    unsigned sum, cnt, mine, sp = 0u;
    for (;;) {
        sum = 0u; cnt = 0u; mine = 0u;
#pragma unroll
        for (unsigned j = 0; j < 16; ++j) { const unsigned c = xb_ld(&bar[XB_XCNT(j)]); sum += c; cnt += (c > 0u) ? 1u : 0u; mine = (j == x) ? c : mine; }
        if (sum == G) break;
        __builtin_amdgcn_s_sleep(1);
        if ((++sp & 255u) == 0u) { if (xb_ld(&bar[XB_TMO])) break; if (sp > XB_SPIN_CAP) { (void)xb_add(&bar[XB_TMO], 1u); break; } }
    }
    nloc = mine > 0u ? mine : 1u; nx = cnt > 0u ? cnt : 1u;
}
DEV bool is_thread0(int wvs) { return wvs == 0 && __builtin_amdgcn_mbcnt_hi(~0u, __builtin_amdgcn_mbcnt_lo(~0u, 0u)) == 0u; }
DEV void xcd_barrier(const XcdBarrier& b, GAS unsigned* bar_, int wvs) {
    asm volatile("s_waitcnt vmcnt(0)" ::: "memory");
    __syncthreads();
    if (is_thread0(wvs)) {
        GAS unsigned* bar = bar_;
        __builtin_amdgcn_s_waitcnt(0);
        unsigned nloc = b.st[0], nx = b.st[1];
        if (nloc == 0u) { xcd_barrier_complete(bar, b.x, nloc, nx); b.st[0] = nloc; b.st[1] = nx; }
        const unsigned old = xb_add(&bar[XB_XSUB(b.x)], 1u);
        const unsigned gen = old / nloc;
        if (old + 1u == (gen + 1u) * nloc) {
            __builtin_amdgcn_fence(__ATOMIC_RELEASE, "agent");
            asm volatile("s_waitcnt vmcnt(0)" ::: "memory");
            const unsigned og = xb_add(&bar[XB_TOP], 1u);
            const unsigned tg = og / nx;
            if (og + 1u == (tg + 1u) * nx) xb_add(&bar[XB_TOPGEN], 1u);
            else XB_SPIN(xb_ld(&bar[XB_TOPGEN]) == tg, bar);
            __builtin_amdgcn_fence(__ATOMIC_ACQUIRE, "agent");
            xb_add(&bar[XB_XGEN(b.x)], 1u);
            asm volatile("s_waitcnt vmcnt(0)" ::: "memory");
        } else {
            XB_SPIN(xb_ld(&bar[XB_XGEN(b.x)]) == gen, bar);
            __builtin_amdgcn_fence(__ATOMIC_ACQUIRE, "agent");
            asm volatile("s_waitcnt vmcnt(0)" ::: "memory");
        }
    }
    __syncthreads();
}


DEV void sub_barrier(GAS unsigned* cnt, unsigned nmemb, unsigned round, int wvs) {
    asm volatile("s_waitcnt vmcnt(0)" ::: "memory");
    __syncthreads();
    if (is_thread0(wvs)) {
        __builtin_amdgcn_fence(__ATOMIC_RELEASE, "agent");
        asm volatile("s_waitcnt vmcnt(0)" ::: "memory");
        (void)xb_add(cnt, 1u);
        unsigned sp = 0;
        while (xb_ld(cnt) < nmemb * round) { __builtin_amdgcn_s_sleep(1); if (++sp > (1u << 24)) break; }
        __builtin_amdgcn_fence(__ATOMIC_ACQUIRE, "agent");
        asm volatile("s_waitcnt vmcnt(0)" ::: "memory");
    }
    __syncthreads();
}

DEV void sub_wait(GAS unsigned* cnt, unsigned target, int wvs) {
    asm volatile("s_waitcnt vmcnt(0)" ::: "memory");
    __syncthreads();
    if (is_thread0(wvs)) {
        unsigned sp = 0;
        while (xb_ld(cnt) < target) { __builtin_amdgcn_s_sleep(1); if (++sp > (1u << 24)) break; }
        __builtin_amdgcn_fence(__ATOMIC_ACQUIRE, "agent");
        asm volatile("s_waitcnt vmcnt(0)" ::: "memory");
    }
    __syncthreads();
}

constexpr size_t al256(size_t x) { return (x + 255) & ~(size_t)255; }
constexpr size_t WS_MODS = 0;
constexpr size_t WS_P = al256(WS_MODS + 2 * 3 * 3072 * 4);
constexpr size_t WS_Y = al256(WS_P + (size_t)NROWS * INW * 2);
constexpr size_t WS_Q = al256(WS_Y + (size_t)2 * NROWS * 384 * 4);
constexpr size_t WS_Q_BYTES = (size_t)NROWS * 1152 * 4;
constexpr size_t WS_GATES = al256(WS_Q + WS_Q_BYTES);
constexpr size_t WS_BON = al256(WS_GATES + (size_t)NROWS * 16 * 4);
constexpr size_t WS_YG = al256(WS_BON + (size_t)2 * NROWS * 6 * 4);
constexpr size_t WS_S5H = al256(WS_YG + (size_t)NROWS * 256 * 2);
constexpr size_t WS_S5PAR = al256(WS_S5H + (size_t)64 * NCHUNK * 128 * 4);
constexpr size_t WS_S5BB = al256(WS_S5PAR + (size_t)64 * S5PW * 64 * 4);
constexpr size_t WS_S5CC = al256(WS_S5BB + (size_t)64 * 128 * 16 * 2);
constexpr size_t WS_GLUT = al256(WS_S5CC + (size_t)64 * 16 * 128 * 2);
constexpr size_t WS_CTX1 = al256(WS_GLUT + (size_t)2 * 256 * 256 * 2);
constexpr size_t WS_WTIN = al256(WS_CTX1 + (size_t)NCTX * D * 4);
constexpr size_t WS_WTOUT = al256(WS_WTIN + (size_t)2 * 3072 * D * 2);
constexpr size_t WS_RWLT = al256(WS_WTOUT + (size_t)2 * D * D * 2);
constexpr size_t WS_MLGW = al256(WS_RWLT + (size_t)2 * 2 * 2 * 384 * 32 * 2);
constexpr size_t WS_GP = al256(WS_MLGW + (size_t)2 * 16 * 1152 * 2);
constexpr size_t WS_XBAR = al256(WS_GP + 1024);
constexpr size_t WS_END = al256(WS_XBAR + (XCD_BAR_WORDS + 256) * 4);
static_assert(3 * RWM_STRIDE * 2 <= WS_Q_BYTES, "rwkv chunk matrices");
static_assert(al256((size_t)NROWS * 1152 * 2) + al256((size_t)16 * NSC * MLE * 4) + 16 * NSC * 4 <= WS_Q_BYTES, "ml region");

static void fill_params(Params& P, void* const* d_in, void* d_out, void* d_ws) {
    const GAS float** pp = (const GAS float**)&P;
    for (int i = 0; i < 41; ++i) pp[i] = (const GAS float*)d_in[i];
    unsigned char* ws = (unsigned char*)d_ws;
    P.out = (GAS float*)d_out;
    P.mods = (GAS float*)(ws + WS_MODS); P.p = (GAS f16*)(ws + WS_P); P.Yh = (GAS f16*)(ws + WS_Y);
    P.gates = (GAS float*)(ws + WS_GATES); P.bon = (GAS float*)(ws + WS_BON); P.ctx1 = (GAS float*)(ws + WS_CTX1);
    P.hx = (GAS f16*)(ws + WS_Q); P.rwm = (GAS f16*)(ws + WS_Q); P.qkv16 = (GAS f16*)(ws + WS_Q);
    P.mlC = (GAS float*)(ws + WS_Q + al256((size_t)NROWS * 1152 * 2)); P.mlG = (GAS float*)(ws + WS_Q + al256((size_t)NROWS * 1152 * 2) + al256((size_t)16 * NSC * MLE * 4));
    P.wt_in = (GAS f16*)(ws + WS_WTIN); P.wt_out = (GAS f16*)(ws + WS_WTOUT); P.glut = (GAS f16*)(ws + WS_GLUT);
    P.yg = (GAS f16*)(ws + WS_YG); P.s5h = (GAS float*)(ws + WS_S5H); P.s5par = (GAS float*)(ws + WS_S5PAR); P.s5bb = (GAS f16*)(ws + WS_S5BB); P.s5cc = (GAS f16*)(ws + WS_S5CC);
    P.rwlt = (GAS bf16*)(ws + WS_RWLT); P.mlgw = (GAS f16*)(ws + WS_MLGW); P.gp = (GAS Params*)(ws + WS_GP); P.xbar = (GAS unsigned*)(ws + WS_XBAR);
}

constexpr int cmax(int a, int b) { return a > b ? a : b; }
constexpr int MEGA_LDS_BYTES = cmax(cmax(RWP1_LDS_BYTES, S5_LDS_BYTES), cmax(GEMM_LDS_BYTES, ML_LDS_BYTES));
static_assert(8 * 128 * 72 * 2 + NW * 768 * 2 <= MEGA_LDS_BYTES, "S5 pass C tiles + epilogue staging");

template <int l>
DEV void layer_body(PRef P, const int wvs, const int bid, const int nblk, unsigned char* smraw, float* sm, const XcdBarrier& xb) {
        if (l == 0) ph_wprep(P, wvs, lsgpr(bid), nblk, sm);
        for (int rep = 0; rep < REP_HX; ++rep) ph_hx(P, wvs, l, lsgpr(bid), nblk);
        xcd_barrier(xb, P.xbar, wvs);
        for (int rep = 0; rep < REP_G1; ++rep) ph_gemm_8p<1>(P, wvs, l, lsgpr(bid), nblk, smraw);
        for (int rep = 0; rep < REP_SYNC; ++rep) xcd_barrier(xb, P.xbar, wvs);
        for (int rep = 0; rep < REP_P1; ++rep) ph_rw_p1(P, wvs, l, lsgpr(bid), nblk, smraw, rep + 1 < REP_P1);
        for (int rep = 0; rep < REP_S5A; ++rep) ph_s5_a(P, wvs, l, lsgpr(bid), nblk, smraw);
        xcd_barrier(xb, P.xbar, wvs);
        {
            constexpr int S5C_NI = 2 * 16 * (l == 1 ? NCHUNK / 4 - 1 : NCHUNK / 4);
            const int ns5 = nblk - 96, s5c_split = 13 * ns5 < S5C_NI ? 13 * ns5 : S5C_NI;
            if (bid < 96) {
                for (int rep = 0; rep + 1 < REP_ST; ++rep) ph_rw_stream<true>(P, wvs, l, lsgpr(bid), 96, smraw);
                ph_rw_stream<false>(P, wvs, l, lsgpr(bid), 96, smraw);
                sub_wait(P.xbar + 3456 + 64, (unsigned)ns5 * (1u + l), wvs);
                ph_s5_c(P, wvs, l, s5c_split + lsgpr(bid), 96, S5C_NI, smraw);
            } else {
                ph_s5_b(P, wvs, l, lsgpr(bid) - 96, ns5, sm);
                sub_barrier(P.xbar + 3456 + 64, ns5, 1u + l, wvs);
                for (int rep = 0; rep < REP_S5C; ++rep) ph_s5_c(P, wvs, l, lsgpr(bid) - 96, ns5, s5c_split, smraw);
            }
        }
        xcd_barrier(xb, P.xbar, wvs);
        for (int rep = 0; rep < REP_RWF; ++rep) ph_rwkv_fin2(P, wvs, l, lsgpr(bid), nblk, rep + 1 < REP_RWF);
        ph_gemm_mfma<3>(P, wvs, l, lsgpr(bid), nblk, smraw);
        for (int rep = 0; rep < REP_MLA; ++rep) ph_ml_a(P, wvs, l, lsgpr(bid), nblk, sm);
        xcd_barrier(xb, P.xbar, wvs);
        for (int rep = 0; rep < REP_ML1; ++rep) ph_ml_1(P, wvs, l, lsgpr(bid), nblk, smraw);
        xcd_barrier(xb, P.xbar, wvs);
        ph_ml_2(P, wvs, lsgpr(bid), nblk);
        xcd_barrier(xb, P.xbar, wvs);
        for (int rep = 0; rep < REP_ML3; ++rep) ph_ml_3(P, wvs, l, lsgpr(bid), nblk, smraw);
        xcd_barrier(xb, P.xbar, wvs);
        for (int rep = 0; rep < REP_MLF; ++rep) ph_ml_fin2(P, wvs, l, lsgpr(bid), nblk, rep + 1 < REP_MLF);
        xcd_barrier(xb, P.xbar, wvs);
        for (int rep = 0; rep < (l == 0 ? REP_G2 : 1); ++rep) ph_gemm_8p<2>(P, wvs, l, lsgpr(bid), nblk, smraw);
        if (l == 0) ph_gemm_mfma<2>(P, wvs, l, lsgpr(bid), nblk, smraw, false, NCTX / 256);
        xcd_barrier(xb, P.xbar, wvs);
}

__global__ void __launch_bounds__(NT) mega_fwd(Params Pk) {
    __shared__ __attribute__((aligned(16))) unsigned char smraw[MEGA_LDS_BYTES + 16];
    float* sm = (float*)smraw;
    cg::grid_group grid = cg::this_grid();
    const int bid = blockIdx.x, nblk = gridDim.x;
    const int wvs = __builtin_amdgcn_readfirstlane((int)(threadIdx.x >> 6));
    if (threadIdx.x == 0) {
        GAS unsigned long long* dstw = (GAS unsigned long long*)Pk.gp; const unsigned long long* srcw = (const unsigned long long*)&Pk;
#pragma unroll
        for (int i = 0; i < (int)(sizeof(Params) / 8); ++i) dstw[i] = srcw[i];
        *(uintx4*)(smraw + MEGA_LDS_BYTES) = (uintx4){0u, 0u, 0u, 0u};
    }
    if (bid == 0) for (int i = threadIdx.x; i < XCD_BAR_WORDS + 256; i += NT) Pk.xbar[i] = 0u;
    asm volatile("s_waitcnt vmcnt(0)" ::: "memory");
    __syncthreads();
    const GAS Params* pg = Pk.gp;
    asm volatile("" : "+s"(pg) :: "memory");
    PRef P = *pg;
    ph_mods2(P, wvs, lsgpr(bid), nblk, sm);
    ph_tables(P, wvs, lsgpr(bid), nblk);
    grid.sync();
    const XcdBarrier xb = xcd_barrier_post(Pk.xbar, (volatile LAS unsigned*)(smraw + MEGA_LDS_BYTES));
    layer_body<0>(P, wvs, bid, nblk, smraw, sm, xb);
    layer_body<1>(P, wvs, bid, nblk, smraw, sm, xb);
    ph_final2(P, wvs, lsgpr(bid), nblk);
}

extern "C" void kernel_launch(void* const* d_in, const int* in_sizes, int n_in, void* d_out, int out_size, void* d_ws, size_t ws_size, hipStream_t stream) {
    if (ws_size < WS_END) { fprintf(stderr, "workspace too small: %zu < %zu\n", ws_size, (size_t)WS_END); return; }
    static int grid_blocks = 0;
    if (!grid_blocks) {
        int dev = 0, cus = 0, per_cu = 0;
        hipGetDevice(&dev);
        hipDeviceGetAttribute(&cus, hipDeviceAttributeMultiprocessorCount, dev);
        hipOccupancyMaxActiveBlocksPerMultiprocessor(&per_cu, mega_fwd, NT, 0);
        if (per_cu < 1) per_cu = 1;
        grid_blocks = cus * per_cu;
        fprintf(stderr, "mega_fwd: %d CUs x %d blocks/CU\n", cus, per_cu);
    }
    Params P{};
    fill_params(P, d_in, d_out, d_ws);
    void* args[] = {&P};
    hipError_t e = hipLaunchCooperativeKernel((void*)mega_fwd, dim3(grid_blocks), dim3(NT), args, 0, stream);
    if (e != hipSuccess) fprintf(stderr, "cooperative launch failed: %s (grid %d)\n", hipGetErrorString(e), grid_blocks);
}
```
